# Optimizing an MI355X kernel written in HIP

```python
import math
import jax
import jax.numpy as jnp
from jax import lax
import numpy as np

D_MODEL = 1024
BATCH = 32
SEQ = 2048
DEPTH = 1

CHUNK = 64
MIX_WIDTH = D_MODEL
ATT_WIDTH = MIX_WIDTH // 2
N_ATT_HEADS = 8
ATT_HEAD_DIM = ATT_WIDTH // N_ATT_HEADS
KV_LATENT = 128
N_IDX_HEADS = 8
IDX_HEAD_DIM = 64
TOPK_MAX = 256
Q_BLOCK = 128
POOL_WIDTH = MIX_WIDTH - ATT_WIDTH
POOL_WINDOWS = (2, 4, 8, 16)
N_POOL_GROUPS = len(POOL_WINDOWS)
POOL_GROUP = POOL_WIDTH // N_POOL_GROUPS
D_FF = 2816
CONV_WIDTH = 3
EPS = 1e-6

COL_Q = N_ATT_HEADS * ATT_HEAD_DIM
COL_C = KV_LATENT
COL_QI = N_IDX_HEADS * IDX_HEAD_DIM
COL_KI = IDX_HEAD_DIM
COL_WI = N_IDX_HEADS
COL_U = POOL_WIDTH
SPLITS = tuple(np.cumsum([COL_Q, COL_C, COL_QI, COL_KI, COL_WI]).tolist())
IN_COLS = COL_Q + COL_C + COL_QI + COL_KI + COL_WI + COL_U

kernel_name = "hybrid_dsa_pool_convffn"


def rmsnorm(x, g):
    xf = x.astype(jnp.float32)
    y = xf * lax.rsqrt(jnp.mean(xf * xf, axis=-1, keepdims=True) + EPS)
    return (y * g.astype(jnp.float32)).astype(x.dtype)


def alibi_slopes(n_heads):
    h = jnp.arange(1, n_heads + 1, dtype=jnp.float32)
    return jnp.exp2(-8.0 * h / n_heads)


def dsa_attention(q, c, q_idx, k_idx, w_idx, w_uk, w_uv):
    B, S, H, dh = q.shape
    n_top = min(TOPK_MAX, S // 4)
    nb = S // Q_BLOCK
    scale = ATT_HEAD_DIM ** -0.5
    w_idx = w_idx * (N_IDX_HEADS ** -0.5) * (IDX_HEAD_DIM ** -0.5)
    q_lat = jnp.einsum("bshd,hdc->bshc", q, w_uk)
    slopes = alibi_slopes(H)
    key_chunk = jnp.arange(S, dtype=jnp.int32) // CHUNK
    qpos_blocks = jnp.arange(S, dtype=jnp.int32).reshape(nb, Q_BLOCK)

    def to_blocks(a):
        return a.reshape((B, nb, Q_BLOCK) + a.shape[2:]).swapaxes(0, 1)

    def block(args):
        ql, qi, wi, qpos = args
        rel = jax.nn.relu(jnp.einsum("bqid,bsd->bqis", qi, k_idx).astype(jnp.float32))
        score = jnp.einsum("bqi,bqis->bqs", wi.astype(jnp.float32), rel)
        admissible = key_chunk[None, :] <= (qpos // CHUNK)[:, None]
        score = jnp.where(admissible[None], score, -jnp.inf)
        vals, idx = lax.top_k(score, n_top)
        valid = jnp.isfinite(vals)
        c_sel = jax.vmap(lambda cb, ib: cb[ib])(c, idx)
        logits = jnp.einsum("bqhc,bqkc->bqhk", ql, c_sel).astype(jnp.float32) * scale
        dist = jnp.abs(qpos[None, :, None] - idx).astype(jnp.float32)
        logits = logits - slopes[None, None, :, None] * dist[:, :, None, :]
        logits = jnp.where(valid[:, :, None, :], logits, -jnp.inf)
        p = jax.nn.softmax(logits, axis=-1).astype(c.dtype)
        return jnp.einsum("bqhk,bqkc->bqhc", p, c_sel)

    o_lat = lax.map(block, (to_blocks(q_lat), to_blocks(q_idx), to_blocks(w_idx), qpos_blocks))
    o_lat = o_lat.swapaxes(0, 1).reshape(B, S, H, KV_LATENT)
    o = jnp.einsum("bshc,hcd->bshd", o_lat, w_uv)
    return o.reshape(B, S, H * dh)


def multiscale_pool(u, w_pool, pool_scale):
    B, S, W = u.shape
    uf = u.astype(jnp.float32)
    cs = jnp.concatenate([jnp.zeros((B, 1, W), jnp.float32), jnp.cumsum(uf, axis=1)], axis=1)
    t = jnp.arange(S, dtype=jnp.int32)
    outs = []
    for g, win in enumerate(POOL_WINDOWS):
        sl = slice(g * POOL_GROUP, (g + 1) * POOL_GROUP)
        start = jnp.maximum(t + 1 - win, 0)
        win_sum = cs[:, t + 1, sl] - cs[:, start, sl]
        count = (t + 1 - start).astype(jnp.float32)
        outs.append(win_sum / count[None, :, None] - uf[:, :, sl])
    pooled = jnp.stack(outs, axis=2)
    mixed = jnp.einsum("bsgc,gcd->bsgd", pooled, w_pool.astype(jnp.float32)).reshape(B, S, W)
    return (mixed * pool_scale.astype(jnp.float32)).astype(u.dtype)


def conv_glu_ffn(h, w_up, conv_w, conv_b, w_down):
    S = h.shape[1]
    a = h @ w_up
    ap = jnp.pad(a, ((0, 0), (CONV_WIDTH - 1, 0), (0, 0)))
    conv = conv_b + sum(ap[:, j:j + S] * conv_w[j] for j in range(CONV_WIDTH))
    gate, up = jnp.split(conv, 2, axis=-1)
    return (jax.nn.silu(gate) * up) @ w_down


def setup_inputs(seed: int = 0) -> dict:
    key = jax.random.key(seed)
    ks = jax.random.split(key, 16)
    L = DEPTH
    f32 = jnp.float32
    nrm = lambda k, shape, s: jax.random.normal(k, shape, f32) * s
    return {
        "x": jax.random.normal(ks[0], (BATCH, SEQ, D_MODEL), f32),
        "g_mix": 1.0 + nrm(ks[1], (L, D_MODEL), 0.01),
        "w_in": nrm(ks[2], (L, D_MODEL, IN_COLS), D_MODEL ** -0.5),
        "g_kv": 1.0 + nrm(ks[3], (L, KV_LATENT), 0.01),
        "w_uk": nrm(ks[4], (L, N_ATT_HEADS, ATT_HEAD_DIM, KV_LATENT), ATT_HEAD_DIM ** -0.5),
        "w_uv": nrm(ks[5], (L, N_ATT_HEADS, KV_LATENT, ATT_HEAD_DIM), KV_LATENT ** -0.5),
        "w_pool": nrm(ks[6], (L, N_POOL_GROUPS, POOL_GROUP, POOL_GROUP), POOL_GROUP ** -0.5),
        "pool_scale": 1.0 + nrm(ks[7], (L, POOL_WIDTH), 0.1),
        "w_o": nrm(ks[8], (L, MIX_WIDTH, D_MODEL), MIX_WIDTH ** -0.5),
        "g_ffn": 1.0 + nrm(ks[9], (L, D_MODEL), 0.01),
        "w_up": nrm(ks[10], (L, D_MODEL, 2 * D_FF), D_MODEL ** -0.5),
        "conv_w": nrm(ks[11], (L, CONV_WIDTH, 2 * D_FF), CONV_WIDTH ** -0.5),
        "conv_b": nrm(ks[12], (L, 2 * D_FF), 0.01),
        "w_down": nrm(ks[13], (L, D_FF, D_MODEL), D_FF ** -0.5),
        "g_final": 1.0 + nrm(ks[14], (D_MODEL,), 0.01),
    }


def reference(x, g_mix, w_in, g_kv, w_uk, w_uv, w_pool, pool_scale, w_o,
              g_ffn, w_up, conv_w, conv_b, w_down, g_final):
    B, S, _ = x.shape
    for l in range(DEPTH):
        h = rmsnorm(x, g_mix[l])
        proj = h @ w_in[l]
        q, c_raw, q_idx, k_idx, w_idx, u_pool = jnp.split(proj, SPLITS, axis=-1)
        q = q.reshape(B, S, N_ATT_HEADS, ATT_HEAD_DIM)
        c = rmsnorm(c_raw, g_kv[l])
        q_idx = q_idx.reshape(B, S, N_IDX_HEADS, IDX_HEAD_DIM)
        a_out = dsa_attention(q, c, q_idx, k_idx, w_idx, w_uk[l], w_uv[l])
        b_out = multiscale_pool(u_pool, w_pool[l], pool_scale[l])
        x = x + jnp.concatenate([a_out, b_out], axis=-1) @ w_o[l]
        x = x + conv_glu_ffn(rmsnorm(x, g_ffn[l]), w_up[l], conv_w[l], conv_b[l], w_down[l])
    return rmsnorm(x, g_final)
```

```cpp
#include <hip/hip_runtime.h>
#include <hip/hip_cooperative_groups.h>
#include <cstdio>
#include <cstdint>
namespace cg = cooperative_groups;

#ifndef MK_ONE_LAUNCH
#define MK_ONE_LAUNCH 0
#endif

namespace pg8 {
#define PG8_LAS __attribute__((address_space(3)))
typedef unsigned short bf16_t;
typedef short bf16x8 __attribute__((ext_vector_type(8)));
typedef float f32x4 __attribute__((ext_vector_type(4)));
typedef unsigned u32x4 __attribute__((ext_vector_type(4)));
constexpr int BM = 256, BK = 64, HALF = 128, HTB = HALF * BK * 2, STAGE_BYTES = 8 * HTB, NXCD = 8, WGM = 8;

__host__ __device__ __forceinline__ int lds_byte(int r, int c) { const int st = (r >> 4) * 2 + (c >> 5), rr = r & 15, cc = c & 31, ob = rr * 64 + cc * 2; return st * 1024 + (ob ^ (((ob >> 9) & 1) << 5)); }
__host__ __device__ __forceinline__ void stage_rc(int b, int& R, int& C) { const int st = b / 1024, sb = b % 1024, swz = sb ^ (((sb >> 9) & 1) << 5); R = (st >> 1) * 16 + swz / 64; C = (st & 1) * 32 + (swz % 64) / 2; }
__host__ __device__ __forceinline__ int perm32(int rho) { const int n = rho >> 4, i = rho & 15; return 8 * (i >> 2) + 4 * n + (i & 3); }

struct Unit { int pm, pn; };
struct Gemm { const bf16_t* A; const bf16_t* Bt; int M, N, K; };

struct StaticOrder {
    int nM, nN, nwg, G, c;
    __host__ __device__ void init(int M, int N, int G_, int c_) { nM = M / BM; nN = N / BM; nwg = nM * nN; G = G_; c = c_; }
    __host__ __device__ bool next(int i, Unit& u) const {
        const long L = (long)i * G + c; if (L >= nwg) return false;
        int wgid = (int)L; { const int q = nwg / NXCD, r = nwg % NXCD, xcd = wgid % NXCD, off = wgid / NXCD; wgid = (xcd < r ? xcd * (q + 1) : r * (q + 1) + (xcd - r) * q) + off; }
        const int nig = WGM * nN, gid = wgid / nig, fm = gid * WGM, gsz = (nM - fm) < WGM ? (nM - fm) : WGM;
        u.pm = fm + ((wgid % nig) % gsz); u.pn = (wgid % nig) / gsz; return true;
    }
    __device__ __forceinline__ void a_ready(const Unit&) const {}
    __device__ __forceinline__ void done(const Unit&) const {}
};

__device__ __forceinline__ unsigned cvt_pk_bf16(float lo, float hi) { unsigned r; asm volatile("v_cvt_pk_bf16_f32 %0, %1, %2" : "=v"(r) : "v"(lo), "v"(hi)); return r; }


struct EpiStore {
    static constexpr bool PERM = true, AFTER_DRAIN = false;
    bf16_t* O; int ldc; const float* sumsq;
    __device__ __forceinline__ void operator()(const f32x4 (&acc)[2][2][4][2], const Unit& u, int wr, int wc, int fr, int fq) const {
        const int row0 = u.pm * BM + wr * 64 + fr, col0 = u.pn * BM + wc * 32 + 8 * fq;
#pragma unroll
        for (int ai = 0; ai < 2; ++ai)
#pragma unroll
            for (int m = 0; m < 4; ++m) {
                const int row = row0 + ai * HALF + m * 16;
                float sc = 1.f; if (sumsq) sc = 1.0f / sqrtf(sumsq[row] * (1.0f / 1024.0f) + 1e-6f);
                bf16_t* rowp = O + (size_t)row * ldc + col0;
#pragma unroll
                for (int bj = 0; bj < 2; ++bj) { f32x4 v0 = acc[ai][bj][m][0] * sc, v1 = acc[ai][bj][m][1] * sc;
                    u32x4 w; w.x = cvt_pk_bf16(v0[0], v0[1]); w.y = cvt_pk_bf16(v0[2], v0[3]); w.z = cvt_pk_bf16(v1[0], v1[1]); w.w = cvt_pk_bf16(v1[2], v1[3]);
                    *(u32x4*)(rowp + bj * HALF) = w; } }
    }
};
template <bool BASE_F32> struct EpiResid {
    static constexpr bool PERM = true, AFTER_DRAIN = false;
    const void* base; bf16_t* O; float* sumsq;
    __device__ __forceinline__ void operator()(const f32x4 (&acc)[2][2][4][2], const Unit& u, int wr, int wc, int fr, int fq) const {
        const int row0 = u.pm * BM + wr * 64 + fr, col0 = u.pn * BM + wc * 32 + 8 * fq;
#pragma unroll
        for (int ai = 0; ai < 2; ++ai)
#pragma unroll
            for (int m = 0; m < 4; ++m) {
                const int row = row0 + ai * HALF + m * 16; float ss = 0.f;
#pragma unroll
                for (int bj = 0; bj < 2; ++bj) {
                    const size_t off = (size_t)row * 1024 + col0 + bj * HALF;
                    f32x4 b0, b1;
                    if (BASE_F32) { b0 = *(const f32x4*)((const float*)base + off); b1 = *(const f32x4*)((const float*)base + off + 4); }
                    else { const u32x4 r = *(const u32x4*)((const bf16_t*)base + off);
                        b0[0] = __uint_as_float(r.x << 16); b0[1] = __uint_as_float(r.x & 0xffff0000u); b0[2] = __uint_as_float(r.y << 16); b0[3] = __uint_as_float(r.y & 0xffff0000u);
                        b1[0] = __uint_as_float(r.z << 16); b1[1] = __uint_as_float(r.z & 0xffff0000u); b1[2] = __uint_as_float(r.w << 16); b1[3] = __uint_as_float(r.w & 0xffff0000u); }
                    const f32x4 v0 = acc[ai][bj][m][0] + b0, v1 = acc[ai][bj][m][1] + b1;
                    ss += (v0[0] * v0[0] + v0[1] * v0[1]) + (v0[2] * v0[2] + v0[3] * v0[3]) + (v1[0] * v1[0] + v1[1] * v1[1]) + (v1[2] * v1[2] + v1[3] * v1[3]);
                    u32x4 w; w.x = cvt_pk_bf16(v0[0], v0[1]); w.y = cvt_pk_bf16(v0[2], v0[3]); w.z = cvt_pk_bf16(v1[0], v1[1]); w.w = cvt_pk_bf16(v1[2], v1[3]);
                    *(u32x4*)(O + off) = w; }
                ss += __shfl_xor(ss, 16); ss += __shfl_xor(ss, 32);
                if (fq == 0) atomicAdd(sumsq + row, ss);
            }
    }
};

template <class Epi, class Sched, bool ALIGN_EPI = false, bool SP2 = false>
__device__ __forceinline__ void gemm_phase(PG8_LAS unsigned char* lds, const Gemm g, const Sched& S, const Epi& E) {
    const int tid = threadIdx.x, wid = __builtin_amdgcn_readfirstlane(tid >> 6), lane = tid & 63, wr = wid >> 2, wc = wid & 3, fr = lane & 15, fq = lane >> 4;
    const int K = g.K, nt = K / BK;
    unsigned voffA[2], voffB[2];
#pragma unroll
    for (int i = 0; i < 2; ++i) { int R, C; stage_rc(tid * 16 + i * 8192, R, C); const int Rb = Epi::PERM ? ((R & ~31) + perm32(R & 31)) : R;
        voffA[i] = (unsigned)(R * K + C) * 2u; voffB[i] = (unsigned)(Rb * K + C) * 2u; }
    const size_t kstep = (size_t)(BK * 2);
    const size_t hstep = (size_t)HALF * K * 2;
    const size_t tstep = 2 * hstep;
    const unsigned ldsw = (unsigned)wid * 1024u;
    const int aoff = lds_byte(wr * 64 + fr, fq * 8), boff = lds_byte(wc * 32 + fr, fq * 8);
#define PG8_SA(b, h) (((b) * 2 + (h)) * HTB)
#define PG8_SB(b, h) ((4 + (b) * 2 + (h)) * HTB)
#define PG8_STAGE(bufoff, gbase, voff) do { _Pragma("unroll") for (int _i = 0; _i < 2; ++_i) \
        __builtin_amdgcn_global_load_lds((const unsigned*)((const char*)(gbase) + (voff)[_i]), (PG8_LAS unsigned*)(lds + (bufoff) + ldsw + _i * 8192), 16, 0, 0); } while (0)
#define PG8_LDA(dst, b, h) do { _Pragma("unroll") for (int m = 0; m < 4; ++m) _Pragma("unroll") for (int k = 0; k < 2; ++k) dst[m][k] = *(const PG8_LAS bf16x8*)(lds + PG8_SA(b, h) + aoff + m * 2048 + k * 1024); } while (0)
#define PG8_LDB(dst, b, h) do { _Pragma("unroll") for (int n = 0; n < 2; ++n) _Pragma("unroll") for (int k = 0; k < 2; ++k) dst[n][k] = *(const PG8_LAS bf16x8*)(lds + PG8_SB(b, h) + boff + n * 2048 + k * 1024); } while (0)
#define PG8_MMA(ai, bj, At, Bt) do { __builtin_amdgcn_s_setprio(1); _Pragma("unroll") for (int m = 0; m < 4; ++m) _Pragma("unroll") for (int n = 0; n < 2; ++n) _Pragma("unroll") for (int k = 0; k < 2; ++k) \
        acc[ai][bj][m][n] = __builtin_amdgcn_mfma_f32_16x16x32_bf16(Bt[n][k], At[m][k], acc[ai][bj][m][n], 0, 0, 0); __builtin_amdgcn_s_setprio(0); } while (0)
#define PG8_WAIT_V(n) asm volatile("s_waitcnt vmcnt(" #n ")" ::: "memory")
#define PG8_WAIT_L(n) asm volatile("s_waitcnt lgkmcnt(" #n ")" ::: "memory")
#define PG8_BAR __builtin_amdgcn_s_barrier()
#define PG8_SCHED __builtin_amdgcn_sched_barrier(0)
    Unit cur, nxt; int ui = 0;
    if (!S.next(0, cur)) return;
    f32x4 acc[2][2][4][2];
#pragma unroll
    for (int a = 0; a < 2; ++a)
#pragma unroll
        for (int b = 0; b < 2; ++b)
#pragma unroll
            for (int m = 0; m < 4; ++m)
#pragma unroll
                for (int n = 0; n < 2; ++n) acc[a][b][m][n] = (f32x4){0.f, 0.f, 0.f, 0.f};
    bf16x8 At[4][2], B0[2][2], B1[2][2];
    const char* cA = (const char*)g.A + (size_t)cur.pm * tstep; const char* cB = (const char*)g.Bt + (size_t)cur.pn * tstep;
    S.a_ready(cur);
    if constexpr (SP2) {
        PG8_STAGE(PG8_SB(0, 0), cB, voffB); PG8_STAGE(PG8_SB(0, 1), cB + hstep, voffB); PG8_STAGE(PG8_SA(0, 0), cA, voffA); PG8_STAGE(PG8_SA(0, 1), cA + hstep, voffA);
        if (wr == 1) PG8_BAR;
        PG8_WAIT_V(2); PG8_BAR;
        PG8_STAGE(PG8_SB(1, 0), cB + kstep, voffB); PG8_STAGE(PG8_SA(1, 0), cA + kstep, voffA); PG8_STAGE(PG8_SB(1, 1), cB + hstep + kstep, voffB);
        PG8_WAIT_V(6); PG8_BAR;
    } else {
        PG8_STAGE(PG8_SB(0, 0), cB, voffB); PG8_STAGE(PG8_SA(0, 0), cA, voffA); PG8_STAGE(PG8_SB(0, 1), cB + hstep, voffB); PG8_STAGE(PG8_SA(0, 1), cA + hstep, voffA);
        if (wr == 1) PG8_BAR;
        PG8_WAIT_V(4); PG8_BAR;
        PG8_STAGE(PG8_SB(1, 0), cB + kstep, voffB); PG8_STAGE(PG8_SA(1, 0), cA + kstep, voffA); PG8_STAGE(PG8_SB(1, 1), cB + hstep + kstep, voffB);
        PG8_WAIT_V(6); PG8_BAR;
    }
    for (;;) {
        const bool has_next = S.next(ui + 1, nxt);
        const char* nA = has_next ? (const char*)g.A + (size_t)nxt.pm * tstep : cA; const char* nB = has_next ? (const char*)g.Bt + (size_t)nxt.pn * tstep : cB;
        for (int t = 0; t < nt; t += 2) {
            const bool last = (t == nt - 2);
            const char* a1 = cA + (size_t)(t + 1) * kstep;
            const char* a2 = last ? nA : cA + (size_t)(t + 2) * kstep; const char* b2 = last ? nB : cB + (size_t)(t + 2) * kstep;
            const char* a3 = a2 + kstep; const char* b3 = b2 + kstep;
            if (last && has_next) S.a_ready(nxt);
            if constexpr (SP2) {
            PG8_LDB(B0, 0, 0); PG8_LDB(B1, 0, 1); PG8_SCHED; PG8_LDA(At, 0, 0); PG8_STAGE(PG8_SA(1, 1), a1 + hstep, voffA);
            PG8_WAIT_V(8); PG8_WAIT_L(0); PG8_BAR; PG8_MMA(0, 0, At, B0); PG8_MMA(0, 1, At, B1); PG8_BAR; PG8_SCHED;
            PG8_LDA(At, 0, 1); PG8_STAGE(PG8_SB(0, 0), b2, voffB); PG8_STAGE(PG8_SB(0, 1), b2 + hstep, voffB); PG8_STAGE(PG8_SA(0, 0), a2, voffA);
            PG8_WAIT_V(8); PG8_WAIT_L(0); PG8_BAR; PG8_MMA(1, 0, At, B0); PG8_MMA(1, 1, At, B1); PG8_BAR; PG8_SCHED;
            PG8_LDB(B0, 1, 0); PG8_LDB(B1, 1, 1); PG8_SCHED; PG8_LDA(At, 1, 0); PG8_STAGE(PG8_SA(0, 1), a2 + hstep, voffA);
            PG8_WAIT_V(8); PG8_WAIT_L(0); PG8_BAR; PG8_MMA(0, 0, At, B0); PG8_MMA(0, 1, At, B1); PG8_BAR; PG8_SCHED;
            PG8_LDA(At, 1, 1); PG8_STAGE(PG8_SB(1, 0), b3, voffB); PG8_STAGE(PG8_SB(1, 1), b3 + hstep, voffB); PG8_STAGE(PG8_SA(1, 0), a3, voffA);
            PG8_WAIT_V(8); PG8_WAIT_L(0); PG8_BAR; PG8_MMA(1, 0, At, B0); PG8_MMA(1, 1, At, B1); PG8_BAR; PG8_SCHED;
            } else {
            PG8_LDB(B0, 0, 0); PG8_SCHED; PG8_LDA(At, 0, 0); PG8_STAGE(PG8_SA(1, 1), a1 + hstep, voffA);
            PG8_WAIT_L(8); PG8_BAR; PG8_WAIT_L(0); PG8_MMA(0, 0, At, B0); PG8_BAR; PG8_SCHED;
            PG8_LDB(B1, 0, 1); PG8_STAGE(PG8_SB(0, 0), b2, voffB);
            PG8_BAR; PG8_WAIT_L(0); PG8_MMA(0, 1, At, B1); PG8_BAR;
            PG8_LDA(At, 0, 1); PG8_STAGE(PG8_SA(0, 0), a2, voffA);
            PG8_BAR; PG8_WAIT_L(0); PG8_MMA(1, 0, At, B0); PG8_BAR; PG8_SCHED;
            PG8_STAGE(PG8_SB(0, 1), b2 + hstep, voffB);
            PG8_WAIT_V(6); PG8_BAR; PG8_MMA(1, 1, At, B1); PG8_BAR;
            PG8_LDB(B0, 1, 0); PG8_SCHED; PG8_LDA(At, 1, 0); PG8_STAGE(PG8_SA(0, 1), a2 + hstep, voffA);
            PG8_WAIT_L(8); PG8_BAR; PG8_WAIT_L(0); PG8_MMA(0, 0, At, B0); PG8_BAR; PG8_SCHED;
            PG8_LDB(B1, 1, 1); PG8_STAGE(PG8_SB(1, 0), b3, voffB);
            PG8_BAR; PG8_WAIT_L(0); PG8_MMA(0, 1, At, B1); PG8_BAR;
            PG8_LDA(At, 1, 1); PG8_STAGE(PG8_SA(1, 0), a3, voffA);
            PG8_BAR; PG8_WAIT_L(0); PG8_MMA(1, 0, At, B0); PG8_BAR; PG8_SCHED;
            PG8_STAGE(PG8_SB(1, 1), b3 + hstep, voffB);
            PG8_WAIT_V(6); PG8_BAR; PG8_MMA(1, 1, At, B1); PG8_BAR;
            }
        }
        if constexpr (ALIGN_EPI) { if (wr == 0) PG8_BAR; }
        if constexpr (!Epi::AFTER_DRAIN) { E(acc, cur, wr, wc, fr, fq); S.done(cur); }
        if (!has_next) break;
#pragma unroll
        for (int a = 0; a < 2; ++a)
#pragma unroll
            for (int b = 0; b < 2; ++b)
#pragma unroll
                for (int m = 0; m < 4; ++m)
#pragma unroll
                    for (int n = 0; n < 2; ++n) acc[a][b][m][n] = (f32x4){0.f, 0.f, 0.f, 0.f};
        cur = nxt; cA = nA; cB = nB; ++ui;
        if constexpr (ALIGN_EPI) { if (wr == 1) PG8_BAR; }
    }
    PG8_WAIT_V(0);
    if constexpr (!ALIGN_EPI) { if (wr == 0) PG8_BAR; }
    PG8_BAR;
#undef PG8_SA
#undef PG8_SB
#undef PG8_STAGE
#undef PG8_LDA
#undef PG8_LDB
#undef PG8_MMA
#undef PG8_WAIT_V
#undef PG8_WAIT_L
#undef PG8_BAR
#undef PG8_SCHED
}
}

constexpr int NWAVES = 8;
constexpr int BATCH = 32, SEQ = 2048, DM = 1024, NTOK = BATCH * SEQ;
constexpr int IN_COLS = 1736;
constexpr int N1 = 2304, K2 = 1536, FF = 2816, N3 = 2 * FF;
constexpr int OFF_QL = 0, OFF_QI = 1024, OFF_U = 1536, OFF_C = 2048, OFF_KI = 2176, OFF_WI = 2240;
constexpr float EPS = 1e-6f;
constexpr float WI_SCALE = 0.044194173824159216f;

constexpr size_t MiB = 1u << 20;
constexpr size_t WS_CTL = 0, CTL_ZERO_BYTES = 1 * MiB;
constexpr size_t WS_W1T = 1 * MiB, WS_W2T = 6 * MiB, WS_W3T = 9 * MiB, WS_W4T = 20 * MiB, WS_CONVP = 26 * MiB;
constexpr size_t WS_HB = 32 * MiB;
constexpr size_t WS_P1 = 160 * MiB;
constexpr size_t WS_RAW = 32 * MiB;
constexpr size_t WS_X2 = 32 * MiB;
constexpr size_t WS_MIX = 448 * MiB;
constexpr size_t WS_CN = 640 * MiB;
constexpr size_t WS_ACT = 448 * MiB;
constexpr size_t WS_X1B = 800 * MiB;
constexpr size_t WS_END = 928 * MiB;

constexpr int LDS_BYTES = 147456;

#define GAS __attribute__((address_space(1)))
#define LAS __attribute__((address_space(3)))
typedef unsigned short bf16;
typedef unsigned v4u __attribute__((ext_vector_type(4)));
typedef unsigned v2u __attribute__((ext_vector_type(2)));
typedef float f32x4 __attribute__((ext_vector_type(4)));

__device__ __forceinline__ unsigned f2bf(float f) { unsigned u = __builtin_bit_cast(unsigned, f); return (u + 0x7fffu + ((u >> 16) & 1u)) >> 16; }
__device__ __forceinline__ unsigned pk2(float lo, float hi) { return f2bf(lo) | (f2bf(hi) << 16); }
__device__ __forceinline__ float bflo(unsigned u) { return __uint_as_float(u << 16); }
__device__ __forceinline__ float bfhi(unsigned u) { return __uint_as_float(u & 0xffff0000u); }
__device__ __forceinline__ float wave_sum(float v) {
#pragma unroll
    for (int o = 1; o < 64; o <<= 1) v += __shfl_xor(v, o);
    return v;
}
__device__ __forceinline__ float wave_max(float v) {
#pragma unroll
    for (int o = 1; o < 64; o <<= 1) v = fmaxf(v, __shfl_xor(v, o));
    return v;
}
#define WAVE_LDS_SYNC() do { asm volatile("s_waitcnt lgkmcnt(0)" ::: "memory"); __builtin_amdgcn_wave_barrier(); } while (0)

struct Args {
    const float* x; const float* g_mix; const float* w_in; const float* g_kv; const float* w_uk; const float* w_uv; const float* w_pool; const float* pool_scale;
    const float* w_o; const float* g_ffn; const float* w_up; const float* conv_w; const float* conv_b; const float* w_down; const float* g_final;
    float* out; unsigned char* ws; int ph_lo, ph_hi;
};

__device__ __forceinline__ void ph_prologue(const Args& a, int gtid, int gthreads, int gw, int ngw, int lane) {
    unsigned char* ws = a.ws;
    bf16* W1T = (bf16*)(ws + WS_W1T); bf16* W2T = (bf16*)(ws + WS_W2T); bf16* W3T = (bf16*)(ws + WS_W3T); bf16* W4T = (bf16*)(ws + WS_W4T);
    float* CONVP = (float*)(ws + WS_CONVP);
    for (int i = gtid; i < N1 * DM; i += gthreads) {
        const int n = i >> 10, k = i & 1023; float v;
        const float* wr = a.w_in + (size_t)k * IN_COLS;
        if (n < 1024) { const int hd = n >> 7, c = n & 127; float s = 0.f;
            for (int d = 0; d < 64; ++d) s += wr[hd * 64 + d] * a.w_uk[(hd * 64 + d) * 128 + c];
            v = s; }
        else if (n < 1536) v = wr[640 + (n - 1024)];
        else if (n < 2048) v = wr[1224 + (n - 1536)];
        else if (n < 2176) v = wr[512 + (n - 2048)];
        else if (n < 2240) v = wr[1152 + (n - 2176)];
        else if (n < 2248) v = wr[1216 + (n - 2240)] * WI_SCALE;
        else v = 0.f;
        W1T[i] = (bf16)f2bf(v);
    }
    for (int i = gtid; i < DM * K2; i += gthreads) {
        const int n = i / K2, k = i - n * K2; float s = 0.f;
        if (k < 1024) { const int hd = k >> 7, c = k & 127;
            for (int d = 0; d < 64; ++d) s += a.w_uv[(hd * 128 + c) * 64 + d] * a.w_o[(size_t)(hd * 64 + d) * 1024 + n]; }
        else { const int kk = k - 1024, g = kk >> 7, ci = kk & 127;
            for (int dd = 0; dd < 128; ++dd) s += a.w_pool[(g * 128 + ci) * 128 + dd] * a.pool_scale[g * 128 + dd] * a.w_o[(size_t)(512 + g * 128 + dd) * 1024 + n]; }
        W2T[i] = (bf16)f2bf(s);
    }
    for (int i = gtid; i < N3 * DM; i += gthreads) {
        const int r = i >> 10, k = i & 1023, j = r >> 8, ii = r & 255;
        const int col = (ii < 128) ? (128 * j + ii) : (FF + 128 * j + (ii - 128));
        W3T[i] = (bf16)f2bf(a.w_up[(size_t)k * N3 + col] * a.g_ffn[k]);
    }
    for (int r = gtid; r < N3; r += gthreads) {
        const int j = r >> 8, ii = r & 255; const int col = (ii < 128) ? (128 * j + ii) : (FF + 128 * j + (ii - 128));
        CONVP[r] = a.conv_w[col]; CONVP[N3 + r] = a.conv_w[N3 + col]; CONVP[2 * N3 + r] = a.conv_w[2 * N3 + col]; CONVP[3 * N3 + r] = a.conv_b[col];
    }
    for (int i = gtid; i < DM * FF; i += gthreads) {
        const int n = i / FF, k = i - n * FF;
        W4T[i] = (bf16)f2bf(a.w_down[(size_t)k * 1024 + n]);
    }
    bf16* HB = (bf16*)(ws + WS_HB);
    for (int m = gw; m < NTOK; m += ngw) {
        const f32x4* xr = (const f32x4*)(a.x + (size_t)m * DM) + lane;
        f32x4 v[4]; float s = 0.f;
#pragma unroll
        for (int j = 0; j < 4; ++j) { v[j] = xr[64 * j]; s += (v[j].x * v[j].x + v[j].y * v[j].y) + (v[j].z * v[j].z + v[j].w * v[j].w); }
        const float rinv = 1.0f / sqrtf(wave_sum(s) * (1.0f / DM) + EPS);
        unsigned long long* o8 = (unsigned long long*)(HB + (size_t)m * DM) + lane;
#pragma unroll
        for (int j = 0; j < 4; ++j) { const f32x4 g = ((const f32x4*)a.g_mix)[lane + 64 * j];
            o8[64 * j] = (unsigned long long)pk2(v[j].x * rinv * g.x, v[j].y * rinv * g.y) | ((unsigned long long)pk2(v[j].z * rinv * g.z, v[j].w * rinv * g.w) << 32); }
    }
}

__device__ __forceinline__ void ph_cnorm_pool(const Args& a, int gw, int ngw, int lane) {
    const bf16* P1 = (const bf16*)(a.ws + WS_P1); bf16* CN = (bf16*)(a.ws + WS_CN); bf16* MIX = (bf16*)(a.ws + WS_MIX);
    for (int tok = gw; tok < NTOK; tok += ngw) {
        const bf16* prow = P1 + (size_t)tok * N1;
        const unsigned cw = *(const unsigned*)(prow + OFF_C + 2 * lane);
        const float c0 = bflo(cw), c1 = bfhi(cw);
        const float rinv = 1.0f / sqrtf(wave_sum(c0 * c0 + c1 * c1) * (1.0f / 128.0f) + EPS);
        *(unsigned*)(CN + (size_t)tok * 128 + 2 * lane) = pk2(c0 * rinv * a.g_kv[2 * lane], c1 * rinv * a.g_kv[2 * lane + 1]);
        const int pos = tok & (SEQ - 1), win = 2 << (lane >> 4), cnt = (pos + 1 < win) ? pos + 1 : win;
        float s[8];
#pragma unroll
        for (int j = 0; j < 8; ++j) s[j] = 0.f;
        v4u u0 = (v4u){0, 0, 0, 0};
        for (int j = 0; j < cnt; ++j) {
            const v4u u = *(const v4u*)(prow - (size_t)j * N1 + OFF_U + 8 * lane);
            if (j == 0) u0 = u;
            s[0] += bflo(u.x); s[1] += bfhi(u.x); s[2] += bflo(u.y); s[3] += bfhi(u.y); s[4] += bflo(u.z); s[5] += bfhi(u.z); s[6] += bflo(u.w); s[7] += bfhi(u.w);
        }
        const float ic = 1.0f / (float)cnt;
        v4u o; o.x = pk2(s[0] * ic - bflo(u0.x), s[1] * ic - bfhi(u0.x)); o.y = pk2(s[2] * ic - bflo(u0.y), s[3] * ic - bfhi(u0.y));
        o.z = pk2(s[4] * ic - bflo(u0.z), s[5] * ic - bfhi(u0.z)); o.w = pk2(s[6] * ic - bflo(u0.w), s[7] * ic - bfhi(u0.w));
        *(v4u*)(MIX + (size_t)tok * K2 + 1024 + 8 * lane) = o;
    }
}

__device__ __forceinline__ void ph_attn_naive(const Args& a, LAS unsigned char* lds, int wave, int gw, int ngw, int lane) {
    const bf16* P1 = (const bf16*)(a.ws + WS_P1); const bf16* CN = (const bf16*)(a.ws + WS_CN); bf16* MIX = (bf16*)(a.ws + WS_MIX);
    LAS unsigned char* base = lds + wave * 16384;
    LAS unsigned* uk = (LAS unsigned*)base;
    LAS float* pb = (LAS float*)base;
    LAS float* qi = (LAS float*)(base + 8192);
    LAS float* ql = (LAS float*)(base + 10240);
    LAS int* idx = (LAS int*)(base + 14336);
    LAS float* wl = (LAS float*)(base + 15360);
    const unsigned long long lt_mask = (lane == 0) ? 0ull : (~0ull >> (64 - lane));
    for (int q = gw; q < NTOK; q += ngw) {
        const int b = q >> 11, pos = q & (SEQ - 1), n = ((pos >> 6) + 1) << 6;
        const bf16* prow = P1 + (size_t)q * N1;
        { const v4u t = *(const v4u*)(prow + OFF_QI + 8 * lane);
          qi[8 * lane + 0] = bflo(t.x); qi[8 * lane + 1] = bfhi(t.x); qi[8 * lane + 2] = bflo(t.y); qi[8 * lane + 3] = bfhi(t.y);
          qi[8 * lane + 4] = bflo(t.z); qi[8 * lane + 5] = bfhi(t.z); qi[8 * lane + 6] = bflo(t.w); qi[8 * lane + 7] = bfhi(t.w); }
#pragma unroll
        for (int h2 = 0; h2 < 2; ++h2) { const v4u t = *(const v4u*)(prow + OFF_QL + 16 * lane + 8 * h2); const int o = 16 * lane + 8 * h2;
          ql[o + 0] = bflo(t.x); ql[o + 1] = bfhi(t.x); ql[o + 2] = bflo(t.y); ql[o + 3] = bfhi(t.y); ql[o + 4] = bflo(t.z); ql[o + 5] = bfhi(t.z); ql[o + 6] = bflo(t.w); ql[o + 7] = bfhi(t.w); }
        if (lane < 4) { const unsigned t = *(const unsigned*)(prow + OFF_WI + 2 * lane); wl[2 * lane] = bflo(t); wl[2 * lane + 1] = bfhi(t); }
        WAVE_LDS_SYNC();
        const int nk = n >> 6;
        for (int i = 0; i < nk; ++i) {
            const int key = i * 64 + lane;
            const v4u* kr = (const v4u*)(P1 + (size_t)(b * SEQ + key) * N1 + OFF_KI);
            v4u k8[8];
#pragma unroll
            for (int j = 0; j < 8; ++j) k8[j] = kr[j];
            float s = 0.f;
#pragma unroll 1
            for (int hd = 0; hd < 8; ++hd) { float d0 = 0.f, d1 = 0.f;
#pragma unroll
                for (int j = 0; j < 8; ++j) { const f32x4 qa = *(const LAS f32x4*)(qi + hd * 64 + 8 * j), qb = *(const LAS f32x4*)(qi + hd * 64 + 8 * j + 4); const v4u t = k8[j];
                    d0 += (qa.x * bflo(t.x) + qa.z * bflo(t.y)) + (qb.x * bflo(t.z) + qb.z * bflo(t.w));
                    d1 += (qa.y * bfhi(t.x) + qa.w * bfhi(t.y)) + (qb.y * bfhi(t.z) + qb.w * bfhi(t.w)); }
                s += wl[hd] * fmaxf(d0 + d1, 0.f); }
            s += 0.0f;
            unsigned u = __float_as_uint(s); u = (u & 0x80000000u) ? ~u : (u | 0x80000000u);
            uk[key] = u;
        }
        WAVE_LDS_SYNC();
        int nsel;
        if (n <= 256) { for (int j = lane; j < n; j += 64) idx[j] = j; nsel = n; }
        else {
            unsigned prefix = 0u;
            for (int bit = 31; bit >= 0; --bit) {
                const unsigned cand = prefix | (1u << bit); int cnt = 0;
                for (int i = 0; i < nk; ++i) cnt += __popcll(__ballot(uk[i * 64 + lane] >= cand));
                if (cnt >= 256) prefix = cand;
            }
            int cgt = 0;
            for (int i = 0; i < nk; ++i) cgt += __popcll(__ballot(uk[i * 64 + lane] > prefix));
            const int need = 256 - cgt; int basep = 0, eqrun = 0;
            for (int i = 0; i < nk; ++i) {
                const unsigned u = uk[i * 64 + lane]; const bool gt = u > prefix, eq = (u == prefix);
                const unsigned long long eqm = __ballot(eq);
                const int rank = eqrun + __popcll(eqm & lt_mask);
                const bool sel = gt || (eq && rank < need);
                const unsigned long long sm = __ballot(sel);
                if (sel) idx[basep + __popcll(sm & lt_mask)] = i * 64 + lane;
                basep += __popcll(sm); eqrun += __popcll(eqm);
            }
            nsel = 256;
        }
        WAVE_LDS_SYNC();
#pragma unroll 1
        for (int jj = 0; jj < 4; ++jj) {
            const int j = jj * 64 + lane; const bool valid = j < nsel; const int key = valid ? idx[j] : 0;
            const v4u* cr = (const v4u*)(CN + (size_t)(b * SEQ + key) * 128);
            float dot[8];
#pragma unroll
            for (int hd = 0; hd < 8; ++hd) dot[hd] = 0.f;
#pragma unroll 2
            for (int c8 = 0; c8 < 16; ++c8) { const v4u t = cr[c8];
                const float c0 = bflo(t.x), c1 = bfhi(t.x), c2 = bflo(t.y), c3 = bfhi(t.y), c4 = bflo(t.z), c5 = bfhi(t.z), c6 = bflo(t.w), c7 = bfhi(t.w);
#pragma unroll
                for (int hd = 0; hd < 8; ++hd) { const f32x4 qa = *(const LAS f32x4*)(ql + hd * 128 + c8 * 8), qb = *(const LAS f32x4*)(ql + hd * 128 + c8 * 8 + 4);
                    dot[hd] += (qa.x * c0 + qa.y * c1) + (qa.z * c2 + qa.w * c3) + (qb.x * c4 + qb.y * c5) + (qb.z * c6 + qb.w * c7); } }
            const float dist = fabsf((float)(pos - key));
#pragma unroll
            for (int hd = 0; hd < 8; ++hd) { const float slope = __uint_as_float((unsigned)(127 - (hd + 1)) << 23);
                pb[hd * 256 + j] = valid ? (dot[hd] * 0.125f - slope * dist) : -__builtin_inff(); }
        }
        WAVE_LDS_SYNC();
#pragma unroll 1
        for (int hd = 0; hd < 8; ++hd) {
            float p[4];
#pragma unroll
            for (int jj = 0; jj < 4; ++jj) p[jj] = pb[hd * 256 + jj * 64 + lane];
            float m = fmaxf(fmaxf(p[0], p[1]), fmaxf(p[2], p[3])); m = wave_max(m);
            float s = 0.f;
#pragma unroll
            for (int jj = 0; jj < 4; ++jj) { p[jj] = __expf(p[jj] - m); s += p[jj]; }
            s = wave_sum(s); const float inv = 1.0f / s;
#pragma unroll
            for (int jj = 0; jj < 4; ++jj) pb[hd * 256 + jj * 64 + lane] = p[jj] * inv;
        }
        WAVE_LDS_SYNC();
        float o0[8], o1[8];
#pragma unroll
        for (int hd = 0; hd < 8; ++hd) { o0[hd] = 0.f; o1[hd] = 0.f; }
        for (int j = 0; j < nsel; j += 4) {
            unsigned cw[4];
#pragma unroll
            for (int t = 0; t < 4; ++t) cw[t] = *(const unsigned*)(CN + (size_t)(b * SEQ + idx[j + t]) * 128 + 2 * lane);
#pragma unroll
            for (int t = 0; t < 4; ++t) { const float c0 = bflo(cw[t]), c1 = bfhi(cw[t]);
#pragma unroll
                for (int hd = 0; hd < 8; ++hd) { const float p = pb[hd * 256 + j + t]; o0[hd] += p * c0; o1[hd] += p * c1; } }
        }
#pragma unroll
        for (int hd = 0; hd < 8; ++hd) *(unsigned*)(MIX + (size_t)q * K2 + hd * 128 + 2 * lane) = pk2(o0[hd], o1[hd]);
        WAVE_LDS_SYNC();
    }
}

__device__ __forceinline__ void ph_conv(const Args& a, int hsel, int gtid, int gthreads) {
    const bf16* RAW = (const bf16*)(a.ws + WS_RAW); bf16* ACT = (bf16*)(a.ws + WS_ACT); const float* CONVP = (const float*)(a.ws + WS_CONVP);
    constexpr int CH = FF / 8;
    for (int i = gtid; i < (NTOK / 2) * CH; i += gthreads) {
        const int tl = i / CH, ch = i - tl * CH, tok = hsel * (NTOK / 2) + tl, pos = tok & (SEQ - 1);
        const int jc = ch * 8, j = jc >> 7, ii = jc & 127, rg = 256 * j + ii, ru = rg + 128;
        float cg_[8], cu_[8];
#pragma unroll
        for (int e = 0; e < 8; ++e) { cg_[e] = CONVP[3 * N3 + rg + e]; cu_[e] = CONVP[3 * N3 + ru + e]; }
#pragma unroll
        for (int tap = 0; tap < 3; ++tap) {
            const int back = 2 - tap; if (pos - back < 0) continue;
            const bf16* rrow = RAW + (size_t)(tl - back) * N3;
            const v4u g = *(const v4u*)(rrow + rg), u = *(const v4u*)(rrow + ru);
            const float gv[8] = {bflo(g.x), bfhi(g.x), bflo(g.y), bfhi(g.y), bflo(g.z), bfhi(g.z), bflo(g.w), bfhi(g.w)};
            const float uv[8] = {bflo(u.x), bfhi(u.x), bflo(u.y), bfhi(u.y), bflo(u.z), bfhi(u.z), bflo(u.w), bfhi(u.w)};
#pragma unroll
            for (int e = 0; e < 8; ++e) { cg_[e] += CONVP[tap * N3 + rg + e] * gv[e]; cu_[e] += CONVP[tap * N3 + ru + e] * uv[e]; }
        }
        float r[8];
#pragma unroll
        for (int e = 0; e < 8; ++e) r[e] = cg_[e] / (1.0f + __expf(-cg_[e])) * cu_[e];
        v4u o; o.x = pk2(r[0], r[1]); o.y = pk2(r[2], r[3]); o.z = pk2(r[4], r[5]); o.w = pk2(r[6], r[7]);
        *(v4u*)(ACT + (size_t)tok * FF + jc) = o;
    }
}

__device__ __forceinline__ void ph_final(const Args& a, int gw, int ngw, int lane) {
    const bf16* X2 = (const bf16*)(a.ws + WS_X2); const float* ss3 = (const float*)(a.ws + WS_CTL + 256 * 1024);
    for (int m = gw; m < NTOK; m += ngw) {
        const float rinv = 1.0f / sqrtf(ss3[m] * (1.0f / DM) + EPS);
#pragma unroll
        for (int h2 = 0; h2 < 2; ++h2) {
            const int c0 = h2 * 512 + 8 * lane;
            const v4u t = *(const v4u*)(X2 + (size_t)m * DM + c0);
            const f32x4 g0 = *(const f32x4*)(a.g_final + c0), g1 = *(const f32x4*)(a.g_final + c0 + 4);
            f32x4 o0, o1;
            o0.x = bflo(t.x) * rinv * g0.x; o0.y = bfhi(t.x) * rinv * g0.y; o0.z = bflo(t.y) * rinv * g0.z; o0.w = bfhi(t.y) * rinv * g0.w;
            o1.x = bflo(t.z) * rinv * g1.x; o1.y = bfhi(t.z) * rinv * g1.y; o1.z = bflo(t.w) * rinv * g1.z; o1.w = bfhi(t.w) * rinv * g1.w;
            *(f32x4*)(a.out + (size_t)m * DM + c0) = o0; *(f32x4*)(a.out + (size_t)m * DM + c0 + 4) = o1;
        }
    }
}

constexpr int NPHASE = 11;
#define IDS() const int tid = threadIdx.x, lane = tid & 63, wave = __builtin_amdgcn_readfirstlane(tid >> 6); const int G = gridDim.x; \
    const int gtid = blockIdx.x * (NWAVES * 64) + tid, gthreads = G * NWAVES * 64, gw = blockIdx.x * NWAVES + wave, ngw = G * NWAVES; (void)lane; (void)wave; (void)gtid; (void)gthreads; (void)gw; (void)ngw;
__global__ void __launch_bounds__(NWAVES * 64, 2) fwd_kernel(Args a) {
    extern __shared__ __attribute__((aligned(16))) unsigned char lds_raw[];
    LAS unsigned char* lds = (LAS unsigned char*)lds_raw;
    const int lo = a.ph_lo, hi = a.ph_hi;
#define IN(k) (lo <= (k) && (k) < hi)
#define SEAM(k) do { if (IN(k) && IN((k) + 1)) cg::this_grid().sync(); } while (0)
    if (IN(0)) { IDS(); ph_prologue(a, gtid, gthreads, gw, ngw, lane); }
    SEAM(0);
    if (IN(1)) {
        unsigned char* ws = a.ws;
        pg8::Gemm g{(const bf16*)(ws + WS_HB), (const bf16*)(ws + WS_W1T), NTOK, N1, DM}; pg8::StaticOrder S; S.init(NTOK, N1, (int)gridDim.x, (int)blockIdx.x);
        pg8::EpiStore E{(bf16*)(ws + WS_P1), N1, nullptr};
        pg8::gemm_phase<pg8::EpiStore, pg8::StaticOrder, true, true>(lds, g, S, E);
    }
    SEAM(1);
    if (IN(2)) { IDS(); ph_cnorm_pool(a, gw, ngw, lane); }
    SEAM(2);
    if (IN(3)) { IDS(); ph_attn_naive(a, lds, wave, gw, ngw, lane); }
    SEAM(3);
    if (IN(4)) {
        unsigned char* ws = a.ws;
        pg8::Gemm g{(const bf16*)(ws + WS_MIX), (const bf16*)(ws + WS_W2T), NTOK, DM, K2}; pg8::StaticOrder S; S.init(NTOK, DM, (int)gridDim.x, (int)blockIdx.x);
        pg8::EpiResid<true> E{(const void*)a.x, (bf16*)(ws + WS_X1B), (float*)(ws + WS_CTL)};
        pg8::gemm_phase<pg8::EpiResid<true>, pg8::StaticOrder, true, true>(lds, g, S, E);
    }
    SEAM(4);
#pragma unroll 1
    for (int hsel = 0; hsel < 2; ++hsel) {
        const int p5 = 5 + 2 * hsel;
        if (IN(p5)) {
            unsigned char* ws = a.ws;
            pg8::Gemm g{(const bf16*)(ws + WS_X1B) + (size_t)hsel * (NTOK / 2) * DM, (const bf16*)(ws + WS_W3T), NTOK / 2, N3, DM}; pg8::StaticOrder S; S.init(NTOK / 2, N3, (int)gridDim.x, (int)blockIdx.x);
            pg8::EpiStore E{(bf16*)(ws + WS_RAW), N3, (const float*)(ws + WS_CTL) + hsel * (NTOK / 2)};
            pg8::gemm_phase<pg8::EpiStore, pg8::StaticOrder, true, true>(lds, g, S, E);
        }
        SEAM(p5);
        if (IN(p5 + 1)) { IDS(); ph_conv(a, hsel, gtid, gthreads); }
        SEAM(p5 + 1);
    }
    if (IN(9)) {
        unsigned char* ws = a.ws;
        pg8::Gemm g{(const bf16*)(ws + WS_ACT), (const bf16*)(ws + WS_W4T), NTOK, DM, FF}; pg8::StaticOrder S; S.init(NTOK, DM, (int)gridDim.x, (int)blockIdx.x);
        pg8::EpiResid<false> E{(const void*)(ws + WS_X1B), (bf16*)(ws + WS_X2), (float*)(ws + WS_CTL + 256 * 1024)};
        pg8::gemm_phase<pg8::EpiResid<false>, pg8::StaticOrder, true, true>(lds, g, S, E);
    }
    SEAM(9);
    if (IN(10)) { IDS(); ph_final(a, gw, ngw, lane); }
#undef IN
#undef SEAM
}

extern "C" void kernel_launch(void* const* d_in, const int* in_sizes, int n_in, void* d_out, int out_size, void* d_ws, size_t ws_size, hipStream_t stream) {
    static int grid = 0;
    if (grid == 0) {
        if (n_in != 15 || in_sizes[0] != NTOK * DM || out_size != NTOK * DM || ws_size < WS_END) { fprintf(stderr, "kernel_launch: unexpected shapes / workspace (n_in %d, ws %zu)\n", n_in, ws_size); grid = -1; return; }
        int dev = 0, cus = 0, per_cu = 0;
        hipGetDevice(&dev); hipDeviceGetAttribute(&cus, hipDeviceAttributeMultiprocessorCount, dev);
        if (hipFuncSetAttribute((const void*)fwd_kernel, hipFuncAttributeMaxDynamicSharedMemorySize, LDS_BYTES) != hipSuccess) { fprintf(stderr, "kernel_launch: hipFuncSetAttribute failed\n"); grid = -1; return; }
        if (hipOccupancyMaxActiveBlocksPerMultiprocessor(&per_cu, (const void*)fwd_kernel, NWAVES * 64, LDS_BYTES) != hipSuccess || per_cu < 1) { fprintf(stderr, "kernel_launch: occupancy query says %d\n", per_cu); per_cu = 1; }
        (void)hipGetLastError();
        grid = cus;
        if (grid != 256) fprintf(stderr, "kernel_launch: %d CUs (tuned for 256)\n", grid);
    }
    if (grid < 0) return;
    hipMemsetAsync((char*)d_ws + WS_CTL, 0, CTL_ZERO_BYTES, stream);
    Args a{};
    a.x = (const float*)d_in[0]; a.g_mix = (const float*)d_in[1]; a.w_in = (const float*)d_in[2]; a.g_kv = (const float*)d_in[3]; a.w_uk = (const float*)d_in[4]; a.w_uv = (const float*)d_in[5];
    a.w_pool = (const float*)d_in[6]; a.pool_scale = (const float*)d_in[7]; a.w_o = (const float*)d_in[8]; a.g_ffn = (const float*)d_in[9]; a.w_up = (const float*)d_in[10];
    a.conv_w = (const float*)d_in[11]; a.conv_b = (const float*)d_in[12]; a.w_down = (const float*)d_in[13]; a.g_final = (const float*)d_in[14];
    a.out = (float*)d_out; a.ws = (unsigned char*)d_ws;
#if MK_ONE_LAUNCH
    a.ph_lo = 0; a.ph_hi = NPHASE;
    void* args[] = {&a};
    hipError_t e = hipLaunchCooperativeKernel((const void*)fwd_kernel, dim3(grid), dim3(NWAVES * 64), args, LDS_BYTES, stream);
    if (e != hipSuccess) fprintf(stderr, "cooperative launch failed: %s (grid %d)\n", hipGetErrorString(e), grid);
#else
    for (int ph = 0; ph < NPHASE; ++ph) {
        a.ph_lo = ph; a.ph_hi = ph + 1;
        hipLaunchKernelGGL(fwd_kernel, dim3(grid), dim3(NWAVES * 64), LDS_BYTES, stream, a);
    }
#endif
}
```

```cpp
#include <hip/hip_runtime.h>
#include <hip/hip_cooperative_groups.h>
#include <cstdio>
#include <cstdint>
namespace cg = cooperative_groups;

#ifndef MK_ONE_LAUNCH
#define MK_ONE_LAUNCH 1
#endif

namespace pg8 {
#define PG8_LAS __attribute__((address_space(3)))
typedef unsigned short bf16_t;
typedef short bf16x8 __attribute__((ext_vector_type(8)));
typedef float f32x4 __attribute__((ext_vector_type(4)));
typedef unsigned u32x4 __attribute__((ext_vector_type(4)));
constexpr int BM = 256, BK = 64, HALF = 128, HTB = HALF * BK * 2, STAGE_BYTES = 8 * HTB, NXCD = 8, WGM = 8;

__host__ __device__ __forceinline__ int lds_byte(int r, int c) { const int st = (r >> 4) * 2 + (c >> 5), rr = r & 15, cc = c & 31, ob = rr * 64 + cc * 2; return st * 1024 + (ob ^ (((ob >> 9) & 1) << 5)); }
__host__ __device__ __forceinline__ void stage_rc(int b, int& R, int& C) { const int st = b / 1024, sb = b % 1024, swz = sb ^ (((sb >> 9) & 1) << 5); R = (st >> 1) * 16 + swz / 64; C = (st & 1) * 32 + (swz % 64) / 2; }
__host__ __device__ __forceinline__ int perm32(int rho) { const int n = rho >> 4, i = rho & 15; return 8 * (i >> 2) + 4 * n + (i & 3); }

struct Unit { int pm, pn; };
struct Gemm { const bf16_t* A; const bf16_t* Bt; int M, N, K; };

struct StaticOrder {
    int nM, nN, nwg, G, c;
    __host__ __device__ void init(int M, int N, int G_, int c_) { nM = M / BM; nN = N / BM; nwg = nM * nN; G = G_; c = c_; }
    __host__ __device__ bool next(int i, Unit& u) const {
        const long L = (long)i * G + c; if (L >= nwg) return false;
        int wgid = (int)L; { const int q = nwg / NXCD, r = nwg % NXCD, xcd = wgid % NXCD, off = wgid / NXCD; wgid = (xcd < r ? xcd * (q + 1) : r * (q + 1) + (xcd - r) * q) + off; }
        const int nig = WGM * nN, gid = wgid / nig, fm = gid * WGM, gsz = (nM - fm) < WGM ? (nM - fm) : WGM;
        u.pm = fm + ((wgid % nig) % gsz); u.pn = (wgid % nig) / gsz; return true;
    }
    __device__ __forceinline__ void a_ready(const Unit&) const {}
    __device__ __forceinline__ void done(const Unit&) const {}
};

__device__ __forceinline__ unsigned cvt_pk_bf16(float lo, float hi) { unsigned r; asm volatile("v_cvt_pk_bf16_f32 %0, %1, %2" : "=v"(r) : "v"(lo), "v"(hi)); return r; }


struct EpiStore {
    static constexpr bool PERM = true, AFTER_DRAIN = false;
    bf16_t* O; int ldc; const float* sumsq;
    __device__ __forceinline__ void operator()(const f32x4 (&acc)[2][2][4][2], const Unit& u, int wr, int wc, int fr, int fq) const {
        const int row0 = u.pm * BM + wr * 64 + fr, col0 = u.pn * BM + wc * 32 + 8 * fq;
#pragma unroll
        for (int ai = 0; ai < 2; ++ai)
#pragma unroll
            for (int m = 0; m < 4; ++m) {
                const int row = row0 + ai * HALF + m * 16;
                float sc = 1.f; if (sumsq) sc = 1.0f / sqrtf(sumsq[row] * (1.0f / 1024.0f) + 1e-6f);
                bf16_t* rowp = O + (size_t)row * ldc + col0;
#pragma unroll
                for (int bj = 0; bj < 2; ++bj) { f32x4 v0 = acc[ai][bj][m][0] * sc, v1 = acc[ai][bj][m][1] * sc;
                    u32x4 w; w.x = cvt_pk_bf16(v0[0], v0[1]); w.y = cvt_pk_bf16(v0[2], v0[3]); w.z = cvt_pk_bf16(v1[0], v1[1]); w.w = cvt_pk_bf16(v1[2], v1[3]);
                    *(u32x4*)(rowp + bj * HALF) = w; } }
    }
};
template <bool BASE_F32> struct EpiResid {
    static constexpr bool PERM = true, AFTER_DRAIN = false;
    const void* base; bf16_t* O; float* sumsq;
    __device__ __forceinline__ void operator()(const f32x4 (&acc)[2][2][4][2], const Unit& u, int wr, int wc, int fr, int fq) const {
        const int row0 = u.pm * BM + wr * 64 + fr, col0 = u.pn * BM + wc * 32 + 8 * fq;
#pragma unroll
        for (int ai = 0; ai < 2; ++ai)
#pragma unroll
            for (int m = 0; m < 4; ++m) {
                const int row = row0 + ai * HALF + m * 16; float ss = 0.f;
#pragma unroll
                for (int bj = 0; bj < 2; ++bj) {
                    const size_t off = (size_t)row * 1024 + col0 + bj * HALF;
                    f32x4 b0, b1;
                    if (BASE_F32) { b0 = *(const f32x4*)((const float*)base + off); b1 = *(const f32x4*)((const float*)base + off + 4); }
                    else { const u32x4 r = *(const u32x4*)((const bf16_t*)base + off);
                        b0[0] = __uint_as_float(r.x << 16); b0[1] = __uint_as_float(r.x & 0xffff0000u); b0[2] = __uint_as_float(r.y << 16); b0[3] = __uint_as_float(r.y & 0xffff0000u);
                        b1[0] = __uint_as_float(r.z << 16); b1[1] = __uint_as_float(r.z & 0xffff0000u); b1[2] = __uint_as_float(r.w << 16); b1[3] = __uint_as_float(r.w & 0xffff0000u); }
                    const f32x4 v0 = acc[ai][bj][m][0] + b0, v1 = acc[ai][bj][m][1] + b1;
                    ss += (v0[0] * v0[0] + v0[1] * v0[1]) + (v0[2] * v0[2] + v0[3] * v0[3]) + (v1[0] * v1[0] + v1[1] * v1[1]) + (v1[2] * v1[2] + v1[3] * v1[3]);
                    u32x4 w; w.x = cvt_pk_bf16(v0[0], v0[1]); w.y = cvt_pk_bf16(v0[2], v0[3]); w.z = cvt_pk_bf16(v1[0], v1[1]); w.w = cvt_pk_bf16(v1[2], v1[3]);
                    *(u32x4*)(O + off) = w; }
                ss += __shfl_xor(ss, 16); ss += __shfl_xor(ss, 32);
                if (fq == 0) atomicAdd(sumsq + row, ss);
            }
    }
};

template <class Epi, class Sched, bool ALIGN_EPI = false, bool SP2 = false>
__device__ __forceinline__ void gemm_phase(PG8_LAS unsigned char* lds, const Gemm g, const Sched& S, const Epi& E) {
    const int tid = threadIdx.x, wid = __builtin_amdgcn_readfirstlane(tid >> 6), lane = tid & 63, wr = wid >> 2, wc = wid & 3, fr = lane & 15, fq = lane >> 4;
    const int K = g.K, nt = K / BK;
    unsigned voffA[2], voffB[2];
#pragma unroll
    for (int i = 0; i < 2; ++i) { int R, C; stage_rc(tid * 16 + i * 8192, R, C); const int Rb = Epi::PERM ? ((R & ~31) + perm32(R & 31)) : R;
        voffA[i] = (unsigned)(R * K + C) * 2u; voffB[i] = (unsigned)(Rb * K + C) * 2u; }
    const size_t kstep = (size_t)(BK * 2);
    const size_t hstep = (size_t)HALF * K * 2;
    const size_t tstep = 2 * hstep;
    const unsigned ldsw = (unsigned)wid * 1024u;
    const int aoff = lds_byte(wr * 64 + fr, fq * 8), boff = lds_byte(wc * 32 + fr, fq * 8);
#define PG8_SA(b, h) (((b) * 2 + (h)) * HTB)
#define PG8_SB(b, h) ((4 + (b) * 2 + (h)) * HTB)
#define PG8_STAGE(bufoff, gbase, voff) do { _Pragma("unroll") for (int _i = 0; _i < 2; ++_i) \
        __builtin_amdgcn_global_load_lds((const unsigned*)((const char*)(gbase) + (voff)[_i]), (PG8_LAS unsigned*)(lds + (bufoff) + ldsw + _i * 8192), 16, 0, 0); } while (0)
#define PG8_LDA(dst, b, h) do { _Pragma("unroll") for (int m = 0; m < 4; ++m) _Pragma("unroll") for (int k = 0; k < 2; ++k) dst[m][k] = *(const PG8_LAS bf16x8*)(lds + PG8_SA(b, h) + aoff + m * 2048 + k * 1024); } while (0)
#define PG8_LDB(dst, b, h) do { _Pragma("unroll") for (int n = 0; n < 2; ++n) _Pragma("unroll") for (int k = 0; k < 2; ++k) dst[n][k] = *(const PG8_LAS bf16x8*)(lds + PG8_SB(b, h) + boff + n * 2048 + k * 1024); } while (0)
#define PG8_MMA(ai, bj, At, Bt) do { __builtin_amdgcn_s_setprio(1); _Pragma("unroll") for (int m = 0; m < 4; ++m) _Pragma("unroll") for (int n = 0; n < 2; ++n) _Pragma("unroll") for (int k = 0; k < 2; ++k) \
        acc[ai][bj][m][n] = __builtin_amdgcn_mfma_f32_16x16x32_bf16(Bt[n][k], At[m][k], acc[ai][bj][m][n], 0, 0, 0); __builtin_amdgcn_s_setprio(0); } while (0)
#define PG8_WAIT_V(n) asm volatile("s_waitcnt vmcnt(" #n ")" ::: "memory")
#define PG8_WAIT_L(n) asm volatile("s_waitcnt lgkmcnt(" #n ")" ::: "memory")
#define PG8_BAR __builtin_amdgcn_s_barrier()
#define PG8_SCHED __builtin_amdgcn_sched_barrier(0)
    Unit cur, nxt; int ui = 0;
    if (!S.next(0, cur)) return;
    f32x4 acc[2][2][4][2];
#pragma unroll
    for (int a = 0; a < 2; ++a)
#pragma unroll
        for (int b = 0; b < 2; ++b)
#pragma unroll
            for (int m = 0; m < 4; ++m)
#pragma unroll
                for (int n = 0; n < 2; ++n) acc[a][b][m][n] = (f32x4){0.f, 0.f, 0.f, 0.f};
    bf16x8 At[4][2], B0[2][2], B1[2][2];
    const char* cA = (const char*)g.A + (size_t)cur.pm * tstep; const char* cB = (const char*)g.Bt + (size_t)cur.pn * tstep;
    S.a_ready(cur);
    if constexpr (SP2) {
        PG8_STAGE(PG8_SB(0, 0), cB, voffB); PG8_STAGE(PG8_SB(0, 1), cB + hstep, voffB); PG8_STAGE(PG8_SA(0, 0), cA, voffA); PG8_STAGE(PG8_SA(0, 1), cA + hstep, voffA);
        if (wr == 1) PG8_BAR;
        PG8_WAIT_V(2); PG8_BAR;
        PG8_STAGE(PG8_SB(1, 0), cB + kstep, voffB); PG8_STAGE(PG8_SA(1, 0), cA + kstep, voffA); PG8_STAGE(PG8_SB(1, 1), cB + hstep + kstep, voffB);
        PG8_WAIT_V(6); PG8_BAR;
    } else {
        PG8_STAGE(PG8_SB(0, 0), cB, voffB); PG8_STAGE(PG8_SA(0, 0), cA, voffA); PG8_STAGE(PG8_SB(0, 1), cB + hstep, voffB); PG8_STAGE(PG8_SA(0, 1), cA + hstep, voffA);
        if (wr == 1) PG8_BAR;
        PG8_WAIT_V(4); PG8_BAR;
        PG8_STAGE(PG8_SB(1, 0), cB + kstep, voffB); PG8_STAGE(PG8_SA(1, 0), cA + kstep, voffA); PG8_STAGE(PG8_SB(1, 1), cB + hstep + kstep, voffB);
        PG8_WAIT_V(6); PG8_BAR;
    }
    for (;;) {
        const bool has_next = S.next(ui + 1, nxt);
        const char* nA = has_next ? (const char*)g.A + (size_t)nxt.pm * tstep : cA; const char* nB = has_next ? (const char*)g.Bt + (size_t)nxt.pn * tstep : cB;
        for (int t = 0; t < nt; t += 2) {
            const bool last = (t == nt - 2);
            const char* a1 = cA + (size_t)(t + 1) * kstep;
            const char* a2 = last ? nA : cA + (size_t)(t + 2) * kstep; const char* b2 = last ? nB : cB + (size_t)(t + 2) * kstep;
            const char* a3 = a2 + kstep; const char* b3 = b2 + kstep;
            if (last && has_next) S.a_ready(nxt);
            if constexpr (SP2) {
            PG8_LDB(B0, 0, 0); PG8_LDB(B1, 0, 1); PG8_SCHED; PG8_LDA(At, 0, 0); PG8_STAGE(PG8_SA(1, 1), a1 + hstep, voffA);
            PG8_WAIT_V(8); PG8_WAIT_L(0); PG8_BAR; PG8_MMA(0, 0, At, B0); PG8_MMA(0, 1, At, B1); PG8_BAR; PG8_SCHED;
            PG8_LDA(At, 0, 1); PG8_STAGE(PG8_SB(0, 0), b2, voffB); PG8_STAGE(PG8_SB(0, 1), b2 + hstep, voffB); PG8_STAGE(PG8_SA(0, 0), a2, voffA);
            PG8_WAIT_V(8); PG8_WAIT_L(0); PG8_BAR; PG8_MMA(1, 0, At, B0); PG8_MMA(1, 1, At, B1); PG8_BAR; PG8_SCHED;
            PG8_LDB(B0, 1, 0); PG8_LDB(B1, 1, 1); PG8_SCHED; PG8_LDA(At, 1, 0); PG8_STAGE(PG8_SA(0, 1), a2 + hstep, voffA);
            PG8_WAIT_V(8); PG8_WAIT_L(0); PG8_BAR; PG8_MMA(0, 0, At, B0); PG8_MMA(0, 1, At, B1); PG8_BAR; PG8_SCHED;
            PG8_LDA(At, 1, 1); PG8_STAGE(PG8_SB(1, 0), b3, voffB); PG8_STAGE(PG8_SB(1, 1), b3 + hstep, voffB); PG8_STAGE(PG8_SA(1, 0), a3, voffA);
            PG8_WAIT_V(8); PG8_WAIT_L(0); PG8_BAR; PG8_MMA(1, 0, At, B0); PG8_MMA(1, 1, At, B1); PG8_BAR; PG8_SCHED;
            } else {
            PG8_LDB(B0, 0, 0); PG8_SCHED; PG8_LDA(At, 0, 0); PG8_STAGE(PG8_SA(1, 1), a1 + hstep, voffA);
            PG8_WAIT_L(8); PG8_BAR; PG8_WAIT_L(0); PG8_MMA(0, 0, At, B0); PG8_BAR; PG8_SCHED;
            PG8_LDB(B1, 0, 1); PG8_STAGE(PG8_SB(0, 0), b2, voffB);
            PG8_BAR; PG8_WAIT_L(0); PG8_MMA(0, 1, At, B1); PG8_BAR;
            PG8_LDA(At, 0, 1); PG8_STAGE(PG8_SA(0, 0), a2, voffA);
            PG8_BAR; PG8_WAIT_L(0); PG8_MMA(1, 0, At, B0); PG8_BAR; PG8_SCHED;
            PG8_STAGE(PG8_SB(0, 1), b2 + hstep, voffB);
            PG8_WAIT_V(6); PG8_BAR; PG8_MMA(1, 1, At, B1); PG8_BAR;
            PG8_LDB(B0, 1, 0); PG8_SCHED; PG8_LDA(At, 1, 0); PG8_STAGE(PG8_SA(0, 1), a2 + hstep, voffA);
            PG8_WAIT_L(8); PG8_BAR; PG8_WAIT_L(0); PG8_MMA(0, 0, At, B0); PG8_BAR; PG8_SCHED;
            PG8_LDB(B1, 1, 1); PG8_STAGE(PG8_SB(1, 0), b3, voffB);
            PG8_BAR; PG8_WAIT_L(0); PG8_MMA(0, 1, At, B1); PG8_BAR;
            PG8_LDA(At, 1, 1); PG8_STAGE(PG8_SA(1, 0), a3, voffA);
            PG8_BAR; PG8_WAIT_L(0); PG8_MMA(1, 0, At, B0); PG8_BAR; PG8_SCHED;
            PG8_STAGE(PG8_SB(1, 1), b3 + hstep, voffB);
            PG8_WAIT_V(6); PG8_BAR; PG8_MMA(1, 1, At, B1); PG8_BAR;
            }
        }
        if constexpr (ALIGN_EPI) { if (wr == 0) PG8_BAR; }
        if constexpr (!Epi::AFTER_DRAIN) { E(acc, cur, wr, wc, fr, fq); S.done(cur); }
        if (!has_next) break;
#pragma unroll
        for (int a = 0; a < 2; ++a)
#pragma unroll
            for (int b = 0; b < 2; ++b)
#pragma unroll
                for (int m = 0; m < 4; ++m)
#pragma unroll
                    for (int n = 0; n < 2; ++n) acc[a][b][m][n] = (f32x4){0.f, 0.f, 0.f, 0.f};
        cur = nxt; cA = nA; cB = nB; ++ui;
        if constexpr (ALIGN_EPI) { if (wr == 1) PG8_BAR; }
    }
    PG8_WAIT_V(0);
    if constexpr (!ALIGN_EPI) { if (wr == 0) PG8_BAR; }
    PG8_BAR;
#undef PG8_SA
#undef PG8_SB
#undef PG8_STAGE
#undef PG8_LDA
#undef PG8_LDB
#undef PG8_MMA
#undef PG8_WAIT_V
#undef PG8_WAIT_L
#undef PG8_BAR
#undef PG8_SCHED
}
}

constexpr int NWAVES = 8;
constexpr int BATCH = 32, SEQ = 2048, DM = 1024, NTOK = BATCH * SEQ;
constexpr int IN_COLS = 1736;
constexpr int N1 = 2304, K2 = 1536, FF = 2816, N3 = 2 * FF;
constexpr int OFF_QL = 0, OFF_QI = 1024, OFF_U = 1536, OFF_C = 2048, OFF_KI = 2176, OFF_WI = 2240;
constexpr float EPS = 1e-6f;
constexpr float WI_SCALE = 0.044194173824159216f;

constexpr size_t MiB = 1u << 20;
constexpr size_t WS_CTL = 0, CTL_ZERO_BYTES = 1 * MiB;
constexpr size_t WS_W1T = 1 * MiB, WS_W2T = 6 * MiB, WS_W3T = 9 * MiB, WS_W4T = 20 * MiB, WS_CONVP = 26 * MiB;
constexpr size_t WS_HB = 32 * MiB;
constexpr size_t WS_P1 = 160 * MiB;
constexpr size_t WS_RAW = 32 * MiB;
constexpr size_t WS_X2 = 32 * MiB;
constexpr size_t WS_MIX = 448 * MiB;
constexpr size_t WS_CN = 640 * MiB;
constexpr size_t WS_ACT = 448 * MiB;
constexpr size_t WS_X1B = 800 * MiB;
constexpr size_t WS_END = 928 * MiB;

constexpr int LDS_BYTES = 147456;

#define GAS __attribute__((address_space(1)))
#define LAS __attribute__((address_space(3)))
typedef unsigned short bf16;
typedef unsigned v4u __attribute__((ext_vector_type(4)));
typedef unsigned v2u __attribute__((ext_vector_type(2)));
typedef float f32x4 __attribute__((ext_vector_type(4)));

__device__ __forceinline__ unsigned f2bf(float f) { unsigned u = __builtin_bit_cast(unsigned, f); return (u + 0x7fffu + ((u >> 16) & 1u)) >> 16; }
__device__ __forceinline__ unsigned pk2(float lo, float hi) { return f2bf(lo) | (f2bf(hi) << 16); }
__device__ __forceinline__ float bflo(unsigned u) { return __uint_as_float(u << 16); }
__device__ __forceinline__ float bfhi(unsigned u) { return __uint_as_float(u & 0xffff0000u); }
__device__ __forceinline__ float wave_sum(float v) {
#pragma unroll
    for (int o = 1; o < 64; o <<= 1) v += __shfl_xor(v, o);
    return v;
}
__device__ __forceinline__ float wave_max(float v) {
#pragma unroll
    for (int o = 1; o < 64; o <<= 1) v = fmaxf(v, __shfl_xor(v, o));
    return v;
}
#define WAVE_LDS_SYNC() do { asm volatile("s_waitcnt lgkmcnt(0)" ::: "memory"); __builtin_amdgcn_wave_barrier(); } while (0)

struct Args {
    const float* x; const float* g_mix; const float* w_in; const float* g_kv; const float* w_uk; const float* w_uv; const float* w_pool; const float* pool_scale;
    const float* w_o; const float* g_ffn; const float* w_up; const float* conv_w; const float* conv_b; const float* w_down; const float* g_final;
    float* out; unsigned char* ws; int ph_lo, ph_hi;
};

__device__ __forceinline__ void ph_prologue(const Args& a, int gtid, int gthreads, int gw, int ngw, int lane) {
    unsigned char* ws = a.ws;
    bf16* W1T = (bf16*)(ws + WS_W1T); bf16* W2T = (bf16*)(ws + WS_W2T); bf16* W3T = (bf16*)(ws + WS_W3T); bf16* W4T = (bf16*)(ws + WS_W4T);
    float* CONVP = (float*)(ws + WS_CONVP);
    for (int i = gtid; i < N1 * DM; i += gthreads) {
        const int n = i >> 10, k = i & 1023; float v;
        const float* wr = a.w_in + (size_t)k * IN_COLS;
        if (n < 1024) { const int hd = n >> 7, c = n & 127; float s = 0.f;
            for (int d = 0; d < 64; ++d) s += wr[hd * 64 + d] * a.w_uk[(hd * 64 + d) * 128 + c];
            v = s; }
        else if (n < 1536) v = wr[640 + (n - 1024)];
        else if (n < 2048) v = wr[1224 + (n - 1536)];
        else if (n < 2176) v = wr[512 + (n - 2048)];
        else if (n < 2240) v = wr[1152 + (n - 2176)];
        else if (n < 2248) v = wr[1216 + (n - 2240)] * WI_SCALE;
        else v = 0.f;
        W1T[i] = (bf16)f2bf(v);
    }
    for (int i = gtid; i < DM * K2; i += gthreads) {
        const int n = i / K2, k = i - n * K2; float s = 0.f;
        if (k < 1024) { const int hd = k >> 7, c = k & 127;
            for (int d = 0; d < 64; ++d) s += a.w_uv[(hd * 128 + c) * 64 + d] * a.w_o[(size_t)(hd * 64 + d) * 1024 + n]; }
        else { const int kk = k - 1024, g = kk >> 7, ci = kk & 127;
            for (int dd = 0; dd < 128; ++dd) s += a.w_pool[(g * 128 + ci) * 128 + dd] * a.pool_scale[g * 128 + dd] * a.w_o[(size_t)(512 + g * 128 + dd) * 1024 + n]; }
        W2T[i] = (bf16)f2bf(s);
    }
    for (int i = gtid; i < N3 * DM; i += gthreads) {
        const int r = i >> 10, k = i & 1023, j = r >> 8, ii = r & 255;
        const int col = (ii < 128) ? (128 * j + ii) : (FF + 128 * j + (ii - 128));
        W3T[i] = (bf16)f2bf(a.w_up[(size_t)k * N3 + col] * a.g_ffn[k]);
    }
    for (int r = gtid; r < N3; r += gthreads) {
        const int j = r >> 8, ii = r & 255; const int col = (ii < 128) ? (128 * j + ii) : (FF + 128 * j + (ii - 128));
        CONVP[r] = a.conv_w[col]; CONVP[N3 + r] = a.conv_w[N3 + col]; CONVP[2 * N3 + r] = a.conv_w[2 * N3 + col]; CONVP[3 * N3 + r] = a.conv_b[col];
    }
    for (int i = gtid; i < DM * FF; i += gthreads) {
        const int n = i / FF, k = i - n * FF;
        W4T[i] = (bf16)f2bf(a.w_down[(size_t)k * 1024 + n]);
    }
    bf16* HB = (bf16*)(ws + WS_HB);
    for (int m = gw; m < NTOK; m += ngw) {
        const f32x4* xr = (const f32x4*)(a.x + (size_t)m * DM) + lane;
        f32x4 v[4]; float s = 0.f;
#pragma unroll
        for (int j = 0; j < 4; ++j) { v[j] = xr[64 * j]; s += (v[j].x * v[j].x + v[j].y * v[j].y) + (v[j].z * v[j].z + v[j].w * v[j].w); }
        const float rinv = 1.0f / sqrtf(wave_sum(s) * (1.0f / DM) + EPS);
        unsigned long long* o8 = (unsigned long long*)(HB + (size_t)m * DM) + lane;
#pragma unroll
        for (int j = 0; j < 4; ++j) { const f32x4 g = ((const f32x4*)a.g_mix)[lane + 64 * j];
            o8[64 * j] = (unsigned long long)pk2(v[j].x * rinv * g.x, v[j].y * rinv * g.y) | ((unsigned long long)pk2(v[j].z * rinv * g.z, v[j].w * rinv * g.w) << 32); }
    }
}

__device__ __forceinline__ void ph_cnorm_pool(const Args& a, int gw, int ngw, int lane) {
    const bf16* P1 = (const bf16*)(a.ws + WS_P1); bf16* CN = (bf16*)(a.ws + WS_CN); bf16* MIX = (bf16*)(a.ws + WS_MIX);
    for (int tok = gw; tok < NTOK; tok += ngw) {
        const bf16* prow = P1 + (size_t)tok * N1;
        const unsigned cw = *(const unsigned*)(prow + OFF_C + 2 * lane);
        const float c0 = bflo(cw), c1 = bfhi(cw);
        const float rinv = 1.0f / sqrtf(wave_sum(c0 * c0 + c1 * c1) * (1.0f / 128.0f) + EPS);
        *(unsigned*)(CN + (size_t)tok * 128 + 2 * lane) = pk2(c0 * rinv * a.g_kv[2 * lane], c1 * rinv * a.g_kv[2 * lane + 1]);
        const int pos = tok & (SEQ - 1), win = 2 << (lane >> 4), cnt = (pos + 1 < win) ? pos + 1 : win;
        float s[8];
#pragma unroll
        for (int j = 0; j < 8; ++j) s[j] = 0.f;
        v4u u0 = (v4u){0, 0, 0, 0};
        for (int j = 0; j < cnt; ++j) {
            const v4u u = *(const v4u*)(prow - (size_t)j * N1 + OFF_U + 8 * lane);
            if (j == 0) u0 = u;
            s[0] += bflo(u.x); s[1] += bfhi(u.x); s[2] += bflo(u.y); s[3] += bfhi(u.y); s[4] += bflo(u.z); s[5] += bfhi(u.z); s[6] += bflo(u.w); s[7] += bfhi(u.w);
        }
        const float ic = 1.0f / (float)cnt;
        v4u o; o.x = pk2(s[0] * ic - bflo(u0.x), s[1] * ic - bfhi(u0.x)); o.y = pk2(s[2] * ic - bflo(u0.y), s[3] * ic - bfhi(u0.y));
        o.z = pk2(s[4] * ic - bflo(u0.z), s[5] * ic - bfhi(u0.z)); o.w = pk2(s[6] * ic - bflo(u0.w), s[7] * ic - bfhi(u0.w));
        *(v4u*)(MIX + (size_t)tok * K2 + 1024 + 8 * lane) = o;
    }
}

__device__ __forceinline__ void ph_attn_naive(const Args& a, LAS unsigned char* lds, int wave, int gw, int ngw, int lane) {
    const bf16* P1 = (const bf16*)(a.ws + WS_P1); const bf16* CN = (const bf16*)(a.ws + WS_CN); bf16* MIX = (bf16*)(a.ws + WS_MIX);
    LAS unsigned char* base = lds + wave * 16384;
    LAS unsigned* uk = (LAS unsigned*)base;
    LAS float* pb = (LAS float*)base;
    LAS float* qi = (LAS float*)(base + 8192);
    LAS float* ql = (LAS float*)(base + 10240);
    LAS int* idx = (LAS int*)(base + 14336);
    LAS float* wl = (LAS float*)(base + 15360);
    const unsigned long long lt_mask = (lane == 0) ? 0ull : (~0ull >> (64 - lane));
    for (int q = gw; q < NTOK; q += ngw) {
        const int b = q >> 11, pos = q & (SEQ - 1), n = ((pos >> 6) + 1) << 6;
        const bf16* prow = P1 + (size_t)q * N1;
        { const v4u t = *(const v4u*)(prow + OFF_QI + 8 * lane);
          qi[8 * lane + 0] = bflo(t.x); qi[8 * lane + 1] = bfhi(t.x); qi[8 * lane + 2] = bflo(t.y); qi[8 * lane + 3] = bfhi(t.y);
          qi[8 * lane + 4] = bflo(t.z); qi[8 * lane + 5] = bfhi(t.z); qi[8 * lane + 6] = bflo(t.w); qi[8 * lane + 7] = bfhi(t.w); }
#pragma unroll
        for (int h2 = 0; h2 < 2; ++h2) { const v4u t = *(const v4u*)(prow + OFF_QL + 16 * lane + 8 * h2); const int o = 16 * lane + 8 * h2;
          ql[o + 0] = bflo(t.x); ql[o + 1] = bfhi(t.x); ql[o + 2] = bflo(t.y); ql[o + 3] = bfhi(t.y); ql[o + 4] = bflo(t.z); ql[o + 5] = bfhi(t.z); ql[o + 6] = bflo(t.w); ql[o + 7] = bfhi(t.w); }
        if (lane < 4) { const unsigned t = *(const unsigned*)(prow + OFF_WI + 2 * lane); wl[2 * lane] = bflo(t); wl[2 * lane + 1] = bfhi(t); }
        WAVE_LDS_SYNC();
        const int nk = n >> 6;
        for (int i = 0; i < nk; ++i) {
            const int key = i * 64 + lane;
            const v4u* kr = (const v4u*)(P1 + (size_t)(b * SEQ + key) * N1 + OFF_KI);
            v4u k8[8];
#pragma unroll
            for (int j = 0; j < 8; ++j) k8[j] = kr[j];
            float s = 0.f;
#pragma unroll 1
            for (int hd = 0; hd < 8; ++hd) { float d0 = 0.f, d1 = 0.f;
#pragma unroll
                for (int j = 0; j < 8; ++j) { const f32x4 qa = *(const LAS f32x4*)(qi + hd * 64 + 8 * j), qb = *(const LAS f32x4*)(qi + hd * 64 + 8 * j + 4); const v4u t = k8[j];
                    d0 += (qa.x * bflo(t.x) + qa.z * bflo(t.y)) + (qb.x * bflo(t.z) + qb.z * bflo(t.w));
                    d1 += (qa.y * bfhi(t.x) + qa.w * bfhi(t.y)) + (qb.y * bfhi(t.z) + qb.w * bfhi(t.w)); }
                s += wl[hd] * fmaxf(d0 + d1, 0.f); }
            s += 0.0f;
            unsigned u = __float_as_uint(s); u = (u & 0x80000000u) ? ~u : (u | 0x80000000u);
            uk[key] = u;
        }
        WAVE_LDS_SYNC();
        int nsel;
        if (n <= 256) { for (int j = lane; j < n; j += 64) idx[j] = j; nsel = n; }
        else {
            unsigned prefix = 0u;
            for (int bit = 31; bit >= 0; --bit) {
                const unsigned cand = prefix | (1u << bit); int cnt = 0;
                for (int i = 0; i < nk; ++i) cnt += __popcll(__ballot(uk[i * 64 + lane] >= cand));
                if (cnt >= 256) prefix = cand;
            }
            int cgt = 0;
            for (int i = 0; i < nk; ++i) cgt += __popcll(__ballot(uk[i * 64 + lane] > prefix));
            const int need = 256 - cgt; int basep = 0, eqrun = 0;
            for (int i = 0; i < nk; ++i) {
                const unsigned u = uk[i * 64 + lane]; const bool gt = u > prefix, eq = (u == prefix);
                const unsigned long long eqm = __ballot(eq);
                const int rank = eqrun + __popcll(eqm & lt_mask);
                const bool sel = gt || (eq && rank < need);
                const unsigned long long sm = __ballot(sel);
                if (sel) idx[basep + __popcll(sm & lt_mask)] = i * 64 + lane;
                basep += __popcll(sm); eqrun += __popcll(eqm);
            }
            nsel = 256;
        }
        WAVE_LDS_SYNC();
#pragma unroll 1
        for (int jj = 0; jj < 4; ++jj) {
            const int j = jj * 64 + lane; const bool valid = j < nsel; const int key = valid ? idx[j] : 0;
            const v4u* cr = (const v4u*)(CN + (size_t)(b * SEQ + key) * 128);
            float dot[8];
#pragma unroll
            for (int hd = 0; hd < 8; ++hd) dot[hd] = 0.f;
#pragma unroll 2
            for (int c8 = 0; c8 < 16; ++c8) { const v4u t = cr[c8];
                const float c0 = bflo(t.x), c1 = bfhi(t.x), c2 = bflo(t.y), c3 = bfhi(t.y), c4 = bflo(t.z), c5 = bfhi(t.z), c6 = bflo(t.w), c7 = bfhi(t.w);
#pragma unroll
                for (int hd = 0; hd < 8; ++hd) { const f32x4 qa = *(const LAS f32x4*)(ql + hd * 128 + c8 * 8), qb = *(const LAS f32x4*)(ql + hd * 128 + c8 * 8 + 4);
                    dot[hd] += (qa.x * c0 + qa.y * c1) + (qa.z * c2 + qa.w * c3) + (qb.x * c4 + qb.y * c5) + (qb.z * c6 + qb.w * c7); } }
            const float dist = fabsf((float)(pos - key));
#pragma unroll
            for (int hd = 0; hd < 8; ++hd) { const float slope = __uint_as_float((unsigned)(127 - (hd + 1)) << 23);
                pb[hd * 256 + j] = valid ? (dot[hd] * 0.125f - slope * dist) : -__builtin_inff(); }
        }
        WAVE_LDS_SYNC();
#pragma unroll 1
        for (int hd = 0; hd < 8; ++hd) {
            float p[4];
#pragma unroll
            for (int jj = 0; jj < 4; ++jj) p[jj] = pb[hd * 256 + jj * 64 + lane];
            float m = fmaxf(fmaxf(p[0], p[1]), fmaxf(p[2], p[3])); m = wave_max(m);
            float s = 0.f;
#pragma unroll
            for (int jj = 0; jj < 4; ++jj) { p[jj] = __expf(p[jj] - m); s += p[jj]; }
            s = wave_sum(s); const float inv = 1.0f / s;
#pragma unroll
            for (int jj = 0; jj < 4; ++jj) pb[hd * 256 + jj * 64 + lane] = p[jj] * inv;
        }
        WAVE_LDS_SYNC();
        float o0[8], o1[8];
#pragma unroll
        for (int hd = 0; hd < 8; ++hd) { o0[hd] = 0.f; o1[hd] = 0.f; }
        for (int j = 0; j < nsel; j += 4) {
            unsigned cw[4];
#pragma unroll
            for (int t = 0; t < 4; ++t) cw[t] = *(const unsigned*)(CN + (size_t)(b * SEQ + idx[j + t]) * 128 + 2 * lane);
#pragma unroll
            for (int t = 0; t < 4; ++t) { const float c0 = bflo(cw[t]), c1 = bfhi(cw[t]);
#pragma unroll
                for (int hd = 0; hd < 8; ++hd) { const float p = pb[hd * 256 + j + t]; o0[hd] += p * c0; o1[hd] += p * c1; } }
        }
#pragma unroll
        for (int hd = 0; hd < 8; ++hd) *(unsigned*)(MIX + (size_t)q * K2 + hd * 128 + 2 * lane) = pk2(o0[hd], o1[hd]);
        WAVE_LDS_SYNC();
    }
}

__device__ __forceinline__ void ph_conv(const Args& a, int hsel, int gtid, int gthreads) {
    const bf16* RAW = (const bf16*)(a.ws + WS_RAW); bf16* ACT = (bf16*)(a.ws + WS_ACT); const float* CONVP = (const float*)(a.ws + WS_CONVP);
    constexpr int CH = FF / 8;
    for (int i = gtid; i < (NTOK / 2) * CH; i += gthreads) {
        const int tl = i / CH, ch = i - tl * CH, tok = hsel * (NTOK / 2) + tl, pos = tok & (SEQ - 1);
        const int jc = ch * 8, j = jc >> 7, ii = jc & 127, rg = 256 * j + ii, ru = rg + 128;
        float cg_[8], cu_[8];
#pragma unroll
        for (int e = 0; e < 8; ++e) { cg_[e] = CONVP[3 * N3 + rg + e]; cu_[e] = CONVP[3 * N3 + ru + e]; }
#pragma unroll
        for (int tap = 0; tap < 3; ++tap) {
            const int back = 2 - tap; if (pos - back < 0) continue;
            const bf16* rrow = RAW + (size_t)(tl - back) * N3;
            const v4u g = *(const v4u*)(rrow + rg), u = *(const v4u*)(rrow + ru);
            const float gv[8] = {bflo(g.x), bfhi(g.x), bflo(g.y), bfhi(g.y), bflo(g.z), bfhi(g.z), bflo(g.w), bfhi(g.w)};
            const float uv[8] = {bflo(u.x), bfhi(u.x), bflo(u.y), bfhi(u.y), bflo(u.z), bfhi(u.z), bflo(u.w), bfhi(u.w)};
#pragma unroll
            for (int e = 0; e < 8; ++e) { cg_[e] += CONVP[tap * N3 + rg + e] * gv[e]; cu_[e] += CONVP[tap * N3 + ru + e] * uv[e]; }
        }
        float r[8];
#pragma unroll
        for (int e = 0; e < 8; ++e) r[e] = cg_[e] / (1.0f + __expf(-cg_[e])) * cu_[e];
        v4u o; o.x = pk2(r[0], r[1]); o.y = pk2(r[2], r[3]); o.z = pk2(r[4], r[5]); o.w = pk2(r[6], r[7]);
        *(v4u*)(ACT + (size_t)tok * FF + jc) = o;
    }
}

__device__ __forceinline__ void ph_final(const Args& a, int gw, int ngw, int lane) {
    const bf16* X2 = (const bf16*)(a.ws + WS_X2); const float* ss3 = (const float*)(a.ws + WS_CTL + 256 * 1024);
    for (int m = gw; m < NTOK; m += ngw) {
        const float rinv = 1.0f / sqrtf(ss3[m] * (1.0f / DM) + EPS);
#pragma unroll
        for (int h2 = 0; h2 < 2; ++h2) {
            const int c0 = h2 * 512 + 8 * lane;
            const v4u t = *(const v4u*)(X2 + (size_t)m * DM + c0);
            const f32x4 g0 = *(const f32x4*)(a.g_final + c0), g1 = *(const f32x4*)(a.g_final + c0 + 4);
            f32x4 o0, o1;
            o0.x = bflo(t.x) * rinv * g0.x; o0.y = bfhi(t.x) * rinv * g0.y; o0.z = bflo(t.y) * rinv * g0.z; o0.w = bfhi(t.y) * rinv * g0.w;
            o1.x = bflo(t.z) * rinv * g1.x; o1.y = bfhi(t.z) * rinv * g1.y; o1.z = bflo(t.w) * rinv * g1.z; o1.w = bfhi(t.w) * rinv * g1.w;
            *(f32x4*)(a.out + (size_t)m * DM + c0) = o0; *(f32x4*)(a.out + (size_t)m * DM + c0 + 4) = o1;
        }
    }
}

constexpr int NPHASE = 11;
#define IDS() const int tid = threadIdx.x, lane = tid & 63, wave = __builtin_amdgcn_readfirstlane(tid >> 6); const int G = gridDim.x; \
    const int gtid = blockIdx.x * (NWAVES * 64) + tid, gthreads = G * NWAVES * 64, gw = blockIdx.x * NWAVES + wave, ngw = G * NWAVES; (void)lane; (void)wave; (void)gtid; (void)gthreads; (void)gw; (void)ngw;
__global__ void __launch_bounds__(NWAVES * 64, 2) fwd_kernel(Args a) {
    extern __shared__ __attribute__((aligned(16))) unsigned char lds_raw[];
    LAS unsigned char* lds = (LAS unsigned char*)lds_raw;
    const int lo = a.ph_lo, hi = a.ph_hi;
#define IN(k) (lo <= (k) && (k) < hi)
#define SEAM(k) do { if (IN(k) && IN((k) + 1)) cg::this_grid().sync(); } while (0)
    if (IN(0)) { IDS(); ph_prologue(a, gtid, gthreads, gw, ngw, lane); }
    SEAM(0);
    if (IN(1)) {
        unsigned char* ws = a.ws;
        pg8::Gemm g{(const bf16*)(ws + WS_HB), (const bf16*)(ws + WS_W1T), NTOK, N1, DM}; pg8::StaticOrder S; S.init(NTOK, N1, (int)gridDim.x, (int)blockIdx.x);
        pg8::EpiStore E{(bf16*)(ws + WS_P1), N1, nullptr};
        pg8::gemm_phase<pg8::EpiStore, pg8::StaticOrder, true, true>(lds, g, S, E);
    }
    SEAM(1);
    if (IN(2)) { IDS(); ph_cnorm_pool(a, gw, ngw, lane); }
    SEAM(2);
    if (IN(3)) { IDS(); ph_attn_naive(a, lds, wave, gw, ngw, lane); }
    SEAM(3);
    if (IN(4)) {
        unsigned char* ws = a.ws;
        pg8::Gemm g{(const bf16*)(ws + WS_MIX), (const bf16*)(ws + WS_W2T), NTOK, DM, K2}; pg8::StaticOrder S; S.init(NTOK, DM, (int)gridDim.x, (int)blockIdx.x);
        pg8::EpiResid<true> E{(const void*)a.x, (bf16*)(ws + WS_X1B), (float*)(ws + WS_CTL)};
        pg8::gemm_phase<pg8::EpiResid<true>, pg8::StaticOrder, true, true>(lds, g, S, E);
    }
    SEAM(4);
#pragma unroll 1
    for (int hsel = 0; hsel < 2; ++hsel) {
        const int p5 = 5 + 2 * hsel;
        if (IN(p5)) {
            unsigned char* ws = a.ws;
            pg8::Gemm g{(const bf16*)(ws + WS_X1B) + (size_t)hsel * (NTOK / 2) * DM, (const bf16*)(ws + WS_W3T), NTOK / 2, N3, DM}; pg8::StaticOrder S; S.init(NTOK / 2, N3, (int)gridDim.x, (int)blockIdx.x);
            pg8::EpiStore E{(bf16*)(ws + WS_RAW), N3, (const float*)(ws + WS_CTL) + hsel * (NTOK / 2)};
            pg8::gemm_phase<pg8::EpiStore, pg8::StaticOrder, true, true>(lds, g, S, E);
        }
        SEAM(p5);
        if (IN(p5 + 1)) { IDS(); ph_conv(a, hsel, gtid, gthreads); }
        SEAM(p5 + 1);
    }
    if (IN(9)) {
        unsigned char* ws = a.ws;
        pg8::Gemm g{(const bf16*)(ws + WS_ACT), (const bf16*)(ws + WS_W4T), NTOK, DM, FF}; pg8::StaticOrder S; S.init(NTOK, DM, (int)gridDim.x, (int)blockIdx.x);
        pg8::EpiResid<false> E{(const void*)(ws + WS_X1B), (bf16*)(ws + WS_X2), (float*)(ws + WS_CTL + 256 * 1024)};
        pg8::gemm_phase<pg8::EpiResid<false>, pg8::StaticOrder, true, true>(lds, g, S, E);
    }
    SEAM(9);
    if (IN(10)) { IDS(); ph_final(a, gw, ngw, lane); }
#undef IN
#undef SEAM
}

extern "C" void kernel_launch(void* const* d_in, const int* in_sizes, int n_in, void* d_out, int out_size, void* d_ws, size_t ws_size, hipStream_t stream) {
    static int grid = 0;
    if (grid == 0) {
        if (n_in != 15 || in_sizes[0] != NTOK * DM || out_size != NTOK * DM || ws_size < WS_END) { fprintf(stderr, "kernel_launch: unexpected shapes / workspace (n_in %d, ws %zu)\n", n_in, ws_size); grid = -1; return; }
        int dev = 0, cus = 0, per_cu = 0;
        hipGetDevice(&dev); hipDeviceGetAttribute(&cus, hipDeviceAttributeMultiprocessorCount, dev);
        if (hipFuncSetAttribute((const void*)fwd_kernel, hipFuncAttributeMaxDynamicSharedMemorySize, LDS_BYTES) != hipSuccess) { fprintf(stderr, "kernel_launch: hipFuncSetAttribute failed\n"); grid = -1; return; }
        if (hipOccupancyMaxActiveBlocksPerMultiprocessor(&per_cu, (const void*)fwd_kernel, NWAVES * 64, LDS_BYTES) != hipSuccess || per_cu < 1) { fprintf(stderr, "kernel_launch: occupancy query says %d\n", per_cu); per_cu = 1; }
        (void)hipGetLastError();
        grid = cus;
        if (grid != 256) fprintf(stderr, "kernel_launch: %d CUs (tuned for 256)\n", grid);
    }
    if (grid < 0) return;
    hipMemsetAsync((char*)d_ws + WS_CTL, 0, CTL_ZERO_BYTES, stream);
    Args a{};
    a.x = (const float*)d_in[0]; a.g_mix = (const float*)d_in[1]; a.w_in = (const float*)d_in[2]; a.g_kv = (const float*)d_in[3]; a.w_uk = (const float*)d_in[4]; a.w_uv = (const float*)d_in[5];
    a.w_pool = (const float*)d_in[6]; a.pool_scale = (const float*)d_in[7]; a.w_o = (const float*)d_in[8]; a.g_ffn = (const float*)d_in[9]; a.w_up = (const float*)d_in[10];
    a.conv_w = (const float*)d_in[11]; a.conv_b = (const float*)d_in[12]; a.w_down = (const float*)d_in[13]; a.g_final = (const float*)d_in[14];
    a.out = (float*)d_out; a.ws = (unsigned char*)d_ws;
#if MK_ONE_LAUNCH
    a.ph_lo = 0; a.ph_hi = NPHASE;
    void* args[] = {&a};
    hipError_t e = hipLaunchCooperativeKernel((const void*)fwd_kernel, dim3(grid), dim3(NWAVES * 64), args, LDS_BYTES, stream);
    if (e != hipSuccess) fprintf(stderr, "cooperative launch failed: %s (grid %d)\n", hipGetErrorString(e), grid);
#else
    for (int ph = 0; ph < NPHASE; ++ph) {
        a.ph_lo = ph; a.ph_hi = ph + 1;
        hipLaunchKernelGGL(fwd_kernel, dim3(grid), dim3(NWAVES * 64), LDS_BYTES, stream, a);
    }
#endif
}
```

```cpp
#include <hip/hip_runtime.h>
#include <hip/hip_cooperative_groups.h>
#include <cstdio>
#include <cstdint>
namespace cg = cooperative_groups;

#ifndef USE_NAIVE_ATTN
#define USE_NAIVE_ATTN 0
#endif
#ifndef MK_ONE_LAUNCH
#define MK_ONE_LAUNCH 1
#endif

namespace pg8 {
#define PG8_LAS __attribute__((address_space(3)))
typedef unsigned short bf16_t;
typedef short bf16x8 __attribute__((ext_vector_type(8)));
typedef float f32x4 __attribute__((ext_vector_type(4)));
typedef unsigned u32x4 __attribute__((ext_vector_type(4)));
constexpr int BM = 256, BK = 64, HALF = 128, HTB = HALF * BK * 2, STAGE_BYTES = 8 * HTB, NXCD = 8, WGM = 8;

__host__ __device__ __forceinline__ int lds_byte(int r, int c) { const int st = (r >> 4) * 2 + (c >> 5), rr = r & 15, cc = c & 31, ob = rr * 64 + cc * 2; return st * 1024 + (ob ^ (((ob >> 9) & 1) << 5)); }
__host__ __device__ __forceinline__ void stage_rc(int b, int& R, int& C) { const int st = b / 1024, sb = b % 1024, swz = sb ^ (((sb >> 9) & 1) << 5); R = (st >> 1) * 16 + swz / 64; C = (st & 1) * 32 + (swz % 64) / 2; }
__host__ __device__ __forceinline__ int perm32(int rho) { const int n = rho >> 4, i = rho & 15; return 8 * (i >> 2) + 4 * n + (i & 3); }

struct Unit { int pm, pn; };
struct Gemm { const bf16_t* A; const bf16_t* Bt; int M, N, K; };

struct StaticOrder {
    int nM, nN, nwg, G, c;
    __host__ __device__ void init(int M, int N, int G_, int c_) { nM = M / BM; nN = N / BM; nwg = nM * nN; G = G_; c = c_; }
    __host__ __device__ bool next(int i, Unit& u) const {
        const long L = (long)i * G + c; if (L >= nwg) return false;
        int wgid = (int)L; { const int q = nwg / NXCD, r = nwg % NXCD, xcd = wgid % NXCD, off = wgid / NXCD; wgid = (xcd < r ? xcd * (q + 1) : r * (q + 1) + (xcd - r) * q) + off; }
        const int nig = WGM * nN, gid = wgid / nig, fm = gid * WGM, gsz = (nM - fm) < WGM ? (nM - fm) : WGM;
        u.pm = fm + ((wgid % nig) % gsz); u.pn = (wgid % nig) / gsz; return true;
    }
    __device__ __forceinline__ void a_ready(const Unit&) const {}
    __device__ __forceinline__ void done(const Unit&) const {}
};

__device__ __forceinline__ unsigned cvt_pk_bf16(float lo, float hi) { unsigned r; asm volatile("v_cvt_pk_bf16_f32 %0, %1, %2" : "=v"(r) : "v"(lo), "v"(hi)); return r; }


struct EpiStore {
    static constexpr bool PERM = true, AFTER_DRAIN = false;
    bf16_t* O; int ldc; const float* sumsq;
    __device__ __forceinline__ void operator()(const f32x4 (&acc)[2][2][4][2], const Unit& u, int wr, int wc, int fr, int fq) const {
        const int row0 = u.pm * BM + wr * 64 + fr, col0 = u.pn * BM + wc * 32 + 8 * fq;
#pragma unroll
        for (int ai = 0; ai < 2; ++ai)
#pragma unroll
            for (int m = 0; m < 4; ++m) {
                const int row = row0 + ai * HALF + m * 16;
                float sc = 1.f; if (sumsq) sc = 1.0f / sqrtf(sumsq[row] * (1.0f / 1024.0f) + 1e-6f);
                bf16_t* rowp = O + (size_t)row * ldc + col0;
#pragma unroll
                for (int bj = 0; bj < 2; ++bj) { f32x4 v0 = acc[ai][bj][m][0] * sc, v1 = acc[ai][bj][m][1] * sc;
                    u32x4 w; w.x = cvt_pk_bf16(v0[0], v0[1]); w.y = cvt_pk_bf16(v0[2], v0[3]); w.z = cvt_pk_bf16(v1[0], v1[1]); w.w = cvt_pk_bf16(v1[2], v1[3]);
                    *(u32x4*)(rowp + bj * HALF) = w; } }
    }
};
template <bool BASE_F32> struct EpiResid {
    static constexpr bool PERM = true, AFTER_DRAIN = false;
    const void* base; bf16_t* O; float* sumsq;
    __device__ __forceinline__ void operator()(const f32x4 (&acc)[2][2][4][2], const Unit& u, int wr, int wc, int fr, int fq) const {
        const int row0 = u.pm * BM + wr * 64 + fr, col0 = u.pn * BM + wc * 32 + 8 * fq;
#pragma unroll
        for (int ai = 0; ai < 2; ++ai)
#pragma unroll
            for (int m = 0; m < 4; ++m) {
                const int row = row0 + ai * HALF + m * 16; float ss = 0.f;
#pragma unroll
                for (int bj = 0; bj < 2; ++bj) {
                    const size_t off = (size_t)row * 1024 + col0 + bj * HALF;
                    f32x4 b0, b1;
                    if (BASE_F32) { b0 = *(const f32x4*)((const float*)base + off); b1 = *(const f32x4*)((const float*)base + off + 4); }
                    else { const u32x4 r = *(const u32x4*)((const bf16_t*)base + off);
                        b0[0] = __uint_as_float(r.x << 16); b0[1] = __uint_as_float(r.x & 0xffff0000u); b0[2] = __uint_as_float(r.y << 16); b0[3] = __uint_as_float(r.y & 0xffff0000u);
                        b1[0] = __uint_as_float(r.z << 16); b1[1] = __uint_as_float(r.z & 0xffff0000u); b1[2] = __uint_as_float(r.w << 16); b1[3] = __uint_as_float(r.w & 0xffff0000u); }
                    const f32x4 v0 = acc[ai][bj][m][0] + b0, v1 = acc[ai][bj][m][1] + b1;
                    ss += (v0[0] * v0[0] + v0[1] * v0[1]) + (v0[2] * v0[2] + v0[3] * v0[3]) + (v1[0] * v1[0] + v1[1] * v1[1]) + (v1[2] * v1[2] + v1[3] * v1[3]);
                    u32x4 w; w.x = cvt_pk_bf16(v0[0], v0[1]); w.y = cvt_pk_bf16(v0[2], v0[3]); w.z = cvt_pk_bf16(v1[0], v1[1]); w.w = cvt_pk_bf16(v1[2], v1[3]);
                    *(u32x4*)(O + off) = w; }
                ss += __shfl_xor(ss, 16); ss += __shfl_xor(ss, 32);
                if (fq == 0) atomicAdd(sumsq + row, ss);
            }
    }
};

template <class Epi, class Sched, bool ALIGN_EPI = false, bool SP2 = false>
__device__ __forceinline__ void gemm_phase(PG8_LAS unsigned char* lds, const Gemm g, const Sched& S, const Epi& E) {
    const int tid = threadIdx.x, wid = __builtin_amdgcn_readfirstlane(tid >> 6), lane = tid & 63, wr = wid >> 2, wc = wid & 3, fr = lane & 15, fq = lane >> 4;
    const int K = g.K, nt = K / BK;
    unsigned voffA[2], voffB[2];
#pragma unroll
    for (int i = 0; i < 2; ++i) { int R, C; stage_rc(tid * 16 + i * 8192, R, C); const int Rb = Epi::PERM ? ((R & ~31) + perm32(R & 31)) : R;
        voffA[i] = (unsigned)(R * K + C) * 2u; voffB[i] = (unsigned)(Rb * K + C) * 2u; }
    const size_t kstep = (size_t)(BK * 2);
    const size_t hstep = (size_t)HALF * K * 2;
    const size_t tstep = 2 * hstep;
    const unsigned ldsw = (unsigned)wid * 1024u;
    const int aoff = lds_byte(wr * 64 + fr, fq * 8), boff = lds_byte(wc * 32 + fr, fq * 8);
#define PG8_SA(b, h) (((b) * 2 + (h)) * HTB)
#define PG8_SB(b, h) ((4 + (b) * 2 + (h)) * HTB)
#define PG8_STAGE(bufoff, gbase, voff) do { _Pragma("unroll") for (int _i = 0; _i < 2; ++_i) \
        __builtin_amdgcn_global_load_lds((const unsigned*)((const char*)(gbase) + (voff)[_i]), (PG8_LAS unsigned*)(lds + (bufoff) + ldsw + _i * 8192), 16, 0, 0); } while (0)
#define PG8_LDA(dst, b, h) do { _Pragma("unroll") for (int m = 0; m < 4; ++m) _Pragma("unroll") for (int k = 0; k < 2; ++k) dst[m][k] = *(const PG8_LAS bf16x8*)(lds + PG8_SA(b, h) + aoff + m * 2048 + k * 1024); } while (0)
#define PG8_LDB(dst, b, h) do { _Pragma("unroll") for (int n = 0; n < 2; ++n) _Pragma("unroll") for (int k = 0; k < 2; ++k) dst[n][k] = *(const PG8_LAS bf16x8*)(lds + PG8_SB(b, h) + boff + n * 2048 + k * 1024); } while (0)
#define PG8_MMA(ai, bj, At, Bt) do { __builtin_amdgcn_s_setprio(1); _Pragma("unroll") for (int m = 0; m < 4; ++m) _Pragma("unroll") for (int n = 0; n < 2; ++n) _Pragma("unroll") for (int k = 0; k < 2; ++k) \
        acc[ai][bj][m][n] = __builtin_amdgcn_mfma_f32_16x16x32_bf16(Bt[n][k], At[m][k], acc[ai][bj][m][n], 0, 0, 0); __builtin_amdgcn_s_setprio(0); } while (0)
#define PG8_WAIT_V(n) asm volatile("s_waitcnt vmcnt(" #n ")" ::: "memory")
#define PG8_WAIT_L(n) asm volatile("s_waitcnt lgkmcnt(" #n ")" ::: "memory")
#define PG8_BAR __builtin_amdgcn_s_barrier()
#define PG8_SCHED __builtin_amdgcn_sched_barrier(0)
    Unit cur, nxt; int ui = 0;
    if (!S.next(0, cur)) return;
    f32x4 acc[2][2][4][2];
#pragma unroll
    for (int a = 0; a < 2; ++a)
#pragma unroll
        for (int b = 0; b < 2; ++b)
#pragma unroll
            for (int m = 0; m < 4; ++m)
#pragma unroll
                for (int n = 0; n < 2; ++n) acc[a][b][m][n] = (f32x4){0.f, 0.f, 0.f, 0.f};
    bf16x8 At[4][2], B0[2][2], B1[2][2];
    const char* cA = (const char*)g.A + (size_t)cur.pm * tstep; const char* cB = (const char*)g.Bt + (size_t)cur.pn * tstep;
    S.a_ready(cur);
    if constexpr (SP2) {
        PG8_STAGE(PG8_SB(0, 0), cB, voffB); PG8_STAGE(PG8_SB(0, 1), cB + hstep, voffB); PG8_STAGE(PG8_SA(0, 0), cA, voffA); PG8_STAGE(PG8_SA(0, 1), cA + hstep, voffA);
        if (wr == 1) PG8_BAR;
        PG8_WAIT_V(2); PG8_BAR;
        PG8_STAGE(PG8_SB(1, 0), cB + kstep, voffB); PG8_STAGE(PG8_SA(1, 0), cA + kstep, voffA); PG8_STAGE(PG8_SB(1, 1), cB + hstep + kstep, voffB);
        PG8_WAIT_V(6); PG8_BAR;
    } else {
        PG8_STAGE(PG8_SB(0, 0), cB, voffB); PG8_STAGE(PG8_SA(0, 0), cA, voffA); PG8_STAGE(PG8_SB(0, 1), cB + hstep, voffB); PG8_STAGE(PG8_SA(0, 1), cA + hstep, voffA);
        if (wr == 1) PG8_BAR;
        PG8_WAIT_V(4); PG8_BAR;
        PG8_STAGE(PG8_SB(1, 0), cB + kstep, voffB); PG8_STAGE(PG8_SA(1, 0), cA + kstep, voffA); PG8_STAGE(PG8_SB(1, 1), cB + hstep + kstep, voffB);
        PG8_WAIT_V(6); PG8_BAR;
    }
    for (;;) {
        const bool has_next = S.next(ui + 1, nxt);
        const char* nA = has_next ? (const char*)g.A + (size_t)nxt.pm * tstep : cA; const char* nB = has_next ? (const char*)g.Bt + (size_t)nxt.pn * tstep : cB;
        for (int t = 0; t < nt; t += 2) {
            const bool last = (t == nt - 2);
            const char* a1 = cA + (size_t)(t + 1) * kstep;
            const char* a2 = last ? nA : cA + (size_t)(t + 2) * kstep; const char* b2 = last ? nB : cB + (size_t)(t + 2) * kstep;
            const char* a3 = a2 + kstep; const char* b3 = b2 + kstep;
            if (last && has_next) S.a_ready(nxt);
            if constexpr (SP2) {
            PG8_LDB(B0, 0, 0); PG8_LDB(B1, 0, 1); PG8_SCHED; PG8_LDA(At, 0, 0); PG8_STAGE(PG8_SA(1, 1), a1 + hstep, voffA);
            PG8_WAIT_V(8); PG8_WAIT_L(0); PG8_BAR; PG8_MMA(0, 0, At, B0); PG8_MMA(0, 1, At, B1); PG8_BAR; PG8_SCHED;
            PG8_LDA(At, 0, 1); PG8_STAGE(PG8_SB(0, 0), b2, voffB); PG8_STAGE(PG8_SB(0, 1), b2 + hstep, voffB); PG8_STAGE(PG8_SA(0, 0), a2, voffA);
            PG8_WAIT_V(8); PG8_WAIT_L(0); PG8_BAR; PG8_MMA(1, 0, At, B0); PG8_MMA(1, 1, At, B1); PG8_BAR; PG8_SCHED;
            PG8_LDB(B0, 1, 0); PG8_LDB(B1, 1, 1); PG8_SCHED; PG8_LDA(At, 1, 0); PG8_STAGE(PG8_SA(0, 1), a2 + hstep, voffA);
            PG8_WAIT_V(8); PG8_WAIT_L(0); PG8_BAR; PG8_MMA(0, 0, At, B0); PG8_MMA(0, 1, At, B1); PG8_BAR; PG8_SCHED;
            PG8_LDA(At, 1, 1); PG8_STAGE(PG8_SB(1, 0), b3, voffB); PG8_STAGE(PG8_SB(1, 1), b3 + hstep, voffB); PG8_STAGE(PG8_SA(1, 0), a3, voffA);
            PG8_WAIT_V(8); PG8_WAIT_L(0); PG8_BAR; PG8_MMA(1, 0, At, B0); PG8_MMA(1, 1, At, B1); PG8_BAR; PG8_SCHED;
            } else {
            PG8_LDB(B0, 0, 0); PG8_SCHED; PG8_LDA(At, 0, 0); PG8_STAGE(PG8_SA(1, 1), a1 + hstep, voffA);
            PG8_WAIT_L(8); PG8_BAR; PG8_WAIT_L(0); PG8_MMA(0, 0, At, B0); PG8_BAR; PG8_SCHED;
            PG8_LDB(B1, 0, 1); PG8_STAGE(PG8_SB(0, 0), b2, voffB);
            PG8_BAR; PG8_WAIT_L(0); PG8_MMA(0, 1, At, B1); PG8_BAR;
            PG8_LDA(At, 0, 1); PG8_STAGE(PG8_SA(0, 0), a2, voffA);
            PG8_BAR; PG8_WAIT_L(0); PG8_MMA(1, 0, At, B0); PG8_BAR; PG8_SCHED;
            PG8_STAGE(PG8_SB(0, 1), b2 + hstep, voffB);
            PG8_WAIT_V(6); PG8_BAR; PG8_MMA(1, 1, At, B1); PG8_BAR;
            PG8_LDB(B0, 1, 0); PG8_SCHED; PG8_LDA(At, 1, 0); PG8_STAGE(PG8_SA(0, 1), a2 + hstep, voffA);
            PG8_WAIT_L(8); PG8_BAR; PG8_WAIT_L(0); PG8_MMA(0, 0, At, B0); PG8_BAR; PG8_SCHED;
            PG8_LDB(B1, 1, 1); PG8_STAGE(PG8_SB(1, 0), b3, voffB);
            PG8_BAR; PG8_WAIT_L(0); PG8_MMA(0, 1, At, B1); PG8_BAR;
            PG8_LDA(At, 1, 1); PG8_STAGE(PG8_SA(1, 0), a3, voffA);
            PG8_BAR; PG8_WAIT_L(0); PG8_MMA(1, 0, At, B0); PG8_BAR; PG8_SCHED;
            PG8_STAGE(PG8_SB(1, 1), b3 + hstep, voffB);
            PG8_WAIT_V(6); PG8_BAR; PG8_MMA(1, 1, At, B1); PG8_BAR;
            }
        }
        if constexpr (ALIGN_EPI) { if (wr == 0) PG8_BAR; }
        if constexpr (!Epi::AFTER_DRAIN) { E(acc, cur, wr, wc, fr, fq); S.done(cur); }
        if (!has_next) break;
#pragma unroll
        for (int a = 0; a < 2; ++a)
#pragma unroll
            for (int b = 0; b < 2; ++b)
#pragma unroll
                for (int m = 0; m < 4; ++m)
#pragma unroll
                    for (int n = 0; n < 2; ++n) acc[a][b][m][n] = (f32x4){0.f, 0.f, 0.f, 0.f};
        cur = nxt; cA = nA; cB = nB; ++ui;
        if constexpr (ALIGN_EPI) { if (wr == 1) PG8_BAR; }
    }
    PG8_WAIT_V(0);
    if constexpr (!ALIGN_EPI) { if (wr == 0) PG8_BAR; }
    PG8_BAR;
#undef PG8_SA
#undef PG8_SB
#undef PG8_STAGE
#undef PG8_LDA
#undef PG8_LDB
#undef PG8_MMA
#undef PG8_WAIT_V
#undef PG8_WAIT_L
#undef PG8_BAR
#undef PG8_SCHED
}
}

constexpr int NWAVES = 8;
constexpr int BATCH = 32, SEQ = 2048, DM = 1024, NTOK = BATCH * SEQ;
constexpr int IN_COLS = 1736;
constexpr int N1 = 2304, K2 = 1536, FF = 2816, N3 = 2 * FF;
constexpr int OFF_QL = 0, OFF_QI = 1024, OFF_U = 1536, OFF_C = 2048, OFF_KI = 2176, OFF_WI = 2240;
constexpr float EPS = 1e-6f;
constexpr float WI_SCALE = 0.044194173824159216f;

constexpr size_t MiB = 1u << 20;
constexpr size_t WS_CTL = 0, CTL_ZERO_BYTES = 1 * MiB;
constexpr size_t WS_W1T = 1 * MiB, WS_W2T = 6 * MiB, WS_W3T = 9 * MiB, WS_W4T = 20 * MiB, WS_CONVP = 26 * MiB;
constexpr size_t WS_HB = 32 * MiB;
constexpr size_t WS_P1 = 160 * MiB;
constexpr size_t WS_RAW = 32 * MiB;
constexpr size_t WS_X2 = 32 * MiB;
constexpr size_t WS_MIX = 448 * MiB;
constexpr size_t WS_CN = 640 * MiB;
constexpr size_t WS_ACT = 448 * MiB;
constexpr size_t WS_X1B = 800 * MiB;
constexpr size_t WS_END = 928 * MiB;

constexpr int LDS_BYTES = 147456;

#define GAS __attribute__((address_space(1)))
#define LAS __attribute__((address_space(3)))
typedef unsigned short bf16;
typedef unsigned v4u __attribute__((ext_vector_type(4)));
typedef unsigned v2u __attribute__((ext_vector_type(2)));
typedef float f32x4 __attribute__((ext_vector_type(4)));

__device__ __forceinline__ unsigned f2bf(float f) { unsigned u = __builtin_bit_cast(unsigned, f); return (u + 0x7fffu + ((u >> 16) & 1u)) >> 16; }
__device__ __forceinline__ unsigned pk2(float lo, float hi) { return f2bf(lo) | (f2bf(hi) << 16); }
__device__ __forceinline__ float bflo(unsigned u) { return __uint_as_float(u << 16); }
__device__ __forceinline__ float bfhi(unsigned u) { return __uint_as_float(u & 0xffff0000u); }
__device__ __forceinline__ float wave_sum(float v) {
#pragma unroll
    for (int o = 1; o < 64; o <<= 1) v += __shfl_xor(v, o);
    return v;
}
__device__ __forceinline__ float wave_max(float v) {
#pragma unroll
    for (int o = 1; o < 64; o <<= 1) v = fmaxf(v, __shfl_xor(v, o));
    return v;
}
#define WAVE_LDS_SYNC() do { asm volatile("s_waitcnt lgkmcnt(0)" ::: "memory"); __builtin_amdgcn_wave_barrier(); } while (0)

struct Args {
    const float* x; const float* g_mix; const float* w_in; const float* g_kv; const float* w_uk; const float* w_uv; const float* w_pool; const float* pool_scale;
    const float* w_o; const float* g_ffn; const float* w_up; const float* conv_w; const float* conv_b; const float* w_down; const float* g_final;
    float* out; unsigned char* ws; int ph_lo, ph_hi;
};

__device__ __forceinline__ void ph_prologue(const Args& a, int gtid, int gthreads, int gw, int ngw, int lane) {
    unsigned char* ws = a.ws;
    bf16* W1T = (bf16*)(ws + WS_W1T); bf16* W2T = (bf16*)(ws + WS_W2T); bf16* W3T = (bf16*)(ws + WS_W3T); bf16* W4T = (bf16*)(ws + WS_W4T);
    float* CONVP = (float*)(ws + WS_CONVP);
    for (int i = gtid; i < N1 * DM; i += gthreads) {
        const int n = i >> 10, k = i & 1023; float v;
        const float* wr = a.w_in + (size_t)k * IN_COLS;
        if (n < 1024) { const int hd = n >> 7, c = n & 127; float s = 0.f;
            for (int d = 0; d < 64; ++d) s += wr[hd * 64 + d] * a.w_uk[(hd * 64 + d) * 128 + c];
            v = s; }
        else if (n < 1536) v = wr[640 + (n - 1024)];
        else if (n < 2048) v = wr[1224 + (n - 1536)];
        else if (n < 2176) v = wr[512 + (n - 2048)];
        else if (n < 2240) v = wr[1152 + (n - 2176)];
        else if (n < 2248) v = wr[1216 + (n - 2240)] * WI_SCALE;
        else v = 0.f;
        W1T[i] = (bf16)f2bf(v);
    }
    for (int i = gtid; i < DM * K2; i += gthreads) {
        const int n = i / K2, k = i - n * K2; float s = 0.f;
        if (k < 1024) { const int hd = k >> 7, c = k & 127;
            for (int d = 0; d < 64; ++d) s += a.w_uv[(hd * 128 + c) * 64 + d] * a.w_o[(size_t)(hd * 64 + d) * 1024 + n]; }
        else { const int kk = k - 1024, g = kk >> 7, ci = kk & 127;
            for (int dd = 0; dd < 128; ++dd) s += a.w_pool[(g * 128 + ci) * 128 + dd] * a.pool_scale[g * 128 + dd] * a.w_o[(size_t)(512 + g * 128 + dd) * 1024 + n]; }
        W2T[i] = (bf16)f2bf(s);
    }
    for (int i = gtid; i < N3 * DM; i += gthreads) {
        const int r = i >> 10, k = i & 1023, j = r >> 8, ii = r & 255;
        const int col = (ii < 128) ? (128 * j + ii) : (FF + 128 * j + (ii - 128));
        W3T[i] = (bf16)f2bf(a.w_up[(size_t)k * N3 + col] * a.g_ffn[k]);
    }
    for (int r = gtid; r < N3; r += gthreads) {
        const int j = r >> 8, ii = r & 255; const int col = (ii < 128) ? (128 * j + ii) : (FF + 128 * j + (ii - 128));
        CONVP[r] = a.conv_w[col]; CONVP[N3 + r] = a.conv_w[N3 + col]; CONVP[2 * N3 + r] = a.conv_w[2 * N3 + col]; CONVP[3 * N3 + r] = a.conv_b[col];
    }
    for (int i = gtid; i < DM * FF; i += gthreads) {
        const int n = i / FF, k = i - n * FF;
        W4T[i] = (bf16)f2bf(a.w_down[(size_t)k * 1024 + n]);
    }
    bf16* HB = (bf16*)(ws + WS_HB);
    for (int m = gw; m < NTOK; m += ngw) {
        const f32x4* xr = (const f32x4*)(a.x + (size_t)m * DM) + lane;
        f32x4 v[4]; float s = 0.f;
#pragma unroll
        for (int j = 0; j < 4; ++j) { v[j] = xr[64 * j]; s += (v[j].x * v[j].x + v[j].y * v[j].y) + (v[j].z * v[j].z + v[j].w * v[j].w); }
        const float rinv = 1.0f / sqrtf(wave_sum(s) * (1.0f / DM) + EPS);
        unsigned long long* o8 = (unsigned long long*)(HB + (size_t)m * DM) + lane;
#pragma unroll
        for (int j = 0; j < 4; ++j) { const f32x4 g = ((const f32x4*)a.g_mix)[lane + 64 * j];
            o8[64 * j] = (unsigned long long)pk2(v[j].x * rinv * g.x, v[j].y * rinv * g.y) | ((unsigned long long)pk2(v[j].z * rinv * g.z, v[j].w * rinv * g.w) << 32); }
    }
}

__device__ __forceinline__ void ph_cnorm_pool(const Args& a, int gw, int ngw, int lane) {
    const bf16* P1 = (const bf16*)(a.ws + WS_P1); bf16* CN = (bf16*)(a.ws + WS_CN); bf16* MIX = (bf16*)(a.ws + WS_MIX);
    for (int tok = gw; tok < NTOK; tok += ngw) {
        const bf16* prow = P1 + (size_t)tok * N1;
        const unsigned cw = *(const unsigned*)(prow + OFF_C + 2 * lane);
        const float c0 = bflo(cw), c1 = bfhi(cw);
        const float rinv = 1.0f / sqrtf(wave_sum(c0 * c0 + c1 * c1) * (1.0f / 128.0f) + EPS);
        *(unsigned*)(CN + (size_t)tok * 128 + 2 * lane) = pk2(c0 * rinv * a.g_kv[2 * lane], c1 * rinv * a.g_kv[2 * lane + 1]);
        const int pos = tok & (SEQ - 1), win = 2 << (lane >> 4), cnt = (pos + 1 < win) ? pos + 1 : win;
        float s[8];
#pragma unroll
        for (int j = 0; j < 8; ++j) s[j] = 0.f;
        v4u u0 = (v4u){0, 0, 0, 0};
        for (int j = 0; j < cnt; ++j) {
            const v4u u = *(const v4u*)(prow - (size_t)j * N1 + OFF_U + 8 * lane);
            if (j == 0) u0 = u;
            s[0] += bflo(u.x); s[1] += bfhi(u.x); s[2] += bflo(u.y); s[3] += bfhi(u.y); s[4] += bflo(u.z); s[5] += bfhi(u.z); s[6] += bflo(u.w); s[7] += bfhi(u.w);
        }
        const float ic = 1.0f / (float)cnt;
        v4u o; o.x = pk2(s[0] * ic - bflo(u0.x), s[1] * ic - bfhi(u0.x)); o.y = pk2(s[2] * ic - bflo(u0.y), s[3] * ic - bfhi(u0.y));
        o.z = pk2(s[4] * ic - bflo(u0.z), s[5] * ic - bfhi(u0.z)); o.w = pk2(s[6] * ic - bflo(u0.w), s[7] * ic - bfhi(u0.w));
        *(v4u*)(MIX + (size_t)tok * K2 + 1024 + 8 * lane) = o;
    }
}

__device__ __forceinline__ void ph_attn_naive(const Args& a, LAS unsigned char* lds, int wave, int gw, int ngw, int lane) {
    const bf16* P1 = (const bf16*)(a.ws + WS_P1); const bf16* CN = (const bf16*)(a.ws + WS_CN); bf16* MIX = (bf16*)(a.ws + WS_MIX);
    LAS unsigned char* base = lds + wave * 16384;
    LAS unsigned* uk = (LAS unsigned*)base;
    LAS float* pb = (LAS float*)base;
    LAS float* qi = (LAS float*)(base + 8192);
    LAS float* ql = (LAS float*)(base + 10240);
    LAS int* idx = (LAS int*)(base + 14336);
    LAS float* wl = (LAS float*)(base + 15360);
    const unsigned long long lt_mask = (lane == 0) ? 0ull : (~0ull >> (64 - lane));
    for (int q = gw; q < NTOK; q += ngw) {
        const int b = q >> 11, pos = q & (SEQ - 1), n = ((pos >> 6) + 1) << 6;
        const bf16* prow = P1 + (size_t)q * N1;
        { const v4u t = *(const v4u*)(prow + OFF_QI + 8 * lane);
          qi[8 * lane + 0] = bflo(t.x); qi[8 * lane + 1] = bfhi(t.x); qi[8 * lane + 2] = bflo(t.y); qi[8 * lane + 3] = bfhi(t.y);
          qi[8 * lane + 4] = bflo(t.z); qi[8 * lane + 5] = bfhi(t.z); qi[8 * lane + 6] = bflo(t.w); qi[8 * lane + 7] = bfhi(t.w); }
#pragma unroll
        for (int h2 = 0; h2 < 2; ++h2) { const v4u t = *(const v4u*)(prow + OFF_QL + 16 * lane + 8 * h2); const int o = 16 * lane + 8 * h2;
          ql[o + 0] = bflo(t.x); ql[o + 1] = bfhi(t.x); ql[o + 2] = bflo(t.y); ql[o + 3] = bfhi(t.y); ql[o + 4] = bflo(t.z); ql[o + 5] = bfhi(t.z); ql[o + 6] = bflo(t.w); ql[o + 7] = bfhi(t.w); }
        if (lane < 4) { const unsigned t = *(const unsigned*)(prow + OFF_WI + 2 * lane); wl[2 * lane] = bflo(t); wl[2 * lane + 1] = bfhi(t); }
        WAVE_LDS_SYNC();
        const int nk = n >> 6;
        for (int i = 0; i < nk; ++i) {
            const int key = i * 64 + lane;
            const v4u* kr = (const v4u*)(P1 + (size_t)(b * SEQ + key) * N1 + OFF_KI);
            v4u k8[8];
#pragma unroll
            for (int j = 0; j < 8; ++j) k8[j] = kr[j];
            float s = 0.f;
#pragma unroll 1
            for (int hd = 0; hd < 8; ++hd) { float d0 = 0.f, d1 = 0.f;
#pragma unroll
                for (int j = 0; j < 8; ++j) { const f32x4 qa = *(const LAS f32x4*)(qi + hd * 64 + 8 * j), qb = *(const LAS f32x4*)(qi + hd * 64 + 8 * j + 4); const v4u t = k8[j];
                    d0 += (qa.x * bflo(t.x) + qa.z * bflo(t.y)) + (qb.x * bflo(t.z) + qb.z * bflo(t.w));
                    d1 += (qa.y * bfhi(t.x) + qa.w * bfhi(t.y)) + (qb.y * bfhi(t.z) + qb.w * bfhi(t.w)); }
                s += wl[hd] * fmaxf(d0 + d1, 0.f); }
            s += 0.0f;
            unsigned u = __float_as_uint(s); u = (u & 0x80000000u) ? ~u : (u | 0x80000000u);
            uk[key] = u;
        }
        WAVE_LDS_SYNC();
        int nsel;
        if (n <= 256) { for (int j = lane; j < n; j += 64) idx[j] = j; nsel = n; }
        else {
            unsigned prefix = 0u;
            for (int bit = 31; bit >= 0; --bit) {
                const unsigned cand = prefix | (1u << bit); int cnt = 0;
                for (int i = 0; i < nk; ++i) cnt += __popcll(__ballot(uk[i * 64 + lane] >= cand));
                if (cnt >= 256) prefix = cand;
            }
            int cgt = 0;
            for (int i = 0; i < nk; ++i) cgt += __popcll(__ballot(uk[i * 64 + lane] > prefix));
            const int need = 256 - cgt; int basep = 0, eqrun = 0;
            for (int i = 0; i < nk; ++i) {
                const unsigned u = uk[i * 64 + lane]; const bool gt = u > prefix, eq = (u == prefix);
                const unsigned long long eqm = __ballot(eq);
                const int rank = eqrun + __popcll(eqm & lt_mask);
                const bool sel = gt || (eq && rank < need);
                const unsigned long long sm = __ballot(sel);
                if (sel) idx[basep + __popcll(sm & lt_mask)] = i * 64 + lane;
                basep += __popcll(sm); eqrun += __popcll(eqm);
            }
            nsel = 256;
        }
        WAVE_LDS_SYNC();
#pragma unroll 1
        for (int jj = 0; jj < 4; ++jj) {
            const int j = jj * 64 + lane; const bool valid = j < nsel; const int key = valid ? idx[j] : 0;
            const v4u* cr = (const v4u*)(CN + (size_t)(b * SEQ + key) * 128);
            float dot[8];
#pragma unroll
            for (int hd = 0; hd < 8; ++hd) dot[hd] = 0.f;
#pragma unroll 2
            for (int c8 = 0; c8 < 16; ++c8) { const v4u t = cr[c8];
                const float c0 = bflo(t.x), c1 = bfhi(t.x), c2 = bflo(t.y), c3 = bfhi(t.y), c4 = bflo(t.z), c5 = bfhi(t.z), c6 = bflo(t.w), c7 = bfhi(t.w);
#pragma unroll
                for (int hd = 0; hd < 8; ++hd) { const f32x4 qa = *(const LAS f32x4*)(ql + hd * 128 + c8 * 8), qb = *(const LAS f32x4*)(ql + hd * 128 + c8 * 8 + 4);
                    dot[hd] += (qa.x * c0 + qa.y * c1) + (qa.z * c2 + qa.w * c3) + (qb.x * c4 + qb.y * c5) + (qb.z * c6 + qb.w * c7); } }
            const float dist = fabsf((float)(pos - key));
#pragma unroll
            for (int hd = 0; hd < 8; ++hd) { const float slope = __uint_as_float((unsigned)(127 - (hd + 1)) << 23);
                pb[hd * 256 + j] = valid ? (dot[hd] * 0.125f - slope * dist) : -__builtin_inff(); }
        }
        WAVE_LDS_SYNC();
#pragma unroll 1
        for (int hd = 0; hd < 8; ++hd) {
            float p[4];
#pragma unroll
            for (int jj = 0; jj < 4; ++jj) p[jj] = pb[hd * 256 + jj * 64 + lane];
            float m = fmaxf(fmaxf(p[0], p[1]), fmaxf(p[2], p[3])); m = wave_max(m);
            float s = 0.f;
#pragma unroll
            for (int jj = 0; jj < 4; ++jj) { p[jj] = __expf(p[jj] - m); s += p[jj]; }
            s = wave_sum(s); const float inv = 1.0f / s;
#pragma unroll
            for (int jj = 0; jj < 4; ++jj) pb[hd * 256 + jj * 64 + lane] = p[jj] * inv;
        }
        WAVE_LDS_SYNC();
        float o0[8], o1[8];
#pragma unroll
        for (int hd = 0; hd < 8; ++hd) { o0[hd] = 0.f; o1[hd] = 0.f; }
        for (int j = 0; j < nsel; j += 4) {
            unsigned cw[4];
#pragma unroll
            for (int t = 0; t < 4; ++t) cw[t] = *(const unsigned*)(CN + (size_t)(b * SEQ + idx[j + t]) * 128 + 2 * lane);
#pragma unroll
            for (int t = 0; t < 4; ++t) { const float c0 = bflo(cw[t]), c1 = bfhi(cw[t]);
#pragma unroll
                for (int hd = 0; hd < 8; ++hd) { const float p = pb[hd * 256 + j + t]; o0[hd] += p * c0; o1[hd] += p * c1; } }
        }
#pragma unroll
        for (int hd = 0; hd < 8; ++hd) *(unsigned*)(MIX + (size_t)q * K2 + hd * 128 + 2 * lane) = pk2(o0[hd], o1[hd]);
        WAVE_LDS_SYNC();
    }
}

namespace dsa {
using bf16x8 = __attribute__((ext_vector_type(8))) short;
using s16x4  = __attribute__((ext_vector_type(4))) short;
using f32x16 = __attribute__((ext_vector_type(16))) float;
using u32x4  = __attribute__((ext_vector_type(4))) unsigned;
constexpr int NW = 8, KVBLK = 64;
constexpr float SCALE = 0.125f, LOG2E = 1.4426950408889634f, THR = 8.f;
constexpr int SHM_V = KVBLK * 128 * 2, SHM_K = KVBLK * 128 * 2, SHM_ATTN = 2 * SHM_V + 2 * SHM_K + NW * 64 * 4;
constexpr unsigned NEG2 = 0xC6EAC6EAu;
#define KSWZ(row, colB) ((row) * 256 + ((colB) ^ (((row) & 7) << 4)))
#define SBAR() __builtin_amdgcn_sched_barrier(0)
__device__ __forceinline__ int crow(int r, int hi) { return (r & 3) + 8 * (r >> 2) + 4 * hi; }
__device__ __forceinline__ unsigned cvtpk(float lo, float hi) { unsigned r; asm volatile("v_cvt_pk_bf16_f32 %0, %1, %2" : "=v"(r) : "v"(lo), "v"(hi)); return r; }

template <int CTRL> __device__ __forceinline__ unsigned dppu(unsigned x) { return (unsigned)__builtin_amdgcn_update_dpp(0, (int)x, CTRL, 0xf, 0xf, true); }
__device__ __forceinline__ unsigned half_sum(unsigned x, int h) {
    x += dppu<0xB1>(x); x += dppu<0x4E>(x); x += dppu<0x141>(x); x += dppu<0x140>(x);
    const unsigned a = __builtin_amdgcn_readlane(x, 0) + __builtin_amdgcn_readlane(x, 16), b = __builtin_amdgcn_readlane(x, 32) + __builtin_amdgcn_readlane(x, 48);
    return h ? b : a;
}
__device__ __forceinline__ unsigned half_min(unsigned x, int h) {
    x = min(x, dppu<0xB1>(x)); x = min(x, dppu<0x4E>(x)); x = min(x, dppu<0x141>(x)); x = min(x, dppu<0x140>(x));
    const unsigned a = min((unsigned)__builtin_amdgcn_readlane(x, 0), (unsigned)__builtin_amdgcn_readlane(x, 16)), b = min((unsigned)__builtin_amdgcn_readlane(x, 32), (unsigned)__builtin_amdgcn_readlane(x, 48));
    return h ? b : a;
}
__device__ __forceinline__ unsigned half_max(unsigned x, int h) {
    x = max(x, dppu<0xB1>(x)); x = max(x, dppu<0x4E>(x)); x = max(x, dppu<0x141>(x)); x = max(x, dppu<0x140>(x));
    const unsigned a = max((unsigned)__builtin_amdgcn_readlane(x, 0), (unsigned)__builtin_amdgcn_readlane(x, 16)), b = max((unsigned)__builtin_amdgcn_readlane(x, 32), (unsigned)__builtin_amdgcn_readlane(x, 48));
    return h ? b : a;
}

__device__ __forceinline__ void idx_select(const bf16* __restrict__ P1, int b, int tokw, int n, int lane_in, unsigned& W0lo, unsigned& W0hi, unsigned& W1lo, unsigned& W1hi) {
    if (n <= 256) { W0lo = W0hi = W1lo = W1hi = 0xffffffffu; return; }
    int lane = lane_in; asm volatile("" : "+v"(lane));
    const int c = lane & 31, h = lane >> 5;
    const int qa = 2 * ((c >> 2) & 1) + (c >> 4), ih = (c & 3) + 4 * ((c >> 3) & 1);
    const bf16* qip = P1 + (size_t)(tokw + qa) * N1 + OFF_QI + ih * 64 + 8 * h;
    bf16x8 af[4];
#pragma unroll
    for (int s = 0; s < 4; ++s) af[s] = *(const bf16x8*)(qip + 16 * s);
    float wq0[8], wq1[8];
    { const u32x4 t = *(const u32x4*)(P1 + (size_t)(tokw + 2 * h) * N1 + OFF_WI), u = *(const u32x4*)(P1 + (size_t)(tokw + 2 * h + 1) * N1 + OFF_WI);
      wq0[0] = bflo(t.x); wq0[1] = bfhi(t.x); wq0[2] = bflo(t.y); wq0[3] = bfhi(t.y); wq0[4] = bflo(t.z); wq0[5] = bfhi(t.z); wq0[6] = bflo(t.w); wq0[7] = bfhi(t.w);
      wq1[0] = bflo(u.x); wq1[1] = bfhi(u.x); wq1[2] = bflo(u.y); wq1[3] = bfhi(u.y); wq1[4] = bflo(u.z); wq1[5] = bfhi(u.z); wq1[6] = bflo(u.w); wq1[7] = bfhi(u.w); }
    const bf16* kbase = P1 + (size_t)(b * SEQ + c) * N1 + OFF_KI + 8 * h;
    const int nt = n >> 5;
    unsigned sc0[64], sc1[64];
    unsigned mn0 = 0xffffffffu, mx0 = 0u, mn1 = 0xffffffffu, mx1 = 0u;
    bf16x8 kf[2][4];
#pragma unroll
    for (int s = 0; s < 4; ++s) kf[0][s] = *(const bf16x8*)(kbase + 16 * s);
#pragma unroll
    for (int i = 0; i < 64; ++i) {
        if (i < nt) {
            if (i + 1 < nt) {
#pragma unroll
                for (int s = 0; s < 4; ++s) kf[(i + 1) & 1][s] = *(const bf16x8*)(kbase + (size_t)(i + 1) * 32 * N1 + 16 * s);
            }
            f32x16 acc = {};
#pragma unroll
            for (int s = 0; s < 4; ++s) acc = __builtin_amdgcn_mfma_f32_32x32x16_bf16(af[s], kf[i & 1][s], acc, 0, 0, 0);
            float s0 = 0.f, s1 = 0.f;
#pragma unroll
            for (int j = 0; j < 8; ++j) { s0 = fmaf(wq0[j], fmaxf(acc[j], 0.f), s0); s1 = fmaf(wq1[j], fmaxf(acc[8 + j], 0.f), s1); }
            s0 += 0.0f; s1 += 0.0f;
            unsigned u0 = __float_as_uint(s0), u1 = __float_as_uint(s1);
            u0 = (u0 & 0x80000000u) ? ~u0 : (u0 | 0x80000000u); u1 = (u1 & 0x80000000u) ? ~u1 : (u1 | 0x80000000u);
            sc0[i] = u0; sc1[i] = u1; mn0 = min(mn0, u0); mx0 = max(mx0, u0); mn1 = min(mn1, u1); mx1 = max(mx1, u1);
        } else { sc0[i] = 0u; sc1[i] = 0u; }
    }
    unsigned lo0 = half_min(mn0, h), hi0 = half_max(mx0, h) + 1u, lo1 = half_min(mn1, h), hi1 = half_max(mx1, h) + 1u;
    unsigned cl0 = (unsigned)n, cl1 = (unsigned)n;
    bool fin0 = false, fin1 = false;
    for (int it = 0; it < 40; ++it) {
        const unsigned mid0 = lo0 + ((hi0 - lo0) >> 1), mid1 = lo1 + ((hi1 - lo1) >> 1);
        unsigned c0 = 0u, c1 = 0u;
#pragma unroll
        for (int g = 0; g < 8; ++g) {
            if (g * 8 < nt) {
#pragma unroll
                for (int i = g * 8; i < g * 8 + 8; ++i) { c0 += (sc0[i] >= mid0) ? 1u : 0u; c1 += (sc1[i] >= mid1) ? 1u : 0u; }
            }
        }
        c0 = half_sum(c0, h); c1 = half_sum(c1, h);
        if (!fin0) { if (c0 >= 256u) { lo0 = mid0; cl0 = c0; } else hi0 = mid0; fin0 = (c0 == 256u) || (hi0 - lo0 <= 1u); }
        if (!fin1) { if (c1 >= 256u) { lo1 = mid1; cl1 = c1; } else hi1 = mid1; fin1 = (c1 == 256u) || (hi1 - lo1 <= 1u); }
        if (__all(fin0 && fin1)) break;
    }
    unsigned w0l = 0u, w0h = 0u, w1l = 0u, w1h = 0u;
    if (__all(cl0 == 256u && cl1 == 256u)) {
#define BITOF(cond) ({ unsigned t__ = (cond) ? 1u : 0u; asm volatile("" : "+v"(t__)); t__; })
#pragma unroll
        for (int i = 0; i < 32; ++i) { w0l |= BITOF(sc0[i] >= lo0) << i; w1l |= BITOF(sc1[i] >= lo1) << i; }
#pragma unroll
        for (int i = 32; i < 64; ++i) { w0h |= BITOF(sc0[i] >= lo0) << (i - 32); w1h |= BITOF(sc1[i] >= lo1) << (i - 32); }
    } else {
        unsigned g0 = 0u, g1 = 0u;
#pragma unroll
        for (int i = 0; i < 64; ++i) { g0 += (sc0[i] > lo0) ? 1u : 0u; g1 += (sc1[i] > lo1) ? 1u : 0u; }
        g0 = half_sum(g0, h); g1 = half_sum(g1, h);
        const unsigned need0 = 256u - g0, need1 = 256u - g1, ltm = (1u << c) - 1u;
        unsigned run0 = 0u, run1 = 0u;
#pragma unroll
        for (int i = 0; i < 64; ++i) {
            const bool e0 = (sc0[i] == lo0), e1 = (sc1[i] == lo1);
            const unsigned long long m0 = __ballot(e0), m1 = __ballot(e1);
            const unsigned hb0 = h ? (unsigned)(m0 >> 32) : (unsigned)m0, hb1 = h ? (unsigned)(m1 >> 32) : (unsigned)m1;
            const bool s0 = (sc0[i] > lo0) || (e0 && (run0 + __popc(hb0 & ltm) < need0));
            const bool s1 = (sc1[i] > lo1) || (e1 && (run1 + __popc(hb1 & ltm) < need1));
            run0 += __popc(hb0); run1 += __popc(hb1);
            if (i < 32) { w0l |= BITOF(s0) << i; w1l |= BITOF(s1) << i; } else { w0h |= BITOF(s0) << (i - 32); w1h |= BITOF(s1) << (i - 32); }
        }
    }
#undef BITOF
    W0lo = w0l; W0hi = w0h; W1lo = w1l; W1hi = w1h;
}

__device__ __forceinline__ void partialSM(f32x16& p0, f32x16& p1, float b0, float& m_reg, float& mn, float& alpha) {
    constexpr float C = SCALE * LOG2E;
    float pmax = p0[0];
#pragma unroll
    for (int r = 1; r < 16; ++r) pmax = fmaxf(pmax, p0[r]);
#pragma unroll
    for (int r = 0; r < 16; ++r) pmax = fmaxf(pmax, p1[r]);
    { auto rr = __builtin_amdgcn_permlane32_swap(__float_as_uint(pmax), __float_as_uint(pmax), false, false);
      pmax = fmaxf(__uint_as_float(rr[0]), __uint_as_float(rr[1])); }
    const float pm = fmaf(pmax, C, b0);
    if (__builtin_expect(__all(pm - m_reg <= THR * LOG2E), 1)) { mn = m_reg; alpha = 1.f; }
    else { mn = fmaxf(m_reg, pm); alpha = __builtin_amdgcn_exp2f(m_reg - mn); m_reg = mn; }
    const float off = b0 - mn;
#pragma unroll
    for (int r = 0; r < 16; ++r) p0[r] = fmaf(p0[r], C, off);
#pragma unroll
    for (int r = 0; r < 16; ++r) p1[r] = fmaf(p1[r], C, off);
#pragma unroll
    for (int r = 0; r < 16; ++r) p0[r] = __builtin_amdgcn_exp2f(p0[r]);
}
__device__ __forceinline__ void finishSM(f32x16& p0, f32x16& p1, float alpha, float& l_reg, bf16x8& pa0, bf16x8& pa1, bf16x8& pa2, bf16x8& pa3) {
#pragma unroll
    for (int r = 0; r < 16; ++r) p1[r] = __builtin_amdgcn_exp2f(p1[r]);
    float ps = 0;
#pragma unroll
    for (int r = 0; r < 16; ++r) ps += p0[r];
#pragma unroll
    for (int r = 0; r < 16; ++r) ps += p1[r];
    { auto rr = __builtin_amdgcn_permlane32_swap(__float_as_uint(ps), __float_as_uint(ps), false, false);
      ps = __uint_as_float(rr[0]) + __uint_as_float(rr[1]); }
    l_reg = l_reg * alpha + ps;
#define PK4(P, BASE, OUT) do { unsigned a0 = cvtpk(P[BASE + 0], P[BASE + 1]), a1 = cvtpk(P[BASE + 2], P[BASE + 3]);   \
    unsigned b0_ = cvtpk(P[BASE + 4], P[BASE + 5]), b1_ = cvtpk(P[BASE + 6], P[BASE + 7]);                              \
    auto r0 = __builtin_amdgcn_permlane32_swap(a0, b0_, false, false); auto r1 = __builtin_amdgcn_permlane32_swap(a1, b1_, false, false); \
    u32x4 w = {r0[0], r1[0], r0[1], r1[1]}; OUT = *reinterpret_cast<bf16x8*>(&w); } while (0)
    PK4(p0, 0, pa0); PK4(p0, 8, pa1); PK4(p1, 0, pa2); PK4(p1, 8, pa3);
#undef PK4
}
__device__ __forceinline__ void qkt(f32x16& p0, f32x16& p1, const LAS char* Ks, const bf16x8* qr, bf16x8 ax0, bf16x8 ax1, bf16x8 ef, int r32, int hi) {
    p0 = __builtin_amdgcn_mfma_f32_32x32x16_bf16(ax0, ef, f32x16{}, 0, 0, 0);
    p1 = __builtin_amdgcn_mfma_f32_32x32x16_bf16(ax1, ef, f32x16{}, 0, 0, 0);
#pragma unroll
    for (int d0 = 0; d0 < 8; ++d0) { const int cb = (d0 * 16 + hi * 8) * 2;
        const bf16x8 b0 = *reinterpret_cast<const LAS bf16x8*>(Ks + KSWZ(r32, cb));
        const bf16x8 b1 = *reinterpret_cast<const LAS bf16x8*>(Ks + KSWZ(32 + r32, cb));
        p0 = __builtin_amdgcn_mfma_f32_32x32x16_bf16(b0, qr[d0], p0, 0, 0, 0);
        p1 = __builtin_amdgcn_mfma_f32_32x32x16_bf16(b1, qr[d0], p1, 0, 0, 0); }
}
__device__ __forceinline__ int v_st(int k, int c) { const int kk = (k & ~0xC) | ((k & 4) << 1) | ((k & 8) >> 1); return ((kk >> 3) * 4 + (c >> 5)) * 512 + ((kk & 7) * 32 + (c & 31)) * 2; }
__device__ __forceinline__ int v_rd_base(int lane) { return ((lane & 3) << 3) | (((lane >> 2) & 3) << 6) | (((lane >> 4) & 1) << 5) | (((lane >> 5) & 1) << 8); }
constexpr int v_rd_off(int d0, int ks, int half) { return d0 * 512 + ks * 4096 + half * 2048; }
template <int OFF> __device__ __forceinline__ s16x4 tr_read(int vb) { s16x4 r; asm volatile("ds_read_b64_tr_b16 %0, %1 offset:%2" : "=&v"(r) : "v"(vb), "i"(OFF) : "memory"); return r; }
template <int D0> __device__ __forceinline__ void pv_one(f32x16& od, int vb, bf16x8 pa0, bf16x8 pa1, bf16x8 pa2, bf16x8 pa3) {
    const s16x4 l0 = tr_read<v_rd_off(D0, 0, 0)>(vb), h0 = tr_read<v_rd_off(D0, 0, 1)>(vb), l1 = tr_read<v_rd_off(D0, 1, 0)>(vb), h1 = tr_read<v_rd_off(D0, 1, 1)>(vb);
    const s16x4 l2 = tr_read<v_rd_off(D0, 2, 0)>(vb), h2 = tr_read<v_rd_off(D0, 2, 1)>(vb), l3 = tr_read<v_rd_off(D0, 3, 0)>(vb), h3 = tr_read<v_rd_off(D0, 3, 1)>(vb);
    asm volatile("s_waitcnt lgkmcnt(0)" ::: "memory"); SBAR();
#define PK(L, H) (bf16x8){L[0], L[1], L[2], L[3], H[0], H[1], H[2], H[3]}
    od = __builtin_amdgcn_mfma_f32_32x32x16_bf16(pa0, PK(l0, h0), od, 0, 0, 0);
    od = __builtin_amdgcn_mfma_f32_32x32x16_bf16(pa1, PK(l1, h1), od, 0, 0, 0);
    od = __builtin_amdgcn_mfma_f32_32x32x16_bf16(pa2, PK(l2, h2), od, 0, 0, 0);
    od = __builtin_amdgcn_mfma_f32_32x32x16_bf16(pa3, PK(l3, h3), od, 0, 0, 0);
#undef PK
}
__device__ __forceinline__ void pv_d0(f32x16* o, int vb, bf16x8 pa0, bf16x8 pa1, bf16x8 pa2, bf16x8 pa3) {
    pv_one<0>(o[0], vb, pa0, pa1, pa2, pa3); pv_one<1>(o[1], vb, pa0, pa1, pa2, pa3); pv_one<2>(o[2], vb, pa0, pa1, pa2, pa3); pv_one<3>(o[3], vb, pa0, pa1, pa2, pa3);
}

__device__ __forceinline__ void attn_item(const bf16* __restrict__ P1, const bf16* __restrict__ Cb, bf16* __restrict__ MIXp, int tok0, int pos0, int n, LAS char* lds) {
    int tid = threadIdx.x; asm volatile("" : "+v"(tid));
    const int wid = tid >> 6, lane = tid & 63, r32 = lane & 31, hi = lane >> 5;
    LAS char* V_lds = lds; LAS char* K_lds = lds + 2 * SHM_V;
    LAS float* wsl = (LAS float*)(lds + 2 * SHM_V + 2 * SHM_K) + wid * 64; LAS float* li_l = wsl; LAS float* al_l = wsl + 32;
    const LAS u32x4* mwl = (const LAS u32x4*)(lds + SHM_ATTN) + tid;
    float m_reg = -1e30f, l_reg = 0; f32x16 o[4] = {}; bf16x8 qr[8];
    const int ql_ = r32 >> 3, hd = r32 & 7;
    { const bf16* Qw = P1 + (size_t)(tok0 + 4 * wid + ql_) * N1 + OFF_QL + hd * 128 + hi * 8;
#pragma unroll
      for (int d0 = 0; d0 < 8; ++d0) qr[d0] = *(const bf16x8*)(Qw + d0 * 16); }
    const float slope2 = __uint_as_float((unsigned)(127 - (hd + 1)) << 23) * LOG2E;
    const float qposf = (float)(pos0 + 4 * wid + ql_);
    bf16x8 ef; { u32x4 w = {0u, 0u, 0u, 0u}; w.x = ((ql_ == 2 * hi) ? 0x3F80u : 0u) | ((ql_ == 2 * hi + 1) ? 0x3F800000u : 0u); w.y = (hi == 0) ? ((unsigned)(129 - hd) << 7) : 0u; ef = *reinterpret_cast<bf16x8*>(&w); }
    const unsigned klw0 = (hi == 0) ? (__float_as_uint((float)r32) >> 16) : 0u, klw1 = (hi == 0) ? (__float_as_uint((float)(32 + r32)) >> 16) : 0u;
    const int NT = n >> 6, NTP = (NT + 1) & ~1;
#define TILE_K0(j) (((j) < NT) ? (NT - 1 - (j)) * KVBLK : 0)
#define MASKW(s_) ({ const int s__ = (s_); const unsigned b0__ = ((s__ < 32) ? (Wv_.x >> s__) : (Wv_.y >> (s__ - 32))) & 1u, b1__ = ((s__ < 32) ? (Wv_.z >> s__) : (Wv_.w >> (s__ - 32))) & 1u; \
        NEG2 & ~((b0__ ? 0xffffu : 0u) | (b1__ ? 0xffff0000u : 0u)); })
#define MKAX(j, ax0, ax1) do { u32x4 w0_ = {NEG2, klw0, 0u, 0u}, w1_ = {NEG2, klw1, 0u, 0u}; if ((j) < NT) { const u32x4 Wv_ = *mwl; const int tt_ = NT - 1 - (j); w0_.x = MASKW(2 * tt_); w1_.x = MASKW(2 * tt_ + 1); } \
        ax0 = *reinterpret_cast<bf16x8*>(&w0_); ax1 = *reinterpret_cast<bf16x8*>(&w1_); } while (0)
#define TILE_B0(j) (slope2 * ((float)TILE_K0(j) - qposf))
    const int sr = tid >> 4, sc = (tid & 15) * 8, vst0 = v_st(sr, sc), vst1 = v_st(32 + sr, sc);
    const int vb0 = (int)(unsigned)(size_t)V_lds + v_rd_base(lane);
    struct { bf16x8 c0, c1; } sr_[1];
#define SLOAD(i, k0) do { sr_[i].c0 = *(const bf16x8*)(Cb + (size_t)((k0) + sr) * 128 + sc); sr_[i].c1 = *(const bf16x8*)(Cb + (size_t)((k0) + 32 + sr) * 128 + sc); } while (0)
#define SWRITE(b, i) do { *(LAS bf16x8*)(V_lds + (b) * SHM_V + vst0) = sr_[i].c0; *(LAS bf16x8*)(V_lds + (b) * SHM_V + vst1) = sr_[i].c1; const int kc = sc * 2; \
    *(LAS bf16x8*)(K_lds + (b) * SHM_K + KSWZ(sr, kc)) = sr_[i].c0; *(LAS bf16x8*)(K_lds + (b) * SHM_K + KSWZ(32 + sr, kc)) = sr_[i].c1; } while (0)
#define SWAIT() asm volatile("s_waitcnt vmcnt(0)" ::: "memory")
#define RESC(a) do { if (__any((a) < 1.f)) { if (hi == 0) al_l[r32] = (a); asm volatile("s_waitcnt lgkmcnt(0)" ::: "memory"); \
    _Pragma("unroll") for (int d = 0; d < 4; ++d) _Pragma("unroll") for (int r = 0; r < 16; ++r) o[d][r] *= al_l[crow(r, hi)]; } } while (0)
    f32x16 pA0, pA1, pB0, pB1; float mnA, mnB, alA, alB; bf16x8 pa0, pa1, pa2, pa3, ax0, ax1;
    constexpr int SE = 0, SO = 0;
    SLOAD(SE, TILE_K0(0)); asm volatile("s_waitcnt vmcnt(0)" ::: "memory"); SWRITE(0, SE); __syncthreads();
    MKAX(0, ax0, ax1); qkt(pA0, pA1, K_lds, qr, ax0, ax1, ef, r32, hi);
    {
        const float base = (float)TILE_K0(0) - qposf + (float)(4 * hi), s16 = -2.0f * __uint_as_float((unsigned)(129 - hd) << 23);
#pragma unroll
        for (int r = 0; r < 16; ++r) { const float cr = (float)((r & 3) + 8 * (r >> 2));
            pA0[r] = fmaf(s16, fmaxf(base + cr, 0.f), pA0[r]); pA1[r] = fmaf(s16, fmaxf(base + cr + 32.f, 0.f), pA1[r]); }
    }
    partialSM(pA0, pA1, TILE_B0(0), m_reg, mnA, alA);
    SLOAD(SO, TILE_K0(1));
    SWAIT(); SWRITE(1, SO); __syncthreads();
    for (int j = 1; j + 1 < NTP; j += 2) {
        SBAR(); MKAX(j, ax0, ax1); qkt(pB0, pB1, K_lds + SHM_K, qr, ax0, ax1, ef, r32, hi);
        finishSM(pA0, pA1, alA, l_reg, pa0, pa1, pa2, pa3); SBAR();
        SLOAD(SO, TILE_K0(j + 1)); SBAR();
        pv_d0(o, vb0, pa0, pa1, pa2, pa3); partialSM(pB0, pB1, TILE_B0(j), m_reg, mnB, alB);
        __syncthreads(); SWAIT(); SWRITE(0, SE);
        RESC(alB); __syncthreads();
        SBAR(); MKAX(j + 1, ax0, ax1); qkt(pA0, pA1, K_lds, qr, ax0, ax1, ef, r32, hi);
        finishSM(pB0, pB1, alB, l_reg, pa0, pa1, pa2, pa3); SBAR();
        SLOAD(SE, TILE_K0(j + 2)); SBAR();
        pv_d0(o, vb0 + SHM_V, pa0, pa1, pa2, pa3); partialSM(pA0, pA1, TILE_B0(j + 1), m_reg, mnA, alA);
        __syncthreads(); SWAIT(); SWRITE(1, SO);
        RESC(alA); __syncthreads();
    }
    SBAR(); MKAX(NTP - 1, ax0, ax1); qkt(pB0, pB1, K_lds + SHM_K, qr, ax0, ax1, ef, r32, hi);
    finishSM(pA0, pA1, alA, l_reg, pa0, pa1, pa2, pa3); SBAR();
    pv_d0(o, vb0, pa0, pa1, pa2, pa3); partialSM(pB0, pB1, TILE_B0(NTP - 1), m_reg, mnB, alB);
    __syncthreads(); RESC(alB);
    finishSM(pB0, pB1, alB, l_reg, pa0, pa1, pa2, pa3); SBAR();
    pv_d0(o, vb0 + SHM_V, pa0, pa1, pa2, pa3);
    if (hi == 0) li_l[r32] = l_reg; asm volatile("s_waitcnt lgkmcnt(0)" ::: "memory");
    float rli[16];
#pragma unroll
    for (int r = 0; r < 16; ++r) rli[r] = __builtin_amdgcn_rcpf(li_l[crow(r, hi)]);
#pragma unroll
    for (int r = 0; r < 16; ++r) { const int orow = crow(r, hi);
        bf16* op = MIXp + (size_t)(tok0 + 4 * wid + (orow >> 3)) * K2 + (orow & 7) * 128 + r32;
#pragma unroll
        for (int d0 = 0; d0 < 4; ++d0) op[d0 * 32] = (bf16)f2bf(o[d0][r] * rli[r]); }
    __syncthreads();
#undef SLOAD
#undef SWRITE
#undef SWAIT
#undef RESC
#undef TILE_K0
#undef MASKW
#undef MKAX
#undef TILE_B0
}
}

__device__ __forceinline__ void ph_attn_fast(const Args& a, LAS unsigned char* lds) {
    const bf16* P1 = (const bf16*)(a.ws + WS_P1); const bf16* CN = (const bf16*)(a.ws + WS_CN); bf16* MIX = (bf16*)(a.ws + WS_MIX);
    const int tid = threadIdx.x, lane = tid & 63, wid = tid >> 6, G = gridDim.x;
    for (int it = blockIdx.x; it < BATCH * 64; it += G) {
        const int gg = it & 255, m = it >> 8;
        const int b = (gg & 7) + 8 * (gg >> 6), jg = (gg >> 3) & 7, qb = (m & 1) ? (63 - jg - 8 * (m >> 1)) : (jg + 8 * (m >> 1));
        const int pos0 = qb * 32, tok0 = b * SEQ + pos0, n = ((pos0 >> 6) + 1) << 6;
        { unsigned w0l, w0h, w1l, w1h;
          dsa::idx_select(P1, b, tok0 + 4 * wid, n, lane, w0l, w0h, w1l, w1h);
          ((LAS dsa::u32x4*)(lds + dsa::SHM_ATTN))[tid] = (dsa::u32x4){w0l, w0h, w1l, w1h};
          asm volatile("s_waitcnt lgkmcnt(0)" ::: "memory"); }
        dsa::attn_item(P1, CN + (size_t)b * SEQ * 128, MIX, tok0, pos0, n, (LAS char*)lds);
    }
}

__device__ __forceinline__ void ph_conv(const Args& a, int hsel, int gtid, int gthreads) {
    const bf16* RAW = (const bf16*)(a.ws + WS_RAW); bf16* ACT = (bf16*)(a.ws + WS_ACT); const float* CONVP = (const float*)(a.ws + WS_CONVP);
    constexpr int CH = FF / 8;
    for (int i = gtid; i < (NTOK / 2) * CH; i += gthreads) {
        const int tl = i / CH, ch = i - tl * CH, tok = hsel * (NTOK / 2) + tl, pos = tok & (SEQ - 1);
        const int jc = ch * 8, j = jc >> 7, ii = jc & 127, rg = 256 * j + ii, ru = rg + 128;
        float cg_[8], cu_[8];
#pragma unroll
        for (int e = 0; e < 8; ++e) { cg_[e] = CONVP[3 * N3 + rg + e]; cu_[e] = CONVP[3 * N3 + ru + e]; }
#pragma unroll
        for (int tap = 0; tap < 3; ++tap) {
            const int back = 2 - tap; if (pos - back < 0) continue;
            const bf16* rrow = RAW + (size_t)(tl - back) * N3;
            const v4u g = *(const v4u*)(rrow + rg), u = *(const v4u*)(rrow + ru);
            const float gv[8] = {bflo(g.x), bfhi(g.x), bflo(g.y), bfhi(g.y), bflo(g.z), bfhi(g.z), bflo(g.w), bfhi(g.w)};
            const float uv[8] = {bflo(u.x), bfhi(u.x), bflo(u.y), bfhi(u.y), bflo(u.z), bfhi(u.z), bflo(u.w), bfhi(u.w)};
#pragma unroll
            for (int e = 0; e < 8; ++e) { cg_[e] += CONVP[tap * N3 + rg + e] * gv[e]; cu_[e] += CONVP[tap * N3 + ru + e] * uv[e]; }
        }
        float r[8];
#pragma unroll
        for (int e = 0; e < 8; ++e) r[e] = cg_[e] / (1.0f + __expf(-cg_[e])) * cu_[e];
        v4u o; o.x = pk2(r[0], r[1]); o.y = pk2(r[2], r[3]); o.z = pk2(r[4], r[5]); o.w = pk2(r[6], r[7]);
        *(v4u*)(ACT + (size_t)tok * FF + jc) = o;
    }
}

__device__ __forceinline__ void ph_final(const Args& a, int gw, int ngw, int lane) {
    const bf16* X2 = (const bf16*)(a.ws + WS_X2); const float* ss3 = (const float*)(a.ws + WS_CTL + 256 * 1024);
    for (int m = gw; m < NTOK; m += ngw) {
        const float rinv = 1.0f / sqrtf(ss3[m] * (1.0f / DM) + EPS);
#pragma unroll
        for (int h2 = 0; h2 < 2; ++h2) {
            const int c0 = h2 * 512 + 8 * lane;
            const v4u t = *(const v4u*)(X2 + (size_t)m * DM + c0);
            const f32x4 g0 = *(const f32x4*)(a.g_final + c0), g1 = *(const f32x4*)(a.g_final + c0 + 4);
            f32x4 o0, o1;
            o0.x = bflo(t.x) * rinv * g0.x; o0.y = bfhi(t.x) * rinv * g0.y; o0.z = bflo(t.y) * rinv * g0.z; o0.w = bfhi(t.y) * rinv * g0.w;
            o1.x = bflo(t.z) * rinv * g1.x; o1.y = bfhi(t.z) * rinv * g1.y; o1.z = bflo(t.w) * rinv * g1.z; o1.w = bfhi(t.w) * rinv * g1.w;
            *(f32x4*)(a.out + (size_t)m * DM + c0) = o0; *(f32x4*)(a.out + (size_t)m * DM + c0 + 4) = o1;
        }
    }
}

constexpr int NPHASE = 11;
#define IDS() const int tid = threadIdx.x, lane = tid & 63, wave = __builtin_amdgcn_readfirstlane(tid >> 6); const int G = gridDim.x; \
    const int gtid = blockIdx.x * (NWAVES * 64) + tid, gthreads = G * NWAVES * 64, gw = blockIdx.x * NWAVES + wave, ngw = G * NWAVES; (void)lane; (void)wave; (void)gtid; (void)gthreads; (void)gw; (void)ngw;
__global__ void __launch_bounds__(NWAVES * 64, 2) fwd_kernel(Args a) {
    extern __shared__ __attribute__((aligned(16))) unsigned char lds_raw[];
    LAS unsigned char* lds = (LAS unsigned char*)lds_raw;
    const int lo = a.ph_lo, hi = a.ph_hi;
#define IN(k) (lo <= (k) && (k) < hi)
#define SEAM(k) do { if (IN(k) && IN((k) + 1)) cg::this_grid().sync(); } while (0)
    if (IN(0)) { IDS(); ph_prologue(a, gtid, gthreads, gw, ngw, lane); }
    SEAM(0);
    if (IN(1)) {
        unsigned char* ws = a.ws;
        pg8::Gemm g{(const bf16*)(ws + WS_HB), (const bf16*)(ws + WS_W1T), NTOK, N1, DM}; pg8::StaticOrder S; S.init(NTOK, N1, (int)gridDim.x, (int)blockIdx.x);
        pg8::EpiStore E{(bf16*)(ws + WS_P1), N1, nullptr};
        pg8::gemm_phase<pg8::EpiStore, pg8::StaticOrder, true, true>(lds, g, S, E);
    }
    SEAM(1);
    if (IN(2)) { IDS(); ph_cnorm_pool(a, gw, ngw, lane); }
    SEAM(2);
    #if USE_NAIVE_ATTN
    if (IN(3)) { IDS(); ph_attn_naive(a, lds, wave, gw, ngw, lane); }
#else
    if (IN(3)) { ph_attn_fast(a, lds); }
#endif
    SEAM(3);
    if (IN(4)) {
        unsigned char* ws = a.ws;
        pg8::Gemm g{(const bf16*)(ws + WS_MIX), (const bf16*)(ws + WS_W2T), NTOK, DM, K2}; pg8::StaticOrder S; S.init(NTOK, DM, (int)gridDim.x, (int)blockIdx.x);
        pg8::EpiResid<true> E{(const void*)a.x, (bf16*)(ws + WS_X1B), (float*)(ws + WS_CTL)};
        pg8::gemm_phase<pg8::EpiResid<true>, pg8::StaticOrder, true, true>(lds, g, S, E);
    }
    SEAM(4);
#pragma unroll 1
    for (int hsel = 0; hsel < 2; ++hsel) {
        const int p5 = 5 + 2 * hsel;
        if (IN(p5)) {
            unsigned char* ws = a.ws;
            pg8::Gemm g{(const bf16*)(ws + WS_X1B) + (size_t)hsel * (NTOK / 2) * DM, (const bf16*)(ws + WS_W3T), NTOK / 2, N3, DM}; pg8::StaticOrder S; S.init(NTOK / 2, N3, (int)gridDim.x, (int)blockIdx.x);
            pg8::EpiStore E{(bf16*)(ws + WS_RAW), N3, (const float*)(ws + WS_CTL) + hsel * (NTOK / 2)};
            pg8::gemm_phase<pg8::EpiStore, pg8::StaticOrder, true, true>(lds, g, S, E);
        }
        SEAM(p5);
        if (IN(p5 + 1)) { IDS(); ph_conv(a, hsel, gtid, gthreads); }
        SEAM(p5 + 1);
    }
    if (IN(9)) {
        unsigned char* ws = a.ws;
        pg8::Gemm g{(const bf16*)(ws + WS_ACT), (const bf16*)(ws + WS_W4T), NTOK, DM, FF}; pg8::StaticOrder S; S.init(NTOK, DM, (int)gridDim.x, (int)blockIdx.x);
        pg8::EpiResid<false> E{(const void*)(ws + WS_X1B), (bf16*)(ws + WS_X2), (float*)(ws + WS_CTL + 256 * 1024)};
        pg8::gemm_phase<pg8::EpiResid<false>, pg8::StaticOrder, true, true>(lds, g, S, E);
    }
    SEAM(9);
    if (IN(10)) { IDS(); ph_final(a, gw, ngw, lane); }
#undef IN
#undef SEAM
}

extern "C" void kernel_launch(void* const* d_in, const int* in_sizes, int n_in, void* d_out, int out_size, void* d_ws, size_t ws_size, hipStream_t stream) {
    static int grid = 0;
    if (grid == 0) {
        if (n_in != 15 || in_sizes[0] != NTOK * DM || out_size != NTOK * DM || ws_size < WS_END) { fprintf(stderr, "kernel_launch: unexpected shapes / workspace (n_in %d, ws %zu)\n", n_in, ws_size); grid = -1; return; }
        int dev = 0, cus = 0, per_cu = 0;
        hipGetDevice(&dev); hipDeviceGetAttribute(&cus, hipDeviceAttributeMultiprocessorCount, dev);
        if (hipFuncSetAttribute((const void*)fwd_kernel, hipFuncAttributeMaxDynamicSharedMemorySize, LDS_BYTES) != hipSuccess) { fprintf(stderr, "kernel_launch: hipFuncSetAttribute failed\n"); grid = -1; return; }
        if (hipOccupancyMaxActiveBlocksPerMultiprocessor(&per_cu, (const void*)fwd_kernel, NWAVES * 64, LDS_BYTES) != hipSuccess || per_cu < 1) { fprintf(stderr, "kernel_launch: occupancy query says %d\n", per_cu); per_cu = 1; }
        (void)hipGetLastError();
        grid = cus;
        if (grid != 256) fprintf(stderr, "kernel_launch: %d CUs (tuned for 256)\n", grid);
    }
    if (grid < 0) return;
    hipMemsetAsync((char*)d_ws + WS_CTL, 0, CTL_ZERO_BYTES, stream);
    Args a{};
    a.x = (const float*)d_in[0]; a.g_mix = (const float*)d_in[1]; a.w_in = (const float*)d_in[2]; a.g_kv = (const float*)d_in[3]; a.w_uk = (const float*)d_in[4]; a.w_uv = (const float*)d_in[5];
    a.w_pool = (const float*)d_in[6]; a.pool_scale = (const float*)d_in[7]; a.w_o = (const float*)d_in[8]; a.g_ffn = (const float*)d_in[9]; a.w_up = (const float*)d_in[10];
    a.conv_w = (const float*)d_in[11]; a.conv_b = (const float*)d_in[12]; a.w_down = (const float*)d_in[13]; a.g_final = (const float*)d_in[14];
    a.out = (float*)d_out; a.ws = (unsigned char*)d_ws;
#if MK_ONE_LAUNCH
    a.ph_lo = 0; a.ph_hi = NPHASE;
    void* args[] = {&a};
    hipError_t e = hipLaunchCooperativeKernel((const void*)fwd_kernel, dim3(grid), dim3(NWAVES * 64), args, LDS_BYTES, stream);
    if (e != hipSuccess) fprintf(stderr, "cooperative launch failed: %s (grid %d)\n", hipGetErrorString(e), grid);
#else
    for (int ph = 0; ph < NPHASE; ++ph) {
        a.ph_lo = ph; a.ph_hi = ph + 1;
        hipLaunchKernelGGL(fwd_kernel, dim3(grid), dim3(NWAVES * 64), LDS_BYTES, stream, a);
    }
#endif
}
```

```cpp
#include <hip/hip_runtime.h>
#include <hip/hip_cooperative_groups.h>
#include <cstdio>
#include <cstdint>
namespace cg = cooperative_groups;

#ifndef USE_NAIVE_ATTN
#define USE_NAIVE_ATTN 0
#endif
#ifndef REP_PH
#define REP_PH -1
#endif
#ifndef ATT_VARIANT
#define ATT_VARIANT 0
#endif
#ifndef MK_ONE_LAUNCH
#define MK_ONE_LAUNCH 1
#endif

namespace pg8 {
#define PG8_LAS __attribute__((address_space(3)))
typedef unsigned short bf16_t;
typedef short bf16x8 __attribute__((ext_vector_type(8)));
typedef float f32x4 __attribute__((ext_vector_type(4)));
typedef unsigned u32x4 __attribute__((ext_vector_type(4)));
constexpr int BM = 256, BK = 64, HALF = 128, HTB = HALF * BK * 2, STAGE_BYTES = 8 * HTB, NXCD = 8, WGM = 8;

__host__ __device__ __forceinline__ int lds_byte(int r, int c) { const int st = (r >> 4) * 2 + (c >> 5), rr = r & 15, cc = c & 31, ob = rr * 64 + cc * 2; return st * 1024 + (ob ^ (((ob >> 9) & 1) << 5)); }
__host__ __device__ __forceinline__ void stage_rc(int b, int& R, int& C) { const int st = b / 1024, sb = b % 1024, swz = sb ^ (((sb >> 9) & 1) << 5); R = (st >> 1) * 16 + swz / 64; C = (st & 1) * 32 + (swz % 64) / 2; }
__host__ __device__ __forceinline__ int perm32(int rho) { const int n = rho >> 4, i = rho & 15; return 8 * (i >> 2) + 4 * n + (i & 3); }

struct Unit { int pm, pn; };
struct Gemm { const bf16_t* A; const bf16_t* Bt; int M, N, K; };

struct StaticOrder {
    int nM, nN, nwg, G, c;
    __host__ __device__ void init(int M, int N, int G_, int c_) { nM = M / BM; nN = N / BM; nwg = nM * nN; G = G_; c = c_; }
    __host__ __device__ bool next(int i, Unit& u) const {
        const long L = (long)i * G + c; if (L >= nwg) return false;
        int wgid = (int)L; { const int q = nwg / NXCD, r = nwg % NXCD, xcd = wgid % NXCD, off = wgid / NXCD; wgid = (xcd < r ? xcd * (q + 1) : r * (q + 1) + (xcd - r) * q) + off; }
        const int nig = WGM * nN, gid = wgid / nig, fm = gid * WGM, gsz = (nM - fm) < WGM ? (nM - fm) : WGM;
        u.pm = fm + ((wgid % nig) % gsz); u.pn = (wgid % nig) / gsz; return true;
    }
    __device__ __forceinline__ void a_ready(const Unit&) const {}
    __device__ __forceinline__ void done(const Unit&) const {}
};

__device__ __forceinline__ unsigned cvt_pk_bf16(float lo, float hi) { unsigned r; asm volatile("v_cvt_pk_bf16_f32 %0, %1, %2" : "=v"(r) : "v"(lo), "v"(hi)); return r; }


struct EpiStore {
    static constexpr bool PERM = true, AFTER_DRAIN = false;
    bf16_t* O; int ldc; const float* sumsq;
    __device__ __forceinline__ void operator()(const f32x4 (&acc)[2][2][4][2], const Unit& u, int wr, int wc, int fr, int fq) const {
        const int row0 = u.pm * BM + wr * 64 + fr, col0 = u.pn * BM + wc * 32 + 8 * fq;
#pragma unroll
        for (int ai = 0; ai < 2; ++ai)
#pragma unroll
            for (int m = 0; m < 4; ++m) {
                const int row = row0 + ai * HALF + m * 16;
                float sc = 1.f; if (sumsq) sc = 1.0f / sqrtf(sumsq[row] * (1.0f / 1024.0f) + 1e-6f);
                bf16_t* rowp = O + (size_t)row * ldc + col0;
#pragma unroll
                for (int bj = 0; bj < 2; ++bj) { f32x4 v0 = acc[ai][bj][m][0] * sc, v1 = acc[ai][bj][m][1] * sc;
                    u32x4 w; w.x = cvt_pk_bf16(v0[0], v0[1]); w.y = cvt_pk_bf16(v0[2], v0[3]); w.z = cvt_pk_bf16(v1[0], v1[1]); w.w = cvt_pk_bf16(v1[2], v1[3]);
                    *(u32x4*)(rowp + bj * HALF) = w; } }
    }
};
template <bool BASE_F32> struct EpiResid {
    static constexpr bool PERM = true, AFTER_DRAIN = false;
    const void* base; bf16_t* O; float* sumsq;
    __device__ __forceinline__ void operator()(const f32x4 (&acc)[2][2][4][2], const Unit& u, int wr, int wc, int fr, int fq) const {
        const int row0 = u.pm * BM + wr * 64 + fr, col0 = u.pn * BM + wc * 32 + 8 * fq;
#pragma unroll
        for (int ai = 0; ai < 2; ++ai)
#pragma unroll
            for (int m = 0; m < 4; ++m) {
                const int row = row0 + ai * HALF + m * 16; float ss = 0.f;
#pragma unroll
                for (int bj = 0; bj < 2; ++bj) {
                    const size_t off = (size_t)row * 1024 + col0 + bj * HALF;
                    f32x4 b0, b1;
                    if (BASE_F32) { b0 = *(const f32x4*)((const float*)base + off); b1 = *(const f32x4*)((const float*)base + off + 4); }
                    else { const u32x4 r = *(const u32x4*)((const bf16_t*)base + off);
                        b0[0] = __uint_as_float(r.x << 16); b0[1] = __uint_as_float(r.x & 0xffff0000u); b0[2] = __uint_as_float(r.y << 16); b0[3] = __uint_as_float(r.y & 0xffff0000u);
                        b1[0] = __uint_as_float(r.z << 16); b1[1] = __uint_as_float(r.z & 0xffff0000u); b1[2] = __uint_as_float(r.w << 16); b1[3] = __uint_as_float(r.w & 0xffff0000u); }
                    const f32x4 v0 = acc[ai][bj][m][0] + b0, v1 = acc[ai][bj][m][1] + b1;
                    ss += (v0[0] * v0[0] + v0[1] * v0[1]) + (v0[2] * v0[2] + v0[3] * v0[3]) + (v1[0] * v1[0] + v1[1] * v1[1]) + (v1[2] * v1[2] + v1[3] * v1[3]);
                    u32x4 w; w.x = cvt_pk_bf16(v0[0], v0[1]); w.y = cvt_pk_bf16(v0[2], v0[3]); w.z = cvt_pk_bf16(v1[0], v1[1]); w.w = cvt_pk_bf16(v1[2], v1[3]);
                    *(u32x4*)(O + off) = w; }
                ss += __shfl_xor(ss, 16); ss += __shfl_xor(ss, 32);
                if (fq == 0) atomicAdd(sumsq + row, ss);
            }
    }
};

template <class Epi, class Sched, bool ALIGN_EPI = false, bool SP2 = false>
__device__ __forceinline__ void gemm_phase(PG8_LAS unsigned char* lds, const Gemm g, const Sched& S, const Epi& E, const int tid) {
    const int wid = __builtin_amdgcn_readfirstlane(tid >> 6), lane = tid & 63, wr = wid >> 2, wc = wid & 3, fr = lane & 15, fq = lane >> 4;
    const int K = g.K, nt = K / BK;
    unsigned voffA[2], voffB[2];
#pragma unroll
    for (int i = 0; i < 2; ++i) { int R, C; stage_rc(tid * 16 + i * 8192, R, C); const int Rb = Epi::PERM ? ((R & ~31) + perm32(R & 31)) : R;
        voffA[i] = (unsigned)(R * K + C) * 2u; voffB[i] = (unsigned)(Rb * K + C) * 2u; }
    const size_t kstep = (size_t)(BK * 2);
    const size_t hstep = (size_t)HALF * K * 2;
    const size_t tstep = 2 * hstep;
    const unsigned ldsw = (unsigned)wid * 1024u;
    const int aoff = lds_byte(wr * 64 + fr, fq * 8), boff = lds_byte(wc * 32 + fr, fq * 8);
#define PG8_SA(b, h) (((b) * 2 + (h)) * HTB)
#define PG8_SB(b, h) ((4 + (b) * 2 + (h)) * HTB)
#define PG8_STAGE(bufoff, gbase, voff) do { _Pragma("unroll") for (int _i = 0; _i < 2; ++_i) \
        __builtin_amdgcn_global_load_lds((const unsigned*)((const char*)(gbase) + (voff)[_i]), (PG8_LAS unsigned*)(lds + (bufoff) + ldsw + _i * 8192), 16, 0, 0); } while (0)
#define PG8_LDA(dst, b, h) do { _Pragma("unroll") for (int m = 0; m < 4; ++m) _Pragma("unroll") for (int k = 0; k < 2; ++k) dst[m][k] = *(const PG8_LAS bf16x8*)(lds + PG8_SA(b, h) + aoff + m * 2048 + k * 1024); } while (0)
#define PG8_LDB(dst, b, h) do { _Pragma("unroll") for (int n = 0; n < 2; ++n) _Pragma("unroll") for (int k = 0; k < 2; ++k) dst[n][k] = *(const PG8_LAS bf16x8*)(lds + PG8_SB(b, h) + boff + n * 2048 + k * 1024); } while (0)
#define PG8_MMA(ai, bj, At, Bt) do { __builtin_amdgcn_s_setprio(1); _Pragma("unroll") for (int m = 0; m < 4; ++m) _Pragma("unroll") for (int n = 0; n < 2; ++n) _Pragma("unroll") for (int k = 0; k < 2; ++k) \
        acc[ai][bj][m][n] = __builtin_amdgcn_mfma_f32_16x16x32_bf16(Bt[n][k], At[m][k], acc[ai][bj][m][n], 0, 0, 0); __builtin_amdgcn_s_setprio(0); } while (0)
#define PG8_WAIT_V(n) asm volatile("s_waitcnt vmcnt(" #n ")" ::: "memory")
#define PG8_WAIT_L(n) asm volatile("s_waitcnt lgkmcnt(" #n ")" ::: "memory")
#define PG8_BAR __builtin_amdgcn_s_barrier()
#define PG8_SCHED __builtin_amdgcn_sched_barrier(0)
    Unit cur, nxt; int ui = 0;
    if (!S.next(0, cur)) return;
    f32x4 acc[2][2][4][2];
#pragma unroll
    for (int a = 0; a < 2; ++a)
#pragma unroll
        for (int b = 0; b < 2; ++b)
#pragma unroll
            for (int m = 0; m < 4; ++m)
#pragma unroll
                for (int n = 0; n < 2; ++n) acc[a][b][m][n] = (f32x4){0.f, 0.f, 0.f, 0.f};
    bf16x8 At[4][2], B0[2][2], B1[2][2];
    const char* cA = (const char*)g.A + (size_t)cur.pm * tstep; const char* cB = (const char*)g.Bt + (size_t)cur.pn * tstep;
    S.a_ready(cur);
    if constexpr (SP2) {
        PG8_STAGE(PG8_SB(0, 0), cB, voffB); PG8_STAGE(PG8_SB(0, 1), cB + hstep, voffB); PG8_STAGE(PG8_SA(0, 0), cA, voffA); PG8_STAGE(PG8_SA(0, 1), cA + hstep, voffA);
        if (wr == 1) PG8_BAR;
        PG8_WAIT_V(2); PG8_BAR;
        PG8_STAGE(PG8_SB(1, 0), cB + kstep, voffB); PG8_STAGE(PG8_SA(1, 0), cA + kstep, voffA); PG8_STAGE(PG8_SB(1, 1), cB + hstep + kstep, voffB);
        PG8_WAIT_V(6); PG8_BAR;
    } else {
        PG8_STAGE(PG8_SB(0, 0), cB, voffB); PG8_STAGE(PG8_SA(0, 0), cA, voffA); PG8_STAGE(PG8_SB(0, 1), cB + hstep, voffB); PG8_STAGE(PG8_SA(0, 1), cA + hstep, voffA);
        if (wr == 1) PG8_BAR;
        PG8_WAIT_V(4); PG8_BAR;
        PG8_STAGE(PG8_SB(1, 0), cB + kstep, voffB); PG8_STAGE(PG8_SA(1, 0), cA + kstep, voffA); PG8_STAGE(PG8_SB(1, 1), cB + hstep + kstep, voffB);
        PG8_WAIT_V(6); PG8_BAR;
    }
    for (;;) {
        const bool has_next = S.next(ui + 1, nxt);
        const char* nA = has_next ? (const char*)g.A + (size_t)nxt.pm * tstep : cA; const char* nB = has_next ? (const char*)g.Bt + (size_t)nxt.pn * tstep : cB;
        for (int t = 0; t < nt; t += 2) {
            const bool last = (t == nt - 2);
            const char* a1 = cA + (size_t)(t + 1) * kstep;
            const char* a2 = last ? nA : cA + (size_t)(t + 2) * kstep; const char* b2 = last ? nB : cB + (size_t)(t + 2) * kstep;
            const char* a3 = a2 + kstep; const char* b3 = b2 + kstep;
            if (last && has_next) S.a_ready(nxt);
            if constexpr (SP2) {
            PG8_LDB(B0, 0, 0); PG8_LDB(B1, 0, 1); PG8_SCHED; PG8_LDA(At, 0, 0); PG8_STAGE(PG8_SA(1, 1), a1 + hstep, voffA);
            PG8_WAIT_V(8); PG8_WAIT_L(0); PG8_BAR; PG8_MMA(0, 0, At, B0); PG8_MMA(0, 1, At, B1); PG8_BAR; PG8_SCHED;
            PG8_LDA(At, 0, 1); PG8_STAGE(PG8_SB(0, 0), b2, voffB); PG8_STAGE(PG8_SB(0, 1), b2 + hstep, voffB); PG8_STAGE(PG8_SA(0, 0), a2, voffA);
            PG8_WAIT_V(8); PG8_WAIT_L(0); PG8_BAR; PG8_MMA(1, 0, At, B0); PG8_MMA(1, 1, At, B1); PG8_BAR; PG8_SCHED;
            PG8_LDB(B0, 1, 0); PG8_LDB(B1, 1, 1); PG8_SCHED; PG8_LDA(At, 1, 0); PG8_STAGE(PG8_SA(0, 1), a2 + hstep, voffA);
            PG8_WAIT_V(8); PG8_WAIT_L(0); PG8_BAR; PG8_MMA(0, 0, At, B0); PG8_MMA(0, 1, At, B1); PG8_BAR; PG8_SCHED;
            PG8_LDA(At, 1, 1); PG8_STAGE(PG8_SB(1, 0), b3, voffB); PG8_STAGE(PG8_SB(1, 1), b3 + hstep, voffB); PG8_STAGE(PG8_SA(1, 0), a3, voffA);
            PG8_WAIT_V(8); PG8_WAIT_L(0); PG8_BAR; PG8_MMA(1, 0, At, B0); PG8_MMA(1, 1, At, B1); PG8_BAR; PG8_SCHED;
            } else {
            PG8_LDB(B0, 0, 0); PG8_SCHED; PG8_LDA(At, 0, 0); PG8_STAGE(PG8_SA(1, 1), a1 + hstep, voffA);
            PG8_WAIT_L(8); PG8_BAR; PG8_WAIT_L(0); PG8_MMA(0, 0, At, B0); PG8_BAR; PG8_SCHED;
            PG8_LDB(B1, 0, 1); PG8_STAGE(PG8_SB(0, 0), b2, voffB);
            PG8_BAR; PG8_WAIT_L(0); PG8_MMA(0, 1, At, B1); PG8_BAR;
            PG8_LDA(At, 0, 1); PG8_STAGE(PG8_SA(0, 0), a2, voffA);
            PG8_BAR; PG8_WAIT_L(0); PG8_MMA(1, 0, At, B0); PG8_BAR; PG8_SCHED;
            PG8_STAGE(PG8_SB(0, 1), b2 + hstep, voffB);
            PG8_WAIT_V(6); PG8_BAR; PG8_MMA(1, 1, At, B1); PG8_BAR;
            PG8_LDB(B0, 1, 0); PG8_SCHED; PG8_LDA(At, 1, 0); PG8_STAGE(PG8_SA(0, 1), a2 + hstep, voffA);
            PG8_WAIT_L(8); PG8_BAR; PG8_WAIT_L(0); PG8_MMA(0, 0, At, B0); PG8_BAR; PG8_SCHED;
            PG8_LDB(B1, 1, 1); PG8_STAGE(PG8_SB(1, 0), b3, voffB);
            PG8_BAR; PG8_WAIT_L(0); PG8_MMA(0, 1, At, B1); PG8_BAR;
            PG8_LDA(At, 1, 1); PG8_STAGE(PG8_SA(1, 0), a3, voffA);
            PG8_BAR; PG8_WAIT_L(0); PG8_MMA(1, 0, At, B0); PG8_BAR; PG8_SCHED;
            PG8_STAGE(PG8_SB(1, 1), b3 + hstep, voffB);
            PG8_WAIT_V(6); PG8_BAR; PG8_MMA(1, 1, At, B1); PG8_BAR;
            }
        }
        if constexpr (ALIGN_EPI) { if (wr == 0) PG8_BAR; }
        if constexpr (!Epi::AFTER_DRAIN) { E(acc, cur, wr, wc, fr, fq); S.done(cur); }
        if (!has_next) break;
#pragma unroll
        for (int a = 0; a < 2; ++a)
#pragma unroll
            for (int b = 0; b < 2; ++b)
#pragma unroll
                for (int m = 0; m < 4; ++m)
#pragma unroll
                    for (int n = 0; n < 2; ++n) acc[a][b][m][n] = (f32x4){0.f, 0.f, 0.f, 0.f};
        cur = nxt; cA = nA; cB = nB; ++ui;
        if constexpr (ALIGN_EPI) { if (wr == 1) PG8_BAR; }
    }
    PG8_WAIT_V(0);
    if constexpr (!ALIGN_EPI) { if (wr == 0) PG8_BAR; }
    PG8_BAR;
#undef PG8_SA
#undef PG8_SB
#undef PG8_STAGE
#undef PG8_LDA
#undef PG8_LDB
#undef PG8_MMA
#undef PG8_WAIT_V
#undef PG8_WAIT_L
#undef PG8_BAR
#undef PG8_SCHED
}
}

constexpr int NWAVES = 8;
constexpr int BATCH = 32, SEQ = 2048, DM = 1024, NTOK = BATCH * SEQ;
constexpr int IN_COLS = 1736;
constexpr int N1 = 2304, K2 = 1536, FF = 2816, N3 = 2 * FF;
constexpr int OFF_QL = 0, OFF_QI = 1024, OFF_U = 1536, OFF_C = 2048, OFF_KI = 2176, OFF_WI = 2240;
constexpr float EPS = 1e-6f;
constexpr float WI_SCALE = 0.044194173824159216f;

constexpr size_t MiB = 1u << 20;
constexpr size_t WS_CTL = 0, CTL_ZERO_BYTES = 1 * MiB;
constexpr size_t WS_W1T = 1 * MiB, WS_W2T = 6 * MiB, WS_W3T = 9 * MiB, WS_W4T = 20 * MiB, WS_CONVP = 26 * MiB;
constexpr size_t WS_HB = 32 * MiB;
constexpr size_t WS_P1 = 160 * MiB;
constexpr size_t WS_RAW = 32 * MiB;
constexpr size_t WS_X2 = 32 * MiB;
constexpr size_t WS_MIX = 448 * MiB;
constexpr size_t WS_CN = 640 * MiB;
constexpr size_t WS_ACT = 448 * MiB;
constexpr size_t WS_X1B = 800 * MiB;
constexpr size_t WS_END = 928 * MiB;

constexpr int LDS_BYTES = 147456;
constexpr int XB_LDS_OFF = 131072 + 1024;
constexpr size_t XB_CTL_OFF = 512 * 1024;

#define GAS __attribute__((address_space(1)))
#define LAS __attribute__((address_space(3)))
typedef unsigned short bf16;
typedef unsigned v4u __attribute__((ext_vector_type(4)));
typedef unsigned v2u __attribute__((ext_vector_type(2)));
typedef float f32x4 __attribute__((ext_vector_type(4)));

__device__ __forceinline__ unsigned f2bf(float f) { unsigned u = __builtin_bit_cast(unsigned, f); return (u + 0x7fffu + ((u >> 16) & 1u)) >> 16; }
__device__ __forceinline__ unsigned pk2(float lo, float hi) { return f2bf(lo) | (f2bf(hi) << 16); }
__device__ __forceinline__ float bflo(unsigned u) { return __uint_as_float(u << 16); }
__device__ __forceinline__ float bfhi(unsigned u) { return __uint_as_float(u & 0xffff0000u); }
__device__ __forceinline__ float wave_sum(float v) {
#pragma unroll
    for (int o = 1; o < 64; o <<= 1) v += __shfl_xor(v, o);
    return v;
}
__device__ __forceinline__ float wave_max(float v) {
#pragma unroll
    for (int o = 1; o < 64; o <<= 1) v = fmaxf(v, __shfl_xor(v, o));
    return v;
}
#define WAVE_LDS_SYNC() do { asm volatile("s_waitcnt lgkmcnt(0)" ::: "memory"); __builtin_amdgcn_wave_barrier(); } while (0)

struct Args {
    const float* x; const float* g_mix; const float* w_in; const float* g_kv; const float* w_uk; const float* w_uv; const float* w_pool; const float* pool_scale;
    const float* w_o; const float* g_ffn; const float* w_up; const float* conv_w; const float* conv_b; const float* w_down; const float* g_final;
    float* out; unsigned char* ws; int ph_lo, ph_hi;
};

__device__ __forceinline__ void tr_item(const float* __restrict__ W, int ldw, int k0, int srccol0, int valid, float colscale, const float* __restrict__ kscale,
                                        bf16* __restrict__ WT, int ldt, int nrow0, LAS float* scr, int lane) {
    const int j = lane & 31;
#pragma unroll 8
    for (int i = 0; i < 32; ++i) { const int kk = 2 * i + (lane >> 5);
        float v = (j < valid) ? W[(size_t)(k0 + kk) * ldw + srccol0 + j] : 0.f;
        if (kscale) v *= kscale[k0 + kk];
        scr[kk * 33 + j] = v * colscale; }
    asm volatile("s_waitcnt lgkmcnt(0)" ::: "memory"); __builtin_amdgcn_wave_barrier();
    const int c = lane & 7;
#pragma unroll
    for (int jj = 0; jj < 4; ++jj) { const int n = (lane >> 3) + 8 * jj; const LAS float* s = scr + (8 * c) * 33 + n;
        v4u o; o.x = pk2(s[0 * 33], s[1 * 33]); o.y = pk2(s[2 * 33], s[3 * 33]); o.z = pk2(s[4 * 33], s[5 * 33]); o.w = pk2(s[6 * 33], s[7 * 33]);
        *(v4u*)(WT + (size_t)(nrow0 + n) * ldt + k0 + 8 * c) = o; }
    asm volatile("s_waitcnt lgkmcnt(0)" ::: "memory"); __builtin_amdgcn_wave_barrier();
}
__device__ __forceinline__ void ph_prologue(const Args& a, LAS unsigned char* lds, const int tid, int gtid, int gthreads, int gw, int ngw, int lane) {
    unsigned char* ws = a.ws;
    bf16* W1T = (bf16*)(ws + WS_W1T); bf16* W2T = (bf16*)(ws + WS_W2T); bf16* W3T = (bf16*)(ws + WS_W3T); bf16* W4T = (bf16*)(ws + WS_W4T);
    float* CONVP = (float*)(ws + WS_CONVP);
    LAS float* L0 = (LAS float*)lds;
    for (int it = blockIdx.x; it < 640; it += gridDim.x) {
        if (it < 256) {
            const int hd = it >> 5, k0 = (it & 31) * 32;
            LAS float* Wuk = L0; LAS float* Win = L0 + 8192;
#pragma unroll
            for (int t = 0; t < 16; ++t) Wuk[tid + 512 * t] = a.w_uk[hd * 8192 + tid + 512 * t];
#pragma unroll
            for (int t = 0; t < 4; ++t) { const int idx = tid + 512 * t; Win[idx] = a.w_in[(size_t)(k0 + (idx >> 6)) * IN_COLS + hd * 64 + (idx & 63)]; }
            __syncthreads();
            const int c = tid & 127, kg = tid >> 7; float acc[8];
#pragma unroll
            for (int j = 0; j < 8; ++j) acc[j] = 0.f;
            for (int d = 0; d < 64; ++d) { const float wu = Wuk[d * 128 + c];
#pragma unroll
                for (int j = 0; j < 8; ++j) acc[j] += Win[(kg * 8 + j) * 64 + d] * wu; }
            v4u o; o.x = pk2(acc[0], acc[1]); o.y = pk2(acc[2], acc[3]); o.z = pk2(acc[4], acc[5]); o.w = pk2(acc[6], acc[7]);
            *(v4u*)(W1T + (size_t)(hd * 128 + c) * DM + k0 + kg * 8) = o;
        } else if (it < 512) {
            const int i2 = it - 256, hd = i2 >> 5, n0 = (i2 & 31) * 32;
            LAS float* Wuv = L0; LAS float* Wo = L0 + 8192;
#pragma unroll
            for (int t = 0; t < 16; ++t) Wuv[tid + 512 * t] = a.w_uv[hd * 8192 + tid + 512 * t];
#pragma unroll
            for (int t = 0; t < 4; ++t) { const int idx = tid + 512 * t; Wo[idx] = a.w_o[(size_t)(hd * 64 + (idx >> 5)) * DM + n0 + (idx & 31)]; }
            __syncthreads();
            const int nn = tid & 31, cg_ = tid >> 5; float acc[8];
#pragma unroll
            for (int j = 0; j < 8; ++j) acc[j] = 0.f;
            for (int d = 0; d < 64; ++d) { const float wo = Wo[d * 32 + nn];
#pragma unroll
                for (int j = 0; j < 8; ++j) acc[j] += Wuv[(cg_ * 8 + j) * 64 + d] * wo; }
            v4u o; o.x = pk2(acc[0], acc[1]); o.y = pk2(acc[2], acc[3]); o.z = pk2(acc[4], acc[5]); o.w = pk2(acc[6], acc[7]);
            *(v4u*)(W2T + (size_t)(n0 + nn) * K2 + hd * 128 + cg_ * 8) = o;
        } else {
            const int i3 = it - 512, g = i3 >> 5, n0 = (i3 & 31) * 32;
            LAS float* Wp = L0; LAS float* Wo = L0 + 16384;
#pragma unroll
            for (int t = 0; t < 32; ++t) Wp[tid + 512 * t] = a.w_pool[g * 16384 + tid + 512 * t];
#pragma unroll
            for (int t = 0; t < 8; ++t) { const int idx = tid + 512 * t, dd = idx >> 5; Wo[idx] = a.pool_scale[g * 128 + dd] * a.w_o[(size_t)(512 + g * 128 + dd) * DM + n0 + (idx & 31)]; }
            __syncthreads();
            const int nn = tid & 31, cg_ = tid >> 5; float acc[8];
#pragma unroll
            for (int j = 0; j < 8; ++j) acc[j] = 0.f;
            for (int dd = 0; dd < 128; ++dd) { const float wo = Wo[dd * 32 + nn];
#pragma unroll
                for (int j = 0; j < 8; ++j) acc[j] += Wp[(cg_ * 8 + j) * 128 + dd] * wo; }
            v4u o; o.x = pk2(acc[0], acc[1]); o.y = pk2(acc[2], acc[3]); o.z = pk2(acc[4], acc[5]); o.w = pk2(acc[6], acc[7]);
            *(v4u*)(W2T + (size_t)(n0 + nn) * K2 + 1024 + g * 128 + cg_ * 8) = o;
        }
        __syncthreads();
    }
    LAS float* scr = (LAS float*)(lds + (tid >> 6) * 16384);
    constexpr int I1 = 40 * 16, I3 = 176 * 16, I4 = 32 * 44;
    for (int it = gw; it < I1 + I3 + I4; it += ngw) {
        if (it < I1) {
            const int nb = it >> 4, k0 = (it & 15) * 64, n0 = 1024 + nb * 32; int sc0, valid = 32; float cs = 1.f;
            if (n0 < 1536) sc0 = 640 + (n0 - 1024); else if (n0 < 2048) sc0 = 1224 + (n0 - 1536); else if (n0 < 2176) sc0 = 512 + (n0 - 2048); else if (n0 < 2240) sc0 = 1152 + (n0 - 2176);
            else if (n0 == 2240) { sc0 = 1216; valid = 8; cs = WI_SCALE; } else { sc0 = 0; valid = 0; }
            tr_item(a.w_in, IN_COLS, k0, sc0, valid, cs, nullptr, W1T, DM, n0, scr, lane);
        } else if (it < I1 + I3) {
            const int i2 = it - I1, nb = i2 >> 4, k0 = (i2 & 15) * 64, r0 = nb * 32, j = r0 >> 8, ii = r0 & 255;
            const int sc0 = (ii < 128) ? (128 * j + ii) : (FF + 128 * j + (ii - 128));
            tr_item(a.w_up, N3, k0, sc0, 32, 1.f, a.g_ffn, W3T, DM, r0, scr, lane);
        } else {
            const int i3 = it - I1 - I3, nb = i3 / 44, k0 = (i3 - nb * 44) * 64;
            tr_item(a.w_down, DM, k0, nb * 32, 32, 1.f, nullptr, W4T, FF, nb * 32, scr, lane);
        }
    }
    for (int r = gtid; r < N3; r += gthreads) {
        const int j = r >> 8, ii = r & 255; const int col = (ii < 128) ? (128 * j + ii) : (FF + 128 * j + (ii - 128));
        CONVP[r] = a.conv_w[col]; CONVP[N3 + r] = a.conv_w[N3 + col]; CONVP[2 * N3 + r] = a.conv_w[2 * N3 + col]; CONVP[3 * N3 + r] = a.conv_b[col];
    }
    bf16* HB = (bf16*)(ws + WS_HB);
    for (int m = gw; m < NTOK; m += ngw) {
        const f32x4* xr = (const f32x4*)(a.x + (size_t)m * DM) + lane;
        f32x4 v[4]; float s = 0.f;
#pragma unroll
        for (int j = 0; j < 4; ++j) { v[j] = xr[64 * j]; s += (v[j].x * v[j].x + v[j].y * v[j].y) + (v[j].z * v[j].z + v[j].w * v[j].w); }
        const float rinv = 1.0f / sqrtf(wave_sum(s) * (1.0f / DM) + EPS);
        unsigned long long* o8 = (unsigned long long*)(HB + (size_t)m * DM) + lane;
#pragma unroll
        for (int j = 0; j < 4; ++j) { const f32x4 g = ((const f32x4*)a.g_mix)[lane + 64 * j];
            o8[64 * j] = (unsigned long long)pk2(v[j].x * rinv * g.x, v[j].y * rinv * g.y) | ((unsigned long long)pk2(v[j].z * rinv * g.z, v[j].w * rinv * g.w) << 32); }
    }
}

__device__ __forceinline__ void ph_cnorm_pool(const Args& a, int gw, int ngw, int lane) {
    const bf16* P1 = (const bf16*)(a.ws + WS_P1); bf16* CN = (bf16*)(a.ws + WS_CN); bf16* MIX = (bf16*)(a.ws + WS_MIX);
    for (int tok = gw; tok < NTOK; tok += ngw) {
        const bf16* prow = P1 + (size_t)tok * N1;
        const unsigned cw = *(const unsigned*)(prow + OFF_C + 2 * lane);
        const float c0 = bflo(cw), c1 = bfhi(cw);
        const float rinv = 1.0f / sqrtf(wave_sum(c0 * c0 + c1 * c1) * (1.0f / 128.0f) + EPS);
        *(unsigned*)(CN + (size_t)tok * 128 + 2 * lane) = pk2(c0 * rinv * a.g_kv[2 * lane], c1 * rinv * a.g_kv[2 * lane + 1]);
        const int pos = tok & (SEQ - 1), win = 2 << (lane >> 4), cnt = (pos + 1 < win) ? pos + 1 : win;
        float s[8];
#pragma unroll
        for (int j = 0; j < 8; ++j) s[j] = 0.f;
        v4u u0 = (v4u){0, 0, 0, 0};
        for (int j = 0; j < cnt; ++j) {
            const v4u u = *(const v4u*)(prow - (size_t)j * N1 + OFF_U + 8 * lane);
            if (j == 0) u0 = u;
            s[0] += bflo(u.x); s[1] += bfhi(u.x); s[2] += bflo(u.y); s[3] += bfhi(u.y); s[4] += bflo(u.z); s[5] += bfhi(u.z); s[6] += bflo(u.w); s[7] += bfhi(u.w);
        }
        const float ic = 1.0f / (float)cnt;
        v4u o; o.x = pk2(s[0] * ic - bflo(u0.x), s[1] * ic - bfhi(u0.x)); o.y = pk2(s[2] * ic - bflo(u0.y), s[3] * ic - bfhi(u0.y));
        o.z = pk2(s[4] * ic - bflo(u0.z), s[5] * ic - bfhi(u0.z)); o.w = pk2(s[6] * ic - bflo(u0.w), s[7] * ic - bfhi(u0.w));
        *(v4u*)(MIX + (size_t)tok * K2 + 1024 + 8 * lane) = o;
    }
}

__device__ __forceinline__ void ph_attn_naive(const Args& a, LAS unsigned char* lds, int wave, int gw, int ngw, int lane) {
    const bf16* P1 = (const bf16*)(a.ws + WS_P1); const bf16* CN = (const bf16*)(a.ws + WS_CN); bf16* MIX = (bf16*)(a.ws + WS_MIX);
    LAS unsigned char* base = lds + wave * 16384;
    LAS unsigned* uk = (LAS unsigned*)base;
    LAS float* pb = (LAS float*)base;
    LAS float* qi = (LAS float*)(base + 8192);
    LAS float* ql = (LAS float*)(base + 10240);
    LAS int* idx = (LAS int*)(base + 14336);
    LAS float* wl = (LAS float*)(base + 15360);
    const unsigned long long lt_mask = (lane == 0) ? 0ull : (~0ull >> (64 - lane));
    for (int q = gw; q < NTOK; q += ngw) {
        const int b = q >> 11, pos = q & (SEQ - 1), n = ((pos >> 6) + 1) << 6;
        const bf16* prow = P1 + (size_t)q * N1;
        { const v4u t = *(const v4u*)(prow + OFF_QI + 8 * lane);
          qi[8 * lane + 0] = bflo(t.x); qi[8 * lane + 1] = bfhi(t.x); qi[8 * lane + 2] = bflo(t.y); qi[8 * lane + 3] = bfhi(t.y);
          qi[8 * lane + 4] = bflo(t.z); qi[8 * lane + 5] = bfhi(t.z); qi[8 * lane + 6] = bflo(t.w); qi[8 * lane + 7] = bfhi(t.w); }
#pragma unroll
        for (int h2 = 0; h2 < 2; ++h2) { const v4u t = *(const v4u*)(prow + OFF_QL + 16 * lane + 8 * h2); const int o = 16 * lane + 8 * h2;
          ql[o + 0] = bflo(t.x); ql[o + 1] = bfhi(t.x); ql[o + 2] = bflo(t.y); ql[o + 3] = bfhi(t.y); ql[o + 4] = bflo(t.z); ql[o + 5] = bfhi(t.z); ql[o + 6] = bflo(t.w); ql[o + 7] = bfhi(t.w); }
        if (lane < 4) { const unsigned t = *(const unsigned*)(prow + OFF_WI + 2 * lane); wl[2 * lane] = bflo(t); wl[2 * lane + 1] = bfhi(t); }
        WAVE_LDS_SYNC();
        const int nk = n >> 6;
        for (int i = 0; i < nk; ++i) {
            const int key = i * 64 + lane;
            const v4u* kr = (const v4u*)(P1 + (size_t)(b * SEQ + key) * N1 + OFF_KI);
            v4u k8[8];
#pragma unroll
            for (int j = 0; j < 8; ++j) k8[j] = kr[j];
            float s = 0.f;
#pragma unroll 1
            for (int hd = 0; hd < 8; ++hd) { float d0 = 0.f, d1 = 0.f;
#pragma unroll
                for (int j = 0; j < 8; ++j) { const f32x4 qa = *(const LAS f32x4*)(qi + hd * 64 + 8 * j), qb = *(const LAS f32x4*)(qi + hd * 64 + 8 * j + 4); const v4u t = k8[j];
                    d0 += (qa.x * bflo(t.x) + qa.z * bflo(t.y)) + (qb.x * bflo(t.z) + qb.z * bflo(t.w));
                    d1 += (qa.y * bfhi(t.x) + qa.w * bfhi(t.y)) + (qb.y * bfhi(t.z) + qb.w * bfhi(t.w)); }
                s += wl[hd] * fmaxf(d0 + d1, 0.f); }
            s += 0.0f;
            unsigned u = __float_as_uint(s); u = (u & 0x80000000u) ? ~u : (u | 0x80000000u);
            uk[key] = u;
        }
        WAVE_LDS_SYNC();
        int nsel;
        if (n <= 256) { for (int j = lane; j < n; j += 64) idx[j] = j; nsel = n; }
        else {
            unsigned prefix = 0u;
            for (int bit = 31; bit >= 0; --bit) {
                const unsigned cand = prefix | (1u << bit); int cnt = 0;
                for (int i = 0; i < nk; ++i) cnt += __popcll(__ballot(uk[i * 64 + lane] >= cand));
                if (cnt >= 256) prefix = cand;
            }
            int cgt = 0;
            for (int i = 0; i < nk; ++i) cgt += __popcll(__ballot(uk[i * 64 + lane] > prefix));
            const int need = 256 - cgt; int basep = 0, eqrun = 0;
            for (int i = 0; i < nk; ++i) {
                const unsigned u = uk[i * 64 + lane]; const bool gt = u > prefix, eq = (u == prefix);
                const unsigned long long eqm = __ballot(eq);
                const int rank = eqrun + __popcll(eqm & lt_mask);
                const bool sel = gt || (eq && rank < need);
                const unsigned long long sm = __ballot(sel);
                if (sel) idx[basep + __popcll(sm & lt_mask)] = i * 64 + lane;
                basep += __popcll(sm); eqrun += __popcll(eqm);
            }
            nsel = 256;
        }
        WAVE_LDS_SYNC();
#pragma unroll 1
        for (int jj = 0; jj < 4; ++jj) {
            const int j = jj * 64 + lane; const bool valid = j < nsel; const int key = valid ? idx[j] : 0;
            const v4u* cr = (const v4u*)(CN + (size_t)(b * SEQ + key) * 128);
            float dot[8];
#pragma unroll
            for (int hd = 0; hd < 8; ++hd) dot[hd] = 0.f;
#pragma unroll 2
            for (int c8 = 0; c8 < 16; ++c8) { const v4u t = cr[c8];
                const float c0 = bflo(t.x), c1 = bfhi(t.x), c2 = bflo(t.y), c3 = bfhi(t.y), c4 = bflo(t.z), c5 = bfhi(t.z), c6 = bflo(t.w), c7 = bfhi(t.w);
#pragma unroll
                for (int hd = 0; hd < 8; ++hd) { const f32x4 qa = *(const LAS f32x4*)(ql + hd * 128 + c8 * 8), qb = *(const LAS f32x4*)(ql + hd * 128 + c8 * 8 + 4);
                    dot[hd] += (qa.x * c0 + qa.y * c1) + (qa.z * c2 + qa.w * c3) + (qb.x * c4 + qb.y * c5) + (qb.z * c6 + qb.w * c7); } }
            const float dist = fabsf((float)(pos - key));
#pragma unroll
            for (int hd = 0; hd < 8; ++hd) { const float slope = __uint_as_float((unsigned)(127 - (hd + 1)) << 23);
                pb[hd * 256 + j] = valid ? (dot[hd] * 0.125f - slope * dist) : -__builtin_inff(); }
        }
        WAVE_LDS_SYNC();
#pragma unroll 1
        for (int hd = 0; hd < 8; ++hd) {
            float p[4];
#pragma unroll
            for (int jj = 0; jj < 4; ++jj) p[jj] = pb[hd * 256 + jj * 64 + lane];
            float m = fmaxf(fmaxf(p[0], p[1]), fmaxf(p[2], p[3])); m = wave_max(m);
            float s = 0.f;
#pragma unroll
            for (int jj = 0; jj < 4; ++jj) { p[jj] = __expf(p[jj] - m); s += p[jj]; }
            s = wave_sum(s); const float inv = 1.0f / s;
#pragma unroll
            for (int jj = 0; jj < 4; ++jj) pb[hd * 256 + jj * 64 + lane] = p[jj] * inv;
        }
        WAVE_LDS_SYNC();
        float o0[8], o1[8];
#pragma unroll
        for (int hd = 0; hd < 8; ++hd) { o0[hd] = 0.f; o1[hd] = 0.f; }
        for (int j = 0; j < nsel; j += 4) {
            unsigned cw[4];
#pragma unroll
            for (int t = 0; t < 4; ++t) cw[t] = *(const unsigned*)(CN + (size_t)(b * SEQ + idx[j + t]) * 128 + 2 * lane);
#pragma unroll
            for (int t = 0; t < 4; ++t) { const float c0 = bflo(cw[t]), c1 = bfhi(cw[t]);
#pragma unroll
                for (int hd = 0; hd < 8; ++hd) { const float p = pb[hd * 256 + j + t]; o0[hd] += p * c0; o1[hd] += p * c1; } }
        }
#pragma unroll
        for (int hd = 0; hd < 8; ++hd) *(unsigned*)(MIX + (size_t)q * K2 + hd * 128 + 2 * lane) = pk2(o0[hd], o1[hd]);
        WAVE_LDS_SYNC();
    }
}

namespace dsa {
using bf16x8 = __attribute__((ext_vector_type(8))) short;
using s16x4  = __attribute__((ext_vector_type(4))) short;
using f32x16 = __attribute__((ext_vector_type(16))) float;
using u32x4  = __attribute__((ext_vector_type(4))) unsigned;
constexpr int NW = 8, KVBLK = 64;
constexpr float SCALE = 0.125f, LOG2E = 1.4426950408889634f, THR = 8.f;
constexpr int SHM_V = KVBLK * 128 * 2, SHM_K = KVBLK * 128 * 2, SHM_ATTN = 2 * SHM_V + 2 * SHM_K + NW * 64 * 4;
constexpr unsigned NEG2 = 0xC6EAC6EAu;
#define KSWZ(row, colB) ((row) * 256 + ((colB) ^ (((row) & 7) << 4)))
#define SBAR() __builtin_amdgcn_sched_barrier(0)
__device__ __forceinline__ int crow(int r, int hi) { return (r & 3) + 8 * (r >> 2) + 4 * hi; }
__device__ __forceinline__ unsigned cvtpk(float lo, float hi) { unsigned r; asm volatile("v_cvt_pk_bf16_f32 %0, %1, %2" : "=v"(r) : "v"(lo), "v"(hi)); return r; }

template <int CTRL> __device__ __forceinline__ unsigned dppu(unsigned x) { return (unsigned)__builtin_amdgcn_update_dpp(0, (int)x, CTRL, 0xf, 0xf, true); }
__device__ __forceinline__ unsigned half_sum(unsigned x, int h) {
    x += dppu<0xB1>(x); x += dppu<0x4E>(x); x += dppu<0x141>(x); x += dppu<0x140>(x);
    const unsigned a = __builtin_amdgcn_readlane(x, 0) + __builtin_amdgcn_readlane(x, 16), b = __builtin_amdgcn_readlane(x, 32) + __builtin_amdgcn_readlane(x, 48);
    return h ? b : a;
}
__device__ __forceinline__ unsigned half_min(unsigned x, int h) {
    x = min(x, dppu<0xB1>(x)); x = min(x, dppu<0x4E>(x)); x = min(x, dppu<0x141>(x)); x = min(x, dppu<0x140>(x));
    const unsigned a = min((unsigned)__builtin_amdgcn_readlane(x, 0), (unsigned)__builtin_amdgcn_readlane(x, 16)), b = min((unsigned)__builtin_amdgcn_readlane(x, 32), (unsigned)__builtin_amdgcn_readlane(x, 48));
    return h ? b : a;
}
__device__ __forceinline__ unsigned half_max(unsigned x, int h) {
    x = max(x, dppu<0xB1>(x)); x = max(x, dppu<0x4E>(x)); x = max(x, dppu<0x141>(x)); x = max(x, dppu<0x140>(x));
    const unsigned a = max((unsigned)__builtin_amdgcn_readlane(x, 0), (unsigned)__builtin_amdgcn_readlane(x, 16)), b = max((unsigned)__builtin_amdgcn_readlane(x, 32), (unsigned)__builtin_amdgcn_readlane(x, 48));
    return h ? b : a;
}

__device__ __forceinline__ void idx_select(const bf16* __restrict__ P1, int b, int tokw, int n, int lane_in, unsigned& W0lo, unsigned& W0hi, unsigned& W1lo, unsigned& W1hi) {
    if (n <= 256) { W0lo = W0hi = W1lo = W1hi = 0xffffffffu; return; }
    int lane = lane_in; asm volatile("" : "+v"(lane));
    const int c = lane & 31, h = lane >> 5;
    const int qa = 2 * ((c >> 2) & 1) + (c >> 4), ih = (c & 3) + 4 * ((c >> 3) & 1);
    const bf16* qip = P1 + (size_t)(tokw + qa) * N1 + OFF_QI + ih * 64 + 8 * h;
    bf16x8 af[4];
#pragma unroll
    for (int s = 0; s < 4; ++s) af[s] = *(const bf16x8*)(qip + 16 * s);
    float wq0[8], wq1[8];
    { const u32x4 t = *(const u32x4*)(P1 + (size_t)(tokw + 2 * h) * N1 + OFF_WI), u = *(const u32x4*)(P1 + (size_t)(tokw + 2 * h + 1) * N1 + OFF_WI);
      wq0[0] = bflo(t.x); wq0[1] = bfhi(t.x); wq0[2] = bflo(t.y); wq0[3] = bfhi(t.y); wq0[4] = bflo(t.z); wq0[5] = bfhi(t.z); wq0[6] = bflo(t.w); wq0[7] = bfhi(t.w);
      wq1[0] = bflo(u.x); wq1[1] = bfhi(u.x); wq1[2] = bflo(u.y); wq1[3] = bfhi(u.y); wq1[4] = bflo(u.z); wq1[5] = bfhi(u.z); wq1[6] = bflo(u.w); wq1[7] = bfhi(u.w); }
    const bf16* kbase = P1 + (size_t)(b * SEQ + c) * N1 + OFF_KI + 8 * h;
    const int nt = n >> 5;
    unsigned sc0[64], sc1[64];
    unsigned mn0 = 0xffffffffu, mx0 = 0u, mn1 = 0xffffffffu, mx1 = 0u;
    bf16x8 kf[2][4];
#pragma unroll
    for (int s = 0; s < 4; ++s) kf[0][s] = *(const bf16x8*)(kbase + 16 * s);
#pragma unroll
    for (int i = 0; i < 64; ++i) {
        if (i < nt) {
            if (i + 1 < nt) {
#pragma unroll
                for (int s = 0; s < 4; ++s) kf[(i + 1) & 1][s] = *(const bf16x8*)(kbase + (size_t)(i + 1) * 32 * N1 + 16 * s);
            }
            f32x16 acc = {};
#pragma unroll
            for (int s = 0; s < 4; ++s) acc = __builtin_amdgcn_mfma_f32_32x32x16_bf16(af[s], kf[i & 1][s], acc, 0, 0, 0);
            float s0 = 0.f, s1 = 0.f;
#pragma unroll
            for (int j = 0; j < 8; ++j) { s0 = fmaf(wq0[j], fmaxf(acc[j], 0.f), s0); s1 = fmaf(wq1[j], fmaxf(acc[8 + j], 0.f), s1); }
            s0 += 0.0f; s1 += 0.0f;
            unsigned u0 = __float_as_uint(s0), u1 = __float_as_uint(s1);
            u0 = (u0 & 0x80000000u) ? ~u0 : (u0 | 0x80000000u); u1 = (u1 & 0x80000000u) ? ~u1 : (u1 | 0x80000000u);
            sc0[i] = u0; sc1[i] = u1; mn0 = min(mn0, u0); mx0 = max(mx0, u0); mn1 = min(mn1, u1); mx1 = max(mx1, u1);
        } else { sc0[i] = 0u; sc1[i] = 0u; }
    }
    unsigned lo0 = half_min(mn0, h), hi0 = half_max(mx0, h) + 1u, lo1 = half_min(mn1, h), hi1 = half_max(mx1, h) + 1u;
    unsigned cl0 = (unsigned)n, cl1 = (unsigned)n;
    bool fin0 = false, fin1 = false;
    for (int it = 0; it < 40; ++it) {
        const unsigned mid0 = lo0 + ((hi0 - lo0) >> 1), mid1 = lo1 + ((hi1 - lo1) >> 1);
        unsigned c0 = 0u, c1 = 0u;
#pragma unroll
        for (int g = 0; g < 8; ++g) {
            if (g * 8 < nt) {
#pragma unroll
                for (int i = g * 8; i < g * 8 + 8; ++i) { c0 += (sc0[i] >= mid0) ? 1u : 0u; c1 += (sc1[i] >= mid1) ? 1u : 0u; }
            }
        }
        c0 = half_sum(c0, h); c1 = half_sum(c1, h);
        if (!fin0) { if (c0 >= 256u) { lo0 = mid0; cl0 = c0; } else hi0 = mid0; fin0 = (c0 == 256u) || (hi0 - lo0 <= 1u); }
        if (!fin1) { if (c1 >= 256u) { lo1 = mid1; cl1 = c1; } else hi1 = mid1; fin1 = (c1 == 256u) || (hi1 - lo1 <= 1u); }
        if (__all(fin0 && fin1)) break;
    }
    unsigned w0l = 0u, w0h = 0u, w1l = 0u, w1h = 0u;
    if (__all(cl0 == 256u && cl1 == 256u)) {
#define BITOF(cond) ({ unsigned t__ = (cond) ? 1u : 0u; asm volatile("" : "+v"(t__)); t__; })
#pragma unroll
        for (int i = 0; i < 32; ++i) { w0l |= BITOF(sc0[i] >= lo0) << i; w1l |= BITOF(sc1[i] >= lo1) << i; }
#pragma unroll
        for (int i = 32; i < 64; ++i) { w0h |= BITOF(sc0[i] >= lo0) << (i - 32); w1h |= BITOF(sc1[i] >= lo1) << (i - 32); }
    } else {
        unsigned g0 = 0u, g1 = 0u;
#pragma unroll
        for (int i = 0; i < 64; ++i) { g0 += (sc0[i] > lo0) ? 1u : 0u; g1 += (sc1[i] > lo1) ? 1u : 0u; }
        g0 = half_sum(g0, h); g1 = half_sum(g1, h);
        const unsigned need0 = 256u - g0, need1 = 256u - g1, ltm = (1u << c) - 1u;
        unsigned run0 = 0u, run1 = 0u;
#pragma unroll
        for (int i = 0; i < 64; ++i) {
            const bool e0 = (sc0[i] == lo0), e1 = (sc1[i] == lo1);
            const unsigned long long m0 = __ballot(e0), m1 = __ballot(e1);
            const unsigned hb0 = h ? (unsigned)(m0 >> 32) : (unsigned)m0, hb1 = h ? (unsigned)(m1 >> 32) : (unsigned)m1;
            const bool s0 = (sc0[i] > lo0) || (e0 && (run0 + __popc(hb0 & ltm) < need0));
            const bool s1 = (sc1[i] > lo1) || (e1 && (run1 + __popc(hb1 & ltm) < need1));
            run0 += __popc(hb0); run1 += __popc(hb1);
            if (i < 32) { w0l |= BITOF(s0) << i; w1l |= BITOF(s1) << i; } else { w0h |= BITOF(s0) << (i - 32); w1h |= BITOF(s1) << (i - 32); }
        }
    }
#undef BITOF
    W0lo = w0l; W0hi = w0h; W1lo = w1l; W1hi = w1h;
}

__device__ __forceinline__ void partialSM(f32x16& p0, f32x16& p1, float b0, float& m_reg, float& mn, float& alpha) {
    constexpr float C = SCALE * LOG2E;
    float pmax = p0[0];
#pragma unroll
    for (int r = 1; r < 16; ++r) pmax = fmaxf(pmax, p0[r]);
#pragma unroll
    for (int r = 0; r < 16; ++r) pmax = fmaxf(pmax, p1[r]);
    { auto rr = __builtin_amdgcn_permlane32_swap(__float_as_uint(pmax), __float_as_uint(pmax), false, false);
      pmax = fmaxf(__uint_as_float(rr[0]), __uint_as_float(rr[1])); }
    const float pm = fmaf(pmax, C, b0);
    if (__builtin_expect(__all(pm - m_reg <= THR * LOG2E), 1)) { mn = m_reg; alpha = 1.f; }
    else { mn = fmaxf(m_reg, pm); alpha = __builtin_amdgcn_exp2f(m_reg - mn); m_reg = mn; }
    const float off = b0 - mn;
#pragma unroll
    for (int r = 0; r < 16; ++r) p0[r] = fmaf(p0[r], C, off);
#pragma unroll
    for (int r = 0; r < 16; ++r) p1[r] = fmaf(p1[r], C, off);
#pragma unroll
    for (int r = 0; r < 16; ++r) p0[r] = __builtin_amdgcn_exp2f(p0[r]);
}
__device__ __forceinline__ void finishSM(f32x16& p0, f32x16& p1, float alpha, float& l_reg, bf16x8& pa0, bf16x8& pa1, bf16x8& pa2, bf16x8& pa3) {
#pragma unroll
    for (int r = 0; r < 16; ++r) p1[r] = __builtin_amdgcn_exp2f(p1[r]);
    float ps = 0;
#pragma unroll
    for (int r = 0; r < 16; ++r) ps += p0[r];
#pragma unroll
    for (int r = 0; r < 16; ++r) ps += p1[r];
    { auto rr = __builtin_amdgcn_permlane32_swap(__float_as_uint(ps), __float_as_uint(ps), false, false);
      ps = __uint_as_float(rr[0]) + __uint_as_float(rr[1]); }
    l_reg = l_reg * alpha + ps;
#define PK4(P, BASE, OUT) do { unsigned a0 = cvtpk(P[BASE + 0], P[BASE + 1]), a1 = cvtpk(P[BASE + 2], P[BASE + 3]);   \
    unsigned b0_ = cvtpk(P[BASE + 4], P[BASE + 5]), b1_ = cvtpk(P[BASE + 6], P[BASE + 7]);                              \
    auto r0 = __builtin_amdgcn_permlane32_swap(a0, b0_, false, false); auto r1 = __builtin_amdgcn_permlane32_swap(a1, b1_, false, false); \
    u32x4 w = {r0[0], r1[0], r0[1], r1[1]}; OUT = *reinterpret_cast<bf16x8*>(&w); } while (0)
    PK4(p0, 0, pa0); PK4(p0, 8, pa1); PK4(p1, 0, pa2); PK4(p1, 8, pa3);
#undef PK4
}
__device__ __forceinline__ void qkt(f32x16& p0, f32x16& p1, const LAS char* Ks, const bf16x8* qr, bf16x8 ax0, bf16x8 ax1, bf16x8 ef, int r32, int hi) {
    p0 = __builtin_amdgcn_mfma_f32_32x32x16_bf16(ax0, ef, f32x16{}, 0, 0, 0);
    p1 = __builtin_amdgcn_mfma_f32_32x32x16_bf16(ax1, ef, f32x16{}, 0, 0, 0);
#pragma unroll
    for (int d0 = 0; d0 < 8; ++d0) { const int cb = (d0 * 16 + hi * 8) * 2;
        const bf16x8 b0 = *reinterpret_cast<const LAS bf16x8*>(Ks + KSWZ(r32, cb));
        const bf16x8 b1 = *reinterpret_cast<const LAS bf16x8*>(Ks + KSWZ(32 + r32, cb));
        p0 = __builtin_amdgcn_mfma_f32_32x32x16_bf16(b0, qr[d0], p0, 0, 0, 0);
        p1 = __builtin_amdgcn_mfma_f32_32x32x16_bf16(b1, qr[d0], p1, 0, 0, 0); }
}
__device__ __forceinline__ int v_st(int k, int c) { const int kk = (k & ~0xC) | ((k & 4) << 1) | ((k & 8) >> 1); return ((kk >> 3) * 4 + (c >> 5)) * 512 + ((kk & 7) * 32 + (c & 31)) * 2; }
__device__ __forceinline__ int v_rd_base(int lane) { return ((lane & 3) << 3) | (((lane >> 2) & 3) << 6) | (((lane >> 4) & 1) << 5) | (((lane >> 5) & 1) << 8); }
constexpr int v_rd_off(int d0, int ks, int half) { return d0 * 512 + ks * 4096 + half * 2048; }
template <int OFF> __device__ __forceinline__ s16x4 tr_read(int vb) { s16x4 r; asm volatile("ds_read_b64_tr_b16 %0, %1 offset:%2" : "=&v"(r) : "v"(vb), "i"(OFF) : "memory"); return r; }
template <int D0> __device__ __forceinline__ void pv_one(f32x16& od, int vb, bf16x8 pa0, bf16x8 pa1, bf16x8 pa2, bf16x8 pa3) {
    const s16x4 l0 = tr_read<v_rd_off(D0, 0, 0)>(vb), h0 = tr_read<v_rd_off(D0, 0, 1)>(vb), l1 = tr_read<v_rd_off(D0, 1, 0)>(vb), h1 = tr_read<v_rd_off(D0, 1, 1)>(vb);
    const s16x4 l2 = tr_read<v_rd_off(D0, 2, 0)>(vb), h2 = tr_read<v_rd_off(D0, 2, 1)>(vb), l3 = tr_read<v_rd_off(D0, 3, 0)>(vb), h3 = tr_read<v_rd_off(D0, 3, 1)>(vb);
    asm volatile("s_waitcnt lgkmcnt(0)" ::: "memory"); SBAR();
#define PK(L, H) (bf16x8){L[0], L[1], L[2], L[3], H[0], H[1], H[2], H[3]}
    od = __builtin_amdgcn_mfma_f32_32x32x16_bf16(pa0, PK(l0, h0), od, 0, 0, 0);
    od = __builtin_amdgcn_mfma_f32_32x32x16_bf16(pa1, PK(l1, h1), od, 0, 0, 0);
    od = __builtin_amdgcn_mfma_f32_32x32x16_bf16(pa2, PK(l2, h2), od, 0, 0, 0);
    od = __builtin_amdgcn_mfma_f32_32x32x16_bf16(pa3, PK(l3, h3), od, 0, 0, 0);
#undef PK
}
__device__ __forceinline__ void pv_d0(f32x16* o, int vb, bf16x8 pa0, bf16x8 pa1, bf16x8 pa2, bf16x8 pa3) {
    pv_one<0>(o[0], vb, pa0, pa1, pa2, pa3); pv_one<1>(o[1], vb, pa0, pa1, pa2, pa3); pv_one<2>(o[2], vb, pa0, pa1, pa2, pa3); pv_one<3>(o[3], vb, pa0, pa1, pa2, pa3);
}

__device__ __forceinline__ void attn_item(const bf16* __restrict__ P1, const bf16* __restrict__ Cb, bf16* __restrict__ MIXp, int tok0, int pos0, int n, LAS char* lds, const int tid_in) {
    int tid = tid_in; asm volatile("" : "+v"(tid));
    const int wid = tid >> 6, lane = tid & 63, r32 = lane & 31, hi = lane >> 5;
    LAS char* V_lds = lds; LAS char* K_lds = lds + 2 * SHM_V;
    LAS float* wsl = (LAS float*)(lds + 2 * SHM_V + 2 * SHM_K) + wid * 64; LAS float* li_l = wsl; LAS float* al_l = wsl + 32;
    const LAS u32x4* mwl = (const LAS u32x4*)(lds + SHM_ATTN) + tid;
    float m_reg = -1e30f, l_reg = 0; f32x16 o[4] = {}; bf16x8 qr[8];
    const int ql_ = r32 >> 3, hd = r32 & 7;
    { const bf16* Qw = P1 + (size_t)(tok0 + 4 * wid + ql_) * N1 + OFF_QL + hd * 128 + hi * 8;
#pragma unroll
      for (int d0 = 0; d0 < 8; ++d0) qr[d0] = *(const bf16x8*)(Qw + d0 * 16); }
    const float slope2 = __uint_as_float((unsigned)(127 - (hd + 1)) << 23) * LOG2E;
    const float qposf = (float)(pos0 + 4 * wid + ql_);
    bf16x8 ef; { u32x4 w = {0u, 0u, 0u, 0u}; w.x = ((ql_ == 2 * hi) ? 0x3F80u : 0u) | ((ql_ == 2 * hi + 1) ? 0x3F800000u : 0u); w.y = (hi == 0) ? ((unsigned)(129 - hd) << 7) : 0u; ef = *reinterpret_cast<bf16x8*>(&w); }
    const unsigned klw0 = (hi == 0) ? (__float_as_uint((float)r32) >> 16) : 0u, klw1 = (hi == 0) ? (__float_as_uint((float)(32 + r32)) >> 16) : 0u;
    const int NT = n >> 6, NTP = (NT + 1) & ~1;
#define TILE_K0(j) (((j) < NT) ? (NT - 1 - (j)) * KVBLK : 0)
#define MASKW(s_) ({ const int s__ = (s_); const unsigned b0__ = ((s__ < 32) ? (Wv_.x >> s__) : (Wv_.y >> (s__ - 32))) & 1u, b1__ = ((s__ < 32) ? (Wv_.z >> s__) : (Wv_.w >> (s__ - 32))) & 1u; \
        NEG2 & ~((b0__ ? 0xffffu : 0u) | (b1__ ? 0xffff0000u : 0u)); })
#define MKAX(j, ax0, ax1) do { u32x4 w0_ = {NEG2, klw0, 0u, 0u}, w1_ = {NEG2, klw1, 0u, 0u}; if ((j) < NT) { const u32x4 Wv_ = *mwl; const int tt_ = NT - 1 - (j); w0_.x = MASKW(2 * tt_); w1_.x = MASKW(2 * tt_ + 1); } \
        ax0 = *reinterpret_cast<bf16x8*>(&w0_); ax1 = *reinterpret_cast<bf16x8*>(&w1_); } while (0)
#define TILE_B0(j) (slope2 * ((float)TILE_K0(j) - qposf))
    const int sr = tid >> 4, sc = (tid & 15) * 8, vst0 = v_st(sr, sc), vst1 = v_st(32 + sr, sc);
    const int vb0 = (int)(unsigned)(size_t)V_lds + v_rd_base(lane);
    struct { bf16x8 c0, c1; } sr_[1];
#define SLOAD(i, k0) do { sr_[i].c0 = *(const bf16x8*)(Cb + (size_t)((k0) + sr) * 128 + sc); sr_[i].c1 = *(const bf16x8*)(Cb + (size_t)((k0) + 32 + sr) * 128 + sc); } while (0)
#define SWRITE(b, i) do { *(LAS bf16x8*)(V_lds + (b) * SHM_V + vst0) = sr_[i].c0; *(LAS bf16x8*)(V_lds + (b) * SHM_V + vst1) = sr_[i].c1; const int kc = sc * 2; \
    *(LAS bf16x8*)(K_lds + (b) * SHM_K + KSWZ(sr, kc)) = sr_[i].c0; *(LAS bf16x8*)(K_lds + (b) * SHM_K + KSWZ(32 + sr, kc)) = sr_[i].c1; } while (0)
#define SWAIT() asm volatile("s_waitcnt vmcnt(0)" ::: "memory")
#define RESC(a) do { if (__any((a) < 1.f)) { if (hi == 0) al_l[r32] = (a); asm volatile("s_waitcnt lgkmcnt(0)" ::: "memory"); \
    _Pragma("unroll") for (int d = 0; d < 4; ++d) _Pragma("unroll") for (int r = 0; r < 16; ++r) o[d][r] *= al_l[crow(r, hi)]; } } while (0)
    f32x16 pA0, pA1, pB0, pB1; float mnA, mnB, alA, alB; bf16x8 pa0, pa1, pa2, pa3, ax0, ax1;
    constexpr int SE = 0, SO = 0;
    SLOAD(SE, TILE_K0(0)); asm volatile("s_waitcnt vmcnt(0)" ::: "memory"); SWRITE(0, SE); __syncthreads();
    MKAX(0, ax0, ax1); qkt(pA0, pA1, K_lds, qr, ax0, ax1, ef, r32, hi);
    {
        const float base = (float)TILE_K0(0) - qposf + (float)(4 * hi), s16 = -2.0f * __uint_as_float((unsigned)(129 - hd) << 23);
#pragma unroll
        for (int r = 0; r < 16; ++r) { const float cr = (float)((r & 3) + 8 * (r >> 2));
            pA0[r] = fmaf(s16, fmaxf(base + cr, 0.f), pA0[r]); pA1[r] = fmaf(s16, fmaxf(base + cr + 32.f, 0.f), pA1[r]); }
    }
    partialSM(pA0, pA1, TILE_B0(0), m_reg, mnA, alA);
    SLOAD(SO, TILE_K0(1));
    SWAIT(); SWRITE(1, SO); __syncthreads();
    for (int j = 1; j + 1 < NTP; j += 2) {
        SBAR(); MKAX(j, ax0, ax1); qkt(pB0, pB1, K_lds + SHM_K, qr, ax0, ax1, ef, r32, hi);
        finishSM(pA0, pA1, alA, l_reg, pa0, pa1, pa2, pa3); SBAR();
        SLOAD(SO, TILE_K0(j + 1)); SBAR();
        pv_d0(o, vb0, pa0, pa1, pa2, pa3); partialSM(pB0, pB1, TILE_B0(j), m_reg, mnB, alB);
        __syncthreads(); SWAIT(); SWRITE(0, SE);
        RESC(alB); __syncthreads();
        SBAR(); MKAX(j + 1, ax0, ax1); qkt(pA0, pA1, K_lds, qr, ax0, ax1, ef, r32, hi);
        finishSM(pB0, pB1, alB, l_reg, pa0, pa1, pa2, pa3); SBAR();
        SLOAD(SE, TILE_K0(j + 2)); SBAR();
        pv_d0(o, vb0 + SHM_V, pa0, pa1, pa2, pa3); partialSM(pA0, pA1, TILE_B0(j + 1), m_reg, mnA, alA);
        __syncthreads(); SWAIT(); SWRITE(1, SO);
        RESC(alA); __syncthreads();
    }
    SBAR(); MKAX(NTP - 1, ax0, ax1); qkt(pB0, pB1, K_lds + SHM_K, qr, ax0, ax1, ef, r32, hi);
    finishSM(pA0, pA1, alA, l_reg, pa0, pa1, pa2, pa3); SBAR();
    pv_d0(o, vb0, pa0, pa1, pa2, pa3); partialSM(pB0, pB1, TILE_B0(NTP - 1), m_reg, mnB, alB);
    __syncthreads(); RESC(alB);
    finishSM(pB0, pB1, alB, l_reg, pa0, pa1, pa2, pa3); SBAR();
    pv_d0(o, vb0 + SHM_V, pa0, pa1, pa2, pa3);
    if (hi == 0) li_l[r32] = l_reg; asm volatile("s_waitcnt lgkmcnt(0)" ::: "memory");
    float rli[16];
#pragma unroll
    for (int r = 0; r < 16; ++r) rli[r] = __builtin_amdgcn_rcpf(li_l[crow(r, hi)]);
#pragma unroll
    for (int r = 0; r < 16; ++r) { const int orow = crow(r, hi);
        bf16* op = MIXp + (size_t)(tok0 + 4 * wid + (orow >> 3)) * K2 + (orow & 7) * 128 + r32;
#pragma unroll
        for (int d0 = 0; d0 < 4; ++d0) op[d0 * 32] = (bf16)f2bf(o[d0][r] * rli[r]); }
    __syncthreads();
#undef SLOAD
#undef SWRITE
#undef SWAIT
#undef RESC
#undef TILE_K0
#undef MASKW
#undef MKAX
#undef TILE_B0
}
}

__device__ __forceinline__ int tid_from(const int wid6) { int l; asm volatile("v_mbcnt_lo_u32_b32 %0, -1, 0\n\tv_mbcnt_hi_u32_b32 %0, -1, %0" : "=v"(l)); return wid6 | l; }
__device__ __forceinline__ void ph_attn_fast(const Args& a, LAS unsigned char* lds, const int variant, const int wid6) {
    const bf16* P1 = (const bf16*)(a.ws + WS_P1); const bf16* CN = (const bf16*)(a.ws + WS_CN); bf16* MIX = (bf16*)(a.ws + WS_MIX);
    const int G = gridDim.x;
    for (int it = blockIdx.x; it < BATCH * 64; it += G) {
        const int tid = tid_from(wid6);
        const int lane = tid & 63, wid = tid >> 6;
        const int gg = it & 255, m = it >> 8;
        const int b = (gg & 7) + 8 * (gg >> 6), jg = (gg >> 3) & 7, qb = (m & 1) ? (63 - jg - 8 * (m >> 1)) : (jg + 8 * (m >> 1));
        const int pos0 = qb * 32, tok0 = b * SEQ + pos0, n = ((pos0 >> 6) + 1) << 6;
        { unsigned w0l, w0h, w1l, w1h;
          if (variant == 2) { w0l = w0h = w1l = w1h = 0xffffffffu; } else
          dsa::idx_select(P1, b, tok0 + 4 * wid, n, lane, w0l, w0h, w1l, w1h);
          ((LAS dsa::u32x4*)(lds + dsa::SHM_ATTN))[tid] = (dsa::u32x4){w0l, w0h, w1l, w1h};
          asm volatile("s_waitcnt lgkmcnt(0)" ::: "memory");
          if (variant == 1) { ((dsa::u32x4*)(a.ws + WS_END))[(size_t)it * 512 + tid] = (dsa::u32x4){w0l, w0h, w1l, w1h}; continue; } }
        dsa::attn_item(P1, CN + (size_t)b * SEQ * 128, variant ? ((bf16*)(a.ws + WS_END) - (size_t)tok0 * K2 + (size_t)(tok0 & 4095) * K2) : MIX, tok0, pos0, n, (LAS char*)lds, tid);
    }
}

__device__ __forceinline__ void ph_conv(const Args& a, int hsel, int gtid, int gthreads) {
    const bf16* RAW = (const bf16*)(a.ws + WS_RAW); bf16* ACT = (bf16*)(a.ws + WS_ACT); const float* CONVP = (const float*)(a.ws + WS_CONVP);
    constexpr int CH = FF / 8;
    for (int i = gtid; i < (NTOK / 2) * CH; i += gthreads) {
        const int tl = i / CH, ch = i - tl * CH, tok = hsel * (NTOK / 2) + tl, pos = tok & (SEQ - 1);
        const int jc = ch * 8, j = jc >> 7, ii = jc & 127, rg = 256 * j + ii, ru = rg + 128;
        float cg_[8], cu_[8];
#pragma unroll
        for (int e = 0; e < 8; ++e) { cg_[e] = CONVP[3 * N3 + rg + e]; cu_[e] = CONVP[3 * N3 + ru + e]; }
#pragma unroll
        for (int tap = 0; tap < 3; ++tap) {
            const int back = 2 - tap; if (pos - back < 0) continue;
            const bf16* rrow = RAW + (size_t)(tl - back) * N3;
            const v4u g = *(const v4u*)(rrow + rg), u = *(const v4u*)(rrow + ru);
            const float gv[8] = {bflo(g.x), bfhi(g.x), bflo(g.y), bfhi(g.y), bflo(g.z), bfhi(g.z), bflo(g.w), bfhi(g.w)};
            const float uv[8] = {bflo(u.x), bfhi(u.x), bflo(u.y), bfhi(u.y), bflo(u.z), bfhi(u.z), bflo(u.w), bfhi(u.w)};
#pragma unroll
            for (int e = 0; e < 8; ++e) { cg_[e] += CONVP[tap * N3 + rg + e] * gv[e]; cu_[e] += CONVP[tap * N3 + ru + e] * uv[e]; }
        }
        float r[8];
#pragma unroll
        for (int e = 0; e < 8; ++e) r[e] = cg_[e] / (1.0f + __expf(-cg_[e])) * cu_[e];
        v4u o; o.x = pk2(r[0], r[1]); o.y = pk2(r[2], r[3]); o.z = pk2(r[4], r[5]); o.w = pk2(r[6], r[7]);
        *(v4u*)(ACT + (size_t)tok * FF + jc) = o;
    }
}

__device__ __forceinline__ void ph_final(const Args& a, int gw, int ngw, int lane) {
    const bf16* X2 = (const bf16*)(a.ws + WS_X2); const float* ss3 = (const float*)(a.ws + WS_CTL + 256 * 1024);
    for (int m = gw; m < NTOK; m += ngw) {
        const float rinv = 1.0f / sqrtf(ss3[m] * (1.0f / DM) + EPS);
#pragma unroll
        for (int h2 = 0; h2 < 2; ++h2) {
            const int c0 = h2 * 512 + 8 * lane;
            const v4u t = *(const v4u*)(X2 + (size_t)m * DM + c0);
            const f32x4 g0 = *(const f32x4*)(a.g_final + c0), g1 = *(const f32x4*)(a.g_final + c0 + 4);
            f32x4 o0, o1;
            o0.x = bflo(t.x) * rinv * g0.x; o0.y = bfhi(t.x) * rinv * g0.y; o0.z = bflo(t.y) * rinv * g0.z; o0.w = bfhi(t.y) * rinv * g0.w;
            o1.x = bflo(t.z) * rinv * g1.x; o1.y = bfhi(t.z) * rinv * g1.y; o1.z = bflo(t.w) * rinv * g1.z; o1.w = bfhi(t.w) * rinv * g1.w;
            *(f32x4*)(a.out + (size_t)m * DM + c0) = o0; *(f32x4*)(a.out + (size_t)m * DM + c0 + 4) = o1;
        }
    }
}

#define XB_TMO      128
#define XB_XCNT(j)  (256  + 64 * (j))
#define XB_XSUB(j)  (1280 + 64 * (j))
#define XB_XGEN(j)  (2304 + 64 * (j))
#define XB_TOP      3328
#define XB_TOPGEN   3392
#define XCD_BAR_WORDS 3456
#define XB_SPIN_CAP (1u << 18)
__device__ __forceinline__ unsigned xb_ld(unsigned* p)              { return __hip_atomic_load(p, __ATOMIC_RELAXED, __HIP_MEMORY_SCOPE_AGENT); }
__device__ __forceinline__ unsigned xb_add(unsigned* p, unsigned v) { return __hip_atomic_fetch_add(p, v, __ATOMIC_RELAXED, __HIP_MEMORY_SCOPE_AGENT); }
__device__ __forceinline__ unsigned xb_xcc_id() { return (unsigned)__builtin_amdgcn_s_getreg((3 << 11) | 20) & 0xFu; }
#define XB_SPIN(cond, bar) do { unsigned _sp = 0; while (cond) { __builtin_amdgcn_s_sleep(1); \
    if ((++_sp & 255u) == 0u) { if (xb_ld(&(bar)[XB_TMO])) break; if (_sp > XB_SPIN_CAP) { atomicAdd(&(bar)[XB_TMO], 1u); break; } } } } while (0)
struct XcdBarrier { unsigned* bar; unsigned x; volatile LAS unsigned* st; };
__device__ __forceinline__ XcdBarrier xcd_barrier_post(unsigned* bar, volatile LAS unsigned* st, const int tid) {
    XcdBarrier b; b.bar = bar; b.x = xb_xcc_id(); b.st = st;
    if (tid == 0) (void)xb_add(&bar[XB_XCNT(b.x)], 1u);
    return b;
}
__device__ __forceinline__ void xcd_barrier_complete(unsigned* bar, unsigned x, unsigned& nloc, unsigned& nx) {
    const unsigned G = gridDim.x * gridDim.y * gridDim.z;
    unsigned sum, cnt, mine, sp = 0u;
    for (;;) {
        sum = 0u; cnt = 0u; mine = 0u;
#pragma unroll
        for (unsigned j = 0; j < 16; ++j) { const unsigned c = xb_ld(&bar[XB_XCNT(j)]); sum += c; cnt += (c > 0u) ? 1u : 0u; mine = (j == x) ? c : mine; }
        if (sum == G) break;
        __builtin_amdgcn_s_sleep(1);
        if ((++sp & 255u) == 0u) { if (xb_ld(&bar[XB_TMO])) break; if (sp > XB_SPIN_CAP) { atomicAdd(&bar[XB_TMO], 1u); break; } }
    }
    nloc = mine > 0u ? mine : 1u; nx = cnt > 0u ? cnt : 1u;
}
__device__ __forceinline__ void xcd_barrier(const XcdBarrier& b, const int tid) {
    asm volatile("s_waitcnt vmcnt(0)" ::: "memory");
    __syncthreads();
    if (tid == 0) {
        unsigned* bar = b.bar;
        __builtin_amdgcn_s_waitcnt(0);
        unsigned nloc = b.st[0], nx = b.st[1];
        if (nloc == 0u) { xcd_barrier_complete(bar, b.x, nloc, nx); b.st[0] = nloc; b.st[1] = nx; }
        const unsigned old = xb_add(&bar[XB_XSUB(b.x)], 1u);
        const unsigned gen = old / nloc;
        if (old + 1u == (gen + 1u) * nloc) {
            __builtin_amdgcn_fence(__ATOMIC_RELEASE, "agent");
            asm volatile("s_waitcnt vmcnt(0)" ::: "memory");
            const unsigned og = xb_add(&bar[XB_TOP], 1u);
            const unsigned tg = og / nx;
            if (og + 1u == (tg + 1u) * nx) xb_add(&bar[XB_TOPGEN], 1u);
            else XB_SPIN(xb_ld(&bar[XB_TOPGEN]) == tg, bar);
            __builtin_amdgcn_fence(__ATOMIC_ACQUIRE, "agent");
            xb_add(&bar[XB_XGEN(b.x)], 1u);
            asm volatile("s_waitcnt vmcnt(0)" ::: "memory");
        } else {
            XB_SPIN(xb_ld(&bar[XB_XGEN(b.x)]) == gen, bar);
            __builtin_amdgcn_fence(__ATOMIC_ACQUIRE, "agent");
            asm volatile("s_waitcnt vmcnt(0)" ::: "memory");
        }
    }
    __syncthreads();
}

constexpr int NPHASE = 11;
#define IDS() const int tid = TIDK, lane = tid & 63, wave = __builtin_amdgcn_readfirstlane(tid >> 6); const int G = gridDim.x; \
    const int gtid = blockIdx.x * (NWAVES * 64) + tid, gthreads = G * NWAVES * 64, gw = blockIdx.x * NWAVES + wave, ngw = G * NWAVES; (void)lane; (void)wave; (void)gtid; (void)gthreads; (void)gw; (void)ngw;
__global__ void __launch_bounds__(NWAVES * 64, 2) fwd_kernel(Args a) {
    extern __shared__ __attribute__((aligned(16))) unsigned char lds_raw[];
    LAS unsigned char* lds = (LAS unsigned char*)lds_raw;
    const int lo = a.ph_lo, hi = a.ph_hi;
    volatile LAS unsigned* xb_st = (volatile LAS unsigned*)(lds + XB_LDS_OFF);
    const int wid6 = __builtin_amdgcn_readfirstlane((int)threadIdx.x) & ~63;
#define TIDK tid_from(wid6)
    { const int t0 = TIDK; if (t0 < 4) xb_st[t0] = 0u;
      __syncthreads();
      (void)xcd_barrier_post((unsigned*)(a.ws + WS_CTL + XB_CTL_OFF), xb_st, t0); }
#define IN(k) (lo <= (k) && (k) < hi)
#define SEAM(k) do { if (IN(k) && IN((k) + 1)) { if ((k) == 0) cg::this_grid().sync(); else { XcdBarrier xb_; xb_.bar = (unsigned*)(a.ws + WS_CTL + XB_CTL_OFF); xb_.x = xb_xcc_id(); \
        xb_.st = (volatile LAS unsigned*)(lds + XB_LDS_OFF); xcd_barrier(xb_, TIDK); } } } while (0)
    if (IN(0)) { IDS(); ph_prologue(a, lds, tid, gtid, gthreads, gw, ngw, lane); }
    SEAM(0);
    if (IN(1)) {
        unsigned char* ws = a.ws;
        pg8::Gemm g{(const bf16*)(ws + WS_HB), (const bf16*)(ws + WS_W1T), NTOK, N1, DM}; pg8::StaticOrder S; S.init(NTOK, N1, (int)gridDim.x, (int)blockIdx.x);
        pg8::EpiStore E{(bf16*)(ws + WS_P1), N1, nullptr};
        pg8::gemm_phase<pg8::EpiStore, pg8::StaticOrder, true, true>(lds, g, S, E, TIDK);
    }
    SEAM(1);
    if (IN(2)) { IDS(); ph_cnorm_pool(a, gw, ngw, lane); }
    SEAM(2);
    #if USE_NAIVE_ATTN
    if (IN(3)) { IDS(); ph_attn_naive(a, lds, wave, gw, ngw, lane); }
#else
    if (IN(3)) { ph_attn_fast(a, lds, (ATT_VARIANT && lo == 3) ? ATT_VARIANT : 0, wid6); }
#endif
    SEAM(3);
    if (IN(4)) {
        unsigned char* ws = a.ws;
        pg8::Gemm g{(const bf16*)(ws + WS_MIX), (const bf16*)(ws + WS_W2T), NTOK, DM, K2}; pg8::StaticOrder S; S.init(NTOK, DM, (int)gridDim.x, (int)blockIdx.x);
        pg8::EpiResid<true> E{(const void*)a.x, (bf16*)(ws + WS_X1B), (float*)(ws + WS_CTL)};
        pg8::gemm_phase<pg8::EpiResid<true>, pg8::StaticOrder, true, true>(lds, g, S, E, TIDK);
    }
    SEAM(4);
#pragma unroll 1
    for (int hsel = 0; hsel < 2; ++hsel) {
        const int p5 = 5 + 2 * hsel;
        if (IN(p5)) {
            unsigned char* ws = a.ws;
            pg8::Gemm g{(const bf16*)(ws + WS_X1B) + (size_t)hsel * (NTOK / 2) * DM, (const bf16*)(ws + WS_W3T), NTOK / 2, N3, DM}; pg8::StaticOrder S; S.init(NTOK / 2, N3, (int)gridDim.x, (int)blockIdx.x);
            pg8::EpiStore E{(bf16*)(ws + WS_RAW), N3, (const float*)(ws + WS_CTL) + hsel * (NTOK / 2)};
            pg8::gemm_phase<pg8::EpiStore, pg8::StaticOrder, true, true>(lds, g, S, E, TIDK);
        }
        SEAM(p5);
        if (IN(p5 + 1)) { IDS(); ph_conv(a, hsel, gtid, gthreads); }
        SEAM(p5 + 1);
    }
    if (IN(9)) {
        unsigned char* ws = a.ws;
        pg8::Gemm g{(const bf16*)(ws + WS_ACT), (const bf16*)(ws + WS_W4T), NTOK, DM, FF}; pg8::StaticOrder S; S.init(NTOK, DM, (int)gridDim.x, (int)blockIdx.x);
        pg8::EpiResid<false> E{(const void*)(ws + WS_X1B), (bf16*)(ws + WS_X2), (float*)(ws + WS_CTL + 256 * 1024)};
        pg8::gemm_phase<pg8::EpiResid<false>, pg8::StaticOrder, true, true>(lds, g, S, E, TIDK);
    }
    SEAM(9);
    if (IN(10)) { IDS(); ph_final(a, gw, ngw, lane); }
#undef IN
#undef SEAM
}

extern "C" void kernel_launch(void* const* d_in, const int* in_sizes, int n_in, void* d_out, int out_size, void* d_ws, size_t ws_size, hipStream_t stream) {
    static int grid = 0;
    if (grid == 0) {
        if (n_in != 15 || in_sizes[0] != NTOK * DM || out_size != NTOK * DM || ws_size < WS_END) { fprintf(stderr, "kernel_launch: unexpected shapes / workspace (n_in %d, ws %zu)\n", n_in, ws_size); grid = -1; return; }
        int dev = 0, cus = 0, per_cu = 0;
        hipGetDevice(&dev); hipDeviceGetAttribute(&cus, hipDeviceAttributeMultiprocessorCount, dev);
        if (hipFuncSetAttribute((const void*)fwd_kernel, hipFuncAttributeMaxDynamicSharedMemorySize, LDS_BYTES) != hipSuccess) { fprintf(stderr, "kernel_launch: hipFuncSetAttribute failed\n"); grid = -1; return; }
        if (hipOccupancyMaxActiveBlocksPerMultiprocessor(&per_cu, (const void*)fwd_kernel, NWAVES * 64, LDS_BYTES) != hipSuccess || per_cu < 1) { fprintf(stderr, "kernel_launch: occupancy query says %d\n", per_cu); per_cu = 1; }
        (void)hipGetLastError();
        grid = cus;
        if (grid != 256) fprintf(stderr, "kernel_launch: %d CUs (tuned for 256)\n", grid);
    }
    if (grid < 0) return;
    hipMemsetAsync((char*)d_ws + WS_CTL, 0, CTL_ZERO_BYTES, stream);
    Args a{};
    a.x = (const float*)d_in[0]; a.g_mix = (const float*)d_in[1]; a.w_in = (const float*)d_in[2]; a.g_kv = (const float*)d_in[3]; a.w_uk = (const float*)d_in[4]; a.w_uv = (const float*)d_in[5];
    a.w_pool = (const float*)d_in[6]; a.pool_scale = (const float*)d_in[7]; a.w_o = (const float*)d_in[8]; a.g_ffn = (const float*)d_in[9]; a.w_up = (const float*)d_in[10];
    a.conv_w = (const float*)d_in[11]; a.conv_b = (const float*)d_in[12]; a.w_down = (const float*)d_in[13]; a.g_final = (const float*)d_in[14];
    a.out = (float*)d_out; a.ws = (unsigned char*)d_ws;
#if REP_PH >= 0
    { void* args[] = {&a};
      a.ph_lo = 0; a.ph_hi = REP_PH + 1; hipLaunchCooperativeKernel((const void*)fwd_kernel, dim3(grid), dim3(NWAVES * 64), args, LDS_BYTES, stream);
      a.ph_lo = REP_PH; a.ph_hi = REP_PH + 1; hipLaunchCooperativeKernel((const void*)fwd_kernel, dim3(grid), dim3(NWAVES * 64), args, LDS_BYTES, stream);
      if (REP_PH + 1 < NPHASE) { a.ph_lo = REP_PH + 1; a.ph_hi = NPHASE; hipLaunchCooperativeKernel((const void*)fwd_kernel, dim3(grid), dim3(NWAVES * 64), args, LDS_BYTES, stream); } }
#elif MK_ONE_LAUNCH
    a.ph_lo = 0; a.ph_hi = NPHASE;
    void* args[] = {&a};
    hipError_t e = hipLaunchCooperativeKernel((const void*)fwd_kernel, dim3(grid), dim3(NWAVES * 64), args, LDS_BYTES, stream);
    if (e != hipSuccess) fprintf(stderr, "cooperative launch failed: %s (grid %d)\n", hipGetErrorString(e), grid);
#else
    for (int ph = 0; ph < NPHASE; ++ph) {
        a.ph_lo = ph; a.ph_hi = ph + 1;
        hipLaunchKernelGGL(fwd_kernel, dim3(grid), dim3(NWAVES * 64), LDS_BYTES, stream, a);
    }
#endif
}
```

```cpp
#include <hip/hip_runtime.h>
#include <hip/hip_cooperative_groups.h>
#include <cstdio>
#include <cstdint>
namespace cg = cooperative_groups;

#ifndef USE_NAIVE_ATTN
#define USE_NAIVE_ATTN 0
#endif
#ifndef REP_PH
#define REP_PH -1
#endif
#ifndef ATT_VARIANT
#define ATT_VARIANT 0
#endif
#ifndef MK_ONE_LAUNCH
#define MK_ONE_LAUNCH 1
#endif

namespace pg8 {
#define PG8_LAS __attribute__((address_space(3)))
typedef unsigned short bf16_t;
typedef short bf16x8 __attribute__((ext_vector_type(8)));
typedef float f32x4 __attribute__((ext_vector_type(4)));
typedef unsigned u32x4 __attribute__((ext_vector_type(4)));
constexpr int BM = 256, BK = 64, HALF = 128, HTB = HALF * BK * 2, STAGE_BYTES = 8 * HTB, NXCD = 8, WGM = 8;

__host__ __device__ __forceinline__ int lds_byte(int r, int c) { const int st = (r >> 4) * 2 + (c >> 5), rr = r & 15, cc = c & 31, ob = rr * 64 + cc * 2; return st * 1024 + (ob ^ (((ob >> 9) & 1) << 5)); }
__host__ __device__ __forceinline__ void stage_rc(int b, int& R, int& C) { const int st = b / 1024, sb = b % 1024, swz = sb ^ (((sb >> 9) & 1) << 5); R = (st >> 1) * 16 + swz / 64; C = (st & 1) * 32 + (swz % 64) / 2; }
__host__ __device__ __forceinline__ int perm32(int rho) { const int n = rho >> 4, i = rho & 15; return 8 * (i >> 2) + 4 * n + (i & 3); }

struct Unit { int pm, pn; };
struct Gemm { const bf16_t* A; const bf16_t* Bt; int M, N, K; };

struct StaticOrder {
    int nM, nN, nwg, G, c;
    __host__ __device__ void init(int M, int N, int G_, int c_) { nM = M / BM; nN = N / BM; nwg = nM * nN; G = G_; c = c_; }
    __host__ __device__ bool next(int i, Unit& u) const {
        const long L = (long)i * G + c; if (L >= nwg) return false;
        int wgid = (int)L; { const int q = nwg / NXCD, r = nwg % NXCD, xcd = wgid % NXCD, off = wgid / NXCD; wgid = (xcd < r ? xcd * (q + 1) : r * (q + 1) + (xcd - r) * q) + off; }
        const int nig = WGM * nN, gid = wgid / nig, fm = gid * WGM, gsz = (nM - fm) < WGM ? (nM - fm) : WGM;
        u.pm = fm + ((wgid % nig) % gsz); u.pn = (wgid % nig) / gsz; return true;
    }
    __device__ __forceinline__ void a_ready(const Unit&) const {}
    __device__ __forceinline__ void done(const Unit&) const {}
};

__device__ __forceinline__ unsigned cvt_pk_bf16(float lo, float hi) { unsigned r; asm volatile("v_cvt_pk_bf16_f32 %0, %1, %2" : "=v"(r) : "v"(lo), "v"(hi)); return r; }


struct EpiStore {
    static constexpr bool PERM = true, AFTER_DRAIN = false;
    bf16_t* O; int ldc; const float* sumsq;
    __device__ __forceinline__ void operator()(const f32x4 (&acc)[2][2][4][2], const Unit& u, int wr, int wc, int fr, int fq) const {
        const int row0 = u.pm * BM + wr * 64 + fr, col0 = u.pn * BM + wc * 32 + 8 * fq;
#pragma unroll
        for (int ai = 0; ai < 2; ++ai)
#pragma unroll
            for (int m = 0; m < 4; ++m) {
                const int row = row0 + ai * HALF + m * 16;
                float sc = 1.f; if (sumsq) sc = 1.0f / sqrtf(sumsq[row] * (1.0f / 1024.0f) + 1e-6f);
                bf16_t* rowp = O + (size_t)row * ldc + col0;
#pragma unroll
                for (int bj = 0; bj < 2; ++bj) { f32x4 v0 = acc[ai][bj][m][0] * sc, v1 = acc[ai][bj][m][1] * sc;
                    u32x4 w; w.x = cvt_pk_bf16(v0[0], v0[1]); w.y = cvt_pk_bf16(v0[2], v0[3]); w.z = cvt_pk_bf16(v1[0], v1[1]); w.w = cvt_pk_bf16(v1[2], v1[3]);
                    *(u32x4*)(rowp + bj * HALF) = w; } }
    }
};
template <bool BASE_F32> struct EpiResid {
    static constexpr bool PERM = true, AFTER_DRAIN = false;
    const void* base; bf16_t* O; float* sumsq;
    __device__ __forceinline__ void operator()(const f32x4 (&acc)[2][2][4][2], const Unit& u, int wr, int wc, int fr, int fq) const {
        const int row0 = u.pm * BM + wr * 64 + fr, col0 = u.pn * BM + wc * 32 + 8 * fq;
#pragma unroll
        for (int ai = 0; ai < 2; ++ai)
#pragma unroll
            for (int m = 0; m < 4; ++m) {
                const int row = row0 + ai * HALF + m * 16; float ss = 0.f;
#pragma unroll
                for (int bj = 0; bj < 2; ++bj) {
                    const size_t off = (size_t)row * 1024 + col0 + bj * HALF;
                    f32x4 b0, b1;
                    if (BASE_F32) { b0 = *(const f32x4*)((const float*)base + off); b1 = *(const f32x4*)((const float*)base + off + 4); }
                    else { const u32x4 r = *(const u32x4*)((const bf16_t*)base + off);
                        b0[0] = __uint_as_float(r.x << 16); b0[1] = __uint_as_float(r.x & 0xffff0000u); b0[2] = __uint_as_float(r.y << 16); b0[3] = __uint_as_float(r.y & 0xffff0000u);
                        b1[0] = __uint_as_float(r.z << 16); b1[1] = __uint_as_float(r.z & 0xffff0000u); b1[2] = __uint_as_float(r.w << 16); b1[3] = __uint_as_float(r.w & 0xffff0000u); }
                    const f32x4 v0 = acc[ai][bj][m][0] + b0, v1 = acc[ai][bj][m][1] + b1;
                    ss += (v0[0] * v0[0] + v0[1] * v0[1]) + (v0[2] * v0[2] + v0[3] * v0[3]) + (v1[0] * v1[0] + v1[1] * v1[1]) + (v1[2] * v1[2] + v1[3] * v1[3]);
                    u32x4 w; w.x = cvt_pk_bf16(v0[0], v0[1]); w.y = cvt_pk_bf16(v0[2], v0[3]); w.z = cvt_pk_bf16(v1[0], v1[1]); w.w = cvt_pk_bf16(v1[2], v1[3]);
                    *(u32x4*)(O + off) = w; }
                ss += __shfl_xor(ss, 16); ss += __shfl_xor(ss, 32);
                if (fq == 0) atomicAdd(sumsq + row, ss);
            }
    }
};

template <class Epi, class Sched, bool ALIGN_EPI = false, bool SP2 = false>
__device__ __forceinline__ void gemm_phase(PG8_LAS unsigned char* lds, const Gemm g, const Sched& S, const Epi& E, const int tid) {
    const int wid = __builtin_amdgcn_readfirstlane(tid >> 6), lane = tid & 63, wr = wid >> 2, wc = wid & 3, fr = lane & 15, fq = lane >> 4;
    const int K = g.K, nt = K / BK;
    unsigned voffA[2], voffB[2];
#pragma unroll
    for (int i = 0; i < 2; ++i) { int R, C; stage_rc(tid * 16 + i * 8192, R, C); const int Rb = Epi::PERM ? ((R & ~31) + perm32(R & 31)) : R;
        voffA[i] = (unsigned)(R * K + C) * 2u; voffB[i] = (unsigned)(Rb * K + C) * 2u; }
    const size_t kstep = (size_t)(BK * 2);
    const size_t hstep = (size_t)HALF * K * 2;
    const size_t tstep = 2 * hstep;
    const unsigned ldsw = (unsigned)wid * 1024u;
    const int aoff = lds_byte(wr * 64 + fr, fq * 8), boff = lds_byte(wc * 32 + fr, fq * 8);
#define PG8_SA(b, h) (((b) * 2 + (h)) * HTB)
#define PG8_SB(b, h) ((4 + (b) * 2 + (h)) * HTB)
#define PG8_STAGE(bufoff, gbase, voff) do { _Pragma("unroll") for (int _i = 0; _i < 2; ++_i) \
        __builtin_amdgcn_global_load_lds((const unsigned*)((const char*)(gbase) + (voff)[_i]), (PG8_LAS unsigned*)(lds + (bufoff) + ldsw + _i * 8192), 16, 0, 0); } while (0)
#define PG8_LDA(dst, b, h) do { _Pragma("unroll") for (int m = 0; m < 4; ++m) _Pragma("unroll") for (int k = 0; k < 2; ++k) dst[m][k] = *(const PG8_LAS bf16x8*)(lds + PG8_SA(b, h) + aoff + m * 2048 + k * 1024); } while (0)
#define PG8_LDB(dst, b, h) do { _Pragma("unroll") for (int n = 0; n < 2; ++n) _Pragma("unroll") for (int k = 0; k < 2; ++k) dst[n][k] = *(const PG8_LAS bf16x8*)(lds + PG8_SB(b, h) + boff + n * 2048 + k * 1024); } while (0)
#define PG8_MMA(ai, bj, At, Bt) do { __builtin_amdgcn_s_setprio(1); _Pragma("unroll") for (int m = 0; m < 4; ++m) _Pragma("unroll") for (int n = 0; n < 2; ++n) _Pragma("unroll") for (int k = 0; k < 2; ++k) \
        acc[ai][bj][m][n] = __builtin_amdgcn_mfma_f32_16x16x32_bf16(Bt[n][k], At[m][k], acc[ai][bj][m][n], 0, 0, 0); __builtin_amdgcn_s_setprio(0); } while (0)
#define PG8_WAIT_V(n) asm volatile("s_waitcnt vmcnt(" #n ")" ::: "memory")
#define PG8_WAIT_L(n) asm volatile("s_waitcnt lgkmcnt(" #n ")" ::: "memory")
#define PG8_BAR __builtin_amdgcn_s_barrier()
#define PG8_SCHED __builtin_amdgcn_sched_barrier(0)
    Unit cur, nxt; int ui = 0;
    if (!S.next(0, cur)) return;
    f32x4 acc[2][2][4][2];
#pragma unroll
    for (int a = 0; a < 2; ++a)
#pragma unroll
        for (int b = 0; b < 2; ++b)
#pragma unroll
            for (int m = 0; m < 4; ++m)
#pragma unroll
                for (int n = 0; n < 2; ++n) acc[a][b][m][n] = (f32x4){0.f, 0.f, 0.f, 0.f};
    bf16x8 At[4][2], B0[2][2], B1[2][2];
    const char* cA = (const char*)g.A + (size_t)cur.pm * tstep; const char* cB = (const char*)g.Bt + (size_t)cur.pn * tstep;
    S.a_ready(cur);
    if constexpr (SP2) {
        PG8_STAGE(PG8_SB(0, 0), cB, voffB); PG8_STAGE(PG8_SB(0, 1), cB + hstep, voffB); PG8_STAGE(PG8_SA(0, 0), cA, voffA); PG8_STAGE(PG8_SA(0, 1), cA + hstep, voffA);
        if (wr == 1) PG8_BAR;
        PG8_WAIT_V(2); PG8_BAR;
        PG8_STAGE(PG8_SB(1, 0), cB + kstep, voffB); PG8_STAGE(PG8_SA(1, 0), cA + kstep, voffA); PG8_STAGE(PG8_SB(1, 1), cB + hstep + kstep, voffB);
        PG8_WAIT_V(6); PG8_BAR;
    } else {
        PG8_STAGE(PG8_SB(0, 0), cB, voffB); PG8_STAGE(PG8_SA(0, 0), cA, voffA); PG8_STAGE(PG8_SB(0, 1), cB + hstep, voffB); PG8_STAGE(PG8_SA(0, 1), cA + hstep, voffA);
        if (wr == 1) PG8_BAR;
        PG8_WAIT_V(4); PG8_BAR;
        PG8_STAGE(PG8_SB(1, 0), cB + kstep, voffB); PG8_STAGE(PG8_SA(1, 0), cA + kstep, voffA); PG8_STAGE(PG8_SB(1, 1), cB + hstep + kstep, voffB);
        PG8_WAIT_V(6); PG8_BAR;
    }
    for (;;) {
        const bool has_next = S.next(ui + 1, nxt);
        const char* nA = has_next ? (const char*)g.A + (size_t)nxt.pm * tstep : cA; const char* nB = has_next ? (const char*)g.Bt + (size_t)nxt.pn * tstep : cB;
        for (int t = 0; t < nt; t += 2) {
            const bool last = (t == nt - 2);
            const char* a1 = cA + (size_t)(t + 1) * kstep;
            const char* a2 = last ? nA : cA + (size_t)(t + 2) * kstep; const char* b2 = last ? nB : cB + (size_t)(t + 2) * kstep;
            const char* a3 = a2 + kstep; const char* b3 = b2 + kstep;
            if (last && has_next) S.a_ready(nxt);
            if constexpr (SP2) {
            PG8_LDB(B0, 0, 0); PG8_LDB(B1, 0, 1); PG8_SCHED; PG8_LDA(At, 0, 0); PG8_STAGE(PG8_SA(1, 1), a1 + hstep, voffA);
            PG8_WAIT_V(8); PG8_WAIT_L(0); PG8_BAR; PG8_MMA(0, 0, At, B0); PG8_MMA(0, 1, At, B1); PG8_BAR; PG8_SCHED;
            PG8_LDA(At, 0, 1); PG8_STAGE(PG8_SB(0, 0), b2, voffB); PG8_STAGE(PG8_SB(0, 1), b2 + hstep, voffB); PG8_STAGE(PG8_SA(0, 0), a2, voffA);
            PG8_WAIT_V(8); PG8_WAIT_L(0); PG8_BAR; PG8_MMA(1, 0, At, B0); PG8_MMA(1, 1, At, B1); PG8_BAR; PG8_SCHED;
            PG8_LDB(B0, 1, 0); PG8_LDB(B1, 1, 1); PG8_SCHED; PG8_LDA(At, 1, 0); PG8_STAGE(PG8_SA(0, 1), a2 + hstep, voffA);
            PG8_WAIT_V(8); PG8_WAIT_L(0); PG8_BAR; PG8_MMA(0, 0, At, B0); PG8_MMA(0, 1, At, B1); PG8_BAR; PG8_SCHED;
            PG8_LDA(At, 1, 1); PG8_STAGE(PG8_SB(1, 0), b3, voffB); PG8_STAGE(PG8_SB(1, 1), b3 + hstep, voffB); PG8_STAGE(PG8_SA(1, 0), a3, voffA);
            PG8_WAIT_V(8); PG8_WAIT_L(0); PG8_BAR; PG8_MMA(1, 0, At, B0); PG8_MMA(1, 1, At, B1); PG8_BAR; PG8_SCHED;
            } else {
            PG8_LDB(B0, 0, 0); PG8_SCHED; PG8_LDA(At, 0, 0); PG8_STAGE(PG8_SA(1, 1), a1 + hstep, voffA);
            PG8_WAIT_L(8); PG8_BAR; PG8_WAIT_L(0); PG8_MMA(0, 0, At, B0); PG8_BAR; PG8_SCHED;
            PG8_LDB(B1, 0, 1); PG8_STAGE(PG8_SB(0, 0), b2, voffB);
            PG8_BAR; PG8_WAIT_L(0); PG8_MMA(0, 1, At, B1); PG8_BAR;
            PG8_LDA(At, 0, 1); PG8_STAGE(PG8_SA(0, 0), a2, voffA);
            PG8_BAR; PG8_WAIT_L(0); PG8_MMA(1, 0, At, B0); PG8_BAR; PG8_SCHED;
            PG8_STAGE(PG8_SB(0, 1), b2 + hstep, voffB);
            PG8_WAIT_V(6); PG8_BAR; PG8_MMA(1, 1, At, B1); PG8_BAR;
            PG8_LDB(B0, 1, 0); PG8_SCHED; PG8_LDA(At, 1, 0); PG8_STAGE(PG8_SA(0, 1), a2 + hstep, voffA);
            PG8_WAIT_L(8); PG8_BAR; PG8_WAIT_L(0); PG8_MMA(0, 0, At, B0); PG8_BAR; PG8_SCHED;
            PG8_LDB(B1, 1, 1); PG8_STAGE(PG8_SB(1, 0), b3, voffB);
            PG8_BAR; PG8_WAIT_L(0); PG8_MMA(0, 1, At, B1); PG8_BAR;
            PG8_LDA(At, 1, 1); PG8_STAGE(PG8_SA(1, 0), a3, voffA);
            PG8_BAR; PG8_WAIT_L(0); PG8_MMA(1, 0, At, B0); PG8_BAR; PG8_SCHED;
            PG8_STAGE(PG8_SB(1, 1), b3 + hstep, voffB);
            PG8_WAIT_V(6); PG8_BAR; PG8_MMA(1, 1, At, B1); PG8_BAR;
            }
        }
        if constexpr (ALIGN_EPI) { if (wr == 0) PG8_BAR; }
        if constexpr (!Epi::AFTER_DRAIN) { E(acc, cur, wr, wc, fr, fq); S.done(cur); }
        if (!has_next) break;
#pragma unroll
        for (int a = 0; a < 2; ++a)
#pragma unroll
            for (int b = 0; b < 2; ++b)
#pragma unroll
                for (int m = 0; m < 4; ++m)
#pragma unroll
                    for (int n = 0; n < 2; ++n) acc[a][b][m][n] = (f32x4){0.f, 0.f, 0.f, 0.f};
        cur = nxt; cA = nA; cB = nB; ++ui;
        if constexpr (ALIGN_EPI) { if (wr == 1) PG8_BAR; }
    }
    PG8_WAIT_V(0);
    if constexpr (!ALIGN_EPI) { if (wr == 0) PG8_BAR; }
    PG8_BAR;
#undef PG8_SA
#undef PG8_SB
#undef PG8_STAGE
#undef PG8_LDA
#undef PG8_LDB
#undef PG8_MMA
#undef PG8_WAIT_V
#undef PG8_WAIT_L
#undef PG8_BAR
#undef PG8_SCHED
}
}

constexpr int NWAVES = 8;
constexpr int BATCH = 32, SEQ = 2048, DM = 1024, NTOK = BATCH * SEQ;
constexpr int IN_COLS = 1736;
constexpr int N1 = 2304, K2 = 1536, FF = 2816, N3 = 2 * FF;
constexpr int OFF_QL = 0, OFF_QI = 1024, OFF_U = 1536, OFF_C = 2048, OFF_KI = 2176, OFF_WI = 2240;
constexpr float EPS = 1e-6f;
constexpr float WI_SCALE = 0.044194173824159216f;

constexpr size_t MiB = 1u << 20;
constexpr size_t WS_CTL = 0, CTL_ZERO_BYTES = 1 * MiB;
constexpr size_t WS_W1T = 1 * MiB, WS_W2T = 6 * MiB, WS_W3T = 9 * MiB, WS_W4T = 20 * MiB, WS_CONVP = 26 * MiB;
constexpr size_t WS_HB = 32 * MiB;
constexpr size_t WS_P1 = 160 * MiB;
constexpr size_t WS_RAW = 32 * MiB;
constexpr size_t WS_X2 = 32 * MiB;
constexpr size_t WS_MIX = 448 * MiB;
constexpr size_t WS_CN = 640 * MiB;
constexpr size_t WS_ACT = 448 * MiB;
constexpr size_t WS_X1B = 800 * MiB;
constexpr size_t WS_END = 928 * MiB;

constexpr int LDS_BYTES = 147456;
constexpr int XB_LDS_OFF = 131072 + 1024;
constexpr size_t XB_CTL_OFF = 512 * 1024;

#define GAS __attribute__((address_space(1)))
#define LAS __attribute__((address_space(3)))
typedef unsigned short bf16;
typedef unsigned v4u __attribute__((ext_vector_type(4)));
typedef unsigned v2u __attribute__((ext_vector_type(2)));
typedef float f32x4 __attribute__((ext_vector_type(4)));

__device__ __forceinline__ unsigned f2bf(float f) { unsigned u = __builtin_bit_cast(unsigned, f); return (u + 0x7fffu + ((u >> 16) & 1u)) >> 16; }
__device__ __forceinline__ unsigned pk2(float lo, float hi) { return f2bf(lo) | (f2bf(hi) << 16); }
__device__ __forceinline__ float bflo(unsigned u) { return __uint_as_float(u << 16); }
__device__ __forceinline__ float bfhi(unsigned u) { return __uint_as_float(u & 0xffff0000u); }
__device__ __forceinline__ float wave_sum(float v) {
#pragma unroll
    for (int o = 1; o < 64; o <<= 1) v += __shfl_xor(v, o);
    return v;
}
__device__ __forceinline__ float wave_max(float v) {
#pragma unroll
    for (int o = 1; o < 64; o <<= 1) v = fmaxf(v, __shfl_xor(v, o));
    return v;
}
#define WAVE_LDS_SYNC() do { asm volatile("s_waitcnt lgkmcnt(0)" ::: "memory"); __builtin_amdgcn_wave_barrier(); } while (0)

struct Args {
    const float* x; const float* g_mix; const float* w_in; const float* g_kv; const float* w_uk; const float* w_uv; const float* w_pool; const float* pool_scale;
    const float* w_o; const float* g_ffn; const float* w_up; const float* conv_w; const float* conv_b; const float* w_down; const float* g_final;
    float* out; unsigned char* ws; int ph_lo, ph_hi, li, pad;
};

__device__ __forceinline__ void tr_item(const float* __restrict__ W, int ldw, int k0, int srccol0, int valid, float colscale, const float* __restrict__ kscale,
                                        bf16* __restrict__ WT, int ldt, int nrow0, LAS float* scr, int lane) {
    const int j = lane & 31;
#pragma unroll 8
    for (int i = 0; i < 32; ++i) { const int kk = 2 * i + (lane >> 5);
        float v = (j < valid) ? W[(size_t)(k0 + kk) * ldw + srccol0 + j] : 0.f;
        if (kscale) v *= kscale[k0 + kk];
        scr[kk * 33 + j] = v * colscale; }
    asm volatile("s_waitcnt lgkmcnt(0)" ::: "memory"); __builtin_amdgcn_wave_barrier();
    const int c = lane & 7;
#pragma unroll
    for (int jj = 0; jj < 4; ++jj) { const int n = (lane >> 3) + 8 * jj; const LAS float* s = scr + (8 * c) * 33 + n;
        v4u o; o.x = pk2(s[0 * 33], s[1 * 33]); o.y = pk2(s[2 * 33], s[3 * 33]); o.z = pk2(s[4 * 33], s[5 * 33]); o.w = pk2(s[6 * 33], s[7 * 33]);
        *(v4u*)(WT + (size_t)(nrow0 + n) * ldt + k0 + 8 * c) = o; }
    asm volatile("s_waitcnt lgkmcnt(0)" ::: "memory"); __builtin_amdgcn_wave_barrier();
}
__device__ __forceinline__ void ph_prologue(const Args& a, LAS unsigned char* lds, const int tid, int gtid, int gthreads, int gw, int ngw, int lane) {
    unsigned char* ws = a.ws;
    bf16* W1T = (bf16*)(ws + WS_W1T); bf16* W2T = (bf16*)(ws + WS_W2T); bf16* W3T = (bf16*)(ws + WS_W3T); bf16* W4T = (bf16*)(ws + WS_W4T);
    float* CONVP = (float*)(ws + WS_CONVP);
    LAS float* L0 = (LAS float*)lds;
    for (int it = blockIdx.x; it < 640; it += gridDim.x) {
        if (it < 256) {
            const int hd = it >> 5, k0 = (it & 31) * 32;
            LAS float* Wuk = L0; LAS float* Win = L0 + 8192;
#pragma unroll
            for (int t = 0; t < 16; ++t) Wuk[tid + 512 * t] = a.w_uk[hd * 8192 + tid + 512 * t];
#pragma unroll
            for (int t = 0; t < 4; ++t) { const int idx = tid + 512 * t; Win[idx] = a.w_in[(size_t)(k0 + (idx >> 6)) * IN_COLS + hd * 64 + (idx & 63)]; }
            __syncthreads();
            const int c = tid & 127, kg = tid >> 7; float acc[8];
#pragma unroll
            for (int j = 0; j < 8; ++j) acc[j] = 0.f;
            for (int d = 0; d < 64; ++d) { const float wu = Wuk[d * 128 + c];
#pragma unroll
                for (int j = 0; j < 8; ++j) acc[j] += Win[(kg * 8 + j) * 64 + d] * wu; }
            v4u o; o.x = pk2(acc[0], acc[1]); o.y = pk2(acc[2], acc[3]); o.z = pk2(acc[4], acc[5]); o.w = pk2(acc[6], acc[7]);
            *(v4u*)(W1T + (size_t)(hd * 128 + c) * DM + k0 + kg * 8) = o;
        } else if (it < 512) {
            const int i2 = it - 256, hd = i2 >> 5, n0 = (i2 & 31) * 32;
            LAS float* Wuv = L0; LAS float* Wo = L0 + 8192;
#pragma unroll
            for (int t = 0; t < 16; ++t) Wuv[tid + 512 * t] = a.w_uv[hd * 8192 + tid + 512 * t];
#pragma unroll
            for (int t = 0; t < 4; ++t) { const int idx = tid + 512 * t; Wo[idx] = a.w_o[(size_t)(hd * 64 + (idx >> 5)) * DM + n0 + (idx & 31)]; }
            __syncthreads();
            const int nn = tid & 31, cg_ = tid >> 5; float acc[8];
#pragma unroll
            for (int j = 0; j < 8; ++j) acc[j] = 0.f;
            for (int d = 0; d < 64; ++d) { const float wo = Wo[d * 32 + nn];
#pragma unroll
                for (int j = 0; j < 8; ++j) acc[j] += Wuv[(cg_ * 8 + j) * 64 + d] * wo; }
            v4u o; o.x = pk2(acc[0], acc[1]); o.y = pk2(acc[2], acc[3]); o.z = pk2(acc[4], acc[5]); o.w = pk2(acc[6], acc[7]);
            *(v4u*)(W2T + (size_t)(n0 + nn) * K2 + hd * 128 + cg_ * 8) = o;
        } else {
            const int i3 = it - 512, g = i3 >> 5, n0 = (i3 & 31) * 32;
            LAS float* Wp = L0; LAS float* Wo = L0 + 16384;
#pragma unroll
            for (int t = 0; t < 32; ++t) Wp[tid + 512 * t] = a.w_pool[g * 16384 + tid + 512 * t];
#pragma unroll
            for (int t = 0; t < 8; ++t) { const int idx = tid + 512 * t, dd = idx >> 5; Wo[idx] = a.pool_scale[g * 128 + dd] * a.w_o[(size_t)(512 + g * 128 + dd) * DM + n0 + (idx & 31)]; }
            __syncthreads();
            const int nn = tid & 31, cg_ = tid >> 5; float acc[8];
#pragma unroll
            for (int j = 0; j < 8; ++j) acc[j] = 0.f;
            for (int dd = 0; dd < 128; ++dd) { const float wo = Wo[dd * 32 + nn];
#pragma unroll
                for (int j = 0; j < 8; ++j) acc[j] += Wp[(cg_ * 8 + j) * 128 + dd] * wo; }
            v4u o; o.x = pk2(acc[0], acc[1]); o.y = pk2(acc[2], acc[3]); o.z = pk2(acc[4], acc[5]); o.w = pk2(acc[6], acc[7]);
            *(v4u*)(W2T + (size_t)(n0 + nn) * K2 + 1024 + g * 128 + cg_ * 8) = o;
        }
        __syncthreads();
    }
    LAS float* scr = (LAS float*)(lds + (tid >> 6) * 16384);
    constexpr int I1 = 40 * 16, I3 = 176 * 16, I4 = 32 * 44;
    for (int it = gw; it < I1 + I3 + I4; it += ngw) {
        if (it < I1) {
            const int nb = it >> 4, k0 = (it & 15) * 64, n0 = 1024 + nb * 32; int sc0, valid = 32; float cs = 1.f;
            if (n0 < 1536) sc0 = 640 + (n0 - 1024); else if (n0 < 2048) sc0 = 1224 + (n0 - 1536); else if (n0 < 2176) sc0 = 512 + (n0 - 2048); else if (n0 < 2240) sc0 = 1152 + (n0 - 2176);
            else if (n0 == 2240) { sc0 = 1216; valid = 8; cs = WI_SCALE; } else { sc0 = 0; valid = 0; }
            tr_item(a.w_in, IN_COLS, k0, sc0, valid, cs, nullptr, W1T, DM, n0, scr, lane);
        } else if (it < I1 + I3) {
            const int i2 = it - I1, nb = i2 >> 4, k0 = (i2 & 15) * 64, r0 = nb * 32, j = r0 >> 8, ii = r0 & 255;
            const int sc0 = (ii < 128) ? (128 * j + ii) : (FF + 128 * j + (ii - 128));
            tr_item(a.w_up, N3, k0, sc0, 32, 1.f, a.g_ffn, W3T, DM, r0, scr, lane);
        } else {
            const int i3 = it - I1 - I3, nb = i3 / 44, k0 = (i3 - nb * 44) * 64;
            tr_item(a.w_down, DM, k0, nb * 32, 32, 1.f, nullptr, W4T, FF, nb * 32, scr, lane);
        }
    }
    for (int r = gtid; r < N3; r += gthreads) {
        const int j = r >> 8, ii = r & 255; const int col = (ii < 128) ? (128 * j + ii) : (FF + 128 * j + (ii - 128));
        CONVP[r] = a.conv_w[col]; CONVP[N3 + r] = a.conv_w[N3 + col]; CONVP[2 * N3 + r] = a.conv_w[2 * N3 + col]; CONVP[3 * N3 + r] = a.conv_b[col];
    }
    bf16* HB = (bf16*)(ws + WS_HB);
    for (int m = gw; m < NTOK; m += ngw) {
        const f32x4* xr = (const f32x4*)(a.x + (size_t)m * DM) + lane;
        f32x4 v[4]; float s = 0.f;
#pragma unroll
        for (int j = 0; j < 4; ++j) { v[j] = xr[64 * j]; s += (v[j].x * v[j].x + v[j].y * v[j].y) + (v[j].z * v[j].z + v[j].w * v[j].w); }
        const float rinv = 1.0f / sqrtf(wave_sum(s) * (1.0f / DM) + EPS);
        unsigned long long* o8 = (unsigned long long*)(HB + (size_t)m * DM) + lane;
#pragma unroll
        for (int j = 0; j < 4; ++j) { const f32x4 g = ((const f32x4*)a.g_mix)[lane + 64 * j];
            o8[64 * j] = (unsigned long long)pk2(v[j].x * rinv * g.x, v[j].y * rinv * g.y) | ((unsigned long long)pk2(v[j].z * rinv * g.z, v[j].w * rinv * g.w) << 32); }
    }
}

__device__ __forceinline__ void ph_cnorm_pool(const Args& a, int gw, int ngw, int lane) {
    const bf16* P1 = (const bf16*)(a.ws + WS_P1); bf16* CN = (bf16*)(a.ws + WS_CN); bf16* MIX = (bf16*)(a.ws + WS_MIX);
    const float gk0 = a.g_kv[2 * lane], gk1 = a.g_kv[2 * lane + 1];
    const int win = 2 << (lane >> 4);
    for (int run = gw; run < NTOK / 32; run += ngw) {
        const int tok0 = run * 32, pos0 = tok0 & (SEQ - 1);
        const bf16* ub = P1 + (size_t)tok0 * N1 + OFF_U + 8 * lane;
        float s[8];
#pragma unroll
        for (int j = 0; j < 8; ++j) s[j] = 0.f;
#pragma unroll
        for (int j = 1; j < 16; ++j) {
            if (j < win && pos0 - j >= 0) { const v4u u = *(const v4u*)(ub - (size_t)j * N1);
                s[0] += bflo(u.x); s[1] += bfhi(u.x); s[2] += bflo(u.y); s[3] += bfhi(u.y); s[4] += bflo(u.z); s[5] += bfhi(u.z); s[6] += bflo(u.w); s[7] += bfhi(u.w); }
        }
#pragma unroll 4
        for (int t = 0; t < 32; ++t) {
            const int tok = tok0 + t, pos = pos0 + t;
            const bf16* prow = P1 + (size_t)tok * N1;
            const v4u u = *(const v4u*)(prow + OFF_U + 8 * lane);
            const unsigned cw = *(const unsigned*)(prow + OFF_C + 2 * lane);
            v4u ud = (v4u){0u, 0u, 0u, 0u};
            const bool drop = (pos - win + 1 >= 0);
            if (drop) ud = *(const v4u*)(prow - (size_t)(win - 1) * N1 + OFF_U + 8 * lane);
            const float c0 = bflo(cw), c1 = bfhi(cw);
            const float rinv = 1.0f / sqrtf(wave_sum(c0 * c0 + c1 * c1) * (1.0f / 128.0f) + EPS);
            *(unsigned*)(CN + (size_t)tok * 128 + 2 * lane) = pk2(c0 * rinv * gk0, c1 * rinv * gk1);
            const float uf[8] = {bflo(u.x), bfhi(u.x), bflo(u.y), bfhi(u.y), bflo(u.z), bfhi(u.z), bflo(u.w), bfhi(u.w)};
#pragma unroll
            for (int j = 0; j < 8; ++j) s[j] += uf[j];
            const int cnt = (pos + 1 < win) ? pos + 1 : win; const float ic = 1.0f / (float)cnt;
            v4u o; o.x = pk2(s[0] * ic - uf[0], s[1] * ic - uf[1]); o.y = pk2(s[2] * ic - uf[2], s[3] * ic - uf[3]);
            o.z = pk2(s[4] * ic - uf[4], s[5] * ic - uf[5]); o.w = pk2(s[6] * ic - uf[6], s[7] * ic - uf[7]);
            *(v4u*)(MIX + (size_t)tok * K2 + 1024 + 8 * lane) = o;
            if (drop) { s[0] -= bflo(ud.x); s[1] -= bfhi(ud.x); s[2] -= bflo(ud.y); s[3] -= bfhi(ud.y); s[4] -= bflo(ud.z); s[5] -= bfhi(ud.z); s[6] -= bflo(ud.w); s[7] -= bfhi(ud.w); }
        }
    }
}

__device__ __forceinline__ void ph_attn_naive(const Args& a, LAS unsigned char* lds, int wave, int gw, int ngw, int lane) {
    const bf16* P1 = (const bf16*)(a.ws + WS_P1); const bf16* CN = (const bf16*)(a.ws + WS_CN); bf16* MIX = (bf16*)(a.ws + WS_MIX);
    LAS unsigned char* base = lds + wave * 16384;
    LAS unsigned* uk = (LAS unsigned*)base;
    LAS float* pb = (LAS float*)base;
    LAS float* qi = (LAS float*)(base + 8192);
    LAS float* ql = (LAS float*)(base + 10240);
    LAS int* idx = (LAS int*)(base + 14336);
    LAS float* wl = (LAS float*)(base + 15360);
    const unsigned long long lt_mask = (lane == 0) ? 0ull : (~0ull >> (64 - lane));
    for (int q = gw; q < NTOK; q += ngw) {
        const int b = q >> 11, pos = q & (SEQ - 1), n = ((pos >> 6) + 1) << 6;
        const bf16* prow = P1 + (size_t)q * N1;
        { const v4u t = *(const v4u*)(prow + OFF_QI + 8 * lane);
          qi[8 * lane + 0] = bflo(t.x); qi[8 * lane + 1] = bfhi(t.x); qi[8 * lane + 2] = bflo(t.y); qi[8 * lane + 3] = bfhi(t.y);
          qi[8 * lane + 4] = bflo(t.z); qi[8 * lane + 5] = bfhi(t.z); qi[8 * lane + 6] = bflo(t.w); qi[8 * lane + 7] = bfhi(t.w); }
#pragma unroll
        for (int h2 = 0; h2 < 2; ++h2) { const v4u t = *(const v4u*)(prow + OFF_QL + 16 * lane + 8 * h2); const int o = 16 * lane + 8 * h2;
          ql[o + 0] = bflo(t.x); ql[o + 1] = bfhi(t.x); ql[o + 2] = bflo(t.y); ql[o + 3] = bfhi(t.y); ql[o + 4] = bflo(t.z); ql[o + 5] = bfhi(t.z); ql[o + 6] = bflo(t.w); ql[o + 7] = bfhi(t.w); }
        if (lane < 4) { const unsigned t = *(const unsigned*)(prow + OFF_WI + 2 * lane); wl[2 * lane] = bflo(t); wl[2 * lane + 1] = bfhi(t); }
        WAVE_LDS_SYNC();
        const int nk = n >> 6;
        for (int i = 0; i < nk; ++i) {
            const int key = i * 64 + lane;
            const v4u* kr = (const v4u*)(P1 + (size_t)(b * SEQ + key) * N1 + OFF_KI);
            v4u k8[8];
#pragma unroll
            for (int j = 0; j < 8; ++j) k8[j] = kr[j];
            float s = 0.f;
#pragma unroll 1
            for (int hd = 0; hd < 8; ++hd) { float d0 = 0.f, d1 = 0.f;
#pragma unroll
                for (int j = 0; j < 8; ++j) { const f32x4 qa = *(const LAS f32x4*)(qi + hd * 64 + 8 * j), qb = *(const LAS f32x4*)(qi + hd * 64 + 8 * j + 4); const v4u t = k8[j];
                    d0 += (qa.x * bflo(t.x) + qa.z * bflo(t.y)) + (qb.x * bflo(t.z) + qb.z * bflo(t.w));
                    d1 += (qa.y * bfhi(t.x) + qa.w * bfhi(t.y)) + (qb.y * bfhi(t.z) + qb.w * bfhi(t.w)); }
                s += wl[hd] * fmaxf(d0 + d1, 0.f); }
            s += 0.0f;
            unsigned u = __float_as_uint(s); u = (u & 0x80000000u) ? ~u : (u | 0x80000000u);
            uk[key] = u;
        }
        WAVE_LDS_SYNC();
        int nsel;
        if (n <= 256) { for (int j = lane; j < n; j += 64) idx[j] = j; nsel = n; }
        else {
            unsigned prefix = 0u;
            for (int bit = 31; bit >= 0; --bit) {
                const unsigned cand = prefix | (1u << bit); int cnt = 0;
                for (int i = 0; i < nk; ++i) cnt += __popcll(__ballot(uk[i * 64 + lane] >= cand));
                if (cnt >= 256) prefix = cand;
            }
            int cgt = 0;
            for (int i = 0; i < nk; ++i) cgt += __popcll(__ballot(uk[i * 64 + lane] > prefix));
            const int need = 256 - cgt; int basep = 0, eqrun = 0;
            for (int i = 0; i < nk; ++i) {
                const unsigned u = uk[i * 64 + lane]; const bool gt = u > prefix, eq = (u == prefix);
                const unsigned long long eqm = __ballot(eq);
                const int rank = eqrun + __popcll(eqm & lt_mask);
                const bool sel = gt || (eq && rank < need);
                const unsigned long long sm = __ballot(sel);
                if (sel) idx[basep + __popcll(sm & lt_mask)] = i * 64 + lane;
                basep += __popcll(sm); eqrun += __popcll(eqm);
            }
            nsel = 256;
        }
        WAVE_LDS_SYNC();
#pragma unroll 1
        for (int jj = 0; jj < 4; ++jj) {
            const int j = jj * 64 + lane; const bool valid = j < nsel; const int key = valid ? idx[j] : 0;
            const v4u* cr = (const v4u*)(CN + (size_t)(b * SEQ + key) * 128);
            float dot[8];
#pragma unroll
            for (int hd = 0; hd < 8; ++hd) dot[hd] = 0.f;
#pragma unroll 2
            for (int c8 = 0; c8 < 16; ++c8) { const v4u t = cr[c8];
                const float c0 = bflo(t.x), c1 = bfhi(t.x), c2 = bflo(t.y), c3 = bfhi(t.y), c4 = bflo(t.z), c5 = bfhi(t.z), c6 = bflo(t.w), c7 = bfhi(t.w);
#pragma unroll
                for (int hd = 0; hd < 8; ++hd) { const f32x4 qa = *(const LAS f32x4*)(ql + hd * 128 + c8 * 8), qb = *(const LAS f32x4*)(ql + hd * 128 + c8 * 8 + 4);
                    dot[hd] += (qa.x * c0 + qa.y * c1) + (qa.z * c2 + qa.w * c3) + (qb.x * c4 + qb.y * c5) + (qb.z * c6 + qb.w * c7); } }
            const float dist = fabsf((float)(pos - key));
#pragma unroll
            for (int hd = 0; hd < 8; ++hd) { const float slope = __uint_as_float((unsigned)(127 - (hd + 1)) << 23);
                pb[hd * 256 + j] = valid ? (dot[hd] * 0.125f - slope * dist) : -__builtin_inff(); }
        }
        WAVE_LDS_SYNC();
#pragma unroll 1
        for (int hd = 0; hd < 8; ++hd) {
            float p[4];
#pragma unroll
            for (int jj = 0; jj < 4; ++jj) p[jj] = pb[hd * 256 + jj * 64 + lane];
            float m = fmaxf(fmaxf(p[0], p[1]), fmaxf(p[2], p[3])); m = wave_max(m);
            float s = 0.f;
#pragma unroll
            for (int jj = 0; jj < 4; ++jj) { p[jj] = __expf(p[jj] - m); s += p[jj]; }
            s = wave_sum(s); const float inv = 1.0f / s;
#pragma unroll
            for (int jj = 0; jj < 4; ++jj) pb[hd * 256 + jj * 64 + lane] = p[jj] * inv;
        }
        WAVE_LDS_SYNC();
        float o0[8], o1[8];
#pragma unroll
        for (int hd = 0; hd < 8; ++hd) { o0[hd] = 0.f; o1[hd] = 0.f; }
        for (int j = 0; j < nsel; j += 4) {
            unsigned cw[4];
#pragma unroll
            for (int t = 0; t < 4; ++t) cw[t] = *(const unsigned*)(CN + (size_t)(b * SEQ + idx[j + t]) * 128 + 2 * lane);
#pragma unroll
            for (int t = 0; t < 4; ++t) { const float c0 = bflo(cw[t]), c1 = bfhi(cw[t]);
#pragma unroll
                for (int hd = 0; hd < 8; ++hd) { const float p = pb[hd * 256 + j + t]; o0[hd] += p * c0; o1[hd] += p * c1; } }
        }
#pragma unroll
        for (int hd = 0; hd < 8; ++hd) *(unsigned*)(MIX + (size_t)q * K2 + hd * 128 + 2 * lane) = pk2(o0[hd], o1[hd]);
        WAVE_LDS_SYNC();
    }
}

namespace dsa {
using bf16x8 = __attribute__((ext_vector_type(8))) short;
using s16x4  = __attribute__((ext_vector_type(4))) short;
using f32x16 = __attribute__((ext_vector_type(16))) float;
using u32x4  = __attribute__((ext_vector_type(4))) unsigned;
constexpr int NW = 8, KVBLK = 64;
constexpr float SCALE = 0.125f, LOG2E = 1.4426950408889634f, THR = 8.f;
constexpr int SHM_V = KVBLK * 128 * 2, SHM_K = KVBLK * 128 * 2, SHM_ATTN = 2 * SHM_V + 2 * SHM_K + NW * 64 * 4;
constexpr unsigned NEG2 = 0xC6EAC6EAu;
#define KSWZ(row, colB) ((row) * 256 + ((colB) ^ (((row) & 7) << 4)))
#define SBAR() __builtin_amdgcn_sched_barrier(0)
__device__ __forceinline__ int crow(int r, int hi) { return (r & 3) + 8 * (r >> 2) + 4 * hi; }
__device__ __forceinline__ unsigned cvtpk(float lo, float hi) { unsigned r; asm volatile("v_cvt_pk_bf16_f32 %0, %1, %2" : "=v"(r) : "v"(lo), "v"(hi)); return r; }

template <int CTRL> __device__ __forceinline__ unsigned dppu(unsigned x) { return (unsigned)__builtin_amdgcn_update_dpp(0, (int)x, CTRL, 0xf, 0xf, true); }
__device__ __forceinline__ unsigned half_sum(unsigned x, int h) {
    x += dppu<0xB1>(x); x += dppu<0x4E>(x); x += dppu<0x141>(x); x += dppu<0x140>(x);
    const unsigned a = __builtin_amdgcn_readlane(x, 0) + __builtin_amdgcn_readlane(x, 16), b = __builtin_amdgcn_readlane(x, 32) + __builtin_amdgcn_readlane(x, 48);
    return h ? b : a;
}
__device__ __forceinline__ unsigned half_min(unsigned x, int h) {
    x = min(x, dppu<0xB1>(x)); x = min(x, dppu<0x4E>(x)); x = min(x, dppu<0x141>(x)); x = min(x, dppu<0x140>(x));
    const unsigned a = min((unsigned)__builtin_amdgcn_readlane(x, 0), (unsigned)__builtin_amdgcn_readlane(x, 16)), b = min((unsigned)__builtin_amdgcn_readlane(x, 32), (unsigned)__builtin_amdgcn_readlane(x, 48));
    return h ? b : a;
}
__device__ __forceinline__ unsigned half_max(unsigned x, int h) {
    x = max(x, dppu<0xB1>(x)); x = max(x, dppu<0x4E>(x)); x = max(x, dppu<0x141>(x)); x = max(x, dppu<0x140>(x));
    const unsigned a = max((unsigned)__builtin_amdgcn_readlane(x, 0), (unsigned)__builtin_amdgcn_readlane(x, 16)), b = max((unsigned)__builtin_amdgcn_readlane(x, 32), (unsigned)__builtin_amdgcn_readlane(x, 48));
    return h ? b : a;
}

template <int CTRL> __device__ __forceinline__ float dppf(float x) { return __int_as_float(__builtin_amdgcn_update_dpp(0, __float_as_int(x), CTRL, 0xf, 0xf, true)); }
__device__ __forceinline__ float half_minf(float x, int h) {
    x = fminf(x, dppf<0xB1>(x)); x = fminf(x, dppf<0x4E>(x)); x = fminf(x, dppf<0x141>(x)); x = fminf(x, dppf<0x140>(x));
    const float a = fminf(__int_as_float(__builtin_amdgcn_readlane(__float_as_int(x), 0)), __int_as_float(__builtin_amdgcn_readlane(__float_as_int(x), 16)));
    const float b = fminf(__int_as_float(__builtin_amdgcn_readlane(__float_as_int(x), 32)), __int_as_float(__builtin_amdgcn_readlane(__float_as_int(x), 48)));
    return h ? b : a;
}
__device__ __forceinline__ float half_maxf(float x, int h) {
    x = fmaxf(x, dppf<0xB1>(x)); x = fmaxf(x, dppf<0x4E>(x)); x = fmaxf(x, dppf<0x141>(x)); x = fmaxf(x, dppf<0x140>(x));
    const float a = fmaxf(__int_as_float(__builtin_amdgcn_readlane(__float_as_int(x), 0)), __int_as_float(__builtin_amdgcn_readlane(__float_as_int(x), 16)));
    const float b = fmaxf(__int_as_float(__builtin_amdgcn_readlane(__float_as_int(x), 32)), __int_as_float(__builtin_amdgcn_readlane(__float_as_int(x), 48)));
    return h ? b : a;
}
__device__ __forceinline__ unsigned f2key(float f) { const unsigned u = __float_as_uint(f); return (u & 0x80000000u) ? ~u : (u | 0x80000000u); }
__device__ __forceinline__ float key2f(unsigned k) { return __uint_as_float((k & 0x80000000u) ? (k & 0x7fffffffu) : ~k); }

template <int PROBE> __device__ __forceinline__ void idx_select(const bf16* __restrict__ P1, int b, int tokw, int n, int tid_in, LAS char* lds, unsigned& W0lo, unsigned& W0hi, unsigned& W1lo, unsigned& W1hi) {
    if (n <= 256) { W0lo = W0hi = W1lo = W1hi = 0xffffffffu; return; }
    int tid = tid_in; asm volatile("" : "+v"(tid));
    const int lane = tid & 63, wid = __builtin_amdgcn_readfirstlane(tid >> 6), c = lane & 31, h = lane >> 5;
    const int nt = n >> 5, nch = (n + 255) >> 8;
    const bf16* kb = P1 + (size_t)b * SEQ * N1 + OFF_KI;
    unsigned dsrc[4];
#pragma unroll
    for (int ii = 0; ii < 4; ++ii) { const int q = wid * 4 + ii, keyl = q * 8 + (lane >> 3), pc = lane & 7; dsrc[ii] = (unsigned)(keyl * N1 + ((pc ^ ((keyl >> 1) & 7)) << 3)); }
#define KI_DMA(cc) do { _Pragma("unroll") for (int ii = 0; ii < 4; ++ii) { const int q_ = wid * 4 + ii; if (256 * (cc) + 8 * q_ < n) \
        __builtin_amdgcn_global_load_lds((const unsigned*)(kb + (size_t)(256 * (cc)) * N1 + dsrc[ii]), (LAS unsigned*)(lds + ((cc) & 1) * 32768 + q_ * 1024), 16, 0, 0); } } while (0)
    KI_DMA(0);
    const int qa = 2 * ((c >> 2) & 1) + (c >> 4), ih = (c & 3) + 4 * ((c >> 3) & 1);
    const bf16* qip = P1 + (size_t)(tokw + qa) * N1 + OFF_QI + ih * 64 + 8 * h;
    bf16x8 af[4];
#pragma unroll
    for (int s = 0; s < 4; ++s) af[s] = *(const bf16x8*)(qip + 16 * s);
    float wq0[8], wq1[8];
    { const u32x4 t = *(const u32x4*)(P1 + (size_t)(tokw + 2 * h) * N1 + OFF_WI), u = *(const u32x4*)(P1 + (size_t)(tokw + 2 * h + 1) * N1 + OFF_WI);
      wq0[0] = bflo(t.x); wq0[1] = bfhi(t.x); wq0[2] = bflo(t.y); wq0[3] = bfhi(t.y); wq0[4] = bflo(t.z); wq0[5] = bfhi(t.z); wq0[6] = bflo(t.w); wq0[7] = bfhi(t.w);
      wq1[0] = bflo(u.x); wq1[1] = bfhi(u.x); wq1[2] = bflo(u.y); wq1[3] = bfhi(u.y); wq1[4] = bflo(u.z); wq1[5] = bfhi(u.z); wq1[6] = bflo(u.w); wq1[7] = bfhi(u.w); }
    const int rdoff = c * 128, rsw = (c >> 1) & 7;
    float sc0[64], sc1[64];
    float mn0 = __builtin_inff(), mx0 = -__builtin_inff(), mn1 = __builtin_inff(), mx1 = -__builtin_inff();
#pragma unroll
    for (int cc = 0; cc < 8; ++cc) {
        if (cc < nch) {
            __syncthreads();
            if (cc + 1 < nch) KI_DMA(cc + 1);
            const LAS char* cb = lds + (cc & 1) * 32768 + rdoff;
#pragma unroll
            for (int t = 0; t < 8; ++t) {
                const int i = cc * 8 + t;
                if (i < nt) {
                    f32x16 acc = {};
#pragma unroll
                    for (int s = 0; s < 4; ++s) { const bf16x8 kf = *(const LAS bf16x8*)(cb + t * 4096 + (((2 * s + h) ^ rsw) << 4));
                        acc = __builtin_amdgcn_mfma_f32_32x32x16_bf16(af[s], kf, acc, 0, 0, 0); }
                    float s0 = 0.f, s1 = 0.f;
#pragma unroll
                    for (int j = 0; j < 8; ++j) { s0 = fmaf(wq0[j], fmaxf(acc[j], 0.f), s0); s1 = fmaf(wq1[j], fmaxf(acc[8 + j], 0.f), s1); }
                    s0 += 0.0f; s1 += 0.0f;
                    sc0[i] = s0; sc1[i] = s1; mn0 = fminf(mn0, s0); mx0 = fmaxf(mx0, s0); mn1 = fminf(mn1, s1); mx1 = fmaxf(mx1, s1);
                } else { sc0[i] = -__builtin_inff(); sc1[i] = -__builtin_inff(); }
            }
        } else {
#pragma unroll
            for (int t = 0; t < 8; ++t) { sc0[cc * 8 + t] = -__builtin_inff(); sc1[cc * 8 + t] = -__builtin_inff(); }
        }
    }
#undef KI_DMA
    __syncthreads();
    unsigned klo0 = f2key(half_minf(mn0, h)), khi0 = f2key(half_maxf(mx0, h)) + 1u, klo1 = f2key(half_minf(mn1, h)), khi1 = f2key(half_maxf(mx1, h)) + 1u;
    unsigned cl0 = (unsigned)n, cl1 = (unsigned)n, ch0 = 0u, ch1 = 0u;
    bool fin0 = (khi0 - klo0 <= 1u), fin1 = (khi1 - klo1 <= 1u);
    for (int it = 0; it < (PROBE == 3 ? 0 : 96); ++it) {
        unsigned km0, km1;
        if (it < 48) {
            const float lo0f = key2f(klo0), hi0f = key2f(khi0), lo1f = key2f(klo1), hi1f = key2f(khi1);
            float f0 = 0.5f, f1 = 0.5f;
            if (!(it & 1)) { f0 = ((float)cl0 - 255.5f) / (float)(cl0 - ch0); f1 = ((float)cl1 - 255.5f) / (float)(cl1 - ch1); }
            const float m0 = fmaf(hi0f - lo0f, f0, lo0f), m1 = fmaf(hi1f - lo1f, f1, lo1f);
            km0 = f2key(m0 + 0.0f); km1 = f2key(m1 + 0.0f);
            if (!(m0 == m0)) km0 = klo0 + ((khi0 - klo0) >> 1);
            if (!(m1 == m1)) km1 = klo1 + ((khi1 - klo1) >> 1);
        } else { km0 = klo0 + ((khi0 - klo0) >> 1); km1 = klo1 + ((khi1 - klo1) >> 1); }
        km0 = min(max(km0, klo0 + 1u), khi0 - 1u); km1 = min(max(km1, klo1 + 1u), khi1 - 1u);
        const float t0 = key2f(km0), t1 = key2f(km1);
        unsigned c0 = 0u, c1 = 0u;
#pragma unroll
        for (int g = 0; g < 8; ++g) {
            if (g * 8 < nt) {
#pragma unroll
                for (int i = g * 8; i < g * 8 + 8; ++i) { c0 += (sc0[i] >= t0) ? 1u : 0u; c1 += (sc1[i] >= t1) ? 1u : 0u; }
            }
        }
        c0 = half_sum(c0, h); c1 = half_sum(c1, h);
        if (!fin0) { if (c0 >= 256u) { klo0 = km0; cl0 = c0; } else { khi0 = km0; ch0 = c0; } fin0 = (c0 == 256u) || (khi0 - klo0 <= 1u); }
        if (!fin1) { if (c1 >= 256u) { klo1 = km1; cl1 = c1; } else { khi1 = km1; ch1 = c1; } fin1 = (c1 == 256u) || (khi1 - klo1 <= 1u); }
        if (__all(fin0 && fin1)) break;
    }
    const float lo0 = key2f(klo0), lo1 = key2f(klo1);
    unsigned w0l = 0u, w0h = 0u, w1l = 0u, w1h = 0u;
#define BITOF(cond) ({ unsigned t__ = (cond) ? 1u : 0u; asm volatile("" : "+v"(t__)); t__; })
    if (__all(cl0 == 256u && cl1 == 256u)) {
#pragma unroll
        for (int i = 0; i < 32; ++i) { w0l |= BITOF(sc0[i] >= lo0) << i; w1l |= BITOF(sc1[i] >= lo1) << i; }
#pragma unroll
        for (int i = 32; i < 64; ++i) { w0h |= BITOF(sc0[i] >= lo0) << (i - 32); w1h |= BITOF(sc1[i] >= lo1) << (i - 32); }
    } else {
        unsigned g0 = 0u, g1 = 0u;
#pragma unroll
        for (int i = 0; i < 64; ++i) { g0 += (sc0[i] > lo0) ? 1u : 0u; g1 += (sc1[i] > lo1) ? 1u : 0u; }
        g0 = half_sum(g0, h); g1 = half_sum(g1, h);
        const unsigned need0 = 256u - g0, need1 = 256u - g1, ltm = (1u << c) - 1u;
        unsigned run0 = 0u, run1 = 0u;
#pragma unroll
        for (int i = 0; i < 64; ++i) {
            const bool e0 = (sc0[i] == lo0), e1 = (sc1[i] == lo1);
            const unsigned long long m0 = __ballot(e0), m1 = __ballot(e1);
            const unsigned hb0 = h ? (unsigned)(m0 >> 32) : (unsigned)m0, hb1 = h ? (unsigned)(m1 >> 32) : (unsigned)m1;
            const bool s0 = (sc0[i] > lo0) || (e0 && (run0 + __popc(hb0 & ltm) < need0));
            const bool s1 = (sc1[i] > lo1) || (e1 && (run1 + __popc(hb1 & ltm) < need1));
            run0 += __popc(hb0); run1 += __popc(hb1);
            if (i < 32) { w0l |= BITOF(s0) << i; w1l |= BITOF(s1) << i; } else { w0h |= BITOF(s0) << (i - 32); w1h |= BITOF(s1) << (i - 32); }
        }
    }
#undef BITOF
    W0lo = w0l; W0hi = w0h; W1lo = w1l; W1hi = w1h;
}

__device__ __forceinline__ void partialSM(f32x16& p0, f32x16& p1, float b0, float& m_reg, float& mn, float& alpha) {
    constexpr float C = SCALE * LOG2E;
    float pmax = p0[0];
#pragma unroll
    for (int r = 1; r < 16; ++r) pmax = fmaxf(pmax, p0[r]);
#pragma unroll
    for (int r = 0; r < 16; ++r) pmax = fmaxf(pmax, p1[r]);
    { auto rr = __builtin_amdgcn_permlane32_swap(__float_as_uint(pmax), __float_as_uint(pmax), false, false);
      pmax = fmaxf(__uint_as_float(rr[0]), __uint_as_float(rr[1])); }
    const float pm = fmaf(pmax, C, b0);
    if (__builtin_expect(__all(pm - m_reg <= THR * LOG2E), 1)) { mn = m_reg; alpha = 1.f; }
    else { mn = fmaxf(m_reg, pm); alpha = __builtin_amdgcn_exp2f(m_reg - mn); m_reg = mn; }
    const float off = b0 - mn;
#pragma unroll
    for (int r = 0; r < 16; ++r) p0[r] = fmaf(p0[r], C, off);
#pragma unroll
    for (int r = 0; r < 16; ++r) p1[r] = fmaf(p1[r], C, off);
#pragma unroll
    for (int r = 0; r < 16; ++r) p0[r] = __builtin_amdgcn_exp2f(p0[r]);
}
__device__ __forceinline__ void finishSM(f32x16& p0, f32x16& p1, float alpha, float& l_reg, bf16x8& pa0, bf16x8& pa1, bf16x8& pa2, bf16x8& pa3) {
#pragma unroll
    for (int r = 0; r < 16; ++r) p1[r] = __builtin_amdgcn_exp2f(p1[r]);
    float ps = 0;
#pragma unroll
    for (int r = 0; r < 16; ++r) ps += p0[r];
#pragma unroll
    for (int r = 0; r < 16; ++r) ps += p1[r];
    { auto rr = __builtin_amdgcn_permlane32_swap(__float_as_uint(ps), __float_as_uint(ps), false, false);
      ps = __uint_as_float(rr[0]) + __uint_as_float(rr[1]); }
    l_reg = l_reg * alpha + ps;
#define PK4(P, BASE, OUT) do { unsigned a0 = cvtpk(P[BASE + 0], P[BASE + 1]), a1 = cvtpk(P[BASE + 2], P[BASE + 3]);   \
    unsigned b0_ = cvtpk(P[BASE + 4], P[BASE + 5]), b1_ = cvtpk(P[BASE + 6], P[BASE + 7]);                              \
    auto r0 = __builtin_amdgcn_permlane32_swap(a0, b0_, false, false); auto r1 = __builtin_amdgcn_permlane32_swap(a1, b1_, false, false); \
    u32x4 w = {r0[0], r1[0], r0[1], r1[1]}; OUT = *reinterpret_cast<bf16x8*>(&w); } while (0)
    PK4(p0, 0, pa0); PK4(p0, 8, pa1); PK4(p1, 0, pa2); PK4(p1, 8, pa3);
#undef PK4
}
__device__ __forceinline__ void qkt(f32x16& p0, f32x16& p1, const LAS char* Ks, const bf16x8* qr, bf16x8 ax0, bf16x8 ax1, bf16x8 ef, int r32, int hi) {
    p0 = __builtin_amdgcn_mfma_f32_32x32x16_bf16(ax0, ef, f32x16{}, 0, 0, 0);
    p1 = __builtin_amdgcn_mfma_f32_32x32x16_bf16(ax1, ef, f32x16{}, 0, 0, 0);
#pragma unroll
    for (int d0 = 0; d0 < 8; ++d0) { const int cb = (d0 * 16 + hi * 8) * 2;
        const bf16x8 b0 = *reinterpret_cast<const LAS bf16x8*>(Ks + KSWZ(r32, cb));
        const bf16x8 b1 = *reinterpret_cast<const LAS bf16x8*>(Ks + KSWZ(32 + r32, cb));
        p0 = __builtin_amdgcn_mfma_f32_32x32x16_bf16(b0, qr[d0], p0, 0, 0, 0);
        p1 = __builtin_amdgcn_mfma_f32_32x32x16_bf16(b1, qr[d0], p1, 0, 0, 0); }
}
__device__ __forceinline__ int v_st(int k, int c) { const int kk = (k & ~0xC) | ((k & 4) << 1) | ((k & 8) >> 1); return ((kk >> 3) * 4 + (c >> 5)) * 512 + ((kk & 7) * 32 + (c & 31)) * 2; }
__device__ __forceinline__ int v_rd_base(int lane) { return ((lane & 3) << 3) | (((lane >> 2) & 3) << 6) | (((lane >> 4) & 1) << 5) | (((lane >> 5) & 1) << 8); }
constexpr int v_rd_off(int d0, int ks, int half) { return d0 * 512 + ks * 4096 + half * 2048; }
template <int OFF> __device__ __forceinline__ s16x4 tr_read(int vb) { s16x4 r; asm volatile("ds_read_b64_tr_b16 %0, %1 offset:%2" : "=&v"(r) : "v"(vb), "i"(OFF) : "memory"); return r; }
template <int D0> __device__ __forceinline__ void pv_one(f32x16& od, int vb, bf16x8 pa0, bf16x8 pa1, bf16x8 pa2, bf16x8 pa3) {
    const s16x4 l0 = tr_read<v_rd_off(D0, 0, 0)>(vb), h0 = tr_read<v_rd_off(D0, 0, 1)>(vb), l1 = tr_read<v_rd_off(D0, 1, 0)>(vb), h1 = tr_read<v_rd_off(D0, 1, 1)>(vb);
    const s16x4 l2 = tr_read<v_rd_off(D0, 2, 0)>(vb), h2 = tr_read<v_rd_off(D0, 2, 1)>(vb), l3 = tr_read<v_rd_off(D0, 3, 0)>(vb), h3 = tr_read<v_rd_off(D0, 3, 1)>(vb);
    asm volatile("s_waitcnt lgkmcnt(0)" ::: "memory"); SBAR();
#define PK(L, H) (bf16x8){L[0], L[1], L[2], L[3], H[0], H[1], H[2], H[3]}
    od = __builtin_amdgcn_mfma_f32_32x32x16_bf16(pa0, PK(l0, h0), od, 0, 0, 0);
    od = __builtin_amdgcn_mfma_f32_32x32x16_bf16(pa1, PK(l1, h1), od, 0, 0, 0);
    od = __builtin_amdgcn_mfma_f32_32x32x16_bf16(pa2, PK(l2, h2), od, 0, 0, 0);
    od = __builtin_amdgcn_mfma_f32_32x32x16_bf16(pa3, PK(l3, h3), od, 0, 0, 0);
#undef PK
}
__device__ __forceinline__ void pv_d0(f32x16* o, int vb, bf16x8 pa0, bf16x8 pa1, bf16x8 pa2, bf16x8 pa3) {
    pv_one<0>(o[0], vb, pa0, pa1, pa2, pa3); pv_one<1>(o[1], vb, pa0, pa1, pa2, pa3); pv_one<2>(o[2], vb, pa0, pa1, pa2, pa3); pv_one<3>(o[3], vb, pa0, pa1, pa2, pa3);
}

__device__ __forceinline__ void attn_item(const bf16* __restrict__ P1, const bf16* __restrict__ Cb, bf16* __restrict__ MIXp, int tok0, int pos0, int n, LAS char* lds, const int tid_in) {
    int tid = tid_in; asm volatile("" : "+v"(tid));
    const int wid = tid >> 6, lane = tid & 63, r32 = lane & 31, hi = lane >> 5;
    LAS char* V_lds = lds; LAS char* K_lds = lds + 2 * SHM_V;
    LAS float* wsl = (LAS float*)(lds + 2 * SHM_V + 2 * SHM_K) + wid * 64; LAS float* li_l = wsl; LAS float* al_l = wsl + 32;
    const LAS u32x4* mwl = (const LAS u32x4*)(lds + SHM_ATTN) + tid;
    float m_reg = -1e30f, l_reg = 0; f32x16 o[4] = {}; bf16x8 qr[8];
    const int ql_ = r32 >> 3, hd = r32 & 7;
    { const bf16* Qw = P1 + (size_t)(tok0 + 4 * wid + ql_) * N1 + OFF_QL + hd * 128 + hi * 8;
#pragma unroll
      for (int d0 = 0; d0 < 8; ++d0) qr[d0] = *(const bf16x8*)(Qw + d0 * 16); }
    const float slope2 = __uint_as_float((unsigned)(127 - (hd + 1)) << 23) * LOG2E;
    const float qposf = (float)(pos0 + 4 * wid + ql_);
    bf16x8 ef; { u32x4 w = {0u, 0u, 0u, 0u}; w.x = ((ql_ == 2 * hi) ? 0x3F80u : 0u) | ((ql_ == 2 * hi + 1) ? 0x3F800000u : 0u); w.y = (hi == 0) ? ((unsigned)(129 - hd) << 7) : 0u; ef = *reinterpret_cast<bf16x8*>(&w); }
    const unsigned klw0 = (hi == 0) ? (__float_as_uint((float)r32) >> 16) : 0u, klw1 = (hi == 0) ? (__float_as_uint((float)(32 + r32)) >> 16) : 0u;
    const int NT = n >> 6, NTP = (NT + 1) & ~1;
#define TILE_K0(j) (((j) < NT) ? (NT - 1 - (j)) * KVBLK : 0)
#define MASKW(s_) ({ const int s__ = (s_); const unsigned b0__ = ((s__ < 32) ? (Wv_.x >> s__) : (Wv_.y >> (s__ - 32))) & 1u, b1__ = ((s__ < 32) ? (Wv_.z >> s__) : (Wv_.w >> (s__ - 32))) & 1u; \
        NEG2 & ~((b0__ ? 0xffffu : 0u) | (b1__ ? 0xffff0000u : 0u)); })
#define MKAX(j, ax0, ax1) do { u32x4 w0_ = {NEG2, klw0, 0u, 0u}, w1_ = {NEG2, klw1, 0u, 0u}; if ((j) < NT) { const u32x4 Wv_ = *mwl; const int tt_ = NT - 1 - (j); w0_.x = MASKW(2 * tt_); w1_.x = MASKW(2 * tt_ + 1); } \
        ax0 = *reinterpret_cast<bf16x8*>(&w0_); ax1 = *reinterpret_cast<bf16x8*>(&w1_); } while (0)
#define TILE_B0(j) (slope2 * ((float)TILE_K0(j) - qposf))
    const int sr = tid >> 4, sc = (tid & 15) * 8, vst0 = v_st(sr, sc), vst1 = v_st(32 + sr, sc);
    const int vb0 = (int)(unsigned)(size_t)V_lds + v_rd_base(lane);
    struct { bf16x8 c0, c1; } sr_[1];
#define SLOAD(i, k0) do { sr_[i].c0 = *(const bf16x8*)(Cb + (size_t)((k0) + sr) * 128 + sc); sr_[i].c1 = *(const bf16x8*)(Cb + (size_t)((k0) + 32 + sr) * 128 + sc); } while (0)
#define SWRITE(b, i) do { *(LAS bf16x8*)(V_lds + (b) * SHM_V + vst0) = sr_[i].c0; *(LAS bf16x8*)(V_lds + (b) * SHM_V + vst1) = sr_[i].c1; const int kc = sc * 2; \
    *(LAS bf16x8*)(K_lds + (b) * SHM_K + KSWZ(sr, kc)) = sr_[i].c0; *(LAS bf16x8*)(K_lds + (b) * SHM_K + KSWZ(32 + sr, kc)) = sr_[i].c1; } while (0)
#define SWAIT() asm volatile("s_waitcnt vmcnt(0)" ::: "memory")
#define RESC(a) do { if (__any((a) < 1.f)) { if (hi == 0) al_l[r32] = (a); asm volatile("s_waitcnt lgkmcnt(0)" ::: "memory"); \
    _Pragma("unroll") for (int d = 0; d < 4; ++d) _Pragma("unroll") for (int r = 0; r < 16; ++r) o[d][r] *= al_l[crow(r, hi)]; } } while (0)
    f32x16 pA0, pA1, pB0, pB1; float mnA, mnB, alA, alB; bf16x8 pa0, pa1, pa2, pa3, ax0, ax1;
    constexpr int SE = 0, SO = 0;
    SLOAD(SE, TILE_K0(0)); asm volatile("s_waitcnt vmcnt(0)" ::: "memory"); SWRITE(0, SE); __syncthreads();
    MKAX(0, ax0, ax1); qkt(pA0, pA1, K_lds, qr, ax0, ax1, ef, r32, hi);
    {
        const float base = (float)TILE_K0(0) - qposf + (float)(4 * hi), s16 = -2.0f * __uint_as_float((unsigned)(129 - hd) << 23);
#pragma unroll
        for (int r = 0; r < 16; ++r) { const float cr = (float)((r & 3) + 8 * (r >> 2));
            pA0[r] = fmaf(s16, fmaxf(base + cr, 0.f), pA0[r]); pA1[r] = fmaf(s16, fmaxf(base + cr + 32.f, 0.f), pA1[r]); }
    }
    partialSM(pA0, pA1, TILE_B0(0), m_reg, mnA, alA);
    SLOAD(SO, TILE_K0(1));
    SWAIT(); SWRITE(1, SO); __syncthreads();
    for (int j = 1; j + 1 < NTP; j += 2) {
        SBAR(); MKAX(j, ax0, ax1); qkt(pB0, pB1, K_lds + SHM_K, qr, ax0, ax1, ef, r32, hi);
        finishSM(pA0, pA1, alA, l_reg, pa0, pa1, pa2, pa3); SBAR();
        SLOAD(SO, TILE_K0(j + 1)); SBAR();
        pv_d0(o, vb0, pa0, pa1, pa2, pa3); partialSM(pB0, pB1, TILE_B0(j), m_reg, mnB, alB);
        __syncthreads(); SWAIT(); SWRITE(0, SE);
        RESC(alB); __syncthreads();
        SBAR(); MKAX(j + 1, ax0, ax1); qkt(pA0, pA1, K_lds, qr, ax0, ax1, ef, r32, hi);
        finishSM(pB0, pB1, alB, l_reg, pa0, pa1, pa2, pa3); SBAR();
        SLOAD(SE, TILE_K0(j + 2)); SBAR();
        pv_d0(o, vb0 + SHM_V, pa0, pa1, pa2, pa3); partialSM(pA0, pA1, TILE_B0(j + 1), m_reg, mnA, alA);
        __syncthreads(); SWAIT(); SWRITE(1, SO);
        RESC(alA); __syncthreads();
    }
    SBAR(); MKAX(NTP - 1, ax0, ax1); qkt(pB0, pB1, K_lds + SHM_K, qr, ax0, ax1, ef, r32, hi);
    finishSM(pA0, pA1, alA, l_reg, pa0, pa1, pa2, pa3); SBAR();
    pv_d0(o, vb0, pa0, pa1, pa2, pa3); partialSM(pB0, pB1, TILE_B0(NTP - 1), m_reg, mnB, alB);
    __syncthreads(); RESC(alB);
    finishSM(pB0, pB1, alB, l_reg, pa0, pa1, pa2, pa3); SBAR();
    pv_d0(o, vb0 + SHM_V, pa0, pa1, pa2, pa3);
    if (hi == 0) li_l[r32] = l_reg; asm volatile("s_waitcnt lgkmcnt(0)" ::: "memory");
    float rli[16];
#pragma unroll
    for (int r = 0; r < 16; ++r) rli[r] = __builtin_amdgcn_rcpf(li_l[crow(r, hi)]);
#pragma unroll
    for (int r = 0; r < 16; ++r) { const int orow = crow(r, hi);
        bf16* op = MIXp + (size_t)(tok0 + 4 * wid + (orow >> 3)) * K2 + (orow & 7) * 128 + r32;
#pragma unroll
        for (int d0 = 0; d0 < 4; ++d0) op[d0 * 32] = (bf16)f2bf(o[d0][r] * rli[r]); }
    __syncthreads();
#undef SLOAD
#undef SWRITE
#undef SWAIT
#undef RESC
#undef TILE_K0
#undef MASKW
#undef MKAX
#undef TILE_B0
}
}

__device__ __forceinline__ int tid_from(const int wid6) { int l; asm volatile("v_mbcnt_lo_u32_b32 %0, -1, 0\n\tv_mbcnt_hi_u32_b32 %0, -1, %0" : "=v"(l)); return wid6 | l; }
__device__ __forceinline__ void ph_attn_fast(const Args& a, LAS unsigned char* lds, const int variant, const int wid6) {
    const bf16* P1 = (const bf16*)(a.ws + WS_P1); const bf16* CN = (const bf16*)(a.ws + WS_CN); bf16* MIX = (bf16*)(a.ws + WS_MIX);
    const int G = gridDim.x;
    for (int it = blockIdx.x; it < BATCH * 64; it += G) {
        const int tid = tid_from(wid6);
        const int lane = tid & 63, wid = tid >> 6;
        const int gg = it & 255, m = it >> 8;
        const int b = (gg & 7) + 8 * (gg >> 6), jg = (gg >> 3) & 7, qb = (m & 1) ? (63 - jg - 8 * (m >> 1)) : (jg + 8 * (m >> 1));
        const int pos0 = qb * 32, tok0 = b * SEQ + pos0, n = ((pos0 >> 6) + 1) << 6;
        { unsigned w0l, w0h, w1l, w1h;
          if (variant == 2) { w0l = w0h = w1l = w1h = 0xffffffffu; }
          else if (ATT_VARIANT == 3 && variant == 3) dsa::idx_select<3>(P1, b, tok0 + 4 * wid, n, tid, (LAS char*)lds, w0l, w0h, w1l, w1h);
          else dsa::idx_select<0>(P1, b, tok0 + 4 * wid, n, tid, (LAS char*)lds, w0l, w0h, w1l, w1h);
          ((LAS dsa::u32x4*)(lds + dsa::SHM_ATTN))[tid] = (dsa::u32x4){w0l, w0h, w1l, w1h};
          asm volatile("s_waitcnt lgkmcnt(0)" ::: "memory");
          if (ATT_VARIANT && (variant == 1 || variant == 3)) { __syncthreads(); continue; } }
        dsa::attn_item(P1, CN + (size_t)b * SEQ * 128, variant ? ((bf16*)(a.ws + WS_END) - (size_t)tok0 * K2 + (size_t)(tok0 & 4095) * K2) : MIX, tok0, pos0, n, (LAS char*)lds, tid);
    }
}

__device__ __forceinline__ void ph_conv(const Args& a, int hsel, int gtid, int gthreads) {
    const bf16* RAW = (const bf16*)(a.ws + WS_RAW); bf16* ACT = (bf16*)(a.ws + WS_ACT); const float* CONVP = (const float*)(a.ws + WS_CONVP);
    constexpr int CH = FF / 8;
    const int nseg = gthreads / CH;
    const int seg = gtid / CH, ch = gtid - seg * CH;
    if (seg >= nseg) return;
    const int per = (NTOK / 2 + nseg - 1) / nseg, tl0 = seg * per, tl1 = (tl0 + per < NTOK / 2) ? tl0 + per : NTOK / 2;
    const int jc = ch * 8, j = jc >> 7, ii = jc & 127, rg = 256 * j + ii, ru = rg + 128;
    float w0g[8], w1g[8], w2g[8], bg[8], w0u[8], w1u[8], w2u[8], bu[8];
#pragma unroll
    for (int e = 0; e < 8; ++e) { w0g[e] = CONVP[rg + e]; w1g[e] = CONVP[N3 + rg + e]; w2g[e] = CONVP[2 * N3 + rg + e]; bg[e] = CONVP[3 * N3 + rg + e];
        w0u[e] = CONVP[ru + e]; w1u[e] = CONVP[N3 + ru + e]; w2u[e] = CONVP[2 * N3 + ru + e]; bu[e] = CONVP[3 * N3 + ru + e]; }
    v4u g1 = (v4u){0u, 0u, 0u, 0u}, g2 = g1, u1 = g1, u2 = g1;
    if (tl0 < tl1) { const int pos = (hsel * (NTOK / 2) + tl0) & (SEQ - 1);
        if (pos >= 1) { g1 = *(const v4u*)(RAW + (size_t)(tl0 - 1) * N3 + rg); u1 = *(const v4u*)(RAW + (size_t)(tl0 - 1) * N3 + ru); }
        if (pos >= 2) { g2 = *(const v4u*)(RAW + (size_t)(tl0 - 2) * N3 + rg); u2 = *(const v4u*)(RAW + (size_t)(tl0 - 2) * N3 + ru); } }
#pragma unroll 4
    for (int tl = tl0; tl < tl1; ++tl) {
        const int tok = hsel * (NTOK / 2) + tl;
        if ((tok & (SEQ - 1)) == 0) { g1 = (v4u){0u, 0u, 0u, 0u}; g2 = g1; u1 = g1; u2 = g1; }
        const v4u g0 = *(const v4u*)(RAW + (size_t)tl * N3 + rg), u0 = *(const v4u*)(RAW + (size_t)tl * N3 + ru);
        const float ga[8] = {bflo(g0.x), bfhi(g0.x), bflo(g0.y), bfhi(g0.y), bflo(g0.z), bfhi(g0.z), bflo(g0.w), bfhi(g0.w)};
        const float gb[8] = {bflo(g1.x), bfhi(g1.x), bflo(g1.y), bfhi(g1.y), bflo(g1.z), bfhi(g1.z), bflo(g1.w), bfhi(g1.w)};
        const float gc[8] = {bflo(g2.x), bfhi(g2.x), bflo(g2.y), bfhi(g2.y), bflo(g2.z), bfhi(g2.z), bflo(g2.w), bfhi(g2.w)};
        const float ua[8] = {bflo(u0.x), bfhi(u0.x), bflo(u0.y), bfhi(u0.y), bflo(u0.z), bfhi(u0.z), bflo(u0.w), bfhi(u0.w)};
        const float ub[8] = {bflo(u1.x), bfhi(u1.x), bflo(u1.y), bfhi(u1.y), bflo(u1.z), bfhi(u1.z), bflo(u1.w), bfhi(u1.w)};
        const float uc[8] = {bflo(u2.x), bfhi(u2.x), bflo(u2.y), bfhi(u2.y), bflo(u2.z), bfhi(u2.z), bflo(u2.w), bfhi(u2.w)};
        float r[8];
#pragma unroll
        for (int e = 0; e < 8; ++e) {
            const float cg_ = bg[e] + w0g[e] * gc[e] + w1g[e] * gb[e] + w2g[e] * ga[e];
            const float cu_ = bu[e] + w0u[e] * uc[e] + w1u[e] * ub[e] + w2u[e] * ua[e];
            r[e] = cg_ / (1.0f + __expf(-cg_)) * cu_;
        }
        v4u o; o.x = pk2(r[0], r[1]); o.y = pk2(r[2], r[3]); o.z = pk2(r[4], r[5]); o.w = pk2(r[6], r[7]);
        *(v4u*)(ACT + (size_t)tok * FF + jc) = o;
        g2 = g1; u2 = u1; g1 = g0; u1 = u0;
    }
}

__device__ __forceinline__ void ph_final(const Args& a, int gw, int ngw, int lane) {
    const bf16* X2 = (const bf16*)(a.ws + WS_X2); const float* ss3 = (const float*)(a.ws + WS_CTL + 256 * 1024);
    for (int m = gw; m < NTOK; m += ngw) {
        const float rinv = 1.0f / sqrtf(ss3[m] * (1.0f / DM) + EPS);
#pragma unroll
        for (int h2 = 0; h2 < 2; ++h2) {
            const int c0 = h2 * 512 + 8 * lane;
            const v4u t = *(const v4u*)(X2 + (size_t)m * DM + c0);
            const f32x4 g0 = *(const f32x4*)(a.g_final + c0), g1 = *(const f32x4*)(a.g_final + c0 + 4);
            f32x4 o0, o1;
            o0.x = bflo(t.x) * rinv * g0.x; o0.y = bfhi(t.x) * rinv * g0.y; o0.z = bflo(t.y) * rinv * g0.z; o0.w = bfhi(t.y) * rinv * g0.w;
            o1.x = bflo(t.z) * rinv * g1.x; o1.y = bfhi(t.z) * rinv * g1.y; o1.z = bflo(t.w) * rinv * g1.z; o1.w = bfhi(t.w) * rinv * g1.w;
            *(f32x4*)(a.out + (size_t)m * DM + c0) = o0; *(f32x4*)(a.out + (size_t)m * DM + c0 + 4) = o1;
        }
    }
}

#define XB_TMO      128
#define XB_XCNT(j)  (256  + 64 * (j))
#define XB_XSUB(j)  (1280 + 64 * (j))
#define XB_XGEN(j)  (2304 + 64 * (j))
#define XB_TOP      3328
#define XB_TOPGEN   3392
#define XCD_BAR_WORDS 3456
#define XB_SPIN_CAP (1u << 18)
__device__ __forceinline__ unsigned xb_ld(unsigned* p)              { return __hip_atomic_load(p, __ATOMIC_RELAXED, __HIP_MEMORY_SCOPE_AGENT); }
__device__ __forceinline__ unsigned xb_add(unsigned* p, unsigned v) { return __hip_atomic_fetch_add(p, v, __ATOMIC_RELAXED, __HIP_MEMORY_SCOPE_AGENT); }
__device__ __forceinline__ unsigned xb_xcc_id() { return (unsigned)__builtin_amdgcn_s_getreg((3 << 11) | 20) & 0xFu; }
#define XB_SPIN(cond, bar) do { unsigned _sp = 0; while (cond) { __builtin_amdgcn_s_sleep(1); \
    if ((++_sp & 255u) == 0u) { if (xb_ld(&(bar)[XB_TMO])) break; if (_sp > XB_SPIN_CAP) { atomicAdd(&(bar)[XB_TMO], 1u); break; } } } } while (0)
struct XcdBarrier { unsigned* bar; unsigned x; volatile LAS unsigned* st; };
__device__ __forceinline__ XcdBarrier xcd_barrier_post(unsigned* bar, volatile LAS unsigned* st, const int tid) {
    XcdBarrier b; b.bar = bar; b.x = xb_xcc_id(); b.st = st;
    if (tid == 0) (void)xb_add(&bar[XB_XCNT(b.x)], 1u);
    return b;
}
__device__ __forceinline__ void xcd_barrier_complete(unsigned* bar, unsigned x, unsigned& nloc, unsigned& nx) {
    const unsigned G = gridDim.x * gridDim.y * gridDim.z;
    unsigned sum, cnt, mine, sp = 0u;
    for (;;) {
        sum = 0u; cnt = 0u; mine = 0u;
#pragma unroll
        for (unsigned j = 0; j < 16; ++j) { const unsigned c = xb_ld(&bar[XB_XCNT(j)]); sum += c; cnt += (c > 0u) ? 1u : 0u; mine = (j == x) ? c : mine; }
        if (sum == G) break;
        __builtin_amdgcn_s_sleep(1);
        if ((++sp & 255u) == 0u) { if (xb_ld(&bar[XB_TMO])) break; if (sp > XB_SPIN_CAP) { atomicAdd(&bar[XB_TMO], 1u); break; } }
    }
    nloc = mine > 0u ? mine : 1u; nx = cnt > 0u ? cnt : 1u;
}
__device__ __forceinline__ void xcd_barrier(const XcdBarrier& b, const int tid) {
    asm volatile("s_waitcnt vmcnt(0)" ::: "memory");
    __syncthreads();
    if (tid == 0) {
        unsigned* bar = b.bar;
        __builtin_amdgcn_s_waitcnt(0);
        unsigned nloc = b.st[0], nx = b.st[1];
        if (nloc == 0u) { xcd_barrier_complete(bar, b.x, nloc, nx); b.st[0] = nloc; b.st[1] = nx; }
        const unsigned old = xb_add(&bar[XB_XSUB(b.x)], 1u);
        const unsigned gen = old / nloc;
        if (old + 1u == (gen + 1u) * nloc) {
            __builtin_amdgcn_fence(__ATOMIC_RELEASE, "agent");
            asm volatile("s_waitcnt vmcnt(0)" ::: "memory");
            const unsigned og = xb_add(&bar[XB_TOP], 1u);
            const unsigned tg = og / nx;
            if (og + 1u == (tg + 1u) * nx) xb_add(&bar[XB_TOPGEN], 1u);
            else XB_SPIN(xb_ld(&bar[XB_TOPGEN]) == tg, bar);
            __builtin_amdgcn_fence(__ATOMIC_ACQUIRE, "agent");
            xb_add(&bar[XB_XGEN(b.x)], 1u);
            asm volatile("s_waitcnt vmcnt(0)" ::: "memory");
        } else {
            XB_SPIN(xb_ld(&bar[XB_XGEN(b.x)]) == gen, bar);
            __builtin_amdgcn_fence(__ATOMIC_ACQUIRE, "agent");
            asm volatile("s_waitcnt vmcnt(0)" ::: "memory");
        }
    }
    __syncthreads();
}

constexpr int NPHASE = 11;
#define IDS() const int tid = TIDK, lane = tid & 63, wave = __builtin_amdgcn_readfirstlane(tid >> 6); const int G = gridDim.x; \
    const int gtid = blockIdx.x * (NWAVES * 64) + tid, gthreads = G * NWAVES * 64, gw = blockIdx.x * NWAVES + wave, ngw = G * NWAVES; (void)lane; (void)wave; (void)gtid; (void)gthreads; (void)gw; (void)ngw;
__global__ void __launch_bounds__(NWAVES * 64, 2) fwd_kernel(Args a) {
    extern __shared__ __attribute__((aligned(16))) unsigned char lds_raw[];
    LAS unsigned char* lds = (LAS unsigned char*)lds_raw;
    const int lo = a.ph_lo, hi = a.ph_hi;
    volatile LAS unsigned* xb_st = (volatile LAS unsigned*)(lds + XB_LDS_OFF);
    const int wid6 = __builtin_amdgcn_readfirstlane((int)threadIdx.x) & ~63;
#define TIDK tid_from(wid6)
    { const int t0 = TIDK; if (t0 < 4) xb_st[t0] = 0u;
      __syncthreads();
      (void)xcd_barrier_post((unsigned*)(a.ws + WS_CTL + XB_CTL_OFF) + a.li * XCD_BAR_WORDS, xb_st, t0); }
#define IN(k) (lo <= (k) && (k) < hi)
#define SEAM(k) do { if (IN(k) && IN((k) + 1)) { if ((k) == 0) cg::this_grid().sync(); else { XcdBarrier xb_; xb_.bar = (unsigned*)(a.ws + WS_CTL + XB_CTL_OFF) + a.li * XCD_BAR_WORDS; xb_.x = xb_xcc_id(); \
        xb_.st = (volatile LAS unsigned*)(lds + XB_LDS_OFF); xcd_barrier(xb_, TIDK); } } } while (0)
    if (IN(0)) { IDS(); ph_prologue(a, lds, tid, gtid, gthreads, gw, ngw, lane); }
    SEAM(0);
    if (IN(1)) {
        unsigned char* ws = a.ws;
        pg8::Gemm g{(const bf16*)(ws + WS_HB), (const bf16*)(ws + WS_W1T), NTOK, N1, DM}; pg8::StaticOrder S; S.init(NTOK, N1, (int)gridDim.x, (int)blockIdx.x);
        pg8::EpiStore E{(bf16*)(ws + WS_P1), N1, nullptr};
        pg8::gemm_phase<pg8::EpiStore, pg8::StaticOrder, true, true>(lds, g, S, E, TIDK);
    }
    SEAM(1);
    if (IN(2)) { IDS(); ph_cnorm_pool(a, gw, ngw, lane); }
    SEAM(2);
    #if USE_NAIVE_ATTN
    if (IN(3)) { IDS(); ph_attn_naive(a, lds, wave, gw, ngw, lane); }
#else
    if (IN(3)) { ph_attn_fast(a, lds, (ATT_VARIANT && lo == 3) ? ATT_VARIANT : 0, wid6); }
#endif
    SEAM(3);
    if (IN(4)) {
        unsigned char* ws = a.ws;
        pg8::Gemm g{(const bf16*)(ws + WS_MIX), (const bf16*)(ws + WS_W2T), NTOK, DM, K2}; pg8::StaticOrder S; S.init(NTOK, DM, (int)gridDim.x, (int)blockIdx.x);
        pg8::EpiResid<true> E{(const void*)a.x, (bf16*)(ws + WS_X1B), (float*)(ws + WS_CTL)};
        pg8::gemm_phase<pg8::EpiResid<true>, pg8::StaticOrder, true, true>(lds, g, S, E, TIDK);
    }
    SEAM(4);
#pragma unroll 1
    for (int hsel = 0; hsel < 2; ++hsel) {
        const int p5 = 5 + 2 * hsel;
        if (IN(p5)) {
            unsigned char* ws = a.ws;
            pg8::Gemm g{(const bf16*)(ws + WS_X1B) + (size_t)hsel * (NTOK / 2) * DM, (const bf16*)(ws + WS_W3T), NTOK / 2, N3, DM}; pg8::StaticOrder S; S.init(NTOK / 2, N3, (int)gridDim.x, (int)blockIdx.x);
            pg8::EpiStore E{(bf16*)(ws + WS_RAW), N3, (const float*)(ws + WS_CTL) + hsel * (NTOK / 2)};
            pg8::gemm_phase<pg8::EpiStore, pg8::StaticOrder, true, true>(lds, g, S, E, TIDK);
        }
        SEAM(p5);
        if (IN(p5 + 1)) { IDS(); ph_conv(a, hsel, gtid, gthreads); }
        SEAM(p5 + 1);
    }
    if (IN(9)) {
        unsigned char* ws = a.ws;
        pg8::Gemm g{(const bf16*)(ws + WS_ACT), (const bf16*)(ws + WS_W4T), NTOK, DM, FF}; pg8::StaticOrder S; S.init(NTOK, DM, (int)gridDim.x, (int)blockIdx.x);
        pg8::EpiResid<false> E{(const void*)(ws + WS_X1B), (bf16*)(ws + WS_X2), (float*)(ws + WS_CTL + 256 * 1024)};
        pg8::gemm_phase<pg8::EpiResid<false>, pg8::StaticOrder, true, true>(lds, g, S, E, TIDK);
    }
    SEAM(9);
    if (IN(10)) { IDS(); ph_final(a, gw, ngw, lane); }
#undef IN
#undef SEAM
}

extern "C" void kernel_launch(void* const* d_in, const int* in_sizes, int n_in, void* d_out, int out_size, void* d_ws, size_t ws_size, hipStream_t stream) {
    static int grid = 0;
    if (grid == 0) {
        if (n_in != 15 || in_sizes[0] != NTOK * DM || out_size != NTOK * DM || ws_size < WS_END) { fprintf(stderr, "kernel_launch: unexpected shapes / workspace (n_in %d, ws %zu)\n", n_in, ws_size); grid = -1; return; }
        int dev = 0, cus = 0, per_cu = 0;
        hipGetDevice(&dev); hipDeviceGetAttribute(&cus, hipDeviceAttributeMultiprocessorCount, dev);
        if (hipFuncSetAttribute((const void*)fwd_kernel, hipFuncAttributeMaxDynamicSharedMemorySize, LDS_BYTES) != hipSuccess) { fprintf(stderr, "kernel_launch: hipFuncSetAttribute failed\n"); grid = -1; return; }
        if (hipOccupancyMaxActiveBlocksPerMultiprocessor(&per_cu, (const void*)fwd_kernel, NWAVES * 64, LDS_BYTES) != hipSuccess || per_cu < 1) { fprintf(stderr, "kernel_launch: occupancy query says %d\n", per_cu); per_cu = 1; }
        (void)hipGetLastError();
        grid = cus;
        if (grid != 256) fprintf(stderr, "kernel_launch: %d CUs (tuned for 256)\n", grid);
    }
    if (grid < 0) return;
    hipMemsetAsync((char*)d_ws + WS_CTL, 0, CTL_ZERO_BYTES, stream);
    Args a{};
    a.x = (const float*)d_in[0]; a.g_mix = (const float*)d_in[1]; a.w_in = (const float*)d_in[2]; a.g_kv = (const float*)d_in[3]; a.w_uk = (const float*)d_in[4]; a.w_uv = (const float*)d_in[5];
    a.w_pool = (const float*)d_in[6]; a.pool_scale = (const float*)d_in[7]; a.w_o = (const float*)d_in[8]; a.g_ffn = (const float*)d_in[9]; a.w_up = (const float*)d_in[10];
    a.conv_w = (const float*)d_in[11]; a.conv_b = (const float*)d_in[12]; a.w_down = (const float*)d_in[13]; a.g_final = (const float*)d_in[14];
    a.out = (float*)d_out; a.ws = (unsigned char*)d_ws;
#if REP_PH >= 0
    { void* args[] = {&a};
      if (REP_PH >= 100) {
        a.ph_lo = 0; a.ph_hi = NPHASE; a.li = 0; hipLaunchCooperativeKernel((const void*)fwd_kernel, dim3(grid), dim3(NWAVES * 64), args, LDS_BYTES, stream);
        a.ph_lo = 0; a.ph_hi = REP_PH - 100; a.li = 1; hipLaunchCooperativeKernel((const void*)fwd_kernel, dim3(grid), dim3(NWAVES * 64), args, LDS_BYTES, stream);
      } else if (REP_PH == 4 || REP_PH == 9) {
        a.ph_lo = 0; a.ph_hi = NPHASE; a.li = 0; hipLaunchCooperativeKernel((const void*)fwd_kernel, dim3(grid), dim3(NWAVES * 64), args, LDS_BYTES, stream);
        a.ph_lo = REP_PH; a.ph_hi = REP_PH + 1; a.li = 1; hipLaunchCooperativeKernel((const void*)fwd_kernel, dim3(grid), dim3(NWAVES * 64), args, LDS_BYTES, stream);
      } else {
      a.ph_lo = 0; a.ph_hi = REP_PH + 1; a.li = 0; hipLaunchCooperativeKernel((const void*)fwd_kernel, dim3(grid), dim3(NWAVES * 64), args, LDS_BYTES, stream);
      a.ph_lo = REP_PH; a.ph_hi = REP_PH + 1; a.li = 1; hipLaunchCooperativeKernel((const void*)fwd_kernel, dim3(grid), dim3(NWAVES * 64), args, LDS_BYTES, stream);
      if (REP_PH + 1 < NPHASE) { a.ph_lo = REP_PH + 1; a.ph_hi = NPHASE; a.li = 2; hipLaunchCooperativeKernel((const void*)fwd_kernel, dim3(grid), dim3(NWAVES * 64), args, LDS_BYTES, stream); } } }
#elif MK_ONE_LAUNCH
    a.ph_lo = 0; a.ph_hi = NPHASE;
    void* args[] = {&a};
    hipError_t e = hipLaunchCooperativeKernel((const void*)fwd_kernel, dim3(grid), dim3(NWAVES * 64), args, LDS_BYTES, stream);
    if (e != hipSuccess) fprintf(stderr, "cooperative launch failed: %s (grid %d)\n", hipGetErrorString(e), grid);
#else
    for (int ph = 0; ph < NPHASE; ++ph) {
        a.ph_lo = ph; a.ph_hi = ph + 1;
        hipLaunchKernelGGL(fwd_kernel, dim3(grid), dim3(NWAVES * 64), LDS_BYTES, stream, a);
    }
#endif
}
```

```cpp
#include <hip/hip_runtime.h>
#include <hip/hip_cooperative_groups.h>
#include <cstdio>
#include <cstdint>
namespace cg = cooperative_groups;

#ifndef USE_NAIVE_ATTN
#define USE_NAIVE_ATTN 0
#endif
#ifndef REP_PH
#define REP_PH -1
#endif
#ifndef ATT_VARIANT
#define ATT_VARIANT 0
#endif
#ifndef MK_ONE_LAUNCH
#define MK_ONE_LAUNCH 1
#endif

namespace pg8 {
#define PG8_LAS __attribute__((address_space(3)))
typedef unsigned short bf16_t;
typedef short bf16x8 __attribute__((ext_vector_type(8)));
typedef float f32x4 __attribute__((ext_vector_type(4)));
typedef unsigned u32x4 __attribute__((ext_vector_type(4)));
constexpr int BM = 256, BK = 64, HALF = 128, HTB = HALF * BK * 2, STAGE_BYTES = 8 * HTB, NXCD = 8, WGM = 8;

__host__ __device__ __forceinline__ int lds_byte(int r, int c) { const int st = (r >> 4) * 2 + (c >> 5), rr = r & 15, cc = c & 31, ob = rr * 64 + cc * 2; return st * 1024 + (ob ^ (((ob >> 9) & 1) << 5)); }
__host__ __device__ __forceinline__ void stage_rc(int b, int& R, int& C) { const int st = b / 1024, sb = b % 1024, swz = sb ^ (((sb >> 9) & 1) << 5); R = (st >> 1) * 16 + swz / 64; C = (st & 1) * 32 + (swz % 64) / 2; }
__host__ __device__ __forceinline__ int perm32(int rho) { const int n = rho >> 4, i = rho & 15; return 8 * (i >> 2) + 4 * n + (i & 3); }

struct Unit { int pm, pn; };
struct Gemm { const bf16_t* A; const bf16_t* Bt; int M, N, K; };

struct StaticOrder {
    int nM, nN, nwg, G, c;
    __host__ __device__ void init(int M, int N, int G_, int c_) { nM = M / BM; nN = N / BM; nwg = nM * nN; G = G_; c = c_; }
    __host__ __device__ bool next(int i, Unit& u) const {
        const long L = (long)i * G + c; if (L >= nwg) return false;
        int wgid = (int)L; { const int q = nwg / NXCD, r = nwg % NXCD, xcd = wgid % NXCD, off = wgid / NXCD; wgid = (xcd < r ? xcd * (q + 1) : r * (q + 1) + (xcd - r) * q) + off; }
        const int nig = WGM * nN, gid = wgid / nig, fm = gid * WGM, gsz = (nM - fm) < WGM ? (nM - fm) : WGM;
        u.pm = fm + ((wgid % nig) % gsz); u.pn = (wgid % nig) / gsz; return true;
    }
    __device__ __forceinline__ void a_ready(const Unit&) const {}
    __device__ __forceinline__ void done(const Unit&) const {}
};

__device__ __forceinline__ unsigned cvt_pk_bf16(float lo, float hi) { unsigned r; asm volatile("v_cvt_pk_bf16_f32 %0, %1, %2" : "=v"(r) : "v"(lo), "v"(hi)); return r; }


struct EpiStore {
    static constexpr bool PERM = true, AFTER_DRAIN = false;
    bf16_t* O; int ldc; const float* sumsq;
    __device__ __forceinline__ void operator()(const f32x4 (&acc)[2][2][4][2], const Unit& u, int wr, int wc, int fr, int fq) const {
        const int row0 = u.pm * BM + wr * 64 + fr, col0 = u.pn * BM + wc * 32 + 8 * fq;
#pragma unroll
        for (int ai = 0; ai < 2; ++ai)
#pragma unroll
            for (int m = 0; m < 4; ++m) {
                const int row = row0 + ai * HALF + m * 16;
                float sc = 1.f; if (sumsq) sc = 1.0f / sqrtf(sumsq[row] * (1.0f / 1024.0f) + 1e-6f);
                bf16_t* rowp = O + (size_t)row * ldc + col0;
#pragma unroll
                for (int bj = 0; bj < 2; ++bj) { f32x4 v0 = acc[ai][bj][m][0] * sc, v1 = acc[ai][bj][m][1] * sc;
                    u32x4 w; w.x = cvt_pk_bf16(v0[0], v0[1]); w.y = cvt_pk_bf16(v0[2], v0[3]); w.z = cvt_pk_bf16(v1[0], v1[1]); w.w = cvt_pk_bf16(v1[2], v1[3]);
                    *(u32x4*)(rowp + bj * HALF) = w; } }
    }
};
template <bool BASE_F32> struct EpiResid {
    static constexpr bool PERM = true, AFTER_DRAIN = false;
    const void* base; bf16_t* O; float* sumsq; unsigned char* O8; float accscale; const float* rowfac; const float* colg;
    __device__ __forceinline__ void operator()(const f32x4 (&acc)[2][2][4][2], const Unit& u, int wr, int wc, int fr, int fq) const {
        const int row0 = u.pm * BM + wr * 64 + fr, col0 = u.pn * BM + wc * 32 + 8 * fq;
        f32x4 gi[2][2];
        if (!BASE_F32) {
#pragma unroll
            for (int bj = 0; bj < 2; ++bj)
#pragma unroll
                for (int q = 0; q < 2; ++q) { const f32x4 g_ = *(const f32x4*)(colg + col0 + bj * HALF + 4 * q);
#pragma unroll
                    for (int e = 0; e < 4; ++e) gi[bj][q][e] = __builtin_amdgcn_rcpf(g_[e]); }
        }
#pragma unroll
        for (int ai = 0; ai < 2; ++ai)
#pragma unroll
            for (int m = 0; m < 4; ++m) {
                const int row = row0 + ai * HALF + m * 16; float ss = 0.f;
                float rf = 1.f; if (!BASE_F32) rf = rowfac[row];
#pragma unroll
                for (int bj = 0; bj < 2; ++bj) {
                    const size_t off = (size_t)row * 1024 + col0 + bj * HALF;
                    f32x4 b0, b1;
                    if (BASE_F32) { b0 = *(const f32x4*)((const float*)base + off); b1 = *(const f32x4*)((const float*)base + off + 4); }
                    else { const u32x4 r = __builtin_nontemporal_load((const u32x4*)((const bf16_t*)base + off));
                        b0[0] = __uint_as_float(r.x << 16); b0[1] = __uint_as_float(r.x & 0xffff0000u); b0[2] = __uint_as_float(r.y << 16); b0[3] = __uint_as_float(r.y & 0xffff0000u);
                        b1[0] = __uint_as_float(r.z << 16); b1[1] = __uint_as_float(r.z & 0xffff0000u); b1[2] = __uint_as_float(r.w << 16); b1[3] = __uint_as_float(r.w & 0xffff0000u);
                        b0 = b0 * rf * gi[bj][0]; b1 = b1 * rf * gi[bj][1]; }
                    const f32x4 v0 = acc[ai][bj][m][0] * accscale + b0, v1 = acc[ai][bj][m][1] * accscale + b1;
                    ss += (v0[0] * v0[0] + v0[1] * v0[1]) + (v0[2] * v0[2] + v0[3] * v0[3]) + (v1[0] * v1[0] + v1[1] * v1[1]) + (v1[2] * v1[2] + v1[3] * v1[3]);
                    u32x4 w; w.x = cvt_pk_bf16(v0[0], v0[1]); w.y = cvt_pk_bf16(v0[2], v0[3]); w.z = cvt_pk_bf16(v1[0], v1[1]); w.w = cvt_pk_bf16(v1[2], v1[3]);
                    *(u32x4*)(O + off) = w;
                    if (O8) { typedef unsigned u32x2_ __attribute__((ext_vector_type(2))); u32x2_ q; int t_;
                        t_ = __builtin_amdgcn_cvt_pk_fp8_f32(v0[0] * 16.f, v0[1] * 16.f, 0, false); q.x = (unsigned)__builtin_amdgcn_cvt_pk_fp8_f32(v0[2] * 16.f, v0[3] * 16.f, t_, true);
                        t_ = __builtin_amdgcn_cvt_pk_fp8_f32(v1[0] * 16.f, v1[1] * 16.f, 0, false); q.y = (unsigned)__builtin_amdgcn_cvt_pk_fp8_f32(v1[2] * 16.f, v1[3] * 16.f, t_, true);
                        *(u32x2_*)(O8 + off) = q; } }
                ss += __shfl_xor(ss, 16); ss += __shfl_xor(ss, 32);
                if (fq == 0) atomicAdd(sumsq + row, ss);
            }
    }
};


struct EpiConvGlu {
    static constexpr bool PERM = true, AFTER_DRAIN = false;
    unsigned char* ACT; const float* sumsq; const float* convp; float* hfirst; float* hlast; PG8_LAS float* halo;
    __device__ __forceinline__ void operator()(f32x4 (&acc)[2][2][4][2], const Unit& u, int wr, int wc, int fr, int fq) const {
        constexpr int N3_ = 5632, FF_ = 2816;
        const int row0 = u.pm * BM + wr * 64 + fr, cq = wc * 32 + 8 * fq;
        f32x4 cpar[2][8];
#pragma unroll
        for (int n = 0; n < 2; ++n) { const float* cp = convp + u.pn * BM + cq + 4 * n;
#pragma unroll
            for (int q = 0; q < 4; ++q) { cpar[n][q] = *(const f32x4*)(cp + q * N3_); cpar[n][4 + q] = *(const f32x4*)(cp + HALF + q * N3_); } }
#pragma unroll
        for (int ai = 0; ai < 2; ++ai)
#pragma unroll
            for (int m = 0; m < 4; ++m) { const float sc = __builtin_amdgcn_rsqf(sumsq[row0 + ai * HALF + m * 16] * (1.0f / 1024.0f) + 1e-6f) * (1.0f / 1024.0f);
#pragma unroll
                for (int bj = 0; bj < 2; ++bj) { acc[ai][bj][m][0] *= sc; acc[ai][bj][m][1] *= sc; } }
#pragma unroll
        for (int ai = 0; ai < 2; ++ai)
#pragma unroll
            for (int bj = 0; bj < 2; ++bj)
#pragma unroll
                for (int m = 0; m < 4; ++m) { asm volatile("" : "+v"(acc[ai][bj][m][0])); asm volatile("" : "+v"(acc[ai][bj][m][1])); }
        __builtin_amdgcn_sched_barrier(0);
        if (fr >= 14) {
#pragma unroll
            for (int ai = 0; ai < 2; ++ai)
#pragma unroll
                for (int bj = 0; bj < 2; ++bj)
#pragma unroll
                    for (int n = 0; n < 2; ++n) *(PG8_LAS f32x4*)(halo + ((2 * ai + wr) * 2 + (fr - 14)) * 256 + bj * HALF + cq + 4 * n) = acc[ai][bj][3][n];
            if (wr == 1) {
#pragma unroll
                for (int bj = 0; bj < 2; ++bj)
#pragma unroll
                    for (int n = 0; n < 2; ++n) *(f32x4*)(hlast + (size_t)(u.pm * 2 + (fr - 14)) * N3_ + u.pn * BM + bj * HALF + cq + 4 * n) = acc[1][bj][3][n];
            }
        }
        if (fr < 2 && wr == 0) {
#pragma unroll
            for (int bj = 0; bj < 2; ++bj)
#pragma unroll
                for (int n = 0; n < 2; ++n) *(f32x4*)(hfirst + (size_t)(u.pm * 2 + fr) * N3_ + u.pn * BM + bj * HALF + cq + 4 * n) = acc[0][bj][0][n];
        }
        asm volatile("s_waitcnt lgkmcnt(0)" ::: "memory"); __builtin_amdgcn_s_barrier(); asm volatile("s_nop 1" ::: "memory");
#define CONV_DPP(cv, src, w, ctl) asm("v_fmac_f32_dpp %0, %1, %2 " ctl " row_mask:0xf bank_mask:0xf" : "+v"(cv) : "v"(src), "v"(w))
#pragma unroll
        for (int n = 0; n < 2; ++n) {
            const f32x4 g0 = cpar[n][0], g1 = cpar[n][1], g2 = cpar[n][2], gb = cpar[n][3];
            const f32x4 u0 = cpar[n][4], u1 = cpar[n][5], u2 = cpar[n][6], ub = cpar[n][7];
#pragma unroll
            for (int ai = 0; ai < 2; ++ai) {
                const int pred = 2 * ai + wr - 1;
                f32x4 hg1 = {0.f, 0.f, 0.f, 0.f}, hg2 = hg1, hu1 = hg1, hu2 = hg1;
                if (pred >= 0) { const PG8_LAS float* hp = halo + pred * 512 + cq + 4 * n;
                    hg2 = *(const PG8_LAS f32x4*)(hp); hg1 = *(const PG8_LAS f32x4*)(hp + 256); hu2 = *(const PG8_LAS f32x4*)(hp + HALF); hu1 = *(const PG8_LAS f32x4*)(hp + 256 + HALF); }
#pragma unroll
                for (int m = 3; m >= 0; --m) {
                    f32x4 cg, cu;
#pragma unroll
                    for (int j = 0; j < 4; ++j) {
                        const float ag = acc[ai][0][m][n][j], au = acc[ai][1][m][n][j];
                        float vg = fmaf(g2[j], ag, gb[j]), vu = fmaf(u2[j], au, ub[j]);
                        CONV_DPP(vg, ag, g1[j], "row_shr:1"); CONV_DPP(vg, ag, g0[j], "row_shr:2");
                        CONV_DPP(vu, au, u1[j], "row_shr:1"); CONV_DPP(vu, au, u0[j], "row_shr:2");
                        if (m > 0) { const float pg = acc[ai][0][m - 1][n][j], pu = acc[ai][1][m - 1][n][j];
                            CONV_DPP(vg, pg, g1[j], "row_shl:15"); CONV_DPP(vg, pg, g0[j], "row_shl:14");
                            CONV_DPP(vu, pu, u1[j], "row_shl:15"); CONV_DPP(vu, pu, u0[j], "row_shl:14");
                        } else {
                            const float c1g = (fr == 0) ? hg1[j] : 0.f, c2g = (fr == 0) ? hg2[j] : ((fr == 1) ? hg1[j] : 0.f);
                            const float c1u = (fr == 0) ? hu1[j] : 0.f, c2u = (fr == 0) ? hu2[j] : ((fr == 1) ? hu1[j] : 0.f);
                            vg = fmaf(g1[j], c1g, vg); vg = fmaf(g0[j], c2g, vg); vu = fmaf(u1[j], c1u, vu); vu = fmaf(u0[j], c2u, vu);
                        }
                        cg[j] = vg; cu[j] = vu;
                    }
                    float r[4];
#pragma unroll
                    for (int j = 0; j < 4; ++j) r[j] = cg[j] * __builtin_amdgcn_rcpf(1.0f + __builtin_amdgcn_exp2f(-1.4426950408889634f * cg[j])) * cu[j];
#pragma unroll
                    for (int j = 0; j < 4; ++j) r[j] = fminf(fmaxf(r[j] * 8.0f, -448.f), 448.f);
                    const int t_ = __builtin_amdgcn_cvt_pk_fp8_f32(r[0], r[1], 0, false); const unsigned w4 = (unsigned)__builtin_amdgcn_cvt_pk_fp8_f32(r[2], r[3], t_, true);
                    *(unsigned*)(ACT + (size_t)(row0 + ai * HALF + m * 16) * FF_ + u.pn * HALF + cq + 4 * n) = w4;
                }
            }
        }
#undef CONV_DPP
    }
};


struct EpiFinal {
    static constexpr bool PERM = true, AFTER_DRAIN = false;
    const bf16_t* base; float* out; float* sumsq; unsigned* pcnt; const float* gfin;
    __device__ __forceinline__ void operator()(f32x4 (&acc)[2][2][4][2], const Unit& u, int wr, int wc, int fr, int fq) const {
        const int row0 = u.pm * BM + wr * 64 + fr, col0 = u.pn * BM + wc * 32 + 8 * fq;
#pragma unroll
        for (int ai = 0; ai < 2; ++ai)
#pragma unroll
            for (int m = 0; m < 4; ++m) {
                const int row = row0 + ai * HALF + m * 16; float ss = 0.f;
#pragma unroll
                for (int bj = 0; bj < 2; ++bj) {
                    const u32x4 r = __builtin_nontemporal_load((const u32x4*)(base + (size_t)row * 1024 + col0 + bj * HALF));
                    f32x4 b0, b1;
                    b0[0] = __uint_as_float(r.x << 16); b0[1] = __uint_as_float(r.x & 0xffff0000u); b0[2] = __uint_as_float(r.y << 16); b0[3] = __uint_as_float(r.y & 0xffff0000u);
                    b1[0] = __uint_as_float(r.z << 16); b1[1] = __uint_as_float(r.z & 0xffff0000u); b1[2] = __uint_as_float(r.w << 16); b1[3] = __uint_as_float(r.w & 0xffff0000u);
                    const f32x4 v0 = acc[ai][bj][m][0] * (1.0f / 512.0f) + b0, v1 = acc[ai][bj][m][1] * (1.0f / 512.0f) + b1;
                    acc[ai][bj][m][0] = v0; acc[ai][bj][m][1] = v1;
                    ss += (v0[0] * v0[0] + v0[1] * v0[1]) + (v0[2] * v0[2] + v0[3] * v0[3]) + (v1[0] * v1[0] + v1[1] * v1[1]) + (v1[2] * v1[2] + v1[3] * v1[3]); }
                ss += __shfl_xor(ss, 16); ss += __shfl_xor(ss, 32);
                if (fq == 0) atomicAdd(sumsq + row, ss);
            }
        const bool t0 = (wr == 0 && wc == 0 && fr == 0 && fq == 0);
        asm volatile("s_waitcnt vmcnt(0)" ::: "memory");
        __builtin_amdgcn_s_barrier();
        if (t0) {
            unsigned* pc = pcnt + 64 * u.pm;
            __hip_atomic_fetch_add(pc, 1u, __ATOMIC_RELAXED, __HIP_MEMORY_SCOPE_AGENT);
            unsigned sp = 0;
            while (__hip_atomic_load(pc, __ATOMIC_RELAXED, __HIP_MEMORY_SCOPE_AGENT) < 4u) { __builtin_amdgcn_s_sleep(2); if (++sp > (1u << 22)) break; }
            __builtin_amdgcn_fence(__ATOMIC_ACQUIRE, "agent");
            asm volatile("s_waitcnt vmcnt(0)" ::: "memory");
        }
        __builtin_amdgcn_s_barrier(); asm volatile("" ::: "memory");
#pragma unroll
        for (int ai = 0; ai < 2; ++ai)
#pragma unroll
            for (int m = 0; m < 4; ++m) {
                const int row = row0 + ai * HALF + m * 16;
                const float rinv = __builtin_amdgcn_rsqf(__hip_atomic_load(sumsq + row, __ATOMIC_RELAXED, __HIP_MEMORY_SCOPE_AGENT) * (1.0f / 1024.0f) + 1e-6f);
#pragma unroll
                for (int bj = 0; bj < 2; ++bj) { const int c = col0 + bj * HALF; float* op = out + (size_t)row * 1024 + c;
                    *(f32x4*)(op) = acc[ai][bj][m][0] * rinv * *(const f32x4*)(gfin + c); *(f32x4*)(op + 4) = acc[ai][bj][m][1] * rinv * *(const f32x4*)(gfin + c + 4); }
            }
    }
};

typedef int v8i_t __attribute__((ext_vector_type(8)));
typedef int v4i_t __attribute__((ext_vector_type(4)));
template <bool F8> struct Frag;
template <> struct Frag<false> { bf16x8 k[2]; };
template <> struct Frag<true>  { v8i_t v; };
template <bool F8> __device__ __forceinline__ void ld_frag(Frag<F8>& d, const PG8_LAS unsigned char* p) {
    if constexpr (F8) { const v4i_t lo = *(const PG8_LAS v4i_t*)p, hi = *(const PG8_LAS v4i_t*)(p + 1024); d.v = __builtin_shufflevector(lo, hi, 0, 1, 2, 3, 4, 5, 6, 7); }
    else { d.k[0] = *(const PG8_LAS bf16x8*)p; d.k[1] = *(const PG8_LAS bf16x8*)(p + 1024); }
}
template <bool F8> __device__ __forceinline__ f32x4 mma_frag(const Frag<F8>& b, const Frag<F8>& a, f32x4 c) {
    if constexpr (F8) {
        const int one = 0x7f7f7f7f;
#if defined(__HIP_DEVICE_COMPILE__)
        asm volatile("v_mfma_scale_f32_16x16x128_f8f6f4 %0, %1, %2, %0, %3, %3 op_sel_hi:[0,0,0]" : "+v"(c) : "v"(b.v), "v"(a.v), "v"(one));
#else
        (void)one;
#endif
        return c; }
    else { c = __builtin_amdgcn_mfma_f32_16x16x32_bf16(b.k[0], a.k[0], c, 0, 0, 0); return __builtin_amdgcn_mfma_f32_16x16x32_bf16(b.k[1], a.k[1], c, 0, 0, 0); }
}
template <class Epi, class Sched, bool ALIGN_EPI = false, bool SP2 = false, bool F8 = false>
__device__ __forceinline__ void gemm_phase(PG8_LAS unsigned char* lds, const Gemm g, const Sched& S, const Epi& E, const int tid) {
    const int wid = __builtin_amdgcn_readfirstlane(tid >> 6), lane = tid & 63, wr = wid >> 2, wc = wid & 3, fr = lane & 15, fq = lane >> 4;
    const int K = g.K, nt = K / BK;
    unsigned voffA[2], voffB[2];
#pragma unroll
    for (int i = 0; i < 2; ++i) { int R, C; stage_rc(tid * 16 + i * 8192, R, C); const int Rb = Epi::PERM ? ((R & ~31) + perm32(R & 31)) : R;
        voffA[i] = (unsigned)(R * K + C) * 2u; voffB[i] = (unsigned)(Rb * K + C) * 2u; }
    const size_t kstep = (size_t)(BK * 2);
    const size_t hstep = (size_t)HALF * K * 2;
    const size_t tstep = 2 * hstep;
    const unsigned ldsw = (unsigned)wid * 1024u;
    const int aoff = lds_byte(wr * 64 + fr, fq * 8), boff = lds_byte(wc * 32 + fr, fq * 8);
#define PG8_SA(b, h) (((b) * 2 + (h)) * HTB)
#define PG8_SB(b, h) ((4 + (b) * 2 + (h)) * HTB)
#define PG8_STAGE(bufoff, gbase, voff) do { _Pragma("unroll") for (int _i = 0; _i < 2; ++_i) \
        __builtin_amdgcn_global_load_lds((const unsigned*)((const char*)(gbase) + (voff)[_i]), (PG8_LAS unsigned*)(lds + (bufoff) + ldsw + _i * 8192), 16, 0, 0); } while (0)
#define PG8_LDA(dst, b, h) do { _Pragma("unroll") for (int m = 0; m < 4; ++m) ld_frag<F8>(dst[m], lds + PG8_SA(b, h) + aoff + m * 2048); } while (0)
#define PG8_LDB(dst, b, h) do { _Pragma("unroll") for (int n = 0; n < 2; ++n) ld_frag<F8>(dst[n], lds + PG8_SB(b, h) + boff + n * 2048); } while (0)
#define PG8_MMA(ai, bj, At, Bt) do { __builtin_amdgcn_s_setprio(1); _Pragma("unroll") for (int m = 0; m < 4; ++m) _Pragma("unroll") for (int n = 0; n < 2; ++n) \
        acc[ai][bj][m][n] = mma_frag<F8>(Bt[n], At[m], acc[ai][bj][m][n]); __builtin_amdgcn_s_setprio(0); } while (0)
#define PG8_WAIT_V(n) asm volatile("s_waitcnt vmcnt(" #n ")" ::: "memory")
#define PG8_WAIT_L(n) asm volatile("s_waitcnt lgkmcnt(" #n ")" ::: "memory")
#define PG8_BAR __builtin_amdgcn_s_barrier()
#define PG8_SCHED __builtin_amdgcn_sched_barrier(0)
    Unit cur, nxt; int ui = 0;
    if (!S.next(0, cur)) return;
    f32x4 acc[2][2][4][2];
#pragma unroll
    for (int a = 0; a < 2; ++a)
#pragma unroll
        for (int b = 0; b < 2; ++b)
#pragma unroll
            for (int m = 0; m < 4; ++m)
#pragma unroll
                for (int n = 0; n < 2; ++n) acc[a][b][m][n] = (f32x4){0.f, 0.f, 0.f, 0.f};
    Frag<F8> At[4], B0[2], B1[2];
    const char* cA = (const char*)g.A + (size_t)cur.pm * tstep; const char* cB = (const char*)g.Bt + (size_t)cur.pn * tstep;
    S.a_ready(cur);
    if constexpr (SP2) {
        PG8_STAGE(PG8_SB(0, 0), cB, voffB); PG8_STAGE(PG8_SB(0, 1), cB + hstep, voffB); PG8_STAGE(PG8_SA(0, 0), cA, voffA); PG8_STAGE(PG8_SA(0, 1), cA + hstep, voffA);
        if (wr == 1) PG8_BAR;
        PG8_WAIT_V(2); PG8_BAR;
        PG8_STAGE(PG8_SB(1, 0), cB + kstep, voffB); PG8_STAGE(PG8_SA(1, 0), cA + kstep, voffA); PG8_STAGE(PG8_SB(1, 1), cB + hstep + kstep, voffB);
        PG8_WAIT_V(6); PG8_BAR;
    } else {
        PG8_STAGE(PG8_SB(0, 0), cB, voffB); PG8_STAGE(PG8_SA(0, 0), cA, voffA); PG8_STAGE(PG8_SB(0, 1), cB + hstep, voffB); PG8_STAGE(PG8_SA(0, 1), cA + hstep, voffA);
        if (wr == 1) PG8_BAR;
        PG8_WAIT_V(4); PG8_BAR;
        PG8_STAGE(PG8_SB(1, 0), cB + kstep, voffB); PG8_STAGE(PG8_SA(1, 0), cA + kstep, voffA); PG8_STAGE(PG8_SB(1, 1), cB + hstep + kstep, voffB);
        PG8_WAIT_V(6); PG8_BAR;
    }
    for (;;) {
        const bool has_next = S.next(ui + 1, nxt);
        const char* nA = has_next ? (const char*)g.A + (size_t)nxt.pm * tstep : cA; const char* nB = has_next ? (const char*)g.Bt + (size_t)nxt.pn * tstep : cB;
        for (int t = 0; t < nt; t += 2) {
            const bool last = (t == nt - 2);
            const char* a1 = cA + (size_t)(t + 1) * kstep;
            const char* a2 = last ? nA : cA + (size_t)(t + 2) * kstep; const char* b2 = last ? nB : cB + (size_t)(t + 2) * kstep;
            const char* a3 = a2 + kstep; const char* b3 = b2 + kstep;
            if (last && has_next) S.a_ready(nxt);
            if constexpr (SP2) {
            PG8_LDB(B0, 0, 0); PG8_LDB(B1, 0, 1); PG8_SCHED; PG8_LDA(At, 0, 0); PG8_STAGE(PG8_SA(1, 1), a1 + hstep, voffA);
            PG8_WAIT_V(8); PG8_WAIT_L(0); PG8_BAR; PG8_MMA(0, 0, At, B0); PG8_MMA(0, 1, At, B1); PG8_BAR; PG8_SCHED;
            PG8_LDA(At, 0, 1); PG8_STAGE(PG8_SB(0, 0), b2, voffB); PG8_STAGE(PG8_SB(0, 1), b2 + hstep, voffB); PG8_STAGE(PG8_SA(0, 0), a2, voffA);
            PG8_WAIT_V(8); PG8_WAIT_L(0); PG8_BAR; PG8_MMA(1, 0, At, B0); PG8_MMA(1, 1, At, B1); PG8_BAR; PG8_SCHED;
            PG8_LDB(B0, 1, 0); PG8_LDB(B1, 1, 1); PG8_SCHED; PG8_LDA(At, 1, 0); PG8_STAGE(PG8_SA(0, 1), a2 + hstep, voffA);
            PG8_WAIT_V(8); PG8_WAIT_L(0); PG8_BAR; PG8_MMA(0, 0, At, B0); PG8_MMA(0, 1, At, B1); PG8_BAR; PG8_SCHED;
            PG8_LDA(At, 1, 1); PG8_STAGE(PG8_SB(1, 0), b3, voffB); PG8_STAGE(PG8_SB(1, 1), b3 + hstep, voffB); PG8_STAGE(PG8_SA(1, 0), a3, voffA);
            PG8_WAIT_V(8); PG8_WAIT_L(0); PG8_BAR; PG8_MMA(1, 0, At, B0); PG8_MMA(1, 1, At, B1); PG8_BAR; PG8_SCHED;
            } else {
            PG8_LDB(B0, 0, 0); PG8_SCHED; PG8_LDA(At, 0, 0); PG8_STAGE(PG8_SA(1, 1), a1 + hstep, voffA);
            PG8_WAIT_L(8); PG8_BAR; PG8_WAIT_L(0); PG8_MMA(0, 0, At, B0); PG8_BAR; PG8_SCHED;
            PG8_LDB(B1, 0, 1); PG8_STAGE(PG8_SB(0, 0), b2, voffB);
            PG8_BAR; PG8_WAIT_L(0); PG8_MMA(0, 1, At, B1); PG8_BAR;
            PG8_LDA(At, 0, 1); PG8_STAGE(PG8_SA(0, 0), a2, voffA);
            PG8_BAR; PG8_WAIT_L(0); PG8_MMA(1, 0, At, B0); PG8_BAR; PG8_SCHED;
            PG8_STAGE(PG8_SB(0, 1), b2 + hstep, voffB);
            PG8_WAIT_V(6); PG8_BAR; PG8_MMA(1, 1, At, B1); PG8_BAR;
            PG8_LDB(B0, 1, 0); PG8_SCHED; PG8_LDA(At, 1, 0); PG8_STAGE(PG8_SA(0, 1), a2 + hstep, voffA);
            PG8_WAIT_L(8); PG8_BAR; PG8_WAIT_L(0); PG8_MMA(0, 0, At, B0); PG8_BAR; PG8_SCHED;
            PG8_LDB(B1, 1, 1); PG8_STAGE(PG8_SB(1, 0), b3, voffB);
            PG8_BAR; PG8_WAIT_L(0); PG8_MMA(0, 1, At, B1); PG8_BAR;
            PG8_LDA(At, 1, 1); PG8_STAGE(PG8_SA(1, 0), a3, voffA);
            PG8_BAR; PG8_WAIT_L(0); PG8_MMA(1, 0, At, B0); PG8_BAR; PG8_SCHED;
            PG8_STAGE(PG8_SB(1, 1), b3 + hstep, voffB);
            PG8_WAIT_V(6); PG8_BAR; PG8_MMA(1, 1, At, B1); PG8_BAR;
            }
        }
        if constexpr (ALIGN_EPI) { if (wr == 0) PG8_BAR; }
        if constexpr (F8) asm volatile("s_nop 15\n\ts_nop 15\n\ts_nop 15\n\ts_nop 15" ::: "memory");
        if constexpr (!Epi::AFTER_DRAIN) { E(acc, cur, wr, wc, fr, fq); S.done(cur); }
        if (!has_next) break;
#pragma unroll
        for (int a = 0; a < 2; ++a)
#pragma unroll
            for (int b = 0; b < 2; ++b)
#pragma unroll
                for (int m = 0; m < 4; ++m)
#pragma unroll
                    for (int n = 0; n < 2; ++n) acc[a][b][m][n] = (f32x4){0.f, 0.f, 0.f, 0.f};
        cur = nxt; cA = nA; cB = nB; ++ui;
        if constexpr (ALIGN_EPI) { if (wr == 1) PG8_BAR; }
    }
    PG8_WAIT_V(0);
    if constexpr (!ALIGN_EPI) { if (wr == 0) PG8_BAR; }
    PG8_BAR;
#undef PG8_SA
#undef PG8_SB
#undef PG8_STAGE
#undef PG8_LDA
#undef PG8_LDB
#undef PG8_MMA
#undef PG8_WAIT_V
#undef PG8_WAIT_L
#undef PG8_BAR
#undef PG8_SCHED
}
}

constexpr int NWAVES = 8;
constexpr int BATCH = 32, SEQ = 2048, DM = 1024, NTOK = BATCH * SEQ;
constexpr int IN_COLS = 1736;
constexpr int N1 = 1792, K2 = 1024, FF = 2816, N3 = 2 * FF;
constexpr int OFF_Q = 0, OFF_QI = 512, OFF_U = 1024, OFF_C = 1536, OFF_KI = 1664, OFF_WI = 1728;
constexpr float EPS = 1e-6f;
constexpr float WI_SCALE = 0.044194173824159216f;

constexpr size_t MiB = 1u << 20;
constexpr size_t WS_CTL = 0, CTL_ZERO_BYTES = 1 * MiB;
constexpr size_t WS_W1T = 1 * MiB, WS_W2T = 6 * MiB, WS_W3T = 9 * MiB, WS_W4T = 20 * MiB, WS_CONVP = 26 * MiB, WS_ZT = 27 * MiB, WS_WUKT = 28 * MiB, WS_WUVT = 28 * MiB + 128 * 1024;
constexpr size_t WS_HB = 32 * MiB;
constexpr size_t WS_RS = 27 * MiB + 64 * 1024;
constexpr size_t WS_P1 = 160 * MiB;
constexpr size_t WS_HF = 32 * MiB, WS_HL = 44 * MiB;
constexpr size_t WS_X2 = 64 * MiB;
constexpr size_t WS_MIX = 448 * MiB;
constexpr size_t WS_CN = 640 * MiB;
constexpr size_t WS_CT8 = 672 * MiB;
constexpr size_t WS_ACT = 448 * MiB;
constexpr size_t WS_X1B = 800 * MiB;
constexpr size_t WS_X1F8 = 928 * MiB;
constexpr size_t WS_END = 992 * MiB;

constexpr int LDS_BYTES = 147456;
constexpr int XB_LDS_OFF = 131072 + 1024;
constexpr int HALO_LDS_OFF = 131072 + 2048;
constexpr size_t XB_CTL_OFF = 512 * 1024;
constexpr size_t PCNT_CTL_OFF = 640 * 1024;

#define GAS __attribute__((address_space(1)))
#define LAS __attribute__((address_space(3)))
typedef unsigned short bf16;
typedef unsigned v4u __attribute__((ext_vector_type(4)));
typedef unsigned v2u __attribute__((ext_vector_type(2)));
typedef float f32x4 __attribute__((ext_vector_type(4)));

__device__ __forceinline__ unsigned f2bf(float f) { unsigned u = __builtin_bit_cast(unsigned, f); return (u + 0x7fffu + ((u >> 16) & 1u)) >> 16; }
__device__ __forceinline__ unsigned pk2(float lo, float hi) { return f2bf(lo) | (f2bf(hi) << 16); }
__device__ __forceinline__ float bflo(unsigned u) { return __uint_as_float(u << 16); }
__device__ __forceinline__ float bfhi(unsigned u) { return __uint_as_float(u & 0xffff0000u); }
__device__ __forceinline__ float wave_sum(float v) {
#define WS_DPP(x, ctl) __int_as_float(__builtin_amdgcn_update_dpp(0, __float_as_int(x), ctl, 0xf, 0xf, true))
    v += WS_DPP(v, 0xB1); v += WS_DPP(v, 0x4E); v += WS_DPP(v, 0x141); v += WS_DPP(v, 0x140);
#undef WS_DPP
    { auto rr = __builtin_amdgcn_permlane16_swap(__float_as_uint(v), __float_as_uint(v), false, false); v = __uint_as_float(rr[0]) + __uint_as_float(rr[1]); }
    { auto rr = __builtin_amdgcn_permlane32_swap(__float_as_uint(v), __float_as_uint(v), false, false); v = __uint_as_float(rr[0]) + __uint_as_float(rr[1]); }
    return v;
}
__device__ __forceinline__ float wave_max(float v) {
#pragma unroll
    for (int o = 1; o < 64; o <<= 1) v = fmaxf(v, __shfl_xor(v, o));
    return v;
}
#define WAVE_LDS_SYNC() do { asm volatile("s_waitcnt lgkmcnt(0)" ::: "memory"); __builtin_amdgcn_wave_barrier(); } while (0)

struct Args {
    const float* x; const float* g_mix; const float* w_in; const float* g_kv; const float* w_uk; const float* w_uv; const float* w_pool; const float* pool_scale;
    const float* w_o; const float* g_ffn; const float* w_up; const float* conv_w; const float* conv_b; const float* w_down; const float* g_final;
    float* out; unsigned char* ws; int ph_lo, ph_hi, li, pad;
};

typedef const void __attribute__((address_space(4)))* kargp_t;
template <int OFF> __device__ __forceinline__ void* karg_ptr(kargp_t kp) { __attribute__((address_space(1))) void* p; asm volatile("s_load_dwordx2 %0, %1, %2\n\ts_waitcnt lgkmcnt(0)" : "=s"(p) : "s"(kp), "i"(OFF)); return (void*)p; }
template <int OFF> __device__ __forceinline__ int karg_int(kargp_t kp) { int v; asm volatile("s_load_dword %0, %1, %2\n\ts_waitcnt lgkmcnt(0)" : "=s"(v) : "s"(kp), "i"(OFF)); return v; }
__device__ __forceinline__ Args load_args(kargp_t kp) {
    Args a;
    a.x = (const float*)karg_ptr<0>(kp); a.g_mix = (const float*)karg_ptr<8>(kp); a.w_in = (const float*)karg_ptr<16>(kp); a.g_kv = (const float*)karg_ptr<24>(kp);
    a.w_uk = (const float*)karg_ptr<32>(kp); a.w_uv = (const float*)karg_ptr<40>(kp); a.w_pool = (const float*)karg_ptr<48>(kp); a.pool_scale = (const float*)karg_ptr<56>(kp);
    a.w_o = (const float*)karg_ptr<64>(kp); a.g_ffn = (const float*)karg_ptr<72>(kp); a.w_up = (const float*)karg_ptr<80>(kp); a.conv_w = (const float*)karg_ptr<88>(kp);
    a.conv_b = (const float*)karg_ptr<96>(kp); a.w_down = (const float*)karg_ptr<104>(kp); a.g_final = (const float*)karg_ptr<112>(kp);
    a.out = (float*)karg_ptr<120>(kp); a.ws = (unsigned char*)karg_ptr<128>(kp); a.ph_lo = 0; a.ph_hi = 0; a.li = karg_int<144>(kp); a.pad = 0;
    return a;
}
static_assert(sizeof(Args) == 152, "Args layout (kernarg offsets above)");
__device__ __forceinline__ void tr_item(const float* __restrict__ W, int ldw, int k0, int srccol0, int valid, float colscale, const float* __restrict__ kscale,
                                        bf16* __restrict__ WT, int ldt, int nrow0, LAS float* scr, int lane) {
    const int jq = (lane & 7) * 4, kr = lane >> 3;
    f32x4 vv[8];
#pragma unroll
    for (int i = 0; i < 8; ++i) vv[i] = *(const f32x4*)(W + (size_t)(k0 + 8 * i + kr) * ldw + srccol0 + jq);
#pragma unroll
    for (int i = 0; i < 8; ++i) { const int kk = 8 * i + kr; float ks = colscale; if (kscale) ks *= kscale[k0 + kk];
#pragma unroll
        for (int e = 0; e < 4; ++e) scr[kk * 33 + jq + e] = (jq + e < valid) ? vv[i][e] * ks : 0.f; }
    asm volatile("s_waitcnt lgkmcnt(0)" ::: "memory"); __builtin_amdgcn_wave_barrier();
    const int c = lane & 7;
#pragma unroll
    for (int jj = 0; jj < 4; ++jj) { const int n = (lane >> 3) + 8 * jj; const LAS float* s = scr + (8 * c) * 33 + n;
        v4u o; o.x = pk2(s[0 * 33], s[1 * 33]); o.y = pk2(s[2 * 33], s[3 * 33]); o.z = pk2(s[4 * 33], s[5 * 33]); o.w = pk2(s[6 * 33], s[7 * 33]);
        *(v4u*)(WT + (size_t)(nrow0 + n) * ldt + k0 + 8 * c) = o; }
    asm volatile("s_waitcnt lgkmcnt(0)" ::: "memory"); __builtin_amdgcn_wave_barrier();
}
__device__ __forceinline__ void tr_item_f8(const float* __restrict__ W, int ldw, int k0, int srccol0, float colscale, const float* __restrict__ kscale,
                                           unsigned char* __restrict__ WT8, int ldt, int nrow0, LAS float* scr, int lane) {
    const int jq = (lane & 7) * 4, kr = lane >> 3;
    f32x4 vv[8];
#pragma unroll
    for (int i = 0; i < 8; ++i) vv[i] = *(const f32x4*)(W + (size_t)(k0 + 8 * i + kr) * ldw + srccol0 + jq);
#pragma unroll
    for (int i = 0; i < 8; ++i) { const int kk = 8 * i + kr; float ks = colscale; if (kscale) ks *= kscale[k0 + kk];
#pragma unroll
        for (int e = 0; e < 4; ++e) scr[kk * 33 + jq + e] = fminf(fmaxf(vv[i][e] * ks, -448.f), 448.f); }
    asm volatile("s_waitcnt lgkmcnt(0)" ::: "memory"); __builtin_amdgcn_wave_barrier();
    const int c = lane & 7;
#pragma unroll
    for (int jj = 0; jj < 4; ++jj) { const int n = (lane >> 3) + 8 * jj; const LAS float* s = scr + (8 * c) * 33 + n;
        v2u o; int t_;
        t_ = __builtin_amdgcn_cvt_pk_fp8_f32(s[0 * 33], s[1 * 33], 0, false); o.x = (unsigned)__builtin_amdgcn_cvt_pk_fp8_f32(s[2 * 33], s[3 * 33], t_, true);
        t_ = __builtin_amdgcn_cvt_pk_fp8_f32(s[4 * 33], s[5 * 33], 0, false); o.y = (unsigned)__builtin_amdgcn_cvt_pk_fp8_f32(s[6 * 33], s[7 * 33], t_, true);
        *(v2u*)(WT8 + (size_t)(nrow0 + n) * ldt + k0 + 8 * c) = o; }
    asm volatile("s_waitcnt lgkmcnt(0)" ::: "memory"); __builtin_amdgcn_wave_barrier();
}
__device__ __forceinline__ void ph_prologue(const Args& a, LAS unsigned char* lds, const int tid, int gtid, int gthreads, int gw, int ngw, int lane) {
    unsigned char* ws = a.ws;
    bf16* W1T = (bf16*)(ws + WS_W1T); bf16* W2T = (bf16*)(ws + WS_W2T); bf16* W3T = (bf16*)(ws + WS_W3T); bf16* W4T = (bf16*)(ws + WS_W4T);
    float* CONVP = (float*)(ws + WS_CONVP);
    LAS float* L0 = (LAS float*)lds;
    for (int it = blockIdx.x; it < 256; it += gridDim.x) {
        {
            const int g = it >> 6, n0 = ((it >> 1) & 31) * 32, ci0 = (it & 1) * 64;
            LAS float* Wp = L0; LAS float* Wo = L0 + 16384;
#pragma unroll
            for (int t = 0; t < 16; ++t) Wp[tid + 512 * t] = a.w_pool[g * 16384 + ci0 * 128 + tid + 512 * t];
#pragma unroll
            for (int t = 0; t < 8; ++t) { const int idx = tid + 512 * t, dd = idx >> 5; Wo[idx] = a.pool_scale[g * 128 + dd] * a.w_o[(size_t)(512 + g * 128 + dd) * DM + n0 + (idx & 31)]; }
            __syncthreads();
            const int nn = tid & 31, cg_ = tid >> 5; float acc[4];
#pragma unroll
            for (int j = 0; j < 4; ++j) acc[j] = 0.f;
            for (int dd = 0; dd < 128; ++dd) { const float wo = Wo[dd * 32 + nn];
#pragma unroll
                for (int j = 0; j < 4; ++j) acc[j] += Wp[(cg_ * 4 + j) * 128 + dd] * wo; }
#pragma unroll
            for (int j = 0; j < 4; ++j) acc[j] = fminf(fmaxf(acc[j] * 64.0f, -448.f), 448.f);
            const int t_ = __builtin_amdgcn_cvt_pk_fp8_f32(acc[0], acc[1], 0, false);
            *(unsigned*)((unsigned char*)W2T + (size_t)(n0 + nn) * K2 + 512 + g * 128 + ci0 + cg_ * 4) = (unsigned)__builtin_amdgcn_cvt_pk_fp8_f32(acc[2], acc[3], t_, true);
        }
        __syncthreads();
    }
    { bf16* WUKT = (bf16*)(ws + WS_WUKT); bf16* WUVT = (bf16*)(ws + WS_WUVT);
      for (int i = gtid; i < 8 * 128 * 64; i += gthreads) {
          { const int hd = i >> 13, c = (i >> 6) & 127, d = i & 63; WUKT[i] = (bf16)f2bf(a.w_uk[(hd * 64 + d) * 128 + c]); }
          { const int hd = i >> 13, d = (i >> 7) & 63, c = i & 127; WUVT[i] = (bf16)f2bf(a.w_uv[(hd * 128 + c) * 64 + d]); } } }
    LAS float* scr = (LAS float*)(lds + (tid >> 6) * 16384);
    constexpr int I1 = 56 * 16, I3 = 176 * 16, I4 = 32 * 44, I2 = 32 * 8;
    for (int it = gw; it < I1 + I3 + I4 + I2; it += ngw) {
        if (it >= I1 + I3 + I4) {
            const int i4 = it - (I1 + I3 + I4), nb = i4 >> 3, k0 = (i4 & 7) * 64;
            tr_item_f8(a.w_o, DM, k0, nb * 32, 64.f, nullptr, (unsigned char*)W2T, K2, nb * 32, scr, lane);
        } else if (it < I1) {
            const int nb = it >> 4, k0 = (it & 15) * 64, n0 = nb * 32; int sc0, valid = 32; float cs = 1.f;
            if (n0 < 512) sc0 = n0; else if (n0 < 1024) sc0 = 640 + (n0 - 512); else if (n0 < 1536) sc0 = 1224 + (n0 - 1024); else if (n0 < 1664) sc0 = 512 + (n0 - 1536); else if (n0 < 1728) sc0 = 1152 + (n0 - 1664);
            else if (n0 == 1728) { sc0 = 1216; valid = 8; cs = WI_SCALE; } else { sc0 = 0; valid = 0; }
            tr_item(a.w_in, IN_COLS, k0, sc0, valid, cs, nullptr, W1T, DM, n0, scr, lane);
        } else if (it < I1 + I3) {
            const int i2 = it - I1, nb = i2 >> 4, k0 = (i2 & 15) * 64, r0 = nb * 32, j = r0 >> 8, ii = r0 & 255;
            const int sc0 = (ii < 128) ? (128 * j + ii) : (FF + 128 * j + (ii - 128));
            tr_item_f8(a.w_up, N3, k0, sc0, 64.f, a.g_ffn, (unsigned char*)W3T, DM, r0, scr, lane);
        } else {
            const int i3 = it - I1 - I3, nb = i3 / 44, k0 = (i3 - nb * 44) * 64;
            tr_item_f8(a.w_down, DM, k0, nb * 32, 64.f, nullptr, (unsigned char*)W4T, FF, nb * 32, scr, lane);
        }
    }
    if (gtid < 32) {
        float* ZT = (float*)(ws + WS_ZT); const float nn = 64.0f * (float)(gtid + 1); float z = 0.f;
        if (nn > 256.f) { const float p = 256.0f / nn, pt = (p < 0.5f) ? p : 1.0f - p, t = sqrtf(-2.0f * logf(pt));
            const float zz = t - (2.515517f + t * (0.802853f + t * 0.010328f)) / (1.0f + t * (1.432788f + t * (0.189269f + t * 0.001308f))); z = (p < 0.5f) ? zz : -zz; }
        ZT[gtid] = z; ZT[32 + gtid] = nn * 0.3989423f * expf(-0.5f * z * z);
    }
    for (int r = gtid; r < N3; r += gthreads) {
        const int j = r >> 8, ii = r & 255; const int col = (ii < 128) ? (128 * j + ii) : (FF + 128 * j + (ii - 128));
        CONVP[r] = a.conv_w[col]; CONVP[N3 + r] = a.conv_w[N3 + col]; CONVP[2 * N3 + r] = a.conv_w[2 * N3 + col]; CONVP[3 * N3 + r] = a.conv_b[col];
    }
    bf16* HB = (bf16*)(ws + WS_HB);
    for (int m0 = gw; m0 < NTOK; m0 += 4 * ngw) {
        f32x4 v[4][4]; float s[4];
#pragma unroll
        for (int r = 0; r < 4; ++r) { const f32x4* xr = (const f32x4*)(a.x + (size_t)(m0 + r * ngw) * DM) + lane;
#pragma unroll
            for (int j = 0; j < 4; ++j) v[r][j] = __builtin_nontemporal_load(xr + 64 * j); }
        f32x4 g[4];
#pragma unroll
        for (int j = 0; j < 4; ++j) g[j] = ((const f32x4*)a.g_mix)[lane + 64 * j];
#pragma unroll
        for (int r = 0; r < 4; ++r) { s[r] = 0.f;
#pragma unroll
            for (int j = 0; j < 4; ++j) s[r] += (v[r][j].x * v[r][j].x + v[r][j].y * v[r][j].y) + (v[r][j].z * v[r][j].z + v[r][j].w * v[r][j].w); }
#pragma unroll
        for (int r = 0; r < 4; ++r) {
            const float rs_ = sqrtf(wave_sum(s[r]) * (1.0f / DM) + EPS), rinv = 1.0f / rs_;
            if (lane == 0) ((float*)(ws + WS_RS))[m0 + r * ngw] = rs_;
            unsigned long long* o8 = (unsigned long long*)(HB + (size_t)(m0 + r * ngw) * DM) + lane;
#pragma unroll
            for (int j = 0; j < 4; ++j)
                o8[64 * j] = (unsigned long long)pk2(v[r][j].x * rinv * g[j].x, v[r][j].y * rinv * g[j].y) | ((unsigned long long)pk2(v[r][j].z * rinv * g[j].z, v[r][j].w * rinv * g[j].w) << 32);
        }
    }
}

__device__ __forceinline__ void ph_cnorm_pool(const Args& a, int gw, int ngw, int lane) {
    const bf16* P1 = (const bf16*)(a.ws + WS_P1); unsigned char* CN = a.ws + WS_CN; unsigned char* MIX = a.ws + WS_MIX;
    unsigned char* CT8 = a.ws + WS_CT8;
    const float gk0 = a.g_kv[2 * lane], gk1 = a.g_kv[2 * lane + 1];
    const int win = 2 << (lane >> 4);
    for (int run = gw; run < NTOK / 32; run += ngw) {
        const int tok0 = run * 32, pos0 = tok0 & (SEQ - 1);
        const bf16* ub = P1 + (size_t)tok0 * N1 + OFF_U + 8 * lane;
        float s[8];
#pragma unroll
        for (int j = 0; j < 8; ++j) s[j] = 0.f;
#pragma unroll
        for (int j = 1; j < 16; ++j) {
            if (j < win && pos0 - j >= 0) { const v4u u = *(const v4u*)(ub - (size_t)j * N1);
                s[0] += bflo(u.x); s[1] += bfhi(u.x); s[2] += bflo(u.y); s[3] += bfhi(u.y); s[4] += bflo(u.z); s[5] += bfhi(u.z); s[6] += bflo(u.w); s[7] += bfhi(u.w); }
        }
#pragma unroll 1
        for (int tb = 0; tb < 32; tb += 8) {
        v4u ub_[8], udb_[8]; unsigned cwb_[8]; float cn0_[8], cn1_[8];
#pragma unroll
        for (int t8 = 0; t8 < 8; ++t8) {
            const bf16* prow = P1 + (size_t)(tok0 + tb + t8) * N1;
            ub_[t8] = *(const v4u*)(prow + OFF_U + 8 * lane);
            cwb_[t8] = *(const unsigned*)(prow + OFF_C + 2 * lane);
            udb_[t8] = (v4u){0u, 0u, 0u, 0u};
            if (pos0 + tb + t8 - win + 1 >= 0) udb_[t8] = *(const v4u*)(prow - (size_t)(win - 1) * N1 + OFF_U + 8 * lane);
        }
#pragma unroll
        for (int t8 = 0; t8 < 8; ++t8) {
            const int t = tb + t8;
            const int tok = tok0 + t, pos = pos0 + t;
            const v4u u = ub_[t8];
            const unsigned cw = cwb_[t8];
            const v4u ud = udb_[t8];
            const bool drop = (pos - win + 1 >= 0);
            const float c0 = bflo(cw), c1 = bfhi(cw);
            const float rinv = 1.0f / sqrtf(wave_sum(c0 * c0 + c1 * c1) * (1.0f / 128.0f) + EPS);
            cn0_[t8] = c0 * rinv * gk0; cn1_[t8] = c1 * rinv * gk1;
            *(unsigned short*)(CN + (size_t)tok * 128 + 2 * lane) = (unsigned short)__builtin_amdgcn_cvt_pk_fp8_f32(fminf(fmaxf(cn0_[t8] * 16.0f, -448.f), 448.f), fminf(fmaxf(cn1_[t8] * 16.0f, -448.f), 448.f), 0, false);
            const float uf[8] = {bflo(u.x), bfhi(u.x), bflo(u.y), bfhi(u.y), bflo(u.z), bfhi(u.z), bflo(u.w), bfhi(u.w)};
#pragma unroll
            for (int j = 0; j < 8; ++j) s[j] += uf[j];
            const int cnt = (pos + 1 < win) ? pos + 1 : win; const float ic = 1.0f / (float)cnt;
            float pv_[8];
#pragma unroll
            for (int j = 0; j < 8; ++j) pv_[j] = fminf(fmaxf((s[j] * ic - uf[j]) * 16.0f, -448.f), 448.f);
            v2u o; int t_;
            t_ = __builtin_amdgcn_cvt_pk_fp8_f32(pv_[0], pv_[1], 0, false); o.x = (unsigned)__builtin_amdgcn_cvt_pk_fp8_f32(pv_[2], pv_[3], t_, true);
            t_ = __builtin_amdgcn_cvt_pk_fp8_f32(pv_[4], pv_[5], 0, false); o.y = (unsigned)__builtin_amdgcn_cvt_pk_fp8_f32(pv_[6], pv_[7], t_, true);
            *(v2u*)(MIX + (size_t)tok * K2 + 512 + 8 * lane) = o;
            if (drop) { s[0] -= bflo(ud.x); s[1] -= bfhi(ud.x); s[2] -= bflo(ud.y); s[3] -= bfhi(ud.y); s[4] -= bflo(ud.z); s[5] -= bfhi(ud.z); s[6] -= bflo(ud.w); s[7] -= bfhi(ud.w); }
        }
        {
            unsigned char* ctp = CT8 + ((size_t)(tok0 >> 6) * 128 + 2 * lane) * 64 + 16 * ((pos0 >> 5) & 1) + (tb >> 1);
#pragma unroll
            for (int hh = 0; hh < 2; ++hh) {
                float q0[4], q1[4];
#pragma unroll
                for (int e = 0; e < 4; ++e) { q0[e] = fminf(fmaxf(cn0_[4 * hh + e] * 16.0f, -448.f), 448.f); q1[e] = fminf(fmaxf(cn1_[4 * hh + e] * 16.0f, -448.f), 448.f); }
                int t_ = __builtin_amdgcn_cvt_pk_fp8_f32(q0[0], q0[1], 0, false); *(unsigned*)(ctp + 32 * hh) = (unsigned)__builtin_amdgcn_cvt_pk_fp8_f32(q0[2], q0[3], t_, true);
                t_ = __builtin_amdgcn_cvt_pk_fp8_f32(q1[0], q1[1], 0, false); *(unsigned*)(ctp + 64 + 32 * hh) = (unsigned)__builtin_amdgcn_cvt_pk_fp8_f32(q1[2], q1[3], t_, true);
            }
        }
        }
    }
}

namespace dsa {
using bf16x8 = __attribute__((ext_vector_type(8))) short;
using s16x4  = __attribute__((ext_vector_type(4))) short;
using f32x16 = __attribute__((ext_vector_type(16))) float;
using u32x4  = __attribute__((ext_vector_type(4))) unsigned;
constexpr int NW = 8, KVBLK = 64;
constexpr float SCALE = 0.125f, LOG2E = 1.4426950408889634f, THR = 4.f, PSH = 3.f;
typedef int v8i __attribute__((ext_vector_type(8)));
typedef int v4i __attribute__((ext_vector_type(4)));
constexpr int SHM_V = KVBLK * 128 * 2, SHM_K = KVBLK * 128 * 2, SHM_ATTN = 2 * SHM_V + 2 * SHM_K + NW * 64 * 4;
constexpr unsigned NEG2 = 0xCAEACAEAu;
#define KSWZ(row, colB) ((row) * 256 + ((colB) ^ (((row) & 7) << 4)))
#define SBAR() __builtin_amdgcn_sched_barrier(0)
__device__ __forceinline__ int crow(int r, int hi) { return (r & 3) + 8 * (r >> 2) + 4 * hi; }
__device__ __forceinline__ unsigned cvtpk(float lo, float hi) { unsigned r; asm volatile("v_cvt_pk_bf16_f32 %0, %1, %2" : "=v"(r) : "v"(lo), "v"(hi)); return r; }
typedef float f32x2_t __attribute__((ext_vector_type(2))); typedef __bf16 bf16x2_t __attribute__((ext_vector_type(2)));
__device__ __forceinline__ unsigned cvtpk_s(float lo, float hi) { f32x2_t v = {lo, hi}; bf16x2_t b = __builtin_convertvector(v, bf16x2_t); return __builtin_bit_cast(unsigned, b); }

template <int CTRL> __device__ __forceinline__ unsigned dppu(unsigned x) { return (unsigned)__builtin_amdgcn_update_dpp(0, (int)x, CTRL, 0xf, 0xf, true); }
__device__ __forceinline__ unsigned half_sum(unsigned x, int) {
    x += dppu<0xB1>(x); x += dppu<0x4E>(x); x += dppu<0x141>(x); x += dppu<0x140>(x);
    auto rr = __builtin_amdgcn_permlane16_swap(x, x, false, false); return rr[0] + rr[1];
}
__device__ __forceinline__ unsigned half_min(unsigned x, int) {
    x = min(x, dppu<0xB1>(x)); x = min(x, dppu<0x4E>(x)); x = min(x, dppu<0x141>(x)); x = min(x, dppu<0x140>(x));
    auto rr = __builtin_amdgcn_permlane16_swap(x, x, false, false); return min(rr[0], rr[1]);
}
__device__ __forceinline__ unsigned half_max(unsigned x, int) {
    x = max(x, dppu<0xB1>(x)); x = max(x, dppu<0x4E>(x)); x = max(x, dppu<0x141>(x)); x = max(x, dppu<0x140>(x));
    auto rr = __builtin_amdgcn_permlane16_swap(x, x, false, false); return max(rr[0], rr[1]);
}

template <int CTRL> __device__ __forceinline__ float dppf(float x) { return __int_as_float(__builtin_amdgcn_update_dpp(0, __float_as_int(x), CTRL, 0xf, 0xf, true)); }
__device__ __forceinline__ float half_minf(float x, int) {
    x = fminf(x, dppf<0xB1>(x)); x = fminf(x, dppf<0x4E>(x)); x = fminf(x, dppf<0x141>(x)); x = fminf(x, dppf<0x140>(x));
    auto rr = __builtin_amdgcn_permlane16_swap(__float_as_uint(x), __float_as_uint(x), false, false); return fminf(__uint_as_float(rr[0]), __uint_as_float(rr[1]));
}
__device__ __forceinline__ float half_maxf(float x, int) {
    x = fmaxf(x, dppf<0xB1>(x)); x = fmaxf(x, dppf<0x4E>(x)); x = fmaxf(x, dppf<0x141>(x)); x = fmaxf(x, dppf<0x140>(x));
    auto rr = __builtin_amdgcn_permlane16_swap(__float_as_uint(x), __float_as_uint(x), false, false); return fmaxf(__uint_as_float(rr[0]), __uint_as_float(rr[1]));
}
__device__ __forceinline__ float half_sumf(float x, int) {
    x += dppf<0xB1>(x); x += dppf<0x4E>(x); x += dppf<0x141>(x); x += dppf<0x140>(x);
    auto rr = __builtin_amdgcn_permlane16_swap(__float_as_uint(x), __float_as_uint(x), false, false); return __uint_as_float(rr[0]) + __uint_as_float(rr[1]);
}
__device__ __forceinline__ unsigned f2key(float f) { const unsigned u = __float_as_uint(f); return (u & 0x80000000u) ? ~u : (u | 0x80000000u); }
__device__ __forceinline__ float key2f(unsigned k) { return __uint_as_float((k & 0x80000000u) ? (k & 0x7fffffffu) : ~k); }

template <int PROBE> __device__ __forceinline__ void idx_select(const bf16* __restrict__ P1, int b, int tokw, int n, int tid_in, LAS char* lds, const float* __restrict__ ZT, unsigned& W0lo, unsigned& W0hi, unsigned& W1lo, unsigned& W1hi) {
    if (n <= 256) { W0lo = W0hi = W1lo = W1hi = 0xffffffffu; return; }
    int tid = tid_in; asm volatile("" : "+v"(tid));
    const int lane = tid & 63, wid = __builtin_amdgcn_readfirstlane(tid >> 6), c = lane & 31, h = lane >> 5;
    const int nt = n >> 5, nch = (n + 255) >> 8;
    const bf16* kb = P1 + (size_t)b * SEQ * N1 + OFF_KI;
    unsigned dsrc[4];
#pragma unroll
    for (int ii = 0; ii < 4; ++ii) { const int q = wid * 4 + ii, keyl = q * 8 + (lane >> 3), pc = lane & 7; dsrc[ii] = (unsigned)(keyl * N1 + ((pc ^ ((keyl >> 1) & 7)) << 3)); }
#define KI_DMA(cc) do { _Pragma("unroll") for (int ii = 0; ii < 4; ++ii) { const int q_ = wid * 4 + ii; if (256 * (cc) + 8 * q_ < n) \
        __builtin_amdgcn_global_load_lds((const unsigned*)(kb + (size_t)(256 * (cc)) * N1 + dsrc[ii]), (LAS unsigned*)(lds + ((cc) & 1) * 32768 + q_ * 1024), 16, 0, 0); } } while (0)
    KI_DMA(0);
    const int qa = 2 * ((c >> 2) & 1) + (c >> 4), ih = (c & 3) + 4 * ((c >> 3) & 1);
    const bf16* qip = P1 + (size_t)(tokw + qa) * N1 + OFF_QI + ih * 64 + 8 * h;
    bf16x8 af[4];
#pragma unroll
    for (int s = 0; s < 4; ++s) af[s] = *(const bf16x8*)(qip + 16 * s);
    float wq0[8], wq1[8];
    { const u32x4 t = *(const u32x4*)(P1 + (size_t)(tokw + 2 * h) * N1 + OFF_WI), u = *(const u32x4*)(P1 + (size_t)(tokw + 2 * h + 1) * N1 + OFF_WI);
      wq0[0] = bflo(t.x); wq0[1] = bfhi(t.x); wq0[2] = bflo(t.y); wq0[3] = bfhi(t.y); wq0[4] = bflo(t.z); wq0[5] = bfhi(t.z); wq0[6] = bflo(t.w); wq0[7] = bfhi(t.w);
      wq1[0] = bflo(u.x); wq1[1] = bfhi(u.x); wq1[2] = bflo(u.y); wq1[3] = bfhi(u.y); wq1[4] = bflo(u.z); wq1[5] = bfhi(u.z); wq1[6] = bflo(u.w); wq1[7] = bfhi(u.w); }
    const int rdoff = c * 128, rsw = (c >> 1) & 7;
    float sc0[64], sc1[64];
    float mn0 = __builtin_inff(), mx0 = -__builtin_inff(), mn1 = __builtin_inff(), mx1 = -__builtin_inff();
    float sm0 = 0.f, sq0 = 0.f, sm1 = 0.f, sq1 = 0.f;
#pragma unroll
    for (int cc = 0; cc < 8; ++cc) {
        if (cc < nch) {
            __syncthreads();
            if (cc + 1 < nch) KI_DMA(cc + 1);
            const LAS char* cb = lds + (cc & 1) * 32768 + rdoff;
#pragma unroll
            for (int t = 0; t < 8; ++t) {
                const int i = cc * 8 + t;
                if (i < nt) {
                    f32x16 acc = {};
#pragma unroll
                    for (int s = 0; s < 4; ++s) { const bf16x8 kf = *(const LAS bf16x8*)(cb + t * 4096 + (((2 * s + h) ^ rsw) << 4));
                        acc = __builtin_amdgcn_mfma_f32_32x32x16_bf16(af[s], kf, acc, 0, 0, 0); }
                    float s0 = 0.f, s1 = 0.f;
#pragma unroll
                    for (int j = 0; j < 8; ++j) {
                        s0 = fmaf(wq0[j], __int_as_float(max(__float_as_int(acc[j]), 0)), s0); s1 = fmaf(wq1[j], __int_as_float(max(__float_as_int(acc[8 + j]), 0)), s1); }
                    sc0[i] = s0; sc1[i] = s1; mn0 = fminf(mn0, s0); mx0 = fmaxf(mx0, s0); mn1 = fminf(mn1, s1); mx1 = fmaxf(mx1, s1);
                    sm0 += s0; sq0 = fmaf(s0, s0, sq0); sm1 += s1; sq1 = fmaf(s1, s1, sq1);
                } else { sc0[i] = -__builtin_inff(); sc1[i] = -__builtin_inff(); }
            }
        } else {
#pragma unroll
            for (int t = 0; t < 8; ++t) { sc0[cc * 8 + t] = -__builtin_inff(); sc1[cc * 8 + t] = -__builtin_inff(); }
        }
    }
#undef KI_DMA
    __syncthreads();
    unsigned klo0 = f2key(half_minf(mn0, h)), khi0 = f2key(half_maxf(mx0, h)) + 1u, klo1 = f2key(half_minf(mn1, h)), khi1 = f2key(half_maxf(mx1, h)) + 1u;
    unsigned cl0 = (unsigned)n, cl1 = (unsigned)n, ch0 = 0u, ch1 = 0u;
    bool fin0 = (khi0 - klo0 <= 1u), fin1 = (khi1 - klo1 <= 1u);
    const float rn = 1.0f / (float)n;
    const float mu0 = half_sumf(sm0, h) * rn, mu1 = half_sumf(sm1, h) * rn;
    const float sd0 = sqrtf(fmaxf(half_sumf(sq0, h) * rn - mu0 * mu0, 1e-30f)), sd1 = sqrtf(fmaxf(half_sumf(sq1, h) * rn - mu1 * mu1, 1e-30f));
    const float zq = ZT[(n >> 6) - 1], rdphi = __builtin_amdgcn_rcpf(ZT[32 + (n >> 6) - 1]);
    bool np0 = false, np1 = false;
    for (int it = 0; it < (PROBE == 3 ? 0 : 96); ++it) {
        unsigned km0, km1;
        if (it < 48) {
            const float lo0f = key2f(klo0), hi0f = key2f(khi0), lo1f = key2f(klo1), hi1f = key2f(khi1);
            float f0 = 0.5f, f1 = 0.5f;
            if (!(it & 1)) { f0 = ((float)cl0 - 255.5f) * __builtin_amdgcn_rcpf((float)(cl0 - ch0)); f1 = ((float)cl1 - 255.5f) * __builtin_amdgcn_rcpf((float)(cl1 - ch1)); }
            float m0 = fmaf(hi0f - lo0f, f0, lo0f), m1 = fmaf(hi1f - lo1f, f1, lo1f);
            if (it == 0) { m0 = fmaf(zq, sd0, mu0); m1 = fmaf(zq, sd1, mu1); }
            else if (it == 1) {
                m0 = (cl0 != (unsigned)n) ? lo0f + (1.5f * ((float)cl0 - 255.5f) + 4.0f) * sd0 * rdphi : hi0f - (1.5f * (255.5f - (float)ch0) + 4.0f) * sd0 * rdphi;
                m1 = (cl1 != (unsigned)n) ? lo1f + (1.5f * ((float)cl1 - 255.5f) + 4.0f) * sd1 * rdphi : hi1f - (1.5f * (255.5f - (float)ch1) + 4.0f) * sd1 * rdphi;
            }
            km0 = f2key(m0 + 0.0f); km1 = f2key(m1 + 0.0f);
            if (!(m0 == m0)) km0 = klo0 + ((khi0 - klo0) >> 1);
            if (!(m1 == m1)) km1 = klo1 + ((khi1 - klo1) >> 1);
        } else { km0 = klo0 + ((khi0 - klo0) >> 1); km1 = klo1 + ((khi1 - klo1) >> 1); }
        constexpr unsigned EG = 3u;
        const unsigned rb0 = 256u - ch0, ra0 = cl0 - 256u, rb1 = 256u - ch1, ra1 = cl1 - 256u;
        const bool sp0 = !fin0 && ((rb0 <= EG && rb0 <= ra0) || np0), sp1 = !fin1 && ((rb1 <= EG && rb1 <= ra1) || np1);
        const bool sa0 = !fin0 && !sp0 && ra0 <= EG, sa1 = !fin1 && !sp1 && ra1 <= EG;
        if (__any(sp0 || sp1)) {
            const float hf0 = key2f(khi0), hf1 = key2f(khi1); float b0 = -__builtin_inff(), b1 = -__builtin_inff();
#pragma unroll
            for (int g = 0; g < 8; ++g) {
                if (g * 8 < nt) {
#pragma unroll
                    for (int i = g * 8; i < g * 8 + 8; ++i) { b0 = fmaxf(b0, (sc0[i] < hf0) ? sc0[i] : -__builtin_inff()); b1 = fmaxf(b1, (sc1[i] < hf1) ? sc1[i] : -__builtin_inff()); }
                }
            }
            b0 = half_maxf(b0, h); b1 = half_maxf(b1, h);
            if (sp0) km0 = f2key(b0); if (sp1) km1 = f2key(b1);
        }
        if (__any(sa0 || sa1)) {
            const float lf0 = key2f(klo0), lf1 = key2f(klo1); float a0 = __builtin_inff(), a1 = __builtin_inff();
#pragma unroll
            for (int g = 0; g < 8; ++g) {
                if (g * 8 < nt) {
#pragma unroll
                    for (int i = g * 8; i < g * 8 + 8; ++i) { a0 = fminf(a0, (sc0[i] >= lf0) ? sc0[i] : __builtin_inff()); a1 = fminf(a1, (sc1[i] >= lf1) ? sc1[i] : __builtin_inff()); }
                }
            }
            a0 = half_minf(a0, h); a1 = half_minf(a1, h);
            if (sa0) km0 = f2key(a0) + 1u; if (sa1) km1 = f2key(a1) + 1u;
        }
        km0 = min(max(km0, klo0 + 1u), khi0 - 1u); km1 = min(max(km1, klo1 + 1u), khi1 - 1u);
        const float t0 = key2f(km0), t1 = key2f(km1);
        unsigned c0 = 0u, c1 = 0u, c0b = 0u, c1b = 0u;
#pragma unroll
        for (int g = 0; g < 8; ++g) {
            if (g * 8 < nt) {
#pragma unroll
                for (int i = g * 8; i < g * 8 + 8; i += 2)
                    asm volatile("v_cmp_ge_f32_e64 s[36:37], %4, %8\n\tv_cmp_ge_f32_e64 s[38:39], %5, %9\n\tv_cmp_ge_f32_e64 s[40:41], %6, %8\n\tv_cmp_ge_f32_e64 s[42:43], %7, %9\n\t"
                                 "v_addc_co_u32_e64 %0, vcc, 0, %0, s[36:37]\n\tv_addc_co_u32_e64 %1, vcc, 0, %1, s[38:39]\n\tv_addc_co_u32_e64 %2, vcc, 0, %2, s[40:41]\n\tv_addc_co_u32_e64 %3, vcc, 0, %3, s[42:43]"
                                 : "+v"(c0), "+v"(c1), "+v"(c0b), "+v"(c1b) : "v"(sc0[i]), "v"(sc1[i]), "v"(sc0[i + 1]), "v"(sc1[i + 1]), "v"(t0), "v"(t1) : "vcc", "s36", "s37", "s38", "s39", "s40", "s41", "s42", "s43");
            }
        }
        { const unsigned cs = half_sum((c0 + c0b) | ((c1 + c1b) << 16), h); c0 = cs & 0xffffu; c1 = cs >> 16; }
        if (!fin0) { np0 = (it >= 2) && (c0 == cl0 || c0 == ch0);
            if (c0 >= 256u) { klo0 = km0; cl0 = c0; if (sp0) khi0 = km0 + 1u; } else { khi0 = km0; ch0 = c0; if (sa0) klo0 = km0 - 1u; } fin0 = (c0 == 256u) || (khi0 - klo0 <= 1u); }
        if (!fin1) { np1 = (it >= 2) && (c1 == cl1 || c1 == ch1);
            if (c1 >= 256u) { klo1 = km1; cl1 = c1; if (sp1) khi1 = km1 + 1u; } else { khi1 = km1; ch1 = c1; if (sa1) klo1 = km1 - 1u; } fin1 = (c1 == 256u) || (khi1 - klo1 <= 1u); }
        if (__all(fin0 && fin1)) break;
    }
    const float lo0 = key2f(klo0), lo1 = key2f(klo1);
    unsigned w0l = 0u, w0h = 0u, w1l = 0u, w1h = 0u;
#define BITOF(cond) ({ unsigned t__ = (cond) ? 1u : 0u; asm volatile("" : "+v"(t__)); t__; })
    if (__all(cl0 == 256u && cl1 == 256u)) {
#pragma unroll
        for (int g = 0; g < 8; ++g) {
            if (g * 8 < nt) {
#pragma unroll
                for (int i = g * 8; i < g * 8 + 8; ++i) {
                    if (i < 32) { w0l |= BITOF(sc0[i] >= lo0) << i; w1l |= BITOF(sc1[i] >= lo1) << i; } else { w0h |= BITOF(sc0[i] >= lo0) << (i - 32); w1h |= BITOF(sc1[i] >= lo1) << (i - 32); }
                }
            }
        }
    } else {
        unsigned g0 = 0u, g1 = 0u;
#pragma unroll
        for (int i = 0; i < 64; ++i) { g0 += (sc0[i] > lo0) ? 1u : 0u; g1 += (sc1[i] > lo1) ? 1u : 0u; }
        g0 = half_sum(g0, h); g1 = half_sum(g1, h);
        const unsigned need0 = 256u - g0, need1 = 256u - g1, ltm = (1u << c) - 1u;
        unsigned run0 = 0u, run1 = 0u;
#pragma unroll
        for (int i = 0; i < 64; ++i) {
            const bool e0 = (sc0[i] == lo0), e1 = (sc1[i] == lo1);
            const unsigned long long m0 = __ballot(e0), m1 = __ballot(e1);
            const unsigned hb0 = h ? (unsigned)(m0 >> 32) : (unsigned)m0, hb1 = h ? (unsigned)(m1 >> 32) : (unsigned)m1;
            const bool s0 = (sc0[i] > lo0) || (e0 && (run0 + __popc(hb0 & ltm) < need0));
            const bool s1 = (sc1[i] > lo1) || (e1 && (run1 + __popc(hb1 & ltm) < need1));
            run0 += __popc(hb0); run1 += __popc(hb1);
            if (i < 32) { w0l |= BITOF(s0) << i; w1l |= BITOF(s1) << i; } else { w0h |= BITOF(s0) << (i - 32); w1h |= BITOF(s1) << (i - 32); }
        }
    }
#undef BITOF
    W0lo = w0l; W0hi = w0h; W1lo = w1l; W1hi = w1h;
}

__device__ __forceinline__ void partialSM(f32x16& p0, f32x16& p1, float b0, float& m_reg, float& mn, float& alpha) {
    constexpr float C = SCALE * LOG2E * (1.0f / 256.0f);
    float pmax = p0[0];
#pragma unroll
    for (int r = 1; r < 16; ++r) pmax = fmaxf(pmax, p0[r]);
#pragma unroll
    for (int r = 0; r < 16; ++r) pmax = fmaxf(pmax, p1[r]);
    { auto rr = __builtin_amdgcn_permlane32_swap(__float_as_uint(pmax), __float_as_uint(pmax), false, false);
      pmax = fmaxf(__uint_as_float(rr[0]), __uint_as_float(rr[1])); }
    const float pm = fmaf(pmax, C, b0);
    if (__builtin_expect(__all(pm - m_reg <= THR * LOG2E), 1)) { mn = m_reg; alpha = 1.f; }
    else { mn = fmaxf(m_reg, pm); alpha = __builtin_amdgcn_exp2f(m_reg - mn); m_reg = mn; }
    const float off = b0 - mn + PSH;
#pragma unroll
    for (int r = 0; r < 16; ++r) p0[r] = fmaf(p0[r], C, off);
#pragma unroll
    for (int r = 0; r < 16; ++r) p1[r] = fmaf(p1[r], C, off);
#pragma unroll
    for (int r = 0; r < 16; ++r) p0[r] = __builtin_amdgcn_exp2f(p0[r]);
}
__device__ __forceinline__ void finishSM(f32x16& p0, f32x16& p1, float alpha, float& l_reg, v8i& P8) {
#pragma unroll
    for (int r = 0; r < 16; ++r) p1[r] = __builtin_amdgcn_exp2f(p1[r]);
    float ps = 0;
#pragma unroll
    for (int r = 0; r < 16; ++r) ps += p0[r];
#pragma unroll
    for (int r = 0; r < 16; ++r) ps += p1[r];
    { auto rr = __builtin_amdgcn_permlane32_swap(__float_as_uint(ps), __float_as_uint(ps), false, false);
      ps = __uint_as_float(rr[0]) + __uint_as_float(rr[1]); }
    l_reg = l_reg * alpha + ps;
#pragma unroll
    for (int g = 0; g < 4; ++g) { const int t_ = __builtin_amdgcn_cvt_pk_fp8_f32(p0[4 * g], p0[4 * g + 1], __float_as_int(p0[4 * g]), false); P8[g] = __builtin_amdgcn_cvt_pk_fp8_f32(p0[4 * g + 2], p0[4 * g + 3], t_, true); }
#pragma unroll
    for (int g = 0; g < 4; ++g) { const int t_ = __builtin_amdgcn_cvt_pk_fp8_f32(p1[4 * g], p1[4 * g + 1], __float_as_int(p1[4 * g]), false); P8[4 + g] = __builtin_amdgcn_cvt_pk_fp8_f32(p1[4 * g + 2], p1[4 * g + 3], t_, true); }
}
__device__ __forceinline__ void qkt(f32x16& p0, f32x16& p1, const LAS char* Ks, const v8i* qr8, bf16x8 ax0, bf16x8 ax1, bf16x8 ef, int r32, int hi) {
    const LAS char* kr = Ks + r32 * 128; const int sw = (r32 >> 1) & 7;
    v8i kf[2][2];
#pragma unroll
    for (int kb = 0; kb < 2; ++kb)
#pragma unroll
        for (int sx = 0; sx < 2; ++sx) { const int pc = 4 * sx + 2 * hi;
            const v4i lo = *(const LAS v4i*)(kr + kb * 4096 + ((pc ^ sw) << 4)), hi_ = *(const LAS v4i*)(kr + kb * 4096 + (((pc + 1) ^ sw) << 4));
            kf[kb][sx] = __builtin_shufflevector(lo, hi_, 0, 1, 2, 3, 4, 5, 6, 7); }
    const int one = 0x7f7f7f7f;
#if defined(__HIP_DEVICE_COMPILE__)
    asm volatile("s_nop 1\n\tv_mfma_f32_32x32x16_bf16 %0, %1, %2, 0" : "=&v"(p0) : "v"(ax0), "v"(ef));
    asm volatile("s_nop 1\n\tv_mfma_f32_32x32x16_bf16 %0, %1, %2, 0" : "=&v"(p1) : "v"(ax1), "v"(ef));
    asm volatile("s_nop 1\n\tv_mfma_scale_f32_32x32x64_f8f6f4 %0, %1, %2, %0, %3, %3 op_sel_hi:[0,0,0]" : "+v"(p0) : "v"(kf[0][0]), "v"(qr8[0]), "v"(one));
    asm volatile("s_nop 1\n\tv_mfma_scale_f32_32x32x64_f8f6f4 %0, %1, %2, %0, %3, %3 op_sel_hi:[0,0,0]" : "+v"(p1) : "v"(kf[1][0]), "v"(qr8[0]), "v"(one));
    asm volatile("s_nop 1\n\tv_mfma_scale_f32_32x32x64_f8f6f4 %0, %1, %2, %0, %3, %3 op_sel_hi:[0,0,0]" : "+v"(p0) : "v"(kf[0][1]), "v"(qr8[1]), "v"(one));
    asm volatile("s_nop 1\n\tv_mfma_scale_f32_32x32x64_f8f6f4 %0, %1, %2, %0, %3, %3 op_sel_hi:[0,0,0]\n\ts_nop 3" : "+v"(p1) : "v"(kf[1][1]), "v"(qr8[1]), "v"(one));
    asm volatile("" :: "v"(kf[0][0]), "v"(kf[1][0]), "v"(kf[0][1]), "v"(kf[1][1]), "v"(ax0), "v"(ax1), "v"(ef), "v"(one));
#else
    (void)one; (void)ax0; (void)ax1; (void)ef; (void)kf; (void)qr8; p0 = f32x16{}; p1 = f32x16{};
#endif
}
constexpr int VT_PITCH = 80;
__device__ __forceinline__ void pv_d0(f32x16* o, const LAS char* vb, const v8i P8) {
    v8i bf[4];
#pragma unroll
    for (int d0 = 0; d0 < 4; ++d0) { const v4i lo = *(const LAS v4i*)(vb + d0 * 32 * VT_PITCH), hi_ = *(const LAS v4i*)(vb + d0 * 32 * VT_PITCH + 16); bf[d0] = __builtin_shufflevector(lo, hi_, 0, 1, 2, 3, 4, 5, 6, 7); }
    const int one = 0x7f7f7f7f;
#pragma unroll
    for (int d0 = 0; d0 < 4; ++d0) {
#if defined(__HIP_DEVICE_COMPILE__)
        asm volatile("s_nop 1\n\tv_mfma_scale_f32_32x32x64_f8f6f4 %0, %1, %2, %0, %3, %3 op_sel_hi:[0,0,0]" : "+v"(o[d0]) : "v"(P8), "v"(bf[d0]), "v"(one));
#else
        (void)one;
#endif
    }
#if defined(__HIP_DEVICE_COMPILE__)
    asm volatile("s_nop 3" :: "v"(P8), "v"(bf[0]), "v"(bf[1]), "v"(bf[2]), "v"(bf[3]), "v"(one));
#endif
}
#define PTOUCH(a, b) asm volatile("" : "+v"(a), "+v"(b))
#define MFMA_DRAIN() asm volatile("s_nop 15\n\ts_nop 15\n\ts_nop 15\n\ts_nop 15\n\ts_nop 15" ::: "memory")

__device__ __forceinline__ void qlat_stage(const bf16* __restrict__ P1, const bf16* __restrict__ WUKT, int tok0, LAS char* lds, int tid_in) {
    int tid = tid_in; asm volatile("" : "+v"(tid));
    const int hd = tid >> 6, lane = tid & 63, r32 = lane & 31, hi = lane >> 5;
    bf16x8 bq[4];
    { const bf16* qp = P1 + (size_t)(tok0 + r32) * N1 + OFF_Q + hd * 64 + 8 * hi;
#pragma unroll
      for (int s = 0; s < 4; ++s) bq[s] = *(const bf16x8*)(qp + 16 * s); }
    const bf16* wp = WUKT + (size_t)hd * 8192 + (size_t)r32 * 64 + 8 * hi;
#pragma unroll
    for (int mt = 0; mt < 4; ++mt) {
        f32x16 acc = {};
#pragma unroll
        for (int s = 0; s < 4; ++s) { const bf16x8 af = *(const bf16x8*)(wp + mt * 2048 + 16 * s); acc = __builtin_amdgcn_mfma_f32_32x32x16_bf16(af, bq[s], acc, 0, 0, 0); }
#pragma unroll
        for (int r4 = 0; r4 < 4; ++r4) { float q_[4];
#pragma unroll
            for (int e = 0; e < 4; ++e) q_[e] = fminf(fmaxf(acc[4 * r4 + e] * 16.0f, -448.f), 448.f);
            const int t_ = __builtin_amdgcn_cvt_pk_fp8_f32(q_[0], q_[1], 0, false);
            *(LAS unsigned*)(lds + (r32 * 8 + hd) * 128 + 32 * mt + 8 * r4 + 4 * hi) = (unsigned)__builtin_amdgcn_cvt_pk_fp8_f32(q_[2], q_[3], t_, true); }
    }
}

__device__ __forceinline__ void attn_item(const bf16* __restrict__ P1, const bf16* __restrict__ WUKT, const unsigned char* __restrict__ Cb, const unsigned char* __restrict__ CT8b, unsigned char* __restrict__ MIXp, const bf16* __restrict__ WUVT, int tok0, int pos0, int n, LAS char* lds, const int tid_in) {
    int tid = tid_in; asm volatile("" : "+v"(tid));
    const int wid = tid >> 6, lane = tid & 63, r32 = lane & 31, hi = lane >> 5;
    LAS char* V_lds = lds; LAS char* K_lds = lds + 2 * SHM_V;
    LAS float* wsl = (LAS float*)(lds + 2 * SHM_V + 2 * SHM_K) + wid * 64; LAS float* li_l = wsl; LAS float* al_l = wsl + 32;
    const LAS u32x4* mwl = (const LAS u32x4*)(lds + SHM_ATTN) + tid;
    float m_reg = -1e30f, l_reg = 0; f32x16 o[4] = {}; v8i qr8[2];
    const int ql_ = r32 >> 3, hd = r32 & 7;
    const int NT = n >> 6, NTP = (NT + 1) & ~1;
#define TILE_K0(j) (((j) < NT) ? (NT - 1 - (j)) * KVBLK : 0)
    const int vtw = (tid >> 2) * VT_PITCH + (tid & 3) * 16;
    const int kgo = (tid >> 3) * 128 + (tid & 7) * 16, kwo = (tid >> 3) * 128 + (((tid & 7) ^ ((tid >> 4) & 7)) << 4);
    struct { u32x4 k8, vt; } sr_[2];
#define SLOAD(i, k0) do { sr_[i].k8 = *(const u32x4*)(Cb + (size_t)(k0) * 128 + kgo); sr_[i].vt = *(const u32x4*)(CT8b + (size_t)((k0) >> 6) * 8192 + tid * 16); } while (0)
    constexpr int SE = 0, SO = 1;
    SLOAD(SE, TILE_K0(0)); SLOAD(SO, TILE_K0(1));
    qlat_stage(P1, WUKT, tok0, lds, tid);
    __syncthreads();
    { const LAS char* Qw = lds + ((4 * wid + ql_) * 8 + hd) * 128 + hi * 32;
#pragma unroll
      for (int sx = 0; sx < 2; ++sx) { const v4i lo = *(const LAS v4i*)(Qw + 64 * sx), hi_ = *(const LAS v4i*)(Qw + 64 * sx + 16); qr8[sx] = __builtin_shufflevector(lo, hi_, 0, 1, 2, 3, 4, 5, 6, 7); } }
    const float qposf = (float)(pos0 + 4 * wid + ql_);
    bf16x8 ef; { u32x4 w = {0u, 0u, 0u, 0u}; w.x = ((ql_ == 2 * hi) ? 0x3F80u : 0u) | ((ql_ == 2 * hi + 1) ? 0x3F800000u : 0u); w.y = (hi == 0) ? ((unsigned)(137 - hd) << 7) : 0u; ef = *reinterpret_cast<bf16x8*>(&w); }
#define MASKW(s_) 0
#define MKAX(j, ax0, ax1) do { const unsigned klw0 = (hi == 0) ? (__float_as_uint((float)r32) >> 16) : 0u, klw1 = (hi == 0) ? (__float_as_uint((float)(32 + r32)) >> 16) : 0u;   \
        u32x4 w0_ = {NEG2, klw0, 0u, 0u}, w1_ = {NEG2, klw1, 0u, 0u}; if ((j) < NT) { const u32x4 Wv_ = *mwl; const int sh_ = 2 * (NT - 1 - (j)); \
            const unsigned v0_ = (unsigned)((((unsigned long long)Wv_.y << 32) | Wv_.x) >> sh_), v1_ = (unsigned)((((unsigned long long)Wv_.w << 32) | Wv_.z) >> sh_); \
            const unsigned mA_ = (v0_ & 1u) | ((v1_ & 1u) << 16), mB_ = ((v0_ >> 1) & 1u) | ((v1_ & 2u) << 15); \
            w0_.x = NEG2 & ~(mA_ * 0xffffu); w1_.x = NEG2 & ~(mB_ * 0xffffu); } \
        ax0 = *reinterpret_cast<bf16x8*>(&w0_); ax1 = *reinterpret_cast<bf16x8*>(&w1_); } while (0)
#define TILE_B0(j) ({ int r__ = r32; asm volatile("" : "+v"(r__)); const float sl__ = __uint_as_float((unsigned)(126 - (r__ & 7)) << 23) * LOG2E; \
        sl__ * ((float)TILE_K0(j) - (float)(pos0 + 4 * wid + (r__ >> 3))); })
    const LAS char* vb0 = V_lds + r32 * VT_PITCH + 32 * hi;
    constexpr int VSL = 128 * VT_PITCH, KSL = 64 * 128;
#define SWRITE(slot, i) do { *(LAS u32x4*)(V_lds + (slot) * VSL + vtw) = sr_[i].vt; *(LAS u32x4*)(K_lds + (slot) * KSL + kwo) = sr_[i].k8; } while (0)
#define SWAIT() asm volatile("s_waitcnt vmcnt(2)" ::: "memory")
#define RESC(a) do { if (__any((a) < 1.f)) { MFMA_DRAIN(); if (hi == 0) al_l[r32] = (a); asm volatile("s_waitcnt lgkmcnt(0)" ::: "memory"); \
    _Pragma("unroll") for (int d = 0; d < 4; ++d) _Pragma("unroll") for (int r = 0; r < 16; ++r) o[d][r] *= al_l[crow(r, hi)]; } } while (0)
    f32x16 pA0, pA1, pB0, pB1; float mnA, mnB, alA, alB; v8i P8; bf16x8 ax0, ax1;
    asm volatile("s_waitcnt vmcnt(0) lgkmcnt(0)" ::: "memory"); __syncthreads();
    SWRITE(0, SE); __syncthreads();
    MKAX(0, ax0, ax1); qkt(pA0, pA1, K_lds, qr8, ax0, ax1, ef, r32, hi);
    asm volatile("s_nop 15\n\ts_nop 15\n\ts_nop 15\n\ts_nop 15\n\ts_nop 15" : "+v"(pA0), "+v"(pA1));
    {
        const float base = (float)TILE_K0(0) - qposf + (float)(4 * hi), s16 = -2.0f * __uint_as_float((unsigned)(137 - hd) << 23);
#pragma unroll
        for (int r = 0; r < 16; ++r) { const float cr = (float)((r & 3) + 8 * (r >> 2));
            pA0[r] = fmaf(s16, fmaxf(base + cr, 0.f), pA0[r]); pA1[r] = fmaf(s16, fmaxf(base + cr + 32.f, 0.f), pA1[r]); }
    }
    partialSM(pA0, pA1, TILE_B0(0), m_reg, mnA, alA);
    if (2 < NTP) SLOAD(SE, TILE_K0(2));
    SWAIT(); SWRITE(1, SO); __syncthreads();
    int rp = 0, rc = 1, rn = 2;
#define RING_STEP() do { const int t__ = rp; rp = rc; rc = rn; rn = t__; } while (0)
    for (int j = 1; j + 1 < NTP; j += 2) {
        SBAR(); MKAX(j, ax0, ax1); qkt(pB0, pB1, K_lds + rc * KSL, qr8, ax0, ax1, ef, r32, hi);
        finishSM(pA0, pA1, alA, l_reg, P8); SBAR();
        SLOAD(SO, TILE_K0(j + 2)); SBAR();
        pv_d0(o, vb0 + rp * VSL, P8); PTOUCH(pB0, pB1); partialSM(pB0, pB1, TILE_B0(j), m_reg, mnB, alB);
        SWAIT(); SWRITE(rn, SE);
        RESC(alB); __syncthreads(); RING_STEP();
        SBAR(); MKAX(j + 1, ax0, ax1); qkt(pA0, pA1, K_lds + rc * KSL, qr8, ax0, ax1, ef, r32, hi);
        finishSM(pB0, pB1, alB, l_reg, P8); SBAR();
        if (j + 3 < NTP) SLOAD(SE, TILE_K0(j + 3)); SBAR();
        pv_d0(o, vb0 + rp * VSL, P8); PTOUCH(pA0, pA1); partialSM(pA0, pA1, TILE_B0(j + 1), m_reg, mnA, alA);
        SWAIT(); SWRITE(rn, SO);
        RESC(alA); __syncthreads(); RING_STEP();
    }
    SBAR(); MKAX(NTP - 1, ax0, ax1); qkt(pB0, pB1, K_lds + rc * KSL, qr8, ax0, ax1, ef, r32, hi);
    finishSM(pA0, pA1, alA, l_reg, P8); SBAR();
    pv_d0(o, vb0 + rp * VSL, P8); PTOUCH(pB0, pB1); partialSM(pB0, pB1, TILE_B0(NTP - 1), m_reg, mnB, alB);
    RESC(alB);
    finishSM(pB0, pB1, alB, l_reg, P8); SBAR();
    pv_d0(o, vb0 + rc * VSL, P8);
#undef RING_STEP
    MFMA_DRAIN();
    if (hi == 0) li_l[r32] = l_reg; asm volatile("s_waitcnt lgkmcnt(0)" ::: "memory");
    float rli[16];
#pragma unroll
    for (int r = 0; r < 16; ++r) rli[r] = __builtin_amdgcn_rcpf(li_l[crow(r, hi)]) * (1.0f / 16.0f);
    __syncthreads();
#pragma unroll
    for (int r = 0; r < 16; ++r) { const int orow = crow(r, hi);
        LAS bf16* zp = (LAS bf16*)lds + ((4 * wid + (orow >> 3)) * 8 + (orow & 7)) * 128 + r32;
#pragma unroll
        for (int d0 = 0; d0 < 4; ++d0) zp[d0 * 32] = (bf16)f2bf(o[d0][r] * rli[r]); }
    __syncthreads();
    {
        typedef unsigned u32x2 __attribute__((ext_vector_type(2)));
        bf16x8 bo[8];
        { const LAS char* zq = lds + ((r32 * 8 + wid) * 128 + 8 * hi) * 2;
#pragma unroll
          for (int s = 0; s < 8; ++s) bo[s] = *(const LAS bf16x8*)(zq + s * 32); }
        const bf16* wv = WUVT + (size_t)wid * 8192 + (size_t)r32 * 128 + 8 * hi;
#pragma unroll
        for (int mt = 0; mt < 2; ++mt) {
            f32x16 acc = {};
#pragma unroll
            for (int s = 0; s < 8; ++s) { const bf16x8 af = *(const bf16x8*)(wv + mt * 4096 + 16 * s); acc = __builtin_amdgcn_mfma_f32_32x32x16_bf16(af, bo[s], acc, 0, 0, 0); }
            unsigned char* op = MIXp + (size_t)(tok0 + r32) * K2 + wid * 64 + 32 * mt + 4 * hi;
#pragma unroll
            for (int r4 = 0; r4 < 4; ++r4) { float q_[4];
#pragma unroll
                for (int e = 0; e < 4; ++e) q_[e] = fminf(fmaxf(acc[4 * r4 + e] * 16.0f, -448.f), 448.f);
                const int t_ = __builtin_amdgcn_cvt_pk_fp8_f32(q_[0], q_[1], 0, false); *(unsigned*)(op + 8 * r4) = (unsigned)__builtin_amdgcn_cvt_pk_fp8_f32(q_[2], q_[3], t_, true); }
        }
    }
    __syncthreads();
#undef SLOAD
#undef SWRITE
#undef SWAIT
#undef RESC
#undef TILE_K0
#undef MASKW
#undef MKAX
#undef TILE_B0
}
}

__device__ __forceinline__ int tid_from(const int wid6) { int l; asm volatile("v_mbcnt_lo_u32_b32 %0, -1, 0\n\tv_mbcnt_hi_u32_b32 %0, -1, %0" : "=v"(l)); return wid6 | l; }
__device__ __forceinline__ void ph_attn_fast(const Args& a, LAS unsigned char* lds, const int variant, const int wid6) {
    const bf16* P1 = (const bf16*)(a.ws + WS_P1); unsigned char* MIX = a.ws + WS_MIX;
    const int G = gridDim.x;
    for (int it = blockIdx.x; it < BATCH * 64; it += G) {
        const int tid = tid_from(wid6);
        const int lane = tid & 63, wid = tid >> 6;
        const int gg = it & 255, m = it >> 8;
        const int b = (gg & 7) + 8 * (gg >> 6), jg = (gg >> 3) & 7, qb = (m & 1) ? (63 - jg - 8 * (m >> 1)) : (jg + 8 * (m >> 1));
        const int pos0 = qb * 32, tok0 = b * SEQ + pos0, n = ((pos0 >> 6) + 1) << 6;
        { unsigned w0l, w0h, w1l, w1h;
          if (variant == 2) { w0l = w0h = w1l = w1h = 0xffffffffu; }
          else if (ATT_VARIANT == 3 && variant == 3) dsa::idx_select<3>(P1, b, tok0 + 4 * wid, n, tid, (LAS char*)lds, (const float*)(a.ws + WS_ZT), w0l, w0h, w1l, w1h);
          else dsa::idx_select<0>(P1, b, tok0 + 4 * wid, n, tid, (LAS char*)lds, (const float*)(a.ws + WS_ZT), w0l, w0h, w1l, w1h);
          ((LAS dsa::u32x4*)(lds + dsa::SHM_ATTN))[tid] = (dsa::u32x4){w0l, w0h, w1l, w1h};
          asm volatile("s_waitcnt lgkmcnt(0)" ::: "memory");
          if (ATT_VARIANT && (variant == 1 || variant == 3)) { __syncthreads(); continue; } }
        dsa::attn_item(P1, (const bf16*)(a.ws + WS_WUKT), a.ws + WS_CN + (size_t)b * SEQ * 128, a.ws + WS_CT8 + (size_t)b * (SEQ / 64) * 8192, variant ? ((a.ws + WS_END) - (size_t)tok0 * K2 + (size_t)(tok0 & 4095) * K2) : MIX, (const bf16*)(a.ws + WS_WUVT), tok0, pos0, n, (LAS char*)lds, tid);
    }
}

__device__ __forceinline__ void ph_fixup(const Args& a, int gtid, int gthreads) {
    const float* HF = (const float*)(a.ws + WS_HF); const float* HL = (const float*)(a.ws + WS_HL); const float* CONVP = (const float*)(a.ws + WS_CONVP); unsigned char* ACT = a.ws + WS_ACT;
    constexpr int CH = FF / 4;
    for (int i = gtid; i < (NTOK / 256) * 2 * CH; i += gthreads) {
        const int pm = i / (2 * CH), rem = i - pm * (2 * CH), t = rem / CH, ch = rem - t * CH;
        if ((pm & 7) == 0) continue;
        const int jc = ch * 4, j = jc >> 7, ii = jc & 127, cg_ = 256 * j + ii;
        float r[4];
        f32x4 v[2];
#pragma unroll
        for (int half = 0; half < 2; ++half) {
            const int c = cg_ + half * 128;
            const f32x4 lm2 = *(const f32x4*)(HL + (size_t)((pm - 1) * 2 + 0) * N3 + c), lm1 = *(const f32x4*)(HL + (size_t)((pm - 1) * 2 + 1) * N3 + c);
            const f32x4 f0 = *(const f32x4*)(HF + (size_t)(pm * 2 + 0) * N3 + c), f1 = *(const f32x4*)(HF + (size_t)(pm * 2 + 1) * N3 + c);
            const f32x4 w0 = *(const f32x4*)(CONVP + c), w1 = *(const f32x4*)(CONVP + N3 + c), w2 = *(const f32x4*)(CONVP + 2 * N3 + c), bb = *(const f32x4*)(CONVP + 3 * N3 + c);
            v[half] = (t == 0) ? (bb + w0 * lm2 + w1 * lm1 + w2 * f0) : (bb + w0 * lm1 + w1 * f0 + w2 * f1);
        }
#pragma unroll
        for (int e = 0; e < 4; ++e) r[e] = v[0][e] / (1.0f + __expf(-v[0][e])) * v[1][e];
#pragma unroll
        for (int e = 0; e < 4; ++e) r[e] = fminf(fmaxf(r[e] * 8.0f, -448.f), 448.f);
        const int t_ = __builtin_amdgcn_cvt_pk_fp8_f32(r[0], r[1], 0, false);
        *(unsigned*)(ACT + (size_t)(pm * 256 + t) * FF + jc) = (unsigned)__builtin_amdgcn_cvt_pk_fp8_f32(r[2], r[3], t_, true);
    }
}

__device__ __forceinline__ void ph_final(const Args& a, int gw, int ngw, int lane) {
    const bf16* X2 = (const bf16*)(a.ws + WS_X2); const float* ss3 = (const float*)(a.ws + WS_CTL + 256 * 1024);
    for (int m = gw; m < NTOK; m += ngw) {
        const float rinv = 1.0f / sqrtf(ss3[m] * (1.0f / DM) + EPS);
#pragma unroll
        for (int h2 = 0; h2 < 2; ++h2) {
            const int c0 = h2 * 512 + 8 * lane;
            const v4u t = *(const v4u*)(X2 + (size_t)m * DM + c0);
            const f32x4 g0 = *(const f32x4*)(a.g_final + c0), g1 = *(const f32x4*)(a.g_final + c0 + 4);
            f32x4 o0, o1;
            o0.x = bflo(t.x) * rinv * g0.x; o0.y = bfhi(t.x) * rinv * g0.y; o0.z = bflo(t.y) * rinv * g0.z; o0.w = bfhi(t.y) * rinv * g0.w;
            o1.x = bflo(t.z) * rinv * g1.x; o1.y = bfhi(t.z) * rinv * g1.y; o1.z = bflo(t.w) * rinv * g1.z; o1.w = bfhi(t.w) * rinv * g1.w;
            *(f32x4*)(a.out + (size_t)m * DM + c0) = o0; *(f32x4*)(a.out + (size_t)m * DM + c0 + 4) = o1;
        }
    }
}

#define XB_TMO      128
#define XB_XCNT(j)  (256  + 64 * (j))
#define XB_XSUB(j)  (1280 + 64 * (j))
#define XB_XGEN(j)  (2304 + 64 * (j))
#define XB_TOP      3328
#define XB_TOPGEN   3392
#define XCD_BAR_WORDS 3456
#define XB_SPIN_CAP (1u << 18)
__device__ __forceinline__ unsigned xb_ld(unsigned* p)              { return __hip_atomic_load(p, __ATOMIC_RELAXED, __HIP_MEMORY_SCOPE_AGENT); }
__device__ __forceinline__ unsigned xb_add(unsigned* p, unsigned v) { return __hip_atomic_fetch_add(p, v, __ATOMIC_RELAXED, __HIP_MEMORY_SCOPE_AGENT); }
__device__ __forceinline__ unsigned xb_xcc_id() { return (unsigned)__builtin_amdgcn_s_getreg((3 << 11) | 20) & 0xFu; }
#define XB_SPIN(cond, bar) do { unsigned _sp = 0; while (cond) { __builtin_amdgcn_s_sleep(1); \
    if ((++_sp & 255u) == 0u) { if (xb_ld(&(bar)[XB_TMO])) break; if (_sp > XB_SPIN_CAP) { atomicAdd(&(bar)[XB_TMO], 1u); break; } } } } while (0)
struct XcdBarrier { unsigned* bar; unsigned x; volatile LAS unsigned* st; };
__device__ __forceinline__ XcdBarrier xcd_barrier_post(unsigned* bar, volatile LAS unsigned* st, const int tid) {
    XcdBarrier b; b.bar = bar; b.x = xb_xcc_id(); b.st = st;
    if (tid == 0) (void)xb_add(&bar[XB_XCNT(b.x)], 1u);
    return b;
}
__device__ __forceinline__ void xcd_barrier_complete(unsigned* bar, unsigned x, unsigned& nloc, unsigned& nx) {
    const unsigned G = gridDim.x * gridDim.y * gridDim.z;
    unsigned sum, cnt, mine, sp = 0u;
    for (;;) {
        sum = 0u; cnt = 0u; mine = 0u;
#pragma unroll
        for (unsigned j = 0; j < 16; ++j) { const unsigned c = xb_ld(&bar[XB_XCNT(j)]); sum += c; cnt += (c > 0u) ? 1u : 0u; mine = (j == x) ? c : mine; }
        if (sum == G) break;
        __builtin_amdgcn_s_sleep(1);
        if ((++sp & 255u) == 0u) { if (xb_ld(&bar[XB_TMO])) break; if (sp > XB_SPIN_CAP) { atomicAdd(&bar[XB_TMO], 1u); break; } }
    }
    nloc = mine > 0u ? mine : 1u; nx = cnt > 0u ? cnt : 1u;
}
__device__ __forceinline__ void xcd_barrier(const XcdBarrier& b, const int tid) {
    asm volatile("s_waitcnt vmcnt(0)" ::: "memory");
    __syncthreads();
    if (tid == 0) {
        unsigned* bar = b.bar;
        __builtin_amdgcn_s_waitcnt(0);
        unsigned nloc = b.st[0], nx = b.st[1];
        if (nloc == 0u) { xcd_barrier_complete(bar, b.x, nloc, nx); b.st[0] = nloc; b.st[1] = nx; }
        const unsigned old = xb_add(&bar[XB_XSUB(b.x)], 1u);
        const unsigned gen = old / nloc;
        if (old + 1u == (gen + 1u) * nloc) {
            __builtin_amdgcn_fence(__ATOMIC_RELEASE, "agent");
            asm volatile("s_waitcnt vmcnt(0)" ::: "memory");
            const unsigned og = xb_add(&bar[XB_TOP], 1u);
            const unsigned tg = og / nx;
            if (og + 1u == (tg + 1u) * nx) xb_add(&bar[XB_TOPGEN], 1u);
            else XB_SPIN(xb_ld(&bar[XB_TOPGEN]) == tg, bar);
            __builtin_amdgcn_fence(__ATOMIC_ACQUIRE, "agent");
            xb_add(&bar[XB_XGEN(b.x)], 1u);
            asm volatile("s_waitcnt vmcnt(0)" ::: "memory");
        } else {
            XB_SPIN(xb_ld(&bar[XB_XGEN(b.x)]) == gen, bar);
            __builtin_amdgcn_fence(__ATOMIC_ACQUIRE, "agent");
            asm volatile("s_waitcnt vmcnt(0)" ::: "memory");
        }
    }
    __syncthreads();
}

constexpr int NPHASE = 8;
#define IDS() const int tid = TIDK, lane = tid & 63, wave = __builtin_amdgcn_readfirstlane(tid >> 6); const int G = gridDim.x; \
    const int gtid = blockIdx.x * (NWAVES * 64) + tid, gthreads = G * NWAVES * 64, gw = blockIdx.x * NWAVES + wave, ngw = G * NWAVES; (void)lane; (void)wave; (void)gtid; (void)gthreads; (void)gw; (void)ngw;
__global__ void __launch_bounds__(NWAVES * 64, 2) fwd_kernel(Args a_unused) {
    extern __shared__ __attribute__((aligned(16))) unsigned char lds_raw[];
    LAS unsigned char* lds = (LAS unsigned char*)lds_raw;
    const kargp_t kp = (kargp_t)__builtin_amdgcn_kernarg_segment_ptr();
    const int lo = karg_int<136>(kp), hi = karg_int<140>(kp);
#define LOADA() const Args a = load_args(kp)
    volatile LAS unsigned* xb_st = (volatile LAS unsigned*)(lds + XB_LDS_OFF);
    const int wid6 = __builtin_amdgcn_readfirstlane((int)threadIdx.x) & ~63;
#define TIDK tid_from(wid6)
    { const int t0 = TIDK; if (t0 < 4) xb_st[t0] = 0u;
      __syncthreads();
      (void)xcd_barrier_post((unsigned*)((unsigned char*)karg_ptr<128>(kp) + WS_CTL + XB_CTL_OFF) + karg_int<144>(kp) * XCD_BAR_WORDS, xb_st, t0); }
    if (lo < 0) cg::this_grid().sync();
#define IN(k) (lo <= (k) && (k) < hi)
#define SEAM(k) do { if (IN(k) && IN((k) + 1)) { { XcdBarrier xb_; xb_.bar = (unsigned*)((unsigned char*)karg_ptr<128>(kp) + WS_CTL + XB_CTL_OFF) + karg_int<144>(kp) * XCD_BAR_WORDS; xb_.x = xb_xcc_id(); \
        xb_.st = (volatile LAS unsigned*)(lds + XB_LDS_OFF); xcd_barrier(xb_, TIDK); } } } while (0)
    if (IN(0)) { LOADA(); IDS(); ph_prologue(a, lds, tid, gtid, gthreads, gw, ngw, lane); }
    SEAM(0);
    if (IN(1)) {
        unsigned char* ws = (unsigned char*)karg_ptr<128>(kp);
        pg8::Gemm g{(const bf16*)(ws + WS_HB), (const bf16*)(ws + WS_W1T), NTOK, N1, DM}; pg8::StaticOrder S; S.init(NTOK, N1, (int)gridDim.x, (int)blockIdx.x);
        pg8::EpiStore E{(bf16*)(ws + WS_P1), N1, nullptr};
        pg8::gemm_phase<pg8::EpiStore, pg8::StaticOrder, true, true>(lds, g, S, E, TIDK);
    }
    SEAM(1);
    if (IN(2)) { LOADA(); IDS(); ph_cnorm_pool(a, gw, ngw, lane); }
    SEAM(2);
    if (IN(3)) { LOADA(); ph_attn_fast(a, lds, (ATT_VARIANT && a.li == 1) ? ATT_VARIANT : 0, wid6); }
    SEAM(3);
    if (IN(4)) {
        unsigned char* ws = (unsigned char*)karg_ptr<128>(kp);
        pg8::Gemm g{(const bf16*)(ws + WS_MIX), (const bf16*)(ws + WS_W2T), NTOK, DM, K2 / 2}; pg8::StaticOrder S; S.init(NTOK, DM, (int)gridDim.x, (int)blockIdx.x);
        pg8::EpiResid<false> E{(const void*)(ws + WS_HB), (bf16*)(ws + WS_X1B), (float*)(ws + WS_CTL), ws + WS_X1F8, 1.0f / 1024.0f, (const float*)(ws + WS_RS), (const float*)karg_ptr<8>(kp)};
        pg8::gemm_phase<pg8::EpiResid<false>, pg8::StaticOrder, true, true, true>(lds, g, S, E, TIDK);
    }
    SEAM(4);
    if (IN(5)) {
        unsigned char* ws = (unsigned char*)karg_ptr<128>(kp);
        pg8::Gemm g{(const bf16*)(ws + WS_X1F8), (const bf16*)(ws + WS_W3T), NTOK, N3, DM / 2}; pg8::StaticOrder S; S.init(NTOK, N3, (int)gridDim.x, (int)blockIdx.x);
        pg8::EpiConvGlu E{ws + WS_ACT, (const float*)(ws + WS_CTL), (const float*)(ws + WS_CONVP), (float*)(ws + WS_HF), (float*)(ws + WS_HL), (LAS float*)(lds + HALO_LDS_OFF)};
        pg8::gemm_phase<pg8::EpiConvGlu, pg8::StaticOrder, true, true, true>(lds, g, S, E, TIDK);
    }
    SEAM(5);
    if (IN(6)) { LOADA(); IDS(); ph_fixup(a, gtid, gthreads); }
    SEAM(6);
    if (IN(7)) {
        unsigned char* ws = (unsigned char*)karg_ptr<128>(kp);
        pg8::Gemm g{(const bf16*)(ws + WS_ACT), (const bf16*)(ws + WS_W4T), NTOK, DM, FF / 2}; pg8::StaticOrder S; S.init(NTOK, DM, (int)gridDim.x, (int)blockIdx.x);
        pg8::EpiFinal E{(const bf16*)(ws + WS_X1B), (float*)karg_ptr<120>(kp), (float*)(ws + WS_CTL + 256 * 1024), (unsigned*)(ws + WS_CTL + PCNT_CTL_OFF), (const float*)karg_ptr<112>(kp)};
        pg8::gemm_phase<pg8::EpiFinal, pg8::StaticOrder, true, true, true>(lds, g, S, E, TIDK);
    }
#undef IN
#undef SEAM
}

extern "C" void kernel_launch(void* const* d_in, const int* in_sizes, int n_in, void* d_out, int out_size, void* d_ws, size_t ws_size, hipStream_t stream) {
    static int grid = 0;
    if (grid == 0) {
        if (n_in != 15 || in_sizes[0] != NTOK * DM || out_size != NTOK * DM || ws_size < WS_END) { fprintf(stderr, "kernel_launch: unexpected shapes / workspace (n_in %d, ws %zu)\n", n_in, ws_size); grid = -1; return; }
        int dev = 0, cus = 0, per_cu = 0;
        hipGetDevice(&dev); hipDeviceGetAttribute(&cus, hipDeviceAttributeMultiprocessorCount, dev);
        if (hipFuncSetAttribute((const void*)fwd_kernel, hipFuncAttributeMaxDynamicSharedMemorySize, LDS_BYTES) != hipSuccess) { fprintf(stderr, "kernel_launch: hipFuncSetAttribute failed\n"); grid = -1; return; }
        if (hipOccupancyMaxActiveBlocksPerMultiprocessor(&per_cu, (const void*)fwd_kernel, NWAVES * 64, LDS_BYTES) != hipSuccess || per_cu < 1) { fprintf(stderr, "kernel_launch: occupancy query says %d\n", per_cu); per_cu = 1; }
        (void)hipGetLastError();
        grid = cus;
        if (grid != 256) fprintf(stderr, "kernel_launch: %d CUs (tuned for 256)\n", grid);
    }
    if (grid < 0) return;
    hipMemsetAsync((char*)d_ws + WS_CTL, 0, CTL_ZERO_BYTES, stream);
    Args a{};
    a.x = (const float*)d_in[0]; a.g_mix = (const float*)d_in[1]; a.w_in = (const float*)d_in[2]; a.g_kv = (const float*)d_in[3]; a.w_uk = (const float*)d_in[4]; a.w_uv = (const float*)d_in[5];
    a.w_pool = (const float*)d_in[6]; a.pool_scale = (const float*)d_in[7]; a.w_o = (const float*)d_in[8]; a.g_ffn = (const float*)d_in[9]; a.w_up = (const float*)d_in[10];
    a.conv_w = (const float*)d_in[11]; a.conv_b = (const float*)d_in[12]; a.w_down = (const float*)d_in[13]; a.g_final = (const float*)d_in[14];
    a.out = (float*)d_out; a.ws = (unsigned char*)d_ws;
#if REP_PH >= 0
    { void* args[] = {&a};
      if (REP_PH >= 100) {
        a.ph_lo = 0; a.ph_hi = NPHASE; a.li = 0; hipLaunchCooperativeKernel((const void*)fwd_kernel, dim3(grid), dim3(NWAVES * 64), args, LDS_BYTES, stream);
        a.ph_lo = 0; a.ph_hi = REP_PH - 100; a.li = 1; hipLaunchCooperativeKernel((const void*)fwd_kernel, dim3(grid), dim3(NWAVES * 64), args, LDS_BYTES, stream);
      } else if (REP_PH == 4 || REP_PH == 7) {
        a.ph_lo = 0; a.ph_hi = NPHASE; a.li = 0; hipLaunchCooperativeKernel((const void*)fwd_kernel, dim3(grid), dim3(NWAVES * 64), args, LDS_BYTES, stream);
        a.ph_lo = REP_PH; a.ph_hi = REP_PH + 1; a.li = 1; hipLaunchCooperativeKernel((const void*)fwd_kernel, dim3(grid), dim3(NWAVES * 64), args, LDS_BYTES, stream);
      } else {
      a.ph_lo = 0; a.ph_hi = REP_PH + 1; a.li = 0; hipLaunchCooperativeKernel((const void*)fwd_kernel, dim3(grid), dim3(NWAVES * 64), args, LDS_BYTES, stream);
      a.ph_lo = REP_PH; a.ph_hi = REP_PH + 1; a.li = 1; hipLaunchCooperativeKernel((const void*)fwd_kernel, dim3(grid), dim3(NWAVES * 64), args, LDS_BYTES, stream);
      if (REP_PH + 1 < NPHASE) { a.ph_lo = REP_PH + 1; a.ph_hi = NPHASE; a.li = 2; hipLaunchCooperativeKernel((const void*)fwd_kernel, dim3(grid), dim3(NWAVES * 64), args, LDS_BYTES, stream); } } }
#elif MK_ONE_LAUNCH
    a.ph_lo = 0; a.ph_hi = NPHASE;
    void* args[] = {&a};
    hipError_t e = hipLaunchCooperativeKernel((const void*)fwd_kernel, dim3(grid), dim3(NWAVES * 64), args, LDS_BYTES, stream);
    if (e != hipSuccess) fprintf(stderr, "cooperative launch failed: %s (grid %d)\n", hipGetErrorString(e), grid);
#else
    for (int ph = 0; ph < NPHASE; ++ph) {
        a.ph_lo = ph; a.ph_hi = ph + 1;
        hipLaunchKernelGGL(fwd_kernel, dim3(grid), dim3(NWAVES * 64), LDS_BYTES, stream, a);
    }
#endif
}
```

```cpp
#include <hip/hip_runtime.h>
#include <hip/hip_cooperative_groups.h>
#include <cstdio>
#include <cstdint>
namespace cg = cooperative_groups;

#ifndef USE_NAIVE_ATTN
#define USE_NAIVE_ATTN 0
#endif
#ifndef REP_PH
#define REP_PH -1
#endif
#ifndef ATT_VARIANT
#define ATT_VARIANT 0
#endif
#ifndef MK_ONE_LAUNCH
#define MK_ONE_LAUNCH 1
#endif

namespace pg8 {
#define PG8_LAS __attribute__((address_space(3)))
typedef unsigned short bf16_t;
typedef short bf16x8 __attribute__((ext_vector_type(8)));
typedef float f32x4 __attribute__((ext_vector_type(4)));
typedef unsigned u32x4 __attribute__((ext_vector_type(4)));
constexpr int BM = 256, BK = 64, HALF = 128, HTB = HALF * BK * 2, STAGE_BYTES = 8 * HTB, NXCD = 8, WGM = 8;

__host__ __device__ __forceinline__ int lds_byte(int r, int c) { const int st = (r >> 4) * 2 + (c >> 5), rr = r & 15, cc = c & 31, ob = rr * 64 + cc * 2; return st * 1024 + (ob ^ (((ob >> 9) & 1) << 5)); }
__host__ __device__ __forceinline__ void stage_rc(int b, int& R, int& C) { const int st = b / 1024, sb = b % 1024, swz = sb ^ (((sb >> 9) & 1) << 5); R = (st >> 1) * 16 + swz / 64; C = (st & 1) * 32 + (swz % 64) / 2; }
__host__ __device__ __forceinline__ int perm32(int rho) { const int n = rho >> 4, i = rho & 15; return 8 * (i >> 2) + 4 * n + (i & 3); }

struct Unit { int pm, pn; };
struct Gemm { const bf16_t* A; const bf16_t* Bt; int M, N, K; };

struct StaticOrder {
    int nM, nN, nwg, G, c;
    __host__ __device__ void init(int M, int N, int G_, int c_) { nM = M / BM; nN = N / BM; nwg = nM * nN; G = G_; c = c_; }
    __host__ __device__ bool next(int i, Unit& u) const {
        const long L = (long)i * G + c; if (L >= nwg) return false;
        int wgid = (int)L; { const int q = nwg / NXCD, r = nwg % NXCD, xcd = wgid % NXCD, off = wgid / NXCD; wgid = (xcd < r ? xcd * (q + 1) : r * (q + 1) + (xcd - r) * q) + off; }
        const int nig = WGM * nN, gid = wgid / nig, fm = gid * WGM, gsz = (nM - fm) < WGM ? (nM - fm) : WGM;
        u.pm = fm + ((wgid % nig) % gsz); u.pn = (wgid % nig) / gsz; return true;
    }
    __device__ __forceinline__ void a_ready(const Unit&) const {}
    __device__ __forceinline__ void done(const Unit&) const {}
};

__device__ __forceinline__ unsigned cvt_pk_bf16(float lo, float hi) { unsigned r; asm volatile("v_cvt_pk_bf16_f32 %0, %1, %2" : "=v"(r) : "v"(lo), "v"(hi)); return r; }


struct EpiStore {
    static constexpr bool PERM = true, AFTER_DRAIN = false;
    bf16_t* O; int ldc; const float* sumsq;
    __device__ __forceinline__ void operator()(const f32x4 (&acc)[2][2][4][2], const Unit& u, int wr, int wc, int fr, int fq) const {
        const int row0 = u.pm * BM + wr * 64 + fr, col0 = u.pn * BM + wc * 32 + 8 * fq;
#pragma unroll
        for (int ai = 0; ai < 2; ++ai)
#pragma unroll
            for (int m = 0; m < 4; ++m) {
                const int row = row0 + ai * HALF + m * 16;
                float sc = 1.f; if (sumsq) sc = 1.0f / sqrtf(sumsq[row] * (1.0f / 1024.0f) + 1e-6f);
                bf16_t* rowp = O + (size_t)row * ldc + col0;
#pragma unroll
                for (int bj = 0; bj < 2; ++bj) { f32x4 v0 = acc[ai][bj][m][0] * sc, v1 = acc[ai][bj][m][1] * sc;
                    u32x4 w; w.x = cvt_pk_bf16(v0[0], v0[1]); w.y = cvt_pk_bf16(v0[2], v0[3]); w.z = cvt_pk_bf16(v1[0], v1[1]); w.w = cvt_pk_bf16(v1[2], v1[3]);
                    *(u32x4*)(rowp + bj * HALF) = w; } }
    }
};
template <bool BASE_F32> struct EpiResid {
    static constexpr bool PERM = true, AFTER_DRAIN = false;
    const void* base; bf16_t* O; float* sumsq; unsigned char* O8; float accscale; const float* rowfac; const float* colg;
    __device__ __forceinline__ void operator()(const f32x4 (&acc)[2][2][4][2], const Unit& u, int wr, int wc, int fr, int fq) const {
        const int row0 = u.pm * BM + wr * 64 + fr, col0 = u.pn * BM + wc * 32 + 8 * fq;
        f32x4 gi[2][2];
        if (!BASE_F32) {
#pragma unroll
            for (int bj = 0; bj < 2; ++bj)
#pragma unroll
                for (int q = 0; q < 2; ++q) { const f32x4 g_ = *(const f32x4*)(colg + col0 + bj * HALF + 4 * q);
#pragma unroll
                    for (int e = 0; e < 4; ++e) gi[bj][q][e] = __builtin_amdgcn_rcpf(g_[e]); }
        }
#pragma unroll
        for (int ai = 0; ai < 2; ++ai)
#pragma unroll
            for (int m = 0; m < 4; ++m) {
                const int row = row0 + ai * HALF + m * 16; float ss = 0.f;
                float rf = 1.f; if (!BASE_F32) rf = rowfac[row];
#pragma unroll
                for (int bj = 0; bj < 2; ++bj) {
                    const size_t off = (size_t)row * 1024 + col0 + bj * HALF;
                    f32x4 b0, b1;
                    if (BASE_F32) { b0 = *(const f32x4*)((const float*)base + off); b1 = *(const f32x4*)((const float*)base + off + 4); }
                    else { const u32x4 r = *(const u32x4*)((const bf16_t*)base + off);
                        b0[0] = __uint_as_float(r.x << 16); b0[1] = __uint_as_float(r.x & 0xffff0000u); b0[2] = __uint_as_float(r.y << 16); b0[3] = __uint_as_float(r.y & 0xffff0000u);
                        b1[0] = __uint_as_float(r.z << 16); b1[1] = __uint_as_float(r.z & 0xffff0000u); b1[2] = __uint_as_float(r.w << 16); b1[3] = __uint_as_float(r.w & 0xffff0000u);
                        b0 = b0 * rf * gi[bj][0]; b1 = b1 * rf * gi[bj][1]; }
                    const f32x4 v0 = acc[ai][bj][m][0] * accscale + b0, v1 = acc[ai][bj][m][1] * accscale + b1;
                    ss += (v0[0] * v0[0] + v0[1] * v0[1]) + (v0[2] * v0[2] + v0[3] * v0[3]) + (v1[0] * v1[0] + v1[1] * v1[1]) + (v1[2] * v1[2] + v1[3] * v1[3]);
                    u32x4 w; w.x = cvt_pk_bf16(v0[0], v0[1]); w.y = cvt_pk_bf16(v0[2], v0[3]); w.z = cvt_pk_bf16(v1[0], v1[1]); w.w = cvt_pk_bf16(v1[2], v1[3]);
                    *(u32x4*)(O + off) = w;
                    if (O8) { typedef unsigned u32x2_ __attribute__((ext_vector_type(2))); u32x2_ q; int t_;
                        t_ = __builtin_amdgcn_cvt_pk_fp8_f32(v0[0] * 16.f, v0[1] * 16.f, 0, false); q.x = (unsigned)__builtin_amdgcn_cvt_pk_fp8_f32(v0[2] * 16.f, v0[3] * 16.f, t_, true);
                        t_ = __builtin_amdgcn_cvt_pk_fp8_f32(v1[0] * 16.f, v1[1] * 16.f, 0, false); q.y = (unsigned)__builtin_amdgcn_cvt_pk_fp8_f32(v1[2] * 16.f, v1[3] * 16.f, t_, true);
                        *(u32x2_*)(O8 + off) = q; } }
                ss += __shfl_xor(ss, 16); ss += __shfl_xor(ss, 32);
                if (fq == 0) atomicAdd(sumsq + row, ss);
            }
    }
};


struct EpiConvGlu {
    static constexpr bool PERM = true, AFTER_DRAIN = false;
    unsigned char* ACT; const float* sumsq; const float* convp; float* hfirst; float* hlast; PG8_LAS float* halo;
    __device__ __forceinline__ void operator()(f32x4 (&acc)[2][2][4][2], const Unit& u, int wr, int wc, int fr, int fq) const {
        constexpr int N3_ = 5632, FF_ = 2816;
        const int row0 = u.pm * BM + wr * 64 + fr, cq = wc * 32 + 8 * fq;
        f32x4 cpar[2][8];
#pragma unroll
        for (int n = 0; n < 2; ++n) { const float* cp = convp + u.pn * BM + cq + 4 * n;
#pragma unroll
            for (int q = 0; q < 4; ++q) { cpar[n][q] = *(const f32x4*)(cp + q * N3_); cpar[n][4 + q] = *(const f32x4*)(cp + HALF + q * N3_); } }
#pragma unroll
        for (int ai = 0; ai < 2; ++ai)
#pragma unroll
            for (int m = 0; m < 4; ++m) { const float sc = __builtin_amdgcn_rsqf(sumsq[row0 + ai * HALF + m * 16] * (1.0f / 1024.0f) + 1e-6f) * (1.0f / 1024.0f);
#pragma unroll
                for (int bj = 0; bj < 2; ++bj) { acc[ai][bj][m][0] *= sc; acc[ai][bj][m][1] *= sc; } }
#pragma unroll
        for (int ai = 0; ai < 2; ++ai)
#pragma unroll
            for (int bj = 0; bj < 2; ++bj)
#pragma unroll
                for (int m = 0; m < 4; ++m) { asm volatile("" : "+v"(acc[ai][bj][m][0])); asm volatile("" : "+v"(acc[ai][bj][m][1])); }
        __builtin_amdgcn_sched_barrier(0);
        if (fr >= 14) {
#pragma unroll
            for (int ai = 0; ai < 2; ++ai)
#pragma unroll
                for (int bj = 0; bj < 2; ++bj)
#pragma unroll
                    for (int n = 0; n < 2; ++n) *(PG8_LAS f32x4*)(halo + ((2 * ai + wr) * 2 + (fr - 14)) * 256 + bj * HALF + cq + 4 * n) = acc[ai][bj][3][n];
            if (wr == 1) {
#pragma unroll
                for (int bj = 0; bj < 2; ++bj)
#pragma unroll
                    for (int n = 0; n < 2; ++n) *(f32x4*)(hlast + (size_t)(u.pm * 2 + (fr - 14)) * N3_ + u.pn * BM + bj * HALF + cq + 4 * n) = acc[1][bj][3][n];
            }
        }
        if (fr < 2 && wr == 0) {
#pragma unroll
            for (int bj = 0; bj < 2; ++bj)
#pragma unroll
                for (int n = 0; n < 2; ++n) *(f32x4*)(hfirst + (size_t)(u.pm * 2 + fr) * N3_ + u.pn * BM + bj * HALF + cq + 4 * n) = acc[0][bj][0][n];
        }
        asm volatile("s_waitcnt lgkmcnt(0)" ::: "memory"); __builtin_amdgcn_s_barrier(); asm volatile("s_nop 1" ::: "memory");
#define CONV_DPP(cv, src, w, ctl) asm("v_fmac_f32_dpp %0, %1, %2 " ctl " row_mask:0xf bank_mask:0xf" : "+v"(cv) : "v"(src), "v"(w))
#pragma unroll
        for (int n = 0; n < 2; ++n) {
            const f32x4 g0 = cpar[n][0], g1 = cpar[n][1], g2 = cpar[n][2], gb = cpar[n][3];
            const f32x4 u0 = cpar[n][4], u1 = cpar[n][5], u2 = cpar[n][6], ub = cpar[n][7];
#pragma unroll
            for (int ai = 0; ai < 2; ++ai) {
                const int pred = 2 * ai + wr - 1;
                f32x4 hg1 = {0.f, 0.f, 0.f, 0.f}, hg2 = hg1, hu1 = hg1, hu2 = hg1;
                if (pred >= 0) { const PG8_LAS float* hp = halo + pred * 512 + cq + 4 * n;
                    hg2 = *(const PG8_LAS f32x4*)(hp); hg1 = *(const PG8_LAS f32x4*)(hp + 256); hu2 = *(const PG8_LAS f32x4*)(hp + HALF); hu1 = *(const PG8_LAS f32x4*)(hp + 256 + HALF); }
#pragma unroll
                for (int m = 3; m >= 0; --m) {
                    f32x4 cg, cu;
#pragma unroll
                    for (int j = 0; j < 4; ++j) {
                        const float ag = acc[ai][0][m][n][j], au = acc[ai][1][m][n][j];
                        float vg = fmaf(g2[j], ag, gb[j]), vu = fmaf(u2[j], au, ub[j]);
                        CONV_DPP(vg, ag, g1[j], "row_shr:1"); CONV_DPP(vg, ag, g0[j], "row_shr:2");
                        CONV_DPP(vu, au, u1[j], "row_shr:1"); CONV_DPP(vu, au, u0[j], "row_shr:2");
                        if (m > 0) { const float pg = acc[ai][0][m - 1][n][j], pu = acc[ai][1][m - 1][n][j];
                            CONV_DPP(vg, pg, g1[j], "row_shl:15"); CONV_DPP(vg, pg, g0[j], "row_shl:14");
                            CONV_DPP(vu, pu, u1[j], "row_shl:15"); CONV_DPP(vu, pu, u0[j], "row_shl:14");
                        } else {
                            const float c1g = (fr == 0) ? hg1[j] : 0.f, c2g = (fr == 0) ? hg2[j] : ((fr == 1) ? hg1[j] : 0.f);
                            const float c1u = (fr == 0) ? hu1[j] : 0.f, c2u = (fr == 0) ? hu2[j] : ((fr == 1) ? hu1[j] : 0.f);
                            vg = fmaf(g1[j], c1g, vg); vg = fmaf(g0[j], c2g, vg); vu = fmaf(u1[j], c1u, vu); vu = fmaf(u0[j], c2u, vu);
                        }
                        cg[j] = vg; cu[j] = vu;
                    }
                    float r[4];
#pragma unroll
                    for (int j = 0; j < 4; ++j) r[j] = cg[j] * __builtin_amdgcn_rcpf(1.0f + __builtin_amdgcn_exp2f(-1.4426950408889634f * cg[j])) * cu[j];
#pragma unroll
                    for (int j = 0; j < 4; ++j) r[j] = fminf(fmaxf(r[j] * 8.0f, -448.f), 448.f);
                    const int t_ = __builtin_amdgcn_cvt_pk_fp8_f32(r[0], r[1], 0, false); const unsigned w4 = (unsigned)__builtin_amdgcn_cvt_pk_fp8_f32(r[2], r[3], t_, true);
                    *(unsigned*)(ACT + (size_t)(row0 + ai * HALF + m * 16) * FF_ + u.pn * HALF + cq + 4 * n) = w4;
                }
            }
        }
#undef CONV_DPP
    }
};


struct EpiFinal {
    static constexpr bool PERM = true, AFTER_DRAIN = false;
    const bf16_t* base; float* out; float* sumsq; unsigned* pcnt; const float* gfin;
    __device__ __forceinline__ void operator()(f32x4 (&acc)[2][2][4][2], const Unit& u, int wr, int wc, int fr, int fq) const {
        const int row0 = u.pm * BM + wr * 64 + fr, col0 = u.pn * BM + wc * 32 + 8 * fq;
#pragma unroll
        for (int ai = 0; ai < 2; ++ai)
#pragma unroll
            for (int m = 0; m < 4; ++m) {
                const int row = row0 + ai * HALF + m * 16; float ss = 0.f;
#pragma unroll
                for (int bj = 0; bj < 2; ++bj) {
                    const u32x4 r = *(const u32x4*)(base + (size_t)row * 1024 + col0 + bj * HALF);
                    f32x4 b0, b1;
                    b0[0] = __uint_as_float(r.x << 16); b0[1] = __uint_as_float(r.x & 0xffff0000u); b0[2] = __uint_as_float(r.y << 16); b0[3] = __uint_as_float(r.y & 0xffff0000u);
                    b1[0] = __uint_as_float(r.z << 16); b1[1] = __uint_as_float(r.z & 0xffff0000u); b1[2] = __uint_as_float(r.w << 16); b1[3] = __uint_as_float(r.w & 0xffff0000u);
                    const f32x4 v0 = acc[ai][bj][m][0] * (1.0f / 512.0f) + b0, v1 = acc[ai][bj][m][1] * (1.0f / 512.0f) + b1;
                    acc[ai][bj][m][0] = v0; acc[ai][bj][m][1] = v1;
                    ss += (v0[0] * v0[0] + v0[1] * v0[1]) + (v0[2] * v0[2] + v0[3] * v0[3]) + (v1[0] * v1[0] + v1[1] * v1[1]) + (v1[2] * v1[2] + v1[3] * v1[3]); }
                ss += __shfl_xor(ss, 16); ss += __shfl_xor(ss, 32);
                if (fq == 0) atomicAdd(sumsq + row, ss);
            }
        const bool t0 = (wr == 0 && wc == 0 && fr == 0 && fq == 0);
        asm volatile("s_waitcnt vmcnt(0)" ::: "memory");
        __builtin_amdgcn_s_barrier();
        if (t0) {
            unsigned* pc = pcnt + 64 * u.pm;
            __hip_atomic_fetch_add(pc, 1u, __ATOMIC_RELAXED, __HIP_MEMORY_SCOPE_AGENT);
            unsigned sp = 0;
            while (__hip_atomic_load(pc, __ATOMIC_RELAXED, __HIP_MEMORY_SCOPE_AGENT) < 4u) { __builtin_amdgcn_s_sleep(2); if (++sp > (1u << 22)) break; }
            __builtin_amdgcn_fence(__ATOMIC_ACQUIRE, "agent");
            asm volatile("s_waitcnt vmcnt(0)" ::: "memory");
        }
        __builtin_amdgcn_s_barrier(); asm volatile("" ::: "memory");
#pragma unroll
        for (int ai = 0; ai < 2; ++ai)
#pragma unroll
            for (int m = 0; m < 4; ++m) {
                const int row = row0 + ai * HALF + m * 16;
                const float rinv = __builtin_amdgcn_rsqf(__hip_atomic_load(sumsq + row, __ATOMIC_RELAXED, __HIP_MEMORY_SCOPE_AGENT) * (1.0f / 1024.0f) + 1e-6f);
#pragma unroll
                for (int bj = 0; bj < 2; ++bj) { const int c = col0 + bj * HALF; float* op = out + (size_t)row * 1024 + c;
                    *(f32x4*)(op) = acc[ai][bj][m][0] * rinv * *(const f32x4*)(gfin + c); *(f32x4*)(op + 4) = acc[ai][bj][m][1] * rinv * *(const f32x4*)(gfin + c + 4); }
            }
    }
};

typedef int v8i_t __attribute__((ext_vector_type(8)));
typedef int v4i_t __attribute__((ext_vector_type(4)));
template <bool F8> struct Frag;
template <> struct Frag<false> { bf16x8 k[2]; };
template <> struct Frag<true>  { v8i_t v; };
template <bool F8> __device__ __forceinline__ void ld_frag(Frag<F8>& d, const PG8_LAS unsigned char* p) {
    if constexpr (F8) { const v4i_t lo = *(const PG8_LAS v4i_t*)p, hi = *(const PG8_LAS v4i_t*)(p + 1024); d.v = __builtin_shufflevector(lo, hi, 0, 1, 2, 3, 4, 5, 6, 7); }
    else { d.k[0] = *(const PG8_LAS bf16x8*)p; d.k[1] = *(const PG8_LAS bf16x8*)(p + 1024); }
}
template <bool F8> __device__ __forceinline__ f32x4 mma_frag(const Frag<F8>& b, const Frag<F8>& a, f32x4 c) {
    if constexpr (F8) {
        const int one = 0x7f7f7f7f;
#if defined(__HIP_DEVICE_COMPILE__)
        asm volatile("v_mfma_scale_f32_16x16x128_f8f6f4 %0, %1, %2, %0, %3, %3 op_sel_hi:[0,0,0]" : "+v"(c) : "v"(b.v), "v"(a.v), "v"(one));
#else
        (void)one;
#endif
        return c; }
    else { c = __builtin_amdgcn_mfma_f32_16x16x32_bf16(b.k[0], a.k[0], c, 0, 0, 0); return __builtin_amdgcn_mfma_f32_16x16x32_bf16(b.k[1], a.k[1], c, 0, 0, 0); }
}
template <class Epi, class Sched, bool ALIGN_EPI = false, bool SP2 = false, bool F8 = false>
__device__ __forceinline__ void gemm_phase(PG8_LAS unsigned char* lds, const Gemm g, const Sched& S, const Epi& E, const int tid) {
    const int wid = __builtin_amdgcn_readfirstlane(tid >> 6), lane = tid & 63, wr = wid >> 2, wc = wid & 3, fr = lane & 15, fq = lane >> 4;
    const int K = g.K, nt = K / BK;
    unsigned voffA[2], voffB[2];
#pragma unroll
    for (int i = 0; i < 2; ++i) { int R, C; stage_rc(tid * 16 + i * 8192, R, C); const int Rb = Epi::PERM ? ((R & ~31) + perm32(R & 31)) : R;
        voffA[i] = (unsigned)(R * K + C) * 2u; voffB[i] = (unsigned)(Rb * K + C) * 2u; }
    const size_t kstep = (size_t)(BK * 2);
    const size_t hstep = (size_t)HALF * K * 2;
    const size_t tstep = 2 * hstep;
    const unsigned ldsw = (unsigned)wid * 1024u;
    const int aoff = lds_byte(wr * 64 + fr, fq * 8), boff = lds_byte(wc * 32 + fr, fq * 8);
#define PG8_SA(b, h) (((b) * 2 + (h)) * HTB)
#define PG8_SB(b, h) ((4 + (b) * 2 + (h)) * HTB)
#define PG8_STAGE(bufoff, gbase, voff) do { _Pragma("unroll") for (int _i = 0; _i < 2; ++_i) \
        __builtin_amdgcn_global_load_lds((const unsigned*)((const char*)(gbase) + (voff)[_i]), (PG8_LAS unsigned*)(lds + (bufoff) + ldsw + _i * 8192), 16, 0, 0); } while (0)
#define PG8_LDA(dst, b, h) do { _Pragma("unroll") for (int m = 0; m < 4; ++m) ld_frag<F8>(dst[m], lds + PG8_SA(b, h) + aoff + m * 2048); } while (0)
#define PG8_LDB(dst, b, h) do { _Pragma("unroll") for (int n = 0; n < 2; ++n) ld_frag<F8>(dst[n], lds + PG8_SB(b, h) + boff + n * 2048); } while (0)
#define PG8_MMA(ai, bj, At, Bt) do { __builtin_amdgcn_s_setprio(1); _Pragma("unroll") for (int m = 0; m < 4; ++m) _Pragma("unroll") for (int n = 0; n < 2; ++n) \
        acc[ai][bj][m][n] = mma_frag<F8>(Bt[n], At[m], acc[ai][bj][m][n]); __builtin_amdgcn_s_setprio(0); } while (0)
#define PG8_WAIT_V(n) asm volatile("s_waitcnt vmcnt(" #n ")" ::: "memory")
#define PG8_WAIT_L(n) asm volatile("s_waitcnt lgkmcnt(" #n ")" ::: "memory")
#define PG8_BAR __builtin_amdgcn_s_barrier()
#define PG8_SCHED __builtin_amdgcn_sched_barrier(0)
    Unit cur, nxt; int ui = 0;
    if (!S.next(0, cur)) return;
    f32x4 acc[2][2][4][2];
#pragma unroll
    for (int a = 0; a < 2; ++a)
#pragma unroll
        for (int b = 0; b < 2; ++b)
#pragma unroll
            for (int m = 0; m < 4; ++m)
#pragma unroll
                for (int n = 0; n < 2; ++n) acc[a][b][m][n] = (f32x4){0.f, 0.f, 0.f, 0.f};
    Frag<F8> At[4], B0[2], B1[2];
    const char* cA = (const char*)g.A + (size_t)cur.pm * tstep; const char* cB = (const char*)g.Bt + (size_t)cur.pn * tstep;
    S.a_ready(cur);
    if constexpr (SP2) {
        PG8_STAGE(PG8_SB(0, 0), cB, voffB); PG8_STAGE(PG8_SB(0, 1), cB + hstep, voffB); PG8_STAGE(PG8_SA(0, 0), cA, voffA); PG8_STAGE(PG8_SA(0, 1), cA + hstep, voffA);
        if (wr == 1) PG8_BAR;
        PG8_WAIT_V(2); PG8_BAR;
        PG8_STAGE(PG8_SB(1, 0), cB + kstep, voffB); PG8_STAGE(PG8_SA(1, 0), cA + kstep, voffA); PG8_STAGE(PG8_SB(1, 1), cB + hstep + kstep, voffB);
        PG8_WAIT_V(6); PG8_BAR;
    } else {
        PG8_STAGE(PG8_SB(0, 0), cB, voffB); PG8_STAGE(PG8_SA(0, 0), cA, voffA); PG8_STAGE(PG8_SB(0, 1), cB + hstep, voffB); PG8_STAGE(PG8_SA(0, 1), cA + hstep, voffA);
        if (wr == 1) PG8_BAR;
        PG8_WAIT_V(4); PG8_BAR;
        PG8_STAGE(PG8_SB(1, 0), cB + kstep, voffB); PG8_STAGE(PG8_SA(1, 0), cA + kstep, voffA); PG8_STAGE(PG8_SB(1, 1), cB + hstep + kstep, voffB);
        PG8_WAIT_V(6); PG8_BAR;
    }
    for (;;) {
        const bool has_next = S.next(ui + 1, nxt);
        const char* nA = has_next ? (const char*)g.A + (size_t)nxt.pm * tstep : cA; const char* nB = has_next ? (const char*)g.Bt + (size_t)nxt.pn * tstep : cB;
        for (int t = 0; t < nt; t += 2) {
            const bool last = (t == nt - 2);
            const char* a1 = cA + (size_t)(t + 1) * kstep;
            const char* a2 = last ? nA : cA + (size_t)(t + 2) * kstep; const char* b2 = last ? nB : cB + (size_t)(t + 2) * kstep;
            const char* a3 = a2 + kstep; const char* b3 = b2 + kstep;
            if (last && has_next) S.a_ready(nxt);
            if constexpr (SP2) {
            PG8_LDB(B0, 0, 0); PG8_LDB(B1, 0, 1); PG8_SCHED; PG8_LDA(At, 0, 0); PG8_STAGE(PG8_SA(1, 1), a1 + hstep, voffA);
            PG8_WAIT_V(8); PG8_WAIT_L(0); PG8_BAR; PG8_MMA(0, 0, At, B0); PG8_MMA(0, 1, At, B1); PG8_BAR; PG8_SCHED;
            PG8_LDA(At, 0, 1); PG8_STAGE(PG8_SB(0, 0), b2, voffB); PG8_STAGE(PG8_SB(0, 1), b2 + hstep, voffB); PG8_STAGE(PG8_SA(0, 0), a2, voffA);
            PG8_WAIT_V(8); PG8_WAIT_L(0); PG8_BAR; PG8_MMA(1, 0, At, B0); PG8_MMA(1, 1, At, B1); PG8_BAR; PG8_SCHED;
            PG8_LDB(B0, 1, 0); PG8_LDB(B1, 1, 1); PG8_SCHED; PG8_LDA(At, 1, 0); PG8_STAGE(PG8_SA(0, 1), a2 + hstep, voffA);
            PG8_WAIT_V(8); PG8_WAIT_L(0); PG8_BAR; PG8_MMA(0, 0, At, B0); PG8_MMA(0, 1, At, B1); PG8_BAR; PG8_SCHED;
            PG8_LDA(At, 1, 1); PG8_STAGE(PG8_SB(1, 0), b3, voffB); PG8_STAGE(PG8_SB(1, 1), b3 + hstep, voffB); PG8_STAGE(PG8_SA(1, 0), a3, voffA);
            PG8_WAIT_V(8); PG8_WAIT_L(0); PG8_BAR; PG8_MMA(1, 0, At, B0); PG8_MMA(1, 1, At, B1); PG8_BAR; PG8_SCHED;
            } else {
            PG8_LDB(B0, 0, 0); PG8_SCHED; PG8_LDA(At, 0, 0); PG8_STAGE(PG8_SA(1, 1), a1 + hstep, voffA);
            PG8_WAIT_L(8); PG8_BAR; PG8_WAIT_L(0); PG8_MMA(0, 0, At, B0); PG8_BAR; PG8_SCHED;
            PG8_LDB(B1, 0, 1); PG8_STAGE(PG8_SB(0, 0), b2, voffB);
            PG8_BAR; PG8_WAIT_L(0); PG8_MMA(0, 1, At, B1); PG8_BAR;
            PG8_LDA(At, 0, 1); PG8_STAGE(PG8_SA(0, 0), a2, voffA);
            PG8_BAR; PG8_WAIT_L(0); PG8_MMA(1, 0, At, B0); PG8_BAR; PG8_SCHED;
            PG8_STAGE(PG8_SB(0, 1), b2 + hstep, voffB);
            PG8_WAIT_V(6); PG8_BAR; PG8_MMA(1, 1, At, B1); PG8_BAR;
            PG8_LDB(B0, 1, 0); PG8_SCHED; PG8_LDA(At, 1, 0); PG8_STAGE(PG8_SA(0, 1), a2 + hstep, voffA);
            PG8_WAIT_L(8); PG8_BAR; PG8_WAIT_L(0); PG8_MMA(0, 0, At, B0); PG8_BAR; PG8_SCHED;
            PG8_LDB(B1, 1, 1); PG8_STAGE(PG8_SB(1, 0), b3, voffB);
            PG8_BAR; PG8_WAIT_L(0); PG8_MMA(0, 1, At, B1); PG8_BAR;
            PG8_LDA(At, 1, 1); PG8_STAGE(PG8_SA(1, 0), a3, voffA);
            PG8_BAR; PG8_WAIT_L(0); PG8_MMA(1, 0, At, B0); PG8_BAR; PG8_SCHED;
            PG8_STAGE(PG8_SB(1, 1), b3 + hstep, voffB);
            PG8_WAIT_V(6); PG8_BAR; PG8_MMA(1, 1, At, B1); PG8_BAR;
            }
        }
        if constexpr (ALIGN_EPI) { if (wr == 0) PG8_BAR; }
        if constexpr (F8) asm volatile("s_nop 15\n\ts_nop 15\n\ts_nop 15\n\ts_nop 15" ::: "memory");
        if constexpr (!Epi::AFTER_DRAIN) { E(acc, cur, wr, wc, fr, fq); S.done(cur); }
        if (!has_next) break;
#pragma unroll
        for (int a = 0; a < 2; ++a)
#pragma unroll
            for (int b = 0; b < 2; ++b)
#pragma unroll
                for (int m = 0; m < 4; ++m)
#pragma unroll
                    for (int n = 0; n < 2; ++n) acc[a][b][m][n] = (f32x4){0.f, 0.f, 0.f, 0.f};
        cur = nxt; cA = nA; cB = nB; ++ui;
        if constexpr (ALIGN_EPI) { if (wr == 1) PG8_BAR; }
    }
    PG8_WAIT_V(0);
    if constexpr (!ALIGN_EPI) { if (wr == 0) PG8_BAR; }
    PG8_BAR;
#undef PG8_SA
#undef PG8_SB
#undef PG8_STAGE
#undef PG8_LDA
#undef PG8_LDB
#undef PG8_MMA
#undef PG8_WAIT_V
#undef PG8_WAIT_L
#undef PG8_BAR
#undef PG8_SCHED
}
}

constexpr int NWAVES = 8;
constexpr int BATCH = 32, SEQ = 2048, DM = 1024, NTOK = BATCH * SEQ;
constexpr int IN_COLS = 1736;
constexpr int N1 = 1792, K2 = 1024, FF = 2816, N3 = 2 * FF;
constexpr int OFF_Q = 0, OFF_QI = 512, OFF_U = 1024, OFF_C = 1536, OFF_KI = 1664, OFF_WI = 1728;
constexpr float EPS = 1e-6f;
constexpr float WI_SCALE = 0.044194173824159216f;

constexpr size_t MiB = 1u << 20;
constexpr size_t WS_CTL = 0, CTL_ZERO_BYTES = 1 * MiB;
constexpr size_t WS_W1T = 1 * MiB, WS_W2T = 6 * MiB, WS_W3T = 9 * MiB, WS_W4T = 20 * MiB, WS_CONVP = 26 * MiB, WS_ZT = 27 * MiB, WS_WUKT = 28 * MiB, WS_WUVT = 28 * MiB + 128 * 1024;
constexpr size_t WS_HB = 32 * MiB;
constexpr size_t WS_RS = 27 * MiB + 64 * 1024;
constexpr size_t WS_P1 = 160 * MiB;
constexpr size_t WS_HF = 32 * MiB, WS_HL = 44 * MiB;
constexpr size_t WS_X2 = 64 * MiB;
constexpr size_t WS_MIX = 448 * MiB;
constexpr size_t WS_CN = 640 * MiB;
constexpr size_t WS_CT8 = 672 * MiB;
constexpr size_t WS_ACT = 448 * MiB;
constexpr size_t WS_X1B = 800 * MiB;
constexpr size_t WS_X1F8 = 928 * MiB;
constexpr size_t WS_END = 992 * MiB;

constexpr int LDS_BYTES = 147456;
constexpr int XB_LDS_OFF = 131072 + 1024;
constexpr int HALO_LDS_OFF = 131072 + 2048;
constexpr size_t XB_CTL_OFF = 512 * 1024;
constexpr size_t PCNT_CTL_OFF = 640 * 1024;

#define GAS __attribute__((address_space(1)))
#define LAS __attribute__((address_space(3)))
typedef unsigned short bf16;
typedef unsigned v4u __attribute__((ext_vector_type(4)));
typedef unsigned v2u __attribute__((ext_vector_type(2)));
typedef float f32x4 __attribute__((ext_vector_type(4)));

__device__ __forceinline__ unsigned f2bf(float f) { unsigned u = __builtin_bit_cast(unsigned, f); return (u + 0x7fffu + ((u >> 16) & 1u)) >> 16; }
__device__ __forceinline__ unsigned pk2(float lo, float hi) { return f2bf(lo) | (f2bf(hi) << 16); }
__device__ __forceinline__ float bflo(unsigned u) { return __uint_as_float(u << 16); }
__device__ __forceinline__ float bfhi(unsigned u) { return __uint_as_float(u & 0xffff0000u); }
__device__ __forceinline__ float wave_sum(float v) {
#define WS_DPP(x, ctl) __int_as_float(__builtin_amdgcn_update_dpp(0, __float_as_int(x), ctl, 0xf, 0xf, true))
    v += WS_DPP(v, 0xB1); v += WS_DPP(v, 0x4E); v += WS_DPP(v, 0x141); v += WS_DPP(v, 0x140);
#undef WS_DPP
    { auto rr = __builtin_amdgcn_permlane16_swap(__float_as_uint(v), __float_as_uint(v), false, false); v = __uint_as_float(rr[0]) + __uint_as_float(rr[1]); }
    { auto rr = __builtin_amdgcn_permlane32_swap(__float_as_uint(v), __float_as_uint(v), false, false); v = __uint_as_float(rr[0]) + __uint_as_float(rr[1]); }
    return v;
}
__device__ __forceinline__ float wave_max(float v) {
#pragma unroll
    for (int o = 1; o < 64; o <<= 1) v = fmaxf(v, __shfl_xor(v, o));
    return v;
}
#define WAVE_LDS_SYNC() do { asm volatile("s_waitcnt lgkmcnt(0)" ::: "memory"); __builtin_amdgcn_wave_barrier(); } while (0)

struct Args {
    const float* x; const float* g_mix; const float* w_in; const float* g_kv; const float* w_uk; const float* w_uv; const float* w_pool; const float* pool_scale;
    const float* w_o; const float* g_ffn; const float* w_up; const float* conv_w; const float* conv_b; const float* w_down; const float* g_final;
    float* out; unsigned char* ws; int ph_lo, ph_hi, li, pad;
};

typedef const void __attribute__((address_space(4)))* kargp_t;
template <int OFF> __device__ __forceinline__ void* karg_ptr(kargp_t kp) { __attribute__((address_space(1))) void* p; asm volatile("s_load_dwordx2 %0, %1, %2\n\ts_waitcnt lgkmcnt(0)" : "=s"(p) : "s"(kp), "i"(OFF)); return (void*)p; }
template <int OFF> __device__ __forceinline__ int karg_int(kargp_t kp) { int v; asm volatile("s_load_dword %0, %1, %2\n\ts_waitcnt lgkmcnt(0)" : "=s"(v) : "s"(kp), "i"(OFF)); return v; }
__device__ __forceinline__ Args load_args(kargp_t kp) {
    Args a;
    a.x = (const float*)karg_ptr<0>(kp); a.g_mix = (const float*)karg_ptr<8>(kp); a.w_in = (const float*)karg_ptr<16>(kp); a.g_kv = (const float*)karg_ptr<24>(kp);
    a.w_uk = (const float*)karg_ptr<32>(kp); a.w_uv = (const float*)karg_ptr<40>(kp); a.w_pool = (const float*)karg_ptr<48>(kp); a.pool_scale = (const float*)karg_ptr<56>(kp);
    a.w_o = (const float*)karg_ptr<64>(kp); a.g_ffn = (const float*)karg_ptr<72>(kp); a.w_up = (const float*)karg_ptr<80>(kp); a.conv_w = (const float*)karg_ptr<88>(kp);
    a.conv_b = (const float*)karg_ptr<96>(kp); a.w_down = (const float*)karg_ptr<104>(kp); a.g_final = (const float*)karg_ptr<112>(kp);
    a.out = (float*)karg_ptr<120>(kp); a.ws = (unsigned char*)karg_ptr<128>(kp); a.ph_lo = 0; a.ph_hi = 0; a.li = karg_int<144>(kp); a.pad = 0;
    return a;
}
static_assert(sizeof(Args) == 152, "Args layout (kernarg offsets above)");
__device__ __forceinline__ void tr_item(const float* __restrict__ W, int ldw, int k0, int srccol0, int valid, float colscale, const float* __restrict__ kscale,
                                        bf16* __restrict__ WT, int ldt, int nrow0, LAS float* scr, int lane) {
    const int jq = (lane & 7) * 4, kr = lane >> 3;
    f32x4 vv[8];
#pragma unroll
    for (int i = 0; i < 8; ++i) vv[i] = __builtin_nontemporal_load((const f32x4*)(W + (size_t)(k0 + 8 * i + kr) * ldw + srccol0 + jq));
#pragma unroll
    for (int i = 0; i < 8; ++i) { const int kk = 8 * i + kr; float ks = colscale; if (kscale) ks *= kscale[k0 + kk];
#pragma unroll
        for (int e = 0; e < 4; ++e) scr[kk * 33 + jq + e] = (jq + e < valid) ? vv[i][e] * ks : 0.f; }
    asm volatile("s_waitcnt lgkmcnt(0)" ::: "memory"); __builtin_amdgcn_wave_barrier();
    const int c = lane & 7;
#pragma unroll
    for (int jj = 0; jj < 4; ++jj) { const int n = (lane >> 3) + 8 * jj; const LAS float* s = scr + (8 * c) * 33 + n;
        v4u o; o.x = pk2(s[0 * 33], s[1 * 33]); o.y = pk2(s[2 * 33], s[3 * 33]); o.z = pk2(s[4 * 33], s[5 * 33]); o.w = pk2(s[6 * 33], s[7 * 33]);
        *(v4u*)(WT + (size_t)(nrow0 + n) * ldt + k0 + 8 * c) = o; }
    asm volatile("s_waitcnt lgkmcnt(0)" ::: "memory"); __builtin_amdgcn_wave_barrier();
}
__device__ __forceinline__ void tr_item_f8(const float* __restrict__ W, int ldw, int k0, int srccol0, float colscale, const float* __restrict__ kscale,
                                           unsigned char* __restrict__ WT8, int ldt, int nrow0, LAS float* scr, int lane) {
    const int jq = (lane & 7) * 4, kr = lane >> 3;
    f32x4 vv[8];
#pragma unroll
    for (int i = 0; i < 8; ++i) vv[i] = __builtin_nontemporal_load((const f32x4*)(W + (size_t)(k0 + 8 * i + kr) * ldw + srccol0 + jq));
#pragma unroll
    for (int i = 0; i < 8; ++i) { const int kk = 8 * i + kr; float ks = colscale; if (kscale) ks *= kscale[k0 + kk];
#pragma unroll
        for (int e = 0; e < 4; ++e) scr[kk * 33 + jq + e] = fminf(fmaxf(vv[i][e] * ks, -448.f), 448.f); }
    asm volatile("s_waitcnt lgkmcnt(0)" ::: "memory"); __builtin_amdgcn_wave_barrier();
    const int c = lane & 7;
#pragma unroll
    for (int jj = 0; jj < 4; ++jj) { const int n = (lane >> 3) + 8 * jj; const LAS float* s = scr + (8 * c) * 33 + n;
        v2u o; int t_;
        t_ = __builtin_amdgcn_cvt_pk_fp8_f32(s[0 * 33], s[1 * 33], 0, false); o.x = (unsigned)__builtin_amdgcn_cvt_pk_fp8_f32(s[2 * 33], s[3 * 33], t_, true);
        t_ = __builtin_amdgcn_cvt_pk_fp8_f32(s[4 * 33], s[5 * 33], 0, false); o.y = (unsigned)__builtin_amdgcn_cvt_pk_fp8_f32(s[6 * 33], s[7 * 33], t_, true);
        *(v2u*)(WT8 + (size_t)(nrow0 + n) * ldt + k0 + 8 * c) = o; }
    asm volatile("s_waitcnt lgkmcnt(0)" ::: "memory"); __builtin_amdgcn_wave_barrier();
}
__device__ __forceinline__ void ph_prologue(const Args& a, LAS unsigned char* lds, const int tid, int gtid, int gthreads, int gw, int ngw, int lane) {
    unsigned char* ws = a.ws;
    bf16* W1T = (bf16*)(ws + WS_W1T); bf16* W2T = (bf16*)(ws + WS_W2T); bf16* W3T = (bf16*)(ws + WS_W3T); bf16* W4T = (bf16*)(ws + WS_W4T);
    float* CONVP = (float*)(ws + WS_CONVP);
    LAS float* L0 = (LAS float*)lds;
    for (int it = blockIdx.x; it < 256; it += gridDim.x) {
        {
            const int g = it >> 6, n0 = ((it >> 1) & 31) * 32, ci0 = (it & 1) * 64;
            LAS float* Wp = L0; LAS float* Wo = L0 + 16384;
#pragma unroll
            for (int t = 0; t < 16; ++t) Wp[tid + 512 * t] = a.w_pool[g * 16384 + ci0 * 128 + tid + 512 * t];
#pragma unroll
            for (int t = 0; t < 8; ++t) { const int idx = tid + 512 * t, dd = idx >> 5; Wo[idx] = a.pool_scale[g * 128 + dd] * a.w_o[(size_t)(512 + g * 128 + dd) * DM + n0 + (idx & 31)]; }
            __syncthreads();
            const int nn = tid & 31, cg_ = tid >> 5; float acc[4];
#pragma unroll
            for (int j = 0; j < 4; ++j) acc[j] = 0.f;
            for (int dd = 0; dd < 128; ++dd) { const float wo = Wo[dd * 32 + nn];
#pragma unroll
                for (int j = 0; j < 4; ++j) acc[j] += Wp[(cg_ * 4 + j) * 128 + dd] * wo; }
#pragma unroll
            for (int j = 0; j < 4; ++j) acc[j] = fminf(fmaxf(acc[j] * 64.0f, -448.f), 448.f);
            const int t_ = __builtin_amdgcn_cvt_pk_fp8_f32(acc[0], acc[1], 0, false);
            *(unsigned*)((unsigned char*)W2T + (size_t)(n0 + nn) * K2 + 512 + g * 128 + ci0 + cg_ * 4) = (unsigned)__builtin_amdgcn_cvt_pk_fp8_f32(acc[2], acc[3], t_, true);
        }
        __syncthreads();
    }
    { bf16* WUKT = (bf16*)(ws + WS_WUKT); bf16* WUVT = (bf16*)(ws + WS_WUVT);
      for (int i = gtid; i < 8 * 128 * 64; i += gthreads) {
          { const int hd = i >> 13, c = (i >> 6) & 127, d = i & 63; WUKT[i] = (bf16)f2bf(a.w_uk[(hd * 64 + d) * 128 + c]); }
          { const int hd = i >> 13, d = (i >> 7) & 63, c = i & 127; WUVT[i] = (bf16)f2bf(a.w_uv[(hd * 128 + c) * 64 + d]); } } }
    LAS float* scr = (LAS float*)(lds + (tid >> 6) * 16384);
    constexpr int I1 = 56 * 16, I3 = 176 * 16, I4 = 32 * 44, I2 = 32 * 8;
    for (int it = gw; it < I1 + I3 + I4 + I2; it += ngw) {
        if (it >= I1 + I3 + I4) {
            const int i4 = it - (I1 + I3 + I4), nb = i4 >> 3, k0 = (i4 & 7) * 64;
            tr_item_f8(a.w_o, DM, k0, nb * 32, 64.f, nullptr, (unsigned char*)W2T, K2, nb * 32, scr, lane);
        } else if (it < I1) {
            const int nb = it >> 4, k0 = (it & 15) * 64, n0 = nb * 32; int sc0, valid = 32; float cs = 1.f;
            if (n0 < 512) sc0 = n0; else if (n0 < 1024) sc0 = 640 + (n0 - 512); else if (n0 < 1536) sc0 = 1224 + (n0 - 1024); else if (n0 < 1664) sc0 = 512 + (n0 - 1536); else if (n0 < 1728) sc0 = 1152 + (n0 - 1664);
            else if (n0 == 1728) { sc0 = 1216; valid = 8; cs = WI_SCALE; } else { sc0 = 0; valid = 0; }
            tr_item(a.w_in, IN_COLS, k0, sc0, valid, cs, nullptr, W1T, DM, n0, scr, lane);
        } else if (it < I1 + I3) {
            const int i2 = it - I1, nb = i2 >> 4, k0 = (i2 & 15) * 64, r0 = nb * 32, j = r0 >> 8, ii = r0 & 255;
            const int sc0 = (ii < 128) ? (128 * j + ii) : (FF + 128 * j + (ii - 128));
            tr_item_f8(a.w_up, N3, k0, sc0, 64.f, a.g_ffn, (unsigned char*)W3T, DM, r0, scr, lane);
        } else {
            const int i3 = it - I1 - I3, nb = i3 / 44, k0 = (i3 - nb * 44) * 64;
            tr_item_f8(a.w_down, DM, k0, nb * 32, 64.f, nullptr, (unsigned char*)W4T, FF, nb * 32, scr, lane);
        }
    }
    if (gtid < 32) {
        float* ZT = (float*)(ws + WS_ZT); const float nn = 64.0f * (float)(gtid + 1); float z = 0.f;
        if (nn > 256.f) { const float p = 256.0f / nn, pt = (p < 0.5f) ? p : 1.0f - p, t = sqrtf(-2.0f * logf(pt));
            const float zz = t - (2.515517f + t * (0.802853f + t * 0.010328f)) / (1.0f + t * (1.432788f + t * (0.189269f + t * 0.001308f))); z = (p < 0.5f) ? zz : -zz; }
        ZT[gtid] = z; ZT[32 + gtid] = nn * 0.3989423f * expf(-0.5f * z * z);
    }
    for (int r = gtid; r < N3; r += gthreads) {
        const int j = r >> 8, ii = r & 255; const int col = (ii < 128) ? (128 * j + ii) : (FF + 128 * j + (ii - 128));
        CONVP[r] = a.conv_w[col]; CONVP[N3 + r] = a.conv_w[N3 + col]; CONVP[2 * N3 + r] = a.conv_w[2 * N3 + col]; CONVP[3 * N3 + r] = a.conv_b[col];
    }
    bf16* HB = (bf16*)(ws + WS_HB);
    for (int m0 = gw; m0 < NTOK; m0 += 4 * ngw) {
        f32x4 v[4][4]; float s[4];
#pragma unroll
        for (int r = 0; r < 4; ++r) { const f32x4* xr = (const f32x4*)(a.x + (size_t)(m0 + r * ngw) * DM) + lane;
#pragma unroll
            for (int j = 0; j < 4; ++j) v[r][j] = __builtin_nontemporal_load(xr + 64 * j); }
        f32x4 g[4];
#pragma unroll
        for (int j = 0; j < 4; ++j) g[j] = ((const f32x4*)a.g_mix)[lane + 64 * j];
#pragma unroll
        for (int r = 0; r < 4; ++r) { s[r] = 0.f;
#pragma unroll
            for (int j = 0; j < 4; ++j) s[r] += (v[r][j].x * v[r][j].x + v[r][j].y * v[r][j].y) + (v[r][j].z * v[r][j].z + v[r][j].w * v[r][j].w); }
#pragma unroll
        for (int r = 0; r < 4; ++r) {
            const float rs_ = sqrtf(wave_sum(s[r]) * (1.0f / DM) + EPS), rinv = 1.0f / rs_;
            if (lane == 0) ((float*)(ws + WS_RS))[m0 + r * ngw] = rs_;
            unsigned long long* o8 = (unsigned long long*)(HB + (size_t)(m0 + r * ngw) * DM) + lane;
#pragma unroll
            for (int j = 0; j < 4; ++j)
                o8[64 * j] = (unsigned long long)pk2(v[r][j].x * rinv * g[j].x, v[r][j].y * rinv * g[j].y) | ((unsigned long long)pk2(v[r][j].z * rinv * g[j].z, v[r][j].w * rinv * g[j].w) << 32);
        }
    }
}

__device__ __forceinline__ void ph_cnorm_pool(const Args& a, int gw, int ngw, int lane) {
    const bf16* P1 = (const bf16*)(a.ws + WS_P1); unsigned char* CN = a.ws + WS_CN; unsigned char* MIX = a.ws + WS_MIX;
    unsigned char* CT8 = a.ws + WS_CT8;
    const float gk0 = a.g_kv[2 * lane], gk1 = a.g_kv[2 * lane + 1];
    const int win = 2 << (lane >> 4);
    for (int run = gw; run < NTOK / 32; run += ngw) {
        const int tok0 = run * 32, pos0 = tok0 & (SEQ - 1);
        const bf16* ub = P1 + (size_t)tok0 * N1 + OFF_U + 8 * lane;
        float s[8];
#pragma unroll
        for (int j = 0; j < 8; ++j) s[j] = 0.f;
#pragma unroll
        for (int j = 1; j < 16; ++j) {
            if (j < win && pos0 - j >= 0) { const v4u u = *(const v4u*)(ub - (size_t)j * N1);
                s[0] += bflo(u.x); s[1] += bfhi(u.x); s[2] += bflo(u.y); s[3] += bfhi(u.y); s[4] += bflo(u.z); s[5] += bfhi(u.z); s[6] += bflo(u.w); s[7] += bfhi(u.w); }
        }
#pragma unroll 1
        for (int tb = 0; tb < 32; tb += 8) {
        v4u ub_[8], udb_[8]; unsigned cwb_[8]; float cn0_[8], cn1_[8];
#pragma unroll
        for (int t8 = 0; t8 < 8; ++t8) {
            const bf16* prow = P1 + (size_t)(tok0 + tb + t8) * N1;
            ub_[t8] = *(const v4u*)(prow + OFF_U + 8 * lane);
            cwb_[t8] = *(const unsigned*)(prow + OFF_C + 2 * lane);
            udb_[t8] = (v4u){0u, 0u, 0u, 0u};
            if (pos0 + tb + t8 - win + 1 >= 0) udb_[t8] = *(const v4u*)(prow - (size_t)(win - 1) * N1 + OFF_U + 8 * lane);
        }
#pragma unroll
        for (int t8 = 0; t8 < 8; ++t8) {
            const int t = tb + t8;
            const int tok = tok0 + t, pos = pos0 + t;
            const v4u u = ub_[t8];
            const unsigned cw = cwb_[t8];
            const v4u ud = udb_[t8];
            const bool drop = (pos - win + 1 >= 0);
            const float c0 = bflo(cw), c1 = bfhi(cw);
            const float rinv = 1.0f / sqrtf(wave_sum(c0 * c0 + c1 * c1) * (1.0f / 128.0f) + EPS);
            cn0_[t8] = c0 * rinv * gk0; cn1_[t8] = c1 * rinv * gk1;
            *(unsigned short*)(CN + (size_t)tok * 128 + 2 * lane) = (unsigned short)__builtin_amdgcn_cvt_pk_fp8_f32(fminf(fmaxf(cn0_[t8] * 16.0f, -448.f), 448.f), fminf(fmaxf(cn1_[t8] * 16.0f, -448.f), 448.f), 0, false);
            const float uf[8] = {bflo(u.x), bfhi(u.x), bflo(u.y), bfhi(u.y), bflo(u.z), bfhi(u.z), bflo(u.w), bfhi(u.w)};
#pragma unroll
            for (int j = 0; j < 8; ++j) s[j] += uf[j];
            const int cnt = (pos + 1 < win) ? pos + 1 : win; const float ic = 1.0f / (float)cnt;
            float pv_[8];
#pragma unroll
            for (int j = 0; j < 8; ++j) pv_[j] = fminf(fmaxf((s[j] * ic - uf[j]) * 16.0f, -448.f), 448.f);
            v2u o; int t_;
            t_ = __builtin_amdgcn_cvt_pk_fp8_f32(pv_[0], pv_[1], 0, false); o.x = (unsigned)__builtin_amdgcn_cvt_pk_fp8_f32(pv_[2], pv_[3], t_, true);
            t_ = __builtin_amdgcn_cvt_pk_fp8_f32(pv_[4], pv_[5], 0, false); o.y = (unsigned)__builtin_amdgcn_cvt_pk_fp8_f32(pv_[6], pv_[7], t_, true);
            *(v2u*)(MIX + (size_t)tok * K2 + 512 + 8 * lane) = o;
            if (drop) { s[0] -= bflo(ud.x); s[1] -= bfhi(ud.x); s[2] -= bflo(ud.y); s[3] -= bfhi(ud.y); s[4] -= bflo(ud.z); s[5] -= bfhi(ud.z); s[6] -= bflo(ud.w); s[7] -= bfhi(ud.w); }
        }
        {
            unsigned char* ctp = CT8 + ((size_t)(tok0 >> 6) * 128 + 2 * lane) * 64 + 16 * ((pos0 >> 5) & 1) + (tb >> 1);
#pragma unroll
            for (int hh = 0; hh < 2; ++hh) {
                float q0[4], q1[4];
#pragma unroll
                for (int e = 0; e < 4; ++e) { q0[e] = fminf(fmaxf(cn0_[4 * hh + e] * 16.0f, -448.f), 448.f); q1[e] = fminf(fmaxf(cn1_[4 * hh + e] * 16.0f, -448.f), 448.f); }
                int t_ = __builtin_amdgcn_cvt_pk_fp8_f32(q0[0], q0[1], 0, false); *(unsigned*)(ctp + 32 * hh) = (unsigned)__builtin_amdgcn_cvt_pk_fp8_f32(q0[2], q0[3], t_, true);
                t_ = __builtin_amdgcn_cvt_pk_fp8_f32(q1[0], q1[1], 0, false); *(unsigned*)(ctp + 64 + 32 * hh) = (unsigned)__builtin_amdgcn_cvt_pk_fp8_f32(q1[2], q1[3], t_, true);
            }
        }
        }
    }
}

namespace dsa {
using bf16x8 = __attribute__((ext_vector_type(8))) short;
using s16x4  = __attribute__((ext_vector_type(4))) short;
using f32x16 = __attribute__((ext_vector_type(16))) float;
using u32x4  = __attribute__((ext_vector_type(4))) unsigned;
constexpr int NW = 8, KVBLK = 64;
constexpr float SCALE = 0.125f, LOG2E = 1.4426950408889634f, THR = 4.f, PSH = 3.f;
typedef int v8i __attribute__((ext_vector_type(8)));
typedef int v4i __attribute__((ext_vector_type(4)));
constexpr int SHM_V = KVBLK * 128 * 2, SHM_K = KVBLK * 128 * 2, SHM_ATTN = 2 * SHM_V + 2 * SHM_K + NW * 64 * 4;
constexpr unsigned NEG2 = 0xCAEACAEAu;
#define KSWZ(row, colB) ((row) * 256 + ((colB) ^ (((row) & 7) << 4)))
#define SBAR() __builtin_amdgcn_sched_barrier(0)
__device__ __forceinline__ int crow(int r, int hi) { return (r & 3) + 8 * (r >> 2) + 4 * hi; }
__device__ __forceinline__ unsigned cvtpk(float lo, float hi) { unsigned r; asm volatile("v_cvt_pk_bf16_f32 %0, %1, %2" : "=v"(r) : "v"(lo), "v"(hi)); return r; }
typedef float f32x2_t __attribute__((ext_vector_type(2))); typedef __bf16 bf16x2_t __attribute__((ext_vector_type(2)));
__device__ __forceinline__ unsigned cvtpk_s(float lo, float hi) { f32x2_t v = {lo, hi}; bf16x2_t b = __builtin_convertvector(v, bf16x2_t); return __builtin_bit_cast(unsigned, b); }

template <int CTRL> __device__ __forceinline__ unsigned dppu(unsigned x) { return (unsigned)__builtin_amdgcn_update_dpp(0, (int)x, CTRL, 0xf, 0xf, true); }
__device__ __forceinline__ unsigned half_sum(unsigned x, int) {
    x += dppu<0xB1>(x); x += dppu<0x4E>(x); x += dppu<0x141>(x); x += dppu<0x140>(x);
    auto rr = __builtin_amdgcn_permlane16_swap(x, x, false, false); return rr[0] + rr[1];
}
__device__ __forceinline__ unsigned half_min(unsigned x, int) {
    x = min(x, dppu<0xB1>(x)); x = min(x, dppu<0x4E>(x)); x = min(x, dppu<0x141>(x)); x = min(x, dppu<0x140>(x));
    auto rr = __builtin_amdgcn_permlane16_swap(x, x, false, false); return min(rr[0], rr[1]);
}
__device__ __forceinline__ unsigned half_max(unsigned x, int) {
    x = max(x, dppu<0xB1>(x)); x = max(x, dppu<0x4E>(x)); x = max(x, dppu<0x141>(x)); x = max(x, dppu<0x140>(x));
    auto rr = __builtin_amdgcn_permlane16_swap(x, x, false, false); return max(rr[0], rr[1]);
}

template <int CTRL> __device__ __forceinline__ float dppf(float x) { return __int_as_float(__builtin_amdgcn_update_dpp(0, __float_as_int(x), CTRL, 0xf, 0xf, true)); }
__device__ __forceinline__ float half_minf(float x, int) {
    x = fminf(x, dppf<0xB1>(x)); x = fminf(x, dppf<0x4E>(x)); x = fminf(x, dppf<0x141>(x)); x = fminf(x, dppf<0x140>(x));
    auto rr = __builtin_amdgcn_permlane16_swap(__float_as_uint(x), __float_as_uint(x), false, false); return fminf(__uint_as_float(rr[0]), __uint_as_float(rr[1]));
}
__device__ __forceinline__ float half_maxf(float x, int) {
    x = fmaxf(x, dppf<0xB1>(x)); x = fmaxf(x, dppf<0x4E>(x)); x = fmaxf(x, dppf<0x141>(x)); x = fmaxf(x, dppf<0x140>(x));
    auto rr = __builtin_amdgcn_permlane16_swap(__float_as_uint(x), __float_as_uint(x), false, false); return fmaxf(__uint_as_float(rr[0]), __uint_as_float(rr[1]));
}
__device__ __forceinline__ float half_sumf(float x, int) {
    x += dppf<0xB1>(x); x += dppf<0x4E>(x); x += dppf<0x141>(x); x += dppf<0x140>(x);
    auto rr = __builtin_amdgcn_permlane16_swap(__float_as_uint(x), __float_as_uint(x), false, false); return __uint_as_float(rr[0]) + __uint_as_float(rr[1]);
}
__device__ __forceinline__ unsigned f2key(float f) { const unsigned u = __float_as_uint(f); return (u & 0x80000000u) ? ~u : (u | 0x80000000u); }
__device__ __forceinline__ float key2f(unsigned k) { return __uint_as_float((k & 0x80000000u) ? (k & 0x7fffffffu) : ~k); }

template <int PROBE> __device__ __forceinline__ void idx_select(const bf16* __restrict__ P1, int b, int tokw, int n, int tid_in, LAS char* lds, const float* __restrict__ ZT, unsigned& W0lo, unsigned& W0hi, unsigned& W1lo, unsigned& W1hi) {
    if (n <= 256) { W0lo = W0hi = W1lo = W1hi = 0xffffffffu; return; }
    int tid = tid_in; asm volatile("" : "+v"(tid));
    const int lane = tid & 63, wid = __builtin_amdgcn_readfirstlane(tid >> 6), c = lane & 31, h = lane >> 5;
    const int nt = n >> 5, nch = (n + 255) >> 8;
    const bf16* kb = P1 + (size_t)b * SEQ * N1 + OFF_KI;
    unsigned dsrc[4];
#pragma unroll
    for (int ii = 0; ii < 4; ++ii) { const int q = wid * 4 + ii, keyl = q * 8 + (lane >> 3), pc = lane & 7; dsrc[ii] = (unsigned)(keyl * N1 + ((pc ^ ((keyl >> 1) & 7)) << 3)); }
#define KI_DMA(cc) do { _Pragma("unroll") for (int ii = 0; ii < 4; ++ii) { const int q_ = wid * 4 + ii; if (256 * (cc) + 8 * q_ < n) \
        __builtin_amdgcn_global_load_lds((const unsigned*)(kb + (size_t)(256 * (cc)) * N1 + dsrc[ii]), (LAS unsigned*)(lds + ((cc) & 1) * 32768 + q_ * 1024), 16, 0, 0); } } while (0)
    KI_DMA(0);
    const int qa = 2 * ((c >> 2) & 1) + (c >> 4), ih = (c & 3) + 4 * ((c >> 3) & 1);
    const bf16* qip = P1 + (size_t)(tokw + qa) * N1 + OFF_QI + ih * 64 + 8 * h;
    bf16x8 af[4];
#pragma unroll
    for (int s = 0; s < 4; ++s) af[s] = *(const bf16x8*)(qip + 16 * s);
    float wq0[8], wq1[8];
    { const u32x4 t = *(const u32x4*)(P1 + (size_t)(tokw + 2 * h) * N1 + OFF_WI), u = *(const u32x4*)(P1 + (size_t)(tokw + 2 * h + 1) * N1 + OFF_WI);
      wq0[0] = bflo(t.x); wq0[1] = bfhi(t.x); wq0[2] = bflo(t.y); wq0[3] = bfhi(t.y); wq0[4] = bflo(t.z); wq0[5] = bfhi(t.z); wq0[6] = bflo(t.w); wq0[7] = bfhi(t.w);
      wq1[0] = bflo(u.x); wq1[1] = bfhi(u.x); wq1[2] = bflo(u.y); wq1[3] = bfhi(u.y); wq1[4] = bflo(u.z); wq1[5] = bfhi(u.z); wq1[6] = bflo(u.w); wq1[7] = bfhi(u.w); }
    const int rdoff = c * 128, rsw = (c >> 1) & 7;
    float sc0[64], sc1[64];
    float mn0 = __builtin_inff(), mx0 = -__builtin_inff(), mn1 = __builtin_inff(), mx1 = -__builtin_inff();
    float sm0 = 0.f, sq0 = 0.f, sm1 = 0.f, sq1 = 0.f;
#pragma unroll
    for (int cc = 0; cc < 8; ++cc) {
        if (cc < nch) {
            __syncthreads();
            if (cc + 1 < nch) KI_DMA(cc + 1);
            const LAS char* cb = lds + (cc & 1) * 32768 + rdoff;
#pragma unroll
            for (int t = 0; t < 8; ++t) {
                const int i = cc * 8 + t;
                if (i < nt) {
                    f32x16 acc = {};
#pragma unroll
                    for (int s = 0; s < 4; ++s) { const bf16x8 kf = *(const LAS bf16x8*)(cb + t * 4096 + (((2 * s + h) ^ rsw) << 4));
                        acc = __builtin_amdgcn_mfma_f32_32x32x16_bf16(af[s], kf, acc, 0, 0, 0); }
                    float s0 = 0.f, s1 = 0.f;
#pragma unroll
                    for (int j = 0; j < 8; ++j) {
                        s0 = fmaf(wq0[j], __int_as_float(max(__float_as_int(acc[j]), 0)), s0); s1 = fmaf(wq1[j], __int_as_float(max(__float_as_int(acc[8 + j]), 0)), s1); }
                    sc0[i] = s0; sc1[i] = s1; mn0 = fminf(mn0, s0); mx0 = fmaxf(mx0, s0); mn1 = fminf(mn1, s1); mx1 = fmaxf(mx1, s1);
                    sm0 += s0; sq0 = fmaf(s0, s0, sq0); sm1 += s1; sq1 = fmaf(s1, s1, sq1);
                } else { sc0[i] = -__builtin_inff(); sc1[i] = -__builtin_inff(); }
            }
        } else {
#pragma unroll
            for (int t = 0; t < 8; ++t) { sc0[cc * 8 + t] = -__builtin_inff(); sc1[cc * 8 + t] = -__builtin_inff(); }
        }
    }
#undef KI_DMA
    __syncthreads();
    unsigned klo0 = f2key(half_minf(mn0, h)), khi0 = f2key(half_maxf(mx0, h)) + 1u, klo1 = f2key(half_minf(mn1, h)), khi1 = f2key(half_maxf(mx1, h)) + 1u;
    unsigned cl0 = (unsigned)n, cl1 = (unsigned)n, ch0 = 0u, ch1 = 0u;
    bool fin0 = (khi0 - klo0 <= 1u), fin1 = (khi1 - klo1 <= 1u);
    const float rn = 1.0f / (float)n;
    const float mu0 = half_sumf(sm0, h) * rn, mu1 = half_sumf(sm1, h) * rn;
    const float sd0 = sqrtf(fmaxf(half_sumf(sq0, h) * rn - mu0 * mu0, 1e-30f)), sd1 = sqrtf(fmaxf(half_sumf(sq1, h) * rn - mu1 * mu1, 1e-30f));
    const float zq = ZT[(n >> 6) - 1], rdphi = __builtin_amdgcn_rcpf(ZT[32 + (n >> 6) - 1]);
    bool np0 = false, np1 = false;
    for (int it = 0; it < (PROBE == 3 ? 0 : 96); ++it) {
        unsigned km0, km1;
        if (it < 48) {
            const float lo0f = key2f(klo0), hi0f = key2f(khi0), lo1f = key2f(klo1), hi1f = key2f(khi1);
            float f0 = 0.5f, f1 = 0.5f;
            if (!(it & 1)) { f0 = ((float)cl0 - 255.5f) * __builtin_amdgcn_rcpf((float)(cl0 - ch0)); f1 = ((float)cl1 - 255.5f) * __builtin_amdgcn_rcpf((float)(cl1 - ch1)); }
            float m0 = fmaf(hi0f - lo0f, f0, lo0f), m1 = fmaf(hi1f - lo1f, f1, lo1f);
            if (it == 0) { m0 = fmaf(zq, sd0, mu0); m1 = fmaf(zq, sd1, mu1); }
            else if (it == 1) {
                m0 = (cl0 != (unsigned)n) ? lo0f + (1.5f * ((float)cl0 - 255.5f) + 4.0f) * sd0 * rdphi : hi0f - (1.5f * (255.5f - (float)ch0) + 4.0f) * sd0 * rdphi;
                m1 = (cl1 != (unsigned)n) ? lo1f + (1.5f * ((float)cl1 - 255.5f) + 4.0f) * sd1 * rdphi : hi1f - (1.5f * (255.5f - (float)ch1) + 4.0f) * sd1 * rdphi;
            }
            km0 = f2key(m0 + 0.0f); km1 = f2key(m1 + 0.0f);
            if (!(m0 == m0)) km0 = klo0 + ((khi0 - klo0) >> 1);
            if (!(m1 == m1)) km1 = klo1 + ((khi1 - klo1) >> 1);
        } else { km0 = klo0 + ((khi0 - klo0) >> 1); km1 = klo1 + ((khi1 - klo1) >> 1); }
        constexpr unsigned EG = 3u;
        const unsigned rb0 = 256u - ch0, ra0 = cl0 - 256u, rb1 = 256u - ch1, ra1 = cl1 - 256u;
        const bool sp0 = !fin0 && ((rb0 <= EG && rb0 <= ra0) || np0), sp1 = !fin1 && ((rb1 <= EG && rb1 <= ra1) || np1);
        const bool sa0 = !fin0 && !sp0 && ra0 <= EG, sa1 = !fin1 && !sp1 && ra1 <= EG;
        if (__any(sp0 || sp1)) {
            const float hf0 = key2f(khi0), hf1 = key2f(khi1); float b0 = -__builtin_inff(), b1 = -__builtin_inff();
#pragma unroll
            for (int g = 0; g < 8; ++g) {
                if (g * 8 < nt) {
#pragma unroll
                    for (int i = g * 8; i < g * 8 + 8; ++i) { b0 = fmaxf(b0, (sc0[i] < hf0) ? sc0[i] : -__builtin_inff()); b1 = fmaxf(b1, (sc1[i] < hf1) ? sc1[i] : -__builtin_inff()); }
                }
            }
            b0 = half_maxf(b0, h); b1 = half_maxf(b1, h);
            if (sp0) km0 = f2key(b0); if (sp1) km1 = f2key(b1);
        }
        if (__any(sa0 || sa1)) {
            const float lf0 = key2f(klo0), lf1 = key2f(klo1); float a0 = __builtin_inff(), a1 = __builtin_inff();
#pragma unroll
            for (int g = 0; g < 8; ++g) {
                if (g * 8 < nt) {
#pragma unroll
                    for (int i = g * 8; i < g * 8 + 8; ++i) { a0 = fminf(a0, (sc0[i] >= lf0) ? sc0[i] : __builtin_inff()); a1 = fminf(a1, (sc1[i] >= lf1) ? sc1[i] : __builtin_inff()); }
                }
            }
            a0 = half_minf(a0, h); a1 = half_minf(a1, h);
            if (sa0) km0 = f2key(a0) + 1u; if (sa1) km1 = f2key(a1) + 1u;
        }
        km0 = min(max(km0, klo0 + 1u), khi0 - 1u); km1 = min(max(km1, klo1 + 1u), khi1 - 1u);
        const float t0 = key2f(km0), t1 = key2f(km1);
        unsigned c0 = 0u, c1 = 0u, c0b = 0u, c1b = 0u;
#pragma unroll
        for (int g = 0; g < 8; ++g) {
            if (g * 8 < nt) {
#pragma unroll
                for (int i = g * 8; i < g * 8 + 8; i += 2)
                    asm volatile("v_cmp_ge_f32_e64 s[36:37], %4, %8\n\tv_cmp_ge_f32_e64 s[38:39], %5, %9\n\tv_cmp_ge_f32_e64 s[40:41], %6, %8\n\tv_cmp_ge_f32_e64 s[42:43], %7, %9\n\t"
                                 "v_addc_co_u32_e64 %0, vcc, 0, %0, s[36:37]\n\tv_addc_co_u32_e64 %1, vcc, 0, %1, s[38:39]\n\tv_addc_co_u32_e64 %2, vcc, 0, %2, s[40:41]\n\tv_addc_co_u32_e64 %3, vcc, 0, %3, s[42:43]"
                                 : "+v"(c0), "+v"(c1), "+v"(c0b), "+v"(c1b) : "v"(sc0[i]), "v"(sc1[i]), "v"(sc0[i + 1]), "v"(sc1[i + 1]), "v"(t0), "v"(t1) : "vcc", "s36", "s37", "s38", "s39", "s40", "s41", "s42", "s43");
            }
        }
        { const unsigned cs = half_sum((c0 + c0b) | ((c1 + c1b) << 16), h); c0 = cs & 0xffffu; c1 = cs >> 16; }
        if (!fin0) { np0 = (it >= 2) && (c0 == cl0 || c0 == ch0);
            if (c0 >= 256u) { klo0 = km0; cl0 = c0; if (sp0) khi0 = km0 + 1u; } else { khi0 = km0; ch0 = c0; if (sa0) klo0 = km0 - 1u; } fin0 = (c0 == 256u) || (khi0 - klo0 <= 1u); }
        if (!fin1) { np1 = (it >= 2) && (c1 == cl1 || c1 == ch1);
            if (c1 >= 256u) { klo1 = km1; cl1 = c1; if (sp1) khi1 = km1 + 1u; } else { khi1 = km1; ch1 = c1; if (sa1) klo1 = km1 - 1u; } fin1 = (c1 == 256u) || (khi1 - klo1 <= 1u); }
        if (__all(fin0 && fin1)) break;
    }
    const float lo0 = key2f(klo0), lo1 = key2f(klo1);
    unsigned w0l = 0u, w0h = 0u, w1l = 0u, w1h = 0u;
#define BITOF(cond) ({ unsigned t__ = (cond) ? 1u : 0u; asm volatile("" : "+v"(t__)); t__; })
    if (__all(cl0 == 256u && cl1 == 256u)) {
#pragma unroll
        for (int g = 0; g < 8; ++g) {
            if (g * 8 < nt) {
#pragma unroll
                for (int i = g * 8; i < g * 8 + 8; ++i) {
                    if (i < 32) { w0l |= BITOF(sc0[i] >= lo0) << i; w1l |= BITOF(sc1[i] >= lo1) << i; } else { w0h |= BITOF(sc0[i] >= lo0) << (i - 32); w1h |= BITOF(sc1[i] >= lo1) << (i - 32); }
                }
            }
        }
    } else {
        unsigned g0 = 0u, g1 = 0u;
#pragma unroll
        for (int i = 0; i < 64; ++i) { g0 += (sc0[i] > lo0) ? 1u : 0u; g1 += (sc1[i] > lo1) ? 1u : 0u; }
        g0 = half_sum(g0, h); g1 = half_sum(g1, h);
        const unsigned need0 = 256u - g0, need1 = 256u - g1, ltm = (1u << c) - 1u;
        unsigned run0 = 0u, run1 = 0u;
#pragma unroll
        for (int i = 0; i < 64; ++i) {
            const bool e0 = (sc0[i] == lo0), e1 = (sc1[i] == lo1);
            const unsigned long long m0 = __ballot(e0), m1 = __ballot(e1);
            const unsigned hb0 = h ? (unsigned)(m0 >> 32) : (unsigned)m0, hb1 = h ? (unsigned)(m1 >> 32) : (unsigned)m1;
            const bool s0 = (sc0[i] > lo0) || (e0 && (run0 + __popc(hb0 & ltm) < need0));
            const bool s1 = (sc1[i] > lo1) || (e1 && (run1 + __popc(hb1 & ltm) < need1));
            run0 += __popc(hb0); run1 += __popc(hb1);
            if (i < 32) { w0l |= BITOF(s0) << i; w1l |= BITOF(s1) << i; } else { w0h |= BITOF(s0) << (i - 32); w1h |= BITOF(s1) << (i - 32); }
        }
    }
#undef BITOF
    W0lo = w0l; W0hi = w0h; W1lo = w1l; W1hi = w1h;
}

__device__ __forceinline__ void partialSM(f32x16& p0, f32x16& p1, float b0, float& m_reg, float& mn, float& alpha) {
    constexpr float C = SCALE * LOG2E * (1.0f / 256.0f);
    float pmax = p0[0];
#pragma unroll
    for (int r = 1; r < 16; ++r) pmax = fmaxf(pmax, p0[r]);
#pragma unroll
    for (int r = 0; r < 16; ++r) pmax = fmaxf(pmax, p1[r]);
    { auto rr = __builtin_amdgcn_permlane32_swap(__float_as_uint(pmax), __float_as_uint(pmax), false, false);
      pmax = fmaxf(__uint_as_float(rr[0]), __uint_as_float(rr[1])); }
    const float pm = fmaf(pmax, C, b0);
    if (__builtin_expect(__all(pm - m_reg <= THR * LOG2E), 1)) { mn = m_reg; alpha = 1.f; }
    else { mn = fmaxf(m_reg, pm); alpha = __builtin_amdgcn_exp2f(m_reg - mn); m_reg = mn; }
    const float off = b0 - mn + PSH;
#pragma unroll
    for (int r = 0; r < 16; ++r) p0[r] = fmaf(p0[r], C, off);
#pragma unroll
    for (int r = 0; r < 16; ++r) p1[r] = fmaf(p1[r], C, off);
#pragma unroll
    for (int r = 0; r < 16; ++r) p0[r] = __builtin_amdgcn_exp2f(p0[r]);
}
__device__ __forceinline__ void finishSM(f32x16& p0, f32x16& p1, float alpha, float& l_reg, v8i& P8) {
#pragma unroll
    for (int r = 0; r < 16; ++r) p1[r] = __builtin_amdgcn_exp2f(p1[r]);
    float ps = 0;
#pragma unroll
    for (int r = 0; r < 16; ++r) ps += p0[r];
#pragma unroll
    for (int r = 0; r < 16; ++r) ps += p1[r];
    { auto rr = __builtin_amdgcn_permlane32_swap(__float_as_uint(ps), __float_as_uint(ps), false, false);
      ps = __uint_as_float(rr[0]) + __uint_as_float(rr[1]); }
    l_reg = l_reg * alpha + ps;
#pragma unroll
    for (int g = 0; g < 4; ++g) { const int t_ = __builtin_amdgcn_cvt_pk_fp8_f32(p0[4 * g], p0[4 * g + 1], __float_as_int(p0[4 * g]), false); P8[g] = __builtin_amdgcn_cvt_pk_fp8_f32(p0[4 * g + 2], p0[4 * g + 3], t_, true); }
#pragma unroll
    for (int g = 0; g < 4; ++g) { const int t_ = __builtin_amdgcn_cvt_pk_fp8_f32(p1[4 * g], p1[4 * g + 1], __float_as_int(p1[4 * g]), false); P8[4 + g] = __builtin_amdgcn_cvt_pk_fp8_f32(p1[4 * g + 2], p1[4 * g + 3], t_, true); }
}
__device__ __forceinline__ void qkt(f32x16& p0, f32x16& p1, const LAS char* Ks, const v8i* qr8, bf16x8 ax0, bf16x8 ax1, bf16x8 ef, int r32, int hi) {
    const LAS char* kr = Ks + r32 * 128; const int sw = (r32 >> 1) & 7;
    v8i kf[2][2];
#pragma unroll
    for (int kb = 0; kb < 2; ++kb)
#pragma unroll
        for (int sx = 0; sx < 2; ++sx) { const int pc = 4 * sx + 2 * hi;
            const v4i lo = *(const LAS v4i*)(kr + kb * 4096 + ((pc ^ sw) << 4)), hi_ = *(const LAS v4i*)(kr + kb * 4096 + (((pc + 1) ^ sw) << 4));
            kf[kb][sx] = __builtin_shufflevector(lo, hi_, 0, 1, 2, 3, 4, 5, 6, 7); }
    const int one = 0x7f7f7f7f;
#if defined(__HIP_DEVICE_COMPILE__)
    asm volatile("s_nop 1\n\tv_mfma_f32_32x32x16_bf16 %0, %1, %2, 0" : "=&v"(p0) : "v"(ax0), "v"(ef));
    asm volatile("s_nop 1\n\tv_mfma_f32_32x32x16_bf16 %0, %1, %2, 0" : "=&v"(p1) : "v"(ax1), "v"(ef));
    asm volatile("s_nop 1\n\tv_mfma_scale_f32_32x32x64_f8f6f4 %0, %1, %2, %0, %3, %3 op_sel_hi:[0,0,0]" : "+v"(p0) : "v"(kf[0][0]), "v"(qr8[0]), "v"(one));
    asm volatile("s_nop 1\n\tv_mfma_scale_f32_32x32x64_f8f6f4 %0, %1, %2, %0, %3, %3 op_sel_hi:[0,0,0]" : "+v"(p1) : "v"(kf[1][0]), "v"(qr8[0]), "v"(one));
    asm volatile("s_nop 1\n\tv_mfma_scale_f32_32x32x64_f8f6f4 %0, %1, %2, %0, %3, %3 op_sel_hi:[0,0,0]" : "+v"(p0) : "v"(kf[0][1]), "v"(qr8[1]), "v"(one));
    asm volatile("s_nop 1\n\tv_mfma_scale_f32_32x32x64_f8f6f4 %0, %1, %2, %0, %3, %3 op_sel_hi:[0,0,0]\n\ts_nop 3" : "+v"(p1) : "v"(kf[1][1]), "v"(qr8[1]), "v"(one));
    asm volatile("" :: "v"(kf[0][0]), "v"(kf[1][0]), "v"(kf[0][1]), "v"(kf[1][1]), "v"(ax0), "v"(ax1), "v"(ef), "v"(one));
#else
    (void)one; (void)ax0; (void)ax1; (void)ef; (void)kf; (void)qr8; p0 = f32x16{}; p1 = f32x16{};
#endif
}
constexpr int VT_PITCH = 80;
__device__ __forceinline__ void pv_d0(f32x16* o, const LAS char* vb, const v8i P8) {
    v8i bf[4];
#pragma unroll
    for (int d0 = 0; d0 < 4; ++d0) { const v4i lo = *(const LAS v4i*)(vb + d0 * 32 * VT_PITCH), hi_ = *(const LAS v4i*)(vb + d0 * 32 * VT_PITCH + 16); bf[d0] = __builtin_shufflevector(lo, hi_, 0, 1, 2, 3, 4, 5, 6, 7); }
    const int one = 0x7f7f7f7f;
#pragma unroll
    for (int d0 = 0; d0 < 4; ++d0) {
#if defined(__HIP_DEVICE_COMPILE__)
        asm volatile("s_nop 1\n\tv_mfma_scale_f32_32x32x64_f8f6f4 %0, %1, %2, %0, %3, %3 op_sel_hi:[0,0,0]" : "+v"(o[d0]) : "v"(P8), "v"(bf[d0]), "v"(one));
#else
        (void)one;
#endif
    }
#if defined(__HIP_DEVICE_COMPILE__)
    asm volatile("s_nop 3" :: "v"(P8), "v"(bf[0]), "v"(bf[1]), "v"(bf[2]), "v"(bf[3]), "v"(one));
#endif
}
#define PTOUCH(a, b) asm volatile("" : "+v"(a), "+v"(b))
#define MFMA_DRAIN() asm volatile("s_nop 15\n\ts_nop 15\n\ts_nop 15\n\ts_nop 15\n\ts_nop 15" ::: "memory")

__device__ __forceinline__ void qlat_stage(const bf16* __restrict__ P1, const bf16* __restrict__ WUKT, int tok0, LAS char* lds, int tid_in) {
    int tid = tid_in; asm volatile("" : "+v"(tid));
    const int hd = tid >> 6, lane = tid & 63, r32 = lane & 31, hi = lane >> 5;
    bf16x8 bq[4];
    { const bf16* qp = P1 + (size_t)(tok0 + r32) * N1 + OFF_Q + hd * 64 + 8 * hi;
#pragma unroll
      for (int s = 0; s < 4; ++s) bq[s] = *(const bf16x8*)(qp + 16 * s); }
    const bf16* wp = WUKT + (size_t)hd * 8192 + (size_t)r32 * 64 + 8 * hi;
#pragma unroll
    for (int mt = 0; mt < 4; ++mt) {
        f32x16 acc = {};
#pragma unroll
        for (int s = 0; s < 4; ++s) { const bf16x8 af = *(const bf16x8*)(wp + mt * 2048 + 16 * s); acc = __builtin_amdgcn_mfma_f32_32x32x16_bf16(af, bq[s], acc, 0, 0, 0); }
#pragma unroll
        for (int r4 = 0; r4 < 4; ++r4) { float q_[4];
#pragma unroll
            for (int e = 0; e < 4; ++e) q_[e] = fminf(fmaxf(acc[4 * r4 + e] * 16.0f, -448.f), 448.f);
            const int t_ = __builtin_amdgcn_cvt_pk_fp8_f32(q_[0], q_[1], 0, false);
            *(LAS unsigned*)(lds + (r32 * 8 + hd) * 128 + 32 * mt + 8 * r4 + 4 * hi) = (unsigned)__builtin_amdgcn_cvt_pk_fp8_f32(q_[2], q_[3], t_, true); }
    }
}

__device__ __forceinline__ void attn_item(const bf16* __restrict__ P1, const bf16* __restrict__ WUKT, const unsigned char* __restrict__ Cb, const unsigned char* __restrict__ CT8b, unsigned char* __restrict__ MIXp, const bf16* __restrict__ WUVT, int tok0, int pos0, int n, LAS char* lds, const int tid_in) {
    int tid = tid_in; asm volatile("" : "+v"(tid));
    const int wid = tid >> 6, lane = tid & 63, r32 = lane & 31, hi = lane >> 5;
    LAS char* V_lds = lds; LAS char* K_lds = lds + 2 * SHM_V;
    LAS float* wsl = (LAS float*)(lds + 2 * SHM_V + 2 * SHM_K) + wid * 64; LAS float* li_l = wsl; LAS float* al_l = wsl + 32;
    const LAS u32x4* mwl = (const LAS u32x4*)(lds + SHM_ATTN) + tid;
    float m_reg = -1e30f, l_reg = 0; f32x16 o[4] = {}; v8i qr8[2];
    const int ql_ = r32 >> 3, hd = r32 & 7;
    const int NT = n >> 6, NTP = (NT + 1) & ~1;
#define TILE_K0(j) (((j) < NT) ? (NT - 1 - (j)) * KVBLK : 0)
    const int vtw = (tid >> 2) * VT_PITCH + (tid & 3) * 16;
    const int kgo = (tid >> 3) * 128 + (tid & 7) * 16, kwo = (tid >> 3) * 128 + (((tid & 7) ^ ((tid >> 4) & 7)) << 4);
    struct { u32x4 k8, vt; } sr_[2];
#define SLOAD(i, k0) do { sr_[i].k8 = *(const u32x4*)(Cb + (size_t)(k0) * 128 + kgo); sr_[i].vt = *(const u32x4*)(CT8b + (size_t)((k0) >> 6) * 8192 + tid * 16); } while (0)
    constexpr int SE = 0, SO = 1;
    SLOAD(SE, TILE_K0(0)); SLOAD(SO, TILE_K0(1));
    qlat_stage(P1, WUKT, tok0, lds, tid);
    __syncthreads();
    { const LAS char* Qw = lds + ((4 * wid + ql_) * 8 + hd) * 128 + hi * 32;
#pragma unroll
      for (int sx = 0; sx < 2; ++sx) { const v4i lo = *(const LAS v4i*)(Qw + 64 * sx), hi_ = *(const LAS v4i*)(Qw + 64 * sx + 16); qr8[sx] = __builtin_shufflevector(lo, hi_, 0, 1, 2, 3, 4, 5, 6, 7); } }
    const float qposf = (float)(pos0 + 4 * wid + ql_);
    bf16x8 ef; { u32x4 w = {0u, 0u, 0u, 0u}; w.x = ((ql_ == 2 * hi) ? 0x3F80u : 0u) | ((ql_ == 2 * hi + 1) ? 0x3F800000u : 0u); w.y = (hi == 0) ? ((unsigned)(137 - hd) << 7) : 0u; ef = *reinterpret_cast<bf16x8*>(&w); }
#define MASKW(s_) 0
#define MKAX(j, ax0, ax1) do { const unsigned klw0 = (hi == 0) ? (__float_as_uint((float)r32) >> 16) : 0u, klw1 = (hi == 0) ? (__float_as_uint((float)(32 + r32)) >> 16) : 0u;   \
        u32x4 w0_ = {NEG2, klw0, 0u, 0u}, w1_ = {NEG2, klw1, 0u, 0u}; if ((j) < NT) { const u32x4 Wv_ = *mwl; const int sh_ = 2 * (NT - 1 - (j)); \
            const unsigned v0_ = (unsigned)((((unsigned long long)Wv_.y << 32) | Wv_.x) >> sh_), v1_ = (unsigned)((((unsigned long long)Wv_.w << 32) | Wv_.z) >> sh_); \
            const unsigned mA_ = (v0_ & 1u) | ((v1_ & 1u) << 16), mB_ = ((v0_ >> 1) & 1u) | ((v1_ & 2u) << 15); \
            w0_.x = NEG2 & ~(mA_ * 0xffffu); w1_.x = NEG2 & ~(mB_ * 0xffffu); } \
        ax0 = *reinterpret_cast<bf16x8*>(&w0_); ax1 = *reinterpret_cast<bf16x8*>(&w1_); } while (0)
#define TILE_B0(j) ({ int r__ = r32; asm volatile("" : "+v"(r__)); const float sl__ = __uint_as_float((unsigned)(126 - (r__ & 7)) << 23) * LOG2E; \
        sl__ * ((float)TILE_K0(j) - (float)(pos0 + 4 * wid + (r__ >> 3))); })
    const LAS char* vb0 = V_lds + r32 * VT_PITCH + 32 * hi;
    constexpr int VSL = 128 * VT_PITCH, KSL = 64 * 128;
#define SWRITE(slot, i) do { *(LAS u32x4*)(V_lds + (slot) * VSL + vtw) = sr_[i].vt; *(LAS u32x4*)(K_lds + (slot) * KSL + kwo) = sr_[i].k8; } while (0)
#define SWAIT() asm volatile("s_waitcnt vmcnt(2)" ::: "memory")
#define RESC(a) do { if (__any((a) < 1.f)) { MFMA_DRAIN(); if (hi == 0) al_l[r32] = (a); asm volatile("s_waitcnt lgkmcnt(0)" ::: "memory"); \
    _Pragma("unroll") for (int d = 0; d < 4; ++d) _Pragma("unroll") for (int r = 0; r < 16; ++r) o[d][r] *= al_l[crow(r, hi)]; } } while (0)
    f32x16 pA0, pA1, pB0, pB1; float mnA, mnB, alA, alB; v8i P8; bf16x8 ax0, ax1;
    asm volatile("s_waitcnt vmcnt(0) lgkmcnt(0)" ::: "memory"); __syncthreads();
    SWRITE(0, SE); __syncthreads();
    MKAX(0, ax0, ax1); qkt(pA0, pA1, K_lds, qr8, ax0, ax1, ef, r32, hi);
    asm volatile("s_nop 15\n\ts_nop 15\n\ts_nop 15\n\ts_nop 15\n\ts_nop 15" : "+v"(pA0), "+v"(pA1));
    {
        const float base = (float)TILE_K0(0) - qposf + (float)(4 * hi), s16 = -2.0f * __uint_as_float((unsigned)(137 - hd) << 23);
#pragma unroll
        for (int r = 0; r < 16; ++r) { const float cr = (float)((r & 3) + 8 * (r >> 2));
            pA0[r] = fmaf(s16, fmaxf(base + cr, 0.f), pA0[r]); pA1[r] = fmaf(s16, fmaxf(base + cr + 32.f, 0.f), pA1[r]); }
    }
    partialSM(pA0, pA1, TILE_B0(0), m_reg, mnA, alA);
    if (2 < NTP) SLOAD(SE, TILE_K0(2));
    SWAIT(); SWRITE(1, SO); __syncthreads();
    int rp = 0, rc = 1, rn = 2;
#define RING_STEP() do { const int t__ = rp; rp = rc; rc = rn; rn = t__; } while (0)
    for (int j = 1; j + 1 < NTP; j += 2) {
        SBAR(); MKAX(j, ax0, ax1); qkt(pB0, pB1, K_lds + rc * KSL, qr8, ax0, ax1, ef, r32, hi);
        finishSM(pA0, pA1, alA, l_reg, P8); SBAR();
        SLOAD(SO, TILE_K0(j + 2)); SBAR();
        pv_d0(o, vb0 + rp * VSL, P8); PTOUCH(pB0, pB1); partialSM(pB0, pB1, TILE_B0(j), m_reg, mnB, alB);
        SWAIT(); SWRITE(rn, SE);
        RESC(alB); __syncthreads(); RING_STEP();
        SBAR(); MKAX(j + 1, ax0, ax1); qkt(pA0, pA1, K_lds + rc * KSL, qr8, ax0, ax1, ef, r32, hi);
        finishSM(pB0, pB1, alB, l_reg, P8); SBAR();
        if (j + 3 < NTP) SLOAD(SE, TILE_K0(j + 3)); SBAR();
        pv_d0(o, vb0 + rp * VSL, P8); PTOUCH(pA0, pA1); partialSM(pA0, pA1, TILE_B0(j + 1), m_reg, mnA, alA);
        SWAIT(); SWRITE(rn, SO);
        RESC(alA); __syncthreads(); RING_STEP();
    }
    SBAR(); MKAX(NTP - 1, ax0, ax1); qkt(pB0, pB1, K_lds + rc * KSL, qr8, ax0, ax1, ef, r32, hi);
    finishSM(pA0, pA1, alA, l_reg, P8); SBAR();
    pv_d0(o, vb0 + rp * VSL, P8); PTOUCH(pB0, pB1); partialSM(pB0, pB1, TILE_B0(NTP - 1), m_reg, mnB, alB);
    RESC(alB);
    finishSM(pB0, pB1, alB, l_reg, P8); SBAR();
    pv_d0(o, vb0 + rc * VSL, P8);
#undef RING_STEP
    MFMA_DRAIN();
    if (hi == 0) li_l[r32] = l_reg; asm volatile("s_waitcnt lgkmcnt(0)" ::: "memory");
    float rli[16];
#pragma unroll
    for (int r = 0; r < 16; ++r) rli[r] = __builtin_amdgcn_rcpf(li_l[crow(r, hi)]) * (1.0f / 16.0f);
    __syncthreads();
#pragma unroll
    for (int r = 0; r < 16; ++r) { const int orow = crow(r, hi);
        LAS bf16* zp = (LAS bf16*)lds + ((4 * wid + (orow >> 3)) * 8 + (orow & 7)) * 128 + r32;
#pragma unroll
        for (int d0 = 0; d0 < 4; ++d0) zp[d0 * 32] = (bf16)f2bf(o[d0][r] * rli[r]); }
    __syncthreads();
    {
        typedef unsigned u32x2 __attribute__((ext_vector_type(2)));
        bf16x8 bo[8];
        { const LAS char* zq = lds + ((r32 * 8 + wid) * 128 + 8 * hi) * 2;
#pragma unroll
          for (int s = 0; s < 8; ++s) bo[s] = *(const LAS bf16x8*)(zq + s * 32); }
        const bf16* wv = WUVT + (size_t)wid * 8192 + (size_t)r32 * 128 + 8 * hi;
#pragma unroll
        for (int mt = 0; mt < 2; ++mt) {
            f32x16 acc = {};
#pragma unroll
            for (int s = 0; s < 8; ++s) { const bf16x8 af = *(const bf16x8*)(wv + mt * 4096 + 16 * s); acc = __builtin_amdgcn_mfma_f32_32x32x16_bf16(af, bo[s], acc, 0, 0, 0); }
            unsigned char* op = MIXp + (size_t)(tok0 + r32) * K2 + wid * 64 + 32 * mt + 4 * hi;
#pragma unroll
            for (int r4 = 0; r4 < 4; ++r4) { float q_[4];
#pragma unroll
                for (int e = 0; e < 4; ++e) q_[e] = fminf(fmaxf(acc[4 * r4 + e] * 16.0f, -448.f), 448.f);
                const int t_ = __builtin_amdgcn_cvt_pk_fp8_f32(q_[0], q_[1], 0, false); *(unsigned*)(op + 8 * r4) = (unsigned)__builtin_amdgcn_cvt_pk_fp8_f32(q_[2], q_[3], t_, true); }
        }
    }
    __syncthreads();
#undef SLOAD
#undef SWRITE
#undef SWAIT
#undef RESC
#undef TILE_K0
#undef MASKW
#undef MKAX
#undef TILE_B0
}
}

__device__ __forceinline__ int tid_from(const int wid6) { int l; asm volatile("v_mbcnt_lo_u32_b32 %0, -1, 0\n\tv_mbcnt_hi_u32_b32 %0, -1, %0" : "=v"(l)); return wid6 | l; }
__device__ __forceinline__ void ph_attn_fast(const Args& a, LAS unsigned char* lds, const int variant, const int wid6) {
    const bf16* P1 = (const bf16*)(a.ws + WS_P1); unsigned char* MIX = a.ws + WS_MIX;
    const int G = gridDim.x;
    for (int it = blockIdx.x; it < BATCH * 64; it += G) {
        const int tid = tid_from(wid6);
        const int lane = tid & 63, wid = tid >> 6;
        const int gg = it & 255, m = it >> 8;
        const int b = (gg & 7) + 8 * (gg >> 6), jg = (gg >> 3) & 7, qb = (m & 1) ? (63 - jg - 8 * (m >> 1)) : (jg + 8 * (m >> 1));
        const int pos0 = qb * 32, tok0 = b * SEQ + pos0, n = ((pos0 >> 6) + 1) << 6;
        { unsigned w0l, w0h, w1l, w1h;
          if (variant == 2) { w0l = w0h = w1l = w1h = 0xffffffffu; }
          else if (ATT_VARIANT == 3 && variant == 3) dsa::idx_select<3>(P1, b, tok0 + 4 * wid, n, tid, (LAS char*)lds, (const float*)(a.ws + WS_ZT), w0l, w0h, w1l, w1h);
          else dsa::idx_select<0>(P1, b, tok0 + 4 * wid, n, tid, (LAS char*)lds, (const float*)(a.ws + WS_ZT), w0l, w0h, w1l, w1h);
          ((LAS dsa::u32x4*)(lds + dsa::SHM_ATTN))[tid] = (dsa::u32x4){w0l, w0h, w1l, w1h};
          asm volatile("s_waitcnt lgkmcnt(0)" ::: "memory");
          if (ATT_VARIANT && (variant == 1 || variant == 3)) { __syncthreads(); continue; } }
        dsa::attn_item(P1, (const bf16*)(a.ws + WS_WUKT), a.ws + WS_CN + (size_t)b * SEQ * 128, a.ws + WS_CT8 + (size_t)b * (SEQ / 64) * 8192, variant ? ((a.ws + WS_END) - (size_t)tok0 * K2 + (size_t)(tok0 & 4095) * K2) : MIX, (const bf16*)(a.ws + WS_WUVT), tok0, pos0, n, (LAS char*)lds, tid);
    }
}

__device__ __forceinline__ void ph_fixup(const Args& a, int gtid, int gthreads) {
    const float* HF = (const float*)(a.ws + WS_HF); const float* HL = (const float*)(a.ws + WS_HL); const float* CONVP = (const float*)(a.ws + WS_CONVP); unsigned char* ACT = a.ws + WS_ACT;
    constexpr int CH = FF / 4;
    for (int i = gtid; i < (NTOK / 256) * 2 * CH; i += gthreads) {
        const int pm = i / (2 * CH), rem = i - pm * (2 * CH), t = rem / CH, ch = rem - t * CH;
        if ((pm & 7) == 0) continue;
        const int jc = ch * 4, j = jc >> 7, ii = jc & 127, cg_ = 256 * j + ii;
        float r[4];
        f32x4 v[2];
#pragma unroll
        for (int half = 0; half < 2; ++half) {
            const int c = cg_ + half * 128;
            const f32x4 lm2 = *(const f32x4*)(HL + (size_t)((pm - 1) * 2 + 0) * N3 + c), lm1 = *(const f32x4*)(HL + (size_t)((pm - 1) * 2 + 1) * N3 + c);
            const f32x4 f0 = *(const f32x4*)(HF + (size_t)(pm * 2 + 0) * N3 + c), f1 = *(const f32x4*)(HF + (size_t)(pm * 2 + 1) * N3 + c);
            const f32x4 w0 = *(const f32x4*)(CONVP + c), w1 = *(const f32x4*)(CONVP + N3 + c), w2 = *(const f32x4*)(CONVP + 2 * N3 + c), bb = *(const f32x4*)(CONVP + 3 * N3 + c);
            v[half] = (t == 0) ? (bb + w0 * lm2 + w1 * lm1 + w2 * f0) : (bb + w0 * lm1 + w1 * f0 + w2 * f1);
        }
#pragma unroll
        for (int e = 0; e < 4; ++e) r[e] = v[0][e] / (1.0f + __expf(-v[0][e])) * v[1][e];
#pragma unroll
        for (int e = 0; e < 4; ++e) r[e] = fminf(fmaxf(r[e] * 8.0f, -448.f), 448.f);
        const int t_ = __builtin_amdgcn_cvt_pk_fp8_f32(r[0], r[1], 0, false);
        *(unsigned*)(ACT + (size_t)(pm * 256 + t) * FF + jc) = (unsigned)__builtin_amdgcn_cvt_pk_fp8_f32(r[2], r[3], t_, true);
    }
}

__device__ __forceinline__ void ph_final(const Args& a, int gw, int ngw, int lane) {
    const bf16* X2 = (const bf16*)(a.ws + WS_X2); const float* ss3 = (const float*)(a.ws + WS_CTL + 256 * 1024);
    for (int m = gw; m < NTOK; m += ngw) {
        const float rinv = 1.0f / sqrtf(ss3[m] * (1.0f / DM) + EPS);
#pragma unroll
        for (int h2 = 0; h2 < 2; ++h2) {
            const int c0 = h2 * 512 + 8 * lane;
            const v4u t = *(const v4u*)(X2 + (size_t)m * DM + c0);
            const f32x4 g0 = *(const f32x4*)(a.g_final + c0), g1 = *(const f32x4*)(a.g_final + c0 + 4);
            f32x4 o0, o1;
            o0.x = bflo(t.x) * rinv * g0.x; o0.y = bfhi(t.x) * rinv * g0.y; o0.z = bflo(t.y) * rinv * g0.z; o0.w = bfhi(t.y) * rinv * g0.w;
            o1.x = bflo(t.z) * rinv * g1.x; o1.y = bfhi(t.z) * rinv * g1.y; o1.z = bflo(t.w) * rinv * g1.z; o1.w = bfhi(t.w) * rinv * g1.w;
            *(f32x4*)(a.out + (size_t)m * DM + c0) = o0; *(f32x4*)(a.out + (size_t)m * DM + c0 + 4) = o1;
        }
    }
}

#define XB_TMO      128
#define XB_XCNT(j)  (256  + 64 * (j))
#define XB_XSUB(j)  (1280 + 64 * (j))
#define XB_XGEN(j)  (2304 + 64 * (j))
#define XB_TOP      3328
#define XB_TOPGEN   3392
#define XCD_BAR_WORDS 3456
#define XB_SPIN_CAP (1u << 18)
__device__ __forceinline__ unsigned xb_ld(unsigned* p)              { return __hip_atomic_load(p, __ATOMIC_RELAXED, __HIP_MEMORY_SCOPE_AGENT); }
__device__ __forceinline__ unsigned xb_add(unsigned* p, unsigned v) { return __hip_atomic_fetch_add(p, v, __ATOMIC_RELAXED, __HIP_MEMORY_SCOPE_AGENT); }
__device__ __forceinline__ unsigned xb_xcc_id() { return (unsigned)__builtin_amdgcn_s_getreg((3 << 11) | 20) & 0xFu; }
#define XB_SPIN(cond, bar) do { unsigned _sp = 0; while (cond) { __builtin_amdgcn_s_sleep(1); \
    if ((++_sp & 255u) == 0u) { if (xb_ld(&(bar)[XB_TMO])) break; if (_sp > XB_SPIN_CAP) { atomicAdd(&(bar)[XB_TMO], 1u); break; } } } } while (0)
struct XcdBarrier { unsigned* bar; unsigned x; volatile LAS unsigned* st; };
__device__ __forceinline__ XcdBarrier xcd_barrier_post(unsigned* bar, volatile LAS unsigned* st, const int tid) {
    XcdBarrier b; b.bar = bar; b.x = xb_xcc_id(); b.st = st;
    if (tid == 0) (void)xb_add(&bar[XB_XCNT(b.x)], 1u);
    return b;
}
__device__ __forceinline__ void xcd_barrier_complete(unsigned* bar, unsigned x, unsigned& nloc, unsigned& nx) {
    const unsigned G = gridDim.x * gridDim.y * gridDim.z;
    unsigned sum, cnt, mine, sp = 0u;
    for (;;) {
        sum = 0u; cnt = 0u; mine = 0u;
#pragma unroll
        for (unsigned j = 0; j < 16; ++j) { const unsigned c = xb_ld(&bar[XB_XCNT(j)]); sum += c; cnt += (c > 0u) ? 1u : 0u; mine = (j == x) ? c : mine; }
        if (sum == G) break;
        __builtin_amdgcn_s_sleep(1);
        if ((++sp & 255u) == 0u) { if (xb_ld(&bar[XB_TMO])) break; if (sp > XB_SPIN_CAP) { atomicAdd(&bar[XB_TMO], 1u); break; } }
    }
    nloc = mine > 0u ? mine : 1u; nx = cnt > 0u ? cnt : 1u;
}
__device__ __forceinline__ void xcd_barrier(const XcdBarrier& b, const int tid) {
    asm volatile("s_waitcnt vmcnt(0)" ::: "memory");
    __syncthreads();
    if (tid == 0) {
        unsigned* bar = b.bar;
        __builtin_amdgcn_s_waitcnt(0);
        unsigned nloc = b.st[0], nx = b.st[1];
        if (nloc == 0u) { xcd_barrier_complete(bar, b.x, nloc, nx); b.st[0] = nloc; b.st[1] = nx; }
        const unsigned old = xb_add(&bar[XB_XSUB(b.x)], 1u);
        const unsigned gen = old / nloc;
        if (old + 1u == (gen + 1u) * nloc) {
            __builtin_amdgcn_fence(__ATOMIC_RELEASE, "agent");
            asm volatile("s_waitcnt vmcnt(0)" ::: "memory");
            const unsigned og = xb_add(&bar[XB_TOP], 1u);
            const unsigned tg = og / nx;
            if (og + 1u == (tg + 1u) * nx) xb_add(&bar[XB_TOPGEN], 1u);
            else XB_SPIN(xb_ld(&bar[XB_TOPGEN]) == tg, bar);
            __builtin_amdgcn_fence(__ATOMIC_ACQUIRE, "agent");
            xb_add(&bar[XB_XGEN(b.x)], 1u);
            asm volatile("s_waitcnt vmcnt(0)" ::: "memory");
        } else {
            XB_SPIN(xb_ld(&bar[XB_XGEN(b.x)]) == gen, bar);
            __builtin_amdgcn_fence(__ATOMIC_ACQUIRE, "agent");
            asm volatile("s_waitcnt vmcnt(0)" ::: "memory");
        }
    }
    __syncthreads();
}

constexpr int NPHASE = 8;
#define IDS() const int tid = TIDK, lane = tid & 63, wave = __builtin_amdgcn_readfirstlane(tid >> 6); const int G = gridDim.x; \
    const int gtid = blockIdx.x * (NWAVES * 64) + tid, gthreads = G * NWAVES * 64, gw = blockIdx.x * NWAVES + wave, ngw = G * NWAVES; (void)lane; (void)wave; (void)gtid; (void)gthreads; (void)gw; (void)ngw;
__global__ void __launch_bounds__(NWAVES * 64, 2) fwd_kernel(Args a_unused) {
    extern __shared__ __attribute__((aligned(16))) unsigned char lds_raw[];
    LAS unsigned char* lds = (LAS unsigned char*)lds_raw;
    const kargp_t kp = (kargp_t)__builtin_amdgcn_kernarg_segment_ptr();
    const int lo = karg_int<136>(kp), hi = karg_int<140>(kp);
#define LOADA() const Args a = load_args(kp)
    volatile LAS unsigned* xb_st = (volatile LAS unsigned*)(lds + XB_LDS_OFF);
    const int wid6 = __builtin_amdgcn_readfirstlane((int)threadIdx.x) & ~63;
#define TIDK tid_from(wid6)
    { const int t0 = TIDK; if (t0 < 4) xb_st[t0] = 0u;
      __syncthreads();
      (void)xcd_barrier_post((unsigned*)((unsigned char*)karg_ptr<128>(kp) + WS_CTL + XB_CTL_OFF) + karg_int<144>(kp) * XCD_BAR_WORDS, xb_st, t0); }
    if (lo < 0) cg::this_grid().sync();
#define IN(k) (lo <= (k) && (k) < hi)
#define SEAM(k) do { if (IN(k) && IN((k) + 1)) { { XcdBarrier xb_; xb_.bar = (unsigned*)((unsigned char*)karg_ptr<128>(kp) + WS_CTL + XB_CTL_OFF) + karg_int<144>(kp) * XCD_BAR_WORDS; xb_.x = xb_xcc_id(); \
        xb_.st = (volatile LAS unsigned*)(lds + XB_LDS_OFF); xcd_barrier(xb_, TIDK); } } } while (0)
    if (IN(0)) { LOADA(); IDS(); ph_prologue(a, lds, tid, gtid, gthreads, gw, ngw, lane); }
    SEAM(0);
    if (IN(1)) {
        unsigned char* ws = (unsigned char*)karg_ptr<128>(kp);
        pg8::Gemm g{(const bf16*)(ws + WS_HB), (const bf16*)(ws + WS_W1T), NTOK, N1, DM}; pg8::StaticOrder S; S.init(NTOK, N1, (int)gridDim.x, (int)blockIdx.x);
        pg8::EpiStore E{(bf16*)(ws + WS_P1), N1, nullptr};
        pg8::gemm_phase<pg8::EpiStore, pg8::StaticOrder, true, true>(lds, g, S, E, TIDK);
    }
    SEAM(1);
    if (IN(2)) { LOADA(); IDS(); ph_cnorm_pool(a, gw, ngw, lane); }
    SEAM(2);
    if (IN(3)) { LOADA(); ph_attn_fast(a, lds, (ATT_VARIANT && a.li == 1) ? ATT_VARIANT : 0, wid6); }
    SEAM(3);
    if (IN(4)) {
        unsigned char* ws = (unsigned char*)karg_ptr<128>(kp);
        pg8::Gemm g{(const bf16*)(ws + WS_MIX), (const bf16*)(ws + WS_W2T), NTOK, DM, K2 / 2}; pg8::StaticOrder S; S.init(NTOK, DM, (int)gridDim.x, (int)blockIdx.x);
        pg8::EpiResid<false> E{(const void*)(ws + WS_HB), (bf16*)(ws + WS_X1B), (float*)(ws + WS_CTL), ws + WS_X1F8, 1.0f / 1024.0f, (const float*)(ws + WS_RS), (const float*)karg_ptr<8>(kp)};
        pg8::gemm_phase<pg8::EpiResid<false>, pg8::StaticOrder, true, true, true>(lds, g, S, E, TIDK);
    }
    SEAM(4);
    if (IN(5)) {
        unsigned char* ws = (unsigned char*)karg_ptr<128>(kp);
        pg8::Gemm g{(const bf16*)(ws + WS_X1F8), (const bf16*)(ws + WS_W3T), NTOK, N3, DM / 2}; pg8::StaticOrder S; S.init(NTOK, N3, (int)gridDim.x, (int)blockIdx.x);
        pg8::EpiConvGlu E{ws + WS_ACT, (const float*)(ws + WS_CTL), (const float*)(ws + WS_CONVP), (float*)(ws + WS_HF), (float*)(ws + WS_HL), (LAS float*)(lds + HALO_LDS_OFF)};
        pg8::gemm_phase<pg8::EpiConvGlu, pg8::StaticOrder, true, true, true>(lds, g, S, E, TIDK);
    }
    SEAM(5);
    if (IN(6)) { LOADA(); IDS(); ph_fixup(a, gtid, gthreads); }
    SEAM(6);
    if (IN(7)) {
        unsigned char* ws = (unsigned char*)karg_ptr<128>(kp);
        pg8::Gemm g{(const bf16*)(ws + WS_ACT), (const bf16*)(ws + WS_W4T), NTOK, DM, FF / 2}; pg8::StaticOrder S; S.init(NTOK, DM, (int)gridDim.x, (int)blockIdx.x);
        pg8::EpiFinal E{(const bf16*)(ws + WS_X1B), (float*)karg_ptr<120>(kp), (float*)(ws + WS_CTL + 256 * 1024), (unsigned*)(ws + WS_CTL + PCNT_CTL_OFF), (const float*)karg_ptr<112>(kp)};
        pg8::gemm_phase<pg8::EpiFinal, pg8::StaticOrder, true, true, true>(lds, g, S, E, TIDK);
    }
#undef IN
#undef SEAM
}

extern "C" void kernel_launch(void* const* d_in, const int* in_sizes, int n_in, void* d_out, int out_size, void* d_ws, size_t ws_size, hipStream_t stream) {
    static int grid = 0;
    if (grid == 0) {
        if (n_in != 15 || in_sizes[0] != NTOK * DM || out_size != NTOK * DM || ws_size < WS_END) { fprintf(stderr, "kernel_launch: unexpected shapes / workspace (n_in %d, ws %zu)\n", n_in, ws_size); grid = -1; return; }
        int dev = 0, cus = 0, per_cu = 0;
        hipGetDevice(&dev); hipDeviceGetAttribute(&cus, hipDeviceAttributeMultiprocessorCount, dev);
        if (hipFuncSetAttribute((const void*)fwd_kernel, hipFuncAttributeMaxDynamicSharedMemorySize, LDS_BYTES) != hipSuccess) { fprintf(stderr, "kernel_launch: hipFuncSetAttribute failed\n"); grid = -1; return; }
        if (hipOccupancyMaxActiveBlocksPerMultiprocessor(&per_cu, (const void*)fwd_kernel, NWAVES * 64, LDS_BYTES) != hipSuccess || per_cu < 1) { fprintf(stderr, "kernel_launch: occupancy query says %d\n", per_cu); per_cu = 1; }
        (void)hipGetLastError();
        grid = cus;
        if (grid != 256) fprintf(stderr, "kernel_launch: %d CUs (tuned for 256)\n", grid);
    }
    if (grid < 0) return;
    hipMemsetAsync((char*)d_ws + WS_CTL, 0, CTL_ZERO_BYTES, stream);
    Args a{};
    a.x = (const float*)d_in[0]; a.g_mix = (const float*)d_in[1]; a.w_in = (const float*)d_in[2]; a.g_kv = (const float*)d_in[3]; a.w_uk = (const float*)d_in[4]; a.w_uv = (const float*)d_in[5];
    a.w_pool = (const float*)d_in[6]; a.pool_scale = (const float*)d_in[7]; a.w_o = (const float*)d_in[8]; a.g_ffn = (const float*)d_in[9]; a.w_up = (const float*)d_in[10];
    a.conv_w = (const float*)d_in[11]; a.conv_b = (const float*)d_in[12]; a.w_down = (const float*)d_in[13]; a.g_final = (const float*)d_in[14];
    a.out = (float*)d_out; a.ws = (unsigned char*)d_ws;
#if REP_PH >= 0
    { void* args[] = {&a};
      if (REP_PH >= 100) {
        a.ph_lo = 0; a.ph_hi = NPHASE; a.li = 0; hipLaunchCooperativeKernel((const void*)fwd_kernel, dim3(grid), dim3(NWAVES * 64), args, LDS_BYTES, stream);
        a.ph_lo = 0; a.ph_hi = REP_PH - 100; a.li = 1; hipLaunchCooperativeKernel((const void*)fwd_kernel, dim3(grid), dim3(NWAVES * 64), args, LDS_BYTES, stream);
      } else if (REP_PH == 4 || REP_PH == 7) {
        a.ph_lo = 0; a.ph_hi = NPHASE; a.li = 0; hipLaunchCooperativeKernel((const void*)fwd_kernel, dim3(grid), dim3(NWAVES * 64), args, LDS_BYTES, stream);
        a.ph_lo = REP_PH; a.ph_hi = REP_PH + 1; a.li = 1; hipLaunchCooperativeKernel((const void*)fwd_kernel, dim3(grid), dim3(NWAVES * 64), args, LDS_BYTES, stream);
      } else {
      a.ph_lo = 0; a.ph_hi = REP_PH + 1; a.li = 0; hipLaunchCooperativeKernel((const void*)fwd_kernel, dim3(grid), dim3(NWAVES * 64), args, LDS_BYTES, stream);
      a.ph_lo = REP_PH; a.ph_hi = REP_PH + 1; a.li = 1; hipLaunchCooperativeKernel((const void*)fwd_kernel, dim3(grid), dim3(NWAVES * 64), args, LDS_BYTES, stream);
      if (REP_PH + 1 < NPHASE) { a.ph_lo = REP_PH + 1; a.ph_hi = NPHASE; a.li = 2; hipLaunchCooperativeKernel((const void*)fwd_kernel, dim3(grid), dim3(NWAVES * 64), args, LDS_BYTES, stream); } } }
#elif MK_ONE_LAUNCH
    a.ph_lo = 0; a.ph_hi = NPHASE;
    void* args[] = {&a};
    hipError_t e = hipLaunchCooperativeKernel((const void*)fwd_kernel, dim3(grid), dim3(NWAVES * 64), args, LDS_BYTES, stream);
    if (e != hipSuccess) fprintf(stderr, "cooperative launch failed: %s (grid %d)\n", hipGetErrorString(e), grid);
#else
    for (int ph = 0; ph < NPHASE; ++ph) {
        a.ph_lo = ph; a.ph_hi = ph + 1;
        hipLaunchKernelGGL(fwd_kernel, dim3(grid), dim3(NWAVES * 64), LDS_BYTES, stream, a);
    }
#endif
}
```

```cpp
#include <hip/hip_runtime.h>
#include <hip/hip_cooperative_groups.h>
#include <cstdio>
#include <cstdint>
namespace cg = cooperative_groups;

#ifndef USE_NAIVE_ATTN
#define USE_NAIVE_ATTN 0
#endif
#ifndef REP_PH
#define REP_PH -1
#endif
#ifndef ATT_VARIANT
#define ATT_VARIANT 0
#endif
#ifndef MK_ONE_LAUNCH
#define MK_ONE_LAUNCH 1
#endif

namespace pg8 {
#define PG8_LAS __attribute__((address_space(3)))
typedef unsigned short bf16_t;
typedef short bf16x8 __attribute__((ext_vector_type(8)));
typedef float f32x4 __attribute__((ext_vector_type(4)));
typedef unsigned u32x4 __attribute__((ext_vector_type(4)));
constexpr int BM = 256, BK = 64, HALF = 128, HTB = HALF * BK * 2, STAGE_BYTES = 8 * HTB, NXCD = 8, WGM = 8;

__host__ __device__ __forceinline__ int lds_byte(int r, int c) { const int st = (r >> 4) * 2 + (c >> 5), rr = r & 15, cc = c & 31, ob = rr * 64 + cc * 2; return st * 1024 + (ob ^ (((ob >> 9) & 1) << 5)); }
__host__ __device__ __forceinline__ void stage_rc(int b, int& R, int& C) { const int st = b / 1024, sb = b % 1024, swz = sb ^ (((sb >> 9) & 1) << 5); R = (st >> 1) * 16 + swz / 64; C = (st & 1) * 32 + (swz % 64) / 2; }
__host__ __device__ __forceinline__ int perm32(int rho) { const int n = rho >> 4, i = rho & 15; return 8 * (i >> 2) + 4 * n + (i & 3); }

struct Unit { int pm, pn; };
struct Gemm { const bf16_t* A; const bf16_t* Bt; int M, N, K; };

struct StaticOrder {
    int nM, nN, nwg, G, c;
    __host__ __device__ void init(int M, int N, int G_, int c_) { nM = M / BM; nN = N / BM; nwg = nM * nN; G = G_; c = c_; }
    __host__ __device__ bool next(int i, Unit& u) const {
        const long L = (long)i * G + c; if (L >= nwg) return false;
        int wgid = (int)L; { const int q = nwg / NXCD, r = nwg % NXCD, xcd = wgid % NXCD, off = wgid / NXCD; wgid = (xcd < r ? xcd * (q + 1) : r * (q + 1) + (xcd - r) * q) + off; }
        const int nig = WGM * nN, gid = wgid / nig, fm = gid * WGM, gsz = (nM - fm) < WGM ? (nM - fm) : WGM;
        u.pm = fm + ((wgid % nig) % gsz); u.pn = (wgid % nig) / gsz; return true;
    }
    __device__ __forceinline__ void a_ready(const Unit&) const {}
    __device__ __forceinline__ void done(const Unit&) const {}
};

__device__ __forceinline__ unsigned cvt_pk_bf16(float lo, float hi) { unsigned r; asm volatile("v_cvt_pk_bf16_f32 %0, %1, %2" : "=v"(r) : "v"(lo), "v"(hi)); return r; }


struct EpiStore {
    static constexpr bool PERM = true, AFTER_DRAIN = false;
    bf16_t* O; int ldc; const float* sumsq;
    __device__ __forceinline__ void operator()(const f32x4 (&acc)[2][2][4][2], const Unit& u, int wr, int wc, int fr, int fq) const {
        const int row0 = u.pm * BM + wr * 64 + fr, col0 = u.pn * BM + wc * 32 + 8 * fq;
#pragma unroll
        for (int ai = 0; ai < 2; ++ai)
#pragma unroll
            for (int m = 0; m < 4; ++m) {
                const int row = row0 + ai * HALF + m * 16;
                float sc = 1.f; if (sumsq) sc = 1.0f / sqrtf(sumsq[row] * (1.0f / 1024.0f) + 1e-6f);
                bf16_t* rowp = O + (size_t)row * ldc + col0;
#pragma unroll
                for (int bj = 0; bj < 2; ++bj) { f32x4 v0 = acc[ai][bj][m][0] * sc, v1 = acc[ai][bj][m][1] * sc;
                    u32x4 w; w.x = cvt_pk_bf16(v0[0], v0[1]); w.y = cvt_pk_bf16(v0[2], v0[3]); w.z = cvt_pk_bf16(v1[0], v1[1]); w.w = cvt_pk_bf16(v1[2], v1[3]);
                    *(u32x4*)(rowp + bj * HALF) = w; } }
    }
};
template <bool BASE_F32> struct EpiResid {
    static constexpr bool PERM = true, AFTER_DRAIN = false;
    const void* base; bf16_t* O; float* sumsq; unsigned char* O8; float accscale; const float* rowfac; const float* colg;
    __device__ __forceinline__ void operator()(const f32x4 (&acc)[2][2][4][2], const Unit& u, int wr, int wc, int fr, int fq) const {
        const int row0 = u.pm * BM + wr * 64 + fr, col0 = u.pn * BM + wc * 32 + 8 * fq;
        f32x4 gi[2][2];
        if (!BASE_F32) {
#pragma unroll
            for (int bj = 0; bj < 2; ++bj)
#pragma unroll
                for (int q = 0; q < 2; ++q) { const f32x4 g_ = *(const f32x4*)(colg + col0 + bj * HALF + 4 * q);
#pragma unroll
                    for (int e = 0; e < 4; ++e) gi[bj][q][e] = __builtin_amdgcn_rcpf(g_[e]); }
        }
#pragma unroll
        for (int ai = 0; ai < 2; ++ai)
#pragma unroll
            for (int m = 0; m < 4; ++m) {
                const int row = row0 + ai * HALF + m * 16; float ss = 0.f;
                float rf = 1.f; if (!BASE_F32) rf = rowfac[row];
#pragma unroll
                for (int bj = 0; bj < 2; ++bj) {
                    const size_t off = (size_t)row * 1024 + col0 + bj * HALF;
                    f32x4 b0, b1;
                    if (BASE_F32) { b0 = *(const f32x4*)((const float*)base + off); b1 = *(const f32x4*)((const float*)base + off + 4); }
                    else { const u32x4 r = *(const u32x4*)((const bf16_t*)base + off);
                        b0[0] = __uint_as_float(r.x << 16); b0[1] = __uint_as_float(r.x & 0xffff0000u); b0[2] = __uint_as_float(r.y << 16); b0[3] = __uint_as_float(r.y & 0xffff0000u);
                        b1[0] = __uint_as_float(r.z << 16); b1[1] = __uint_as_float(r.z & 0xffff0000u); b1[2] = __uint_as_float(r.w << 16); b1[3] = __uint_as_float(r.w & 0xffff0000u);
                        b0 = b0 * rf * gi[bj][0]; b1 = b1 * rf * gi[bj][1]; }
                    const f32x4 v0 = acc[ai][bj][m][0] * accscale + b0, v1 = acc[ai][bj][m][1] * accscale + b1;
                    ss += (v0[0] * v0[0] + v0[1] * v0[1]) + (v0[2] * v0[2] + v0[3] * v0[3]) + (v1[0] * v1[0] + v1[1] * v1[1]) + (v1[2] * v1[2] + v1[3] * v1[3]);
                    u32x4 w; w.x = cvt_pk_bf16(v0[0], v0[1]); w.y = cvt_pk_bf16(v0[2], v0[3]); w.z = cvt_pk_bf16(v1[0], v1[1]); w.w = cvt_pk_bf16(v1[2], v1[3]);
                    *(u32x4*)(O + off) = w;
                    if (O8) { typedef unsigned u32x2_ __attribute__((ext_vector_type(2))); u32x2_ q; int t_;
                        t_ = __builtin_amdgcn_cvt_pk_fp8_f32(v0[0] * 16.f, v0[1] * 16.f, 0, false); q.x = (unsigned)__builtin_amdgcn_cvt_pk_fp8_f32(v0[2] * 16.f, v0[3] * 16.f, t_, true);
                        t_ = __builtin_amdgcn_cvt_pk_fp8_f32(v1[0] * 16.f, v1[1] * 16.f, 0, false); q.y = (unsigned)__builtin_amdgcn_cvt_pk_fp8_f32(v1[2] * 16.f, v1[3] * 16.f, t_, true);
                        *(u32x2_*)(O8 + off) = q; } }
                ss += __shfl_xor(ss, 16); ss += __shfl_xor(ss, 32);
                if (fq == 0) atomicAdd(sumsq + row, ss);
            }
    }
};


struct EpiConvGlu {
    static constexpr bool PERM = true, AFTER_DRAIN = false;
    unsigned char* ACT; const float* sumsq; const float* convp; float* hfirst; float* hlast; PG8_LAS float* halo;
    __device__ __forceinline__ void operator()(f32x4 (&acc)[2][2][4][2], const Unit& u, int wr, int wc, int fr, int fq) const {
        constexpr int N3_ = 5632, FF_ = 2816;
        const int row0 = u.pm * BM + wr * 64 + fr, cq = wc * 32 + 8 * fq;
        f32x4 cpar[2][8];
#pragma unroll
        for (int n = 0; n < 2; ++n) { const float* cp = convp + u.pn * BM + cq + 4 * n;
#pragma unroll
            for (int q = 0; q < 4; ++q) { cpar[n][q] = *(const f32x4*)(cp + q * N3_); cpar[n][4 + q] = *(const f32x4*)(cp + HALF + q * N3_); } }
#pragma unroll
        for (int ai = 0; ai < 2; ++ai)
#pragma unroll
            for (int m = 0; m < 4; ++m) { const float sc = __builtin_amdgcn_rsqf(sumsq[row0 + ai * HALF + m * 16] * (1.0f / 1024.0f) + 1e-6f) * (1.0f / 1024.0f);
#pragma unroll
                for (int bj = 0; bj < 2; ++bj) { acc[ai][bj][m][0] *= sc; acc[ai][bj][m][1] *= sc; } }
#pragma unroll
        for (int ai = 0; ai < 2; ++ai)
#pragma unroll
            for (int bj = 0; bj < 2; ++bj)
#pragma unroll
                for (int m = 0; m < 4; ++m) { asm volatile("" : "+v"(acc[ai][bj][m][0])); asm volatile("" : "+v"(acc[ai][bj][m][1])); }
        __builtin_amdgcn_sched_barrier(0);
        if (fr >= 14) {
#pragma unroll
            for (int ai = 0; ai < 2; ++ai)
#pragma unroll
                for (int bj = 0; bj < 2; ++bj)
#pragma unroll
                    for (int n = 0; n < 2; ++n) *(PG8_LAS f32x4*)(halo + ((2 * ai + wr) * 2 + (fr - 14)) * 256 + bj * HALF + cq + 4 * n) = acc[ai][bj][3][n];
            if (wr == 1) {
#pragma unroll
                for (int bj = 0; bj < 2; ++bj)
#pragma unroll
                    for (int n = 0; n < 2; ++n) *(f32x4*)(hlast + (size_t)(u.pm * 2 + (fr - 14)) * N3_ + u.pn * BM + bj * HALF + cq + 4 * n) = acc[1][bj][3][n];
            }
        }
        if (fr < 2 && wr == 0) {
#pragma unroll
            for (int bj = 0; bj < 2; ++bj)
#pragma unroll
                for (int n = 0; n < 2; ++n) *(f32x4*)(hfirst + (size_t)(u.pm * 2 + fr) * N3_ + u.pn * BM + bj * HALF + cq + 4 * n) = acc[0][bj][0][n];
        }
        asm volatile("s_waitcnt lgkmcnt(0)" ::: "memory"); __builtin_amdgcn_s_barrier(); asm volatile("s_nop 1" ::: "memory");
#define CONV_DPP(cv, src, w, ctl) asm("v_fmac_f32_dpp %0, %1, %2 " ctl " row_mask:0xf bank_mask:0xf" : "+v"(cv) : "v"(src), "v"(w))
#pragma unroll
        for (int n = 0; n < 2; ++n) {
            const f32x4 g0 = cpar[n][0], g1 = cpar[n][1], g2 = cpar[n][2], gb = cpar[n][3];
            const f32x4 u0 = cpar[n][4], u1 = cpar[n][5], u2 = cpar[n][6], ub = cpar[n][7];
#pragma unroll
            for (int ai = 0; ai < 2; ++ai) {
                const int pred = 2 * ai + wr - 1;
                f32x4 hg1 = {0.f, 0.f, 0.f, 0.f}, hg2 = hg1, hu1 = hg1, hu2 = hg1;
                if (pred >= 0) { const PG8_LAS float* hp = halo + pred * 512 + cq + 4 * n;
                    hg2 = *(const PG8_LAS f32x4*)(hp); hg1 = *(const PG8_LAS f32x4*)(hp + 256); hu2 = *(const PG8_LAS f32x4*)(hp + HALF); hu1 = *(const PG8_LAS f32x4*)(hp + 256 + HALF); }
#pragma unroll
                for (int m = 3; m >= 0; --m) {
                    f32x4 cg, cu;
#pragma unroll
                    for (int j = 0; j < 4; ++j) {
                        const float ag = acc[ai][0][m][n][j], au = acc[ai][1][m][n][j];
                        float vg = fmaf(g2[j], ag, gb[j]), vu = fmaf(u2[j], au, ub[j]);
                        CONV_DPP(vg, ag, g1[j], "row_shr:1"); CONV_DPP(vg, ag, g0[j], "row_shr:2");
                        CONV_DPP(vu, au, u1[j], "row_shr:1"); CONV_DPP(vu, au, u0[j], "row_shr:2");
                        if (m > 0) { const float pg = acc[ai][0][m - 1][n][j], pu = acc[ai][1][m - 1][n][j];
                            CONV_DPP(vg, pg, g1[j], "row_shl:15"); CONV_DPP(vg, pg, g0[j], "row_shl:14");
                            CONV_DPP(vu, pu, u1[j], "row_shl:15"); CONV_DPP(vu, pu, u0[j], "row_shl:14");
                        } else {
                            const float c1g = (fr == 0) ? hg1[j] : 0.f, c2g = (fr == 0) ? hg2[j] : ((fr == 1) ? hg1[j] : 0.f);
                            const float c1u = (fr == 0) ? hu1[j] : 0.f, c2u = (fr == 0) ? hu2[j] : ((fr == 1) ? hu1[j] : 0.f);
                            vg = fmaf(g1[j], c1g, vg); vg = fmaf(g0[j], c2g, vg); vu = fmaf(u1[j], c1u, vu); vu = fmaf(u0[j], c2u, vu);
                        }
                        cg[j] = vg; cu[j] = vu;
                    }
                    float r[4];
#pragma unroll
                    for (int j = 0; j < 4; ++j) r[j] = cg[j] * __builtin_amdgcn_rcpf(1.0f + __builtin_amdgcn_exp2f(-1.4426950408889634f * cg[j])) * cu[j];
#pragma unroll
                    for (int j = 0; j < 4; ++j) r[j] = fminf(fmaxf(r[j] * 8.0f, -448.f), 448.f);
                    const int t_ = __builtin_amdgcn_cvt_pk_fp8_f32(r[0], r[1], 0, false); const unsigned w4 = (unsigned)__builtin_amdgcn_cvt_pk_fp8_f32(r[2], r[3], t_, true);
                    *(unsigned*)(ACT + (size_t)(row0 + ai * HALF + m * 16) * FF_ + u.pn * HALF + cq + 4 * n) = w4;
                }
            }
        }
#undef CONV_DPP
    }
};


struct EpiFinal {
    static constexpr bool PERM = true, AFTER_DRAIN = false;
    const bf16_t* base; float* out; float* sumsq; unsigned* pcnt; const float* gfin;
    __device__ __forceinline__ void operator()(f32x4 (&acc)[2][2][4][2], const Unit& u, int wr, int wc, int fr, int fq) const {
        const int row0 = u.pm * BM + wr * 64 + fr, col0 = u.pn * BM + wc * 32 + 8 * fq;
#pragma unroll
        for (int ai = 0; ai < 2; ++ai)
#pragma unroll
            for (int m = 0; m < 4; ++m) {
                const int row = row0 + ai * HALF + m * 16; float ss = 0.f;
#pragma unroll
                for (int bj = 0; bj < 2; ++bj) {
                    const u32x4 r = *(const u32x4*)(base + (size_t)row * 1024 + col0 + bj * HALF);
                    f32x4 b0, b1;
                    b0[0] = __uint_as_float(r.x << 16); b0[1] = __uint_as_float(r.x & 0xffff0000u); b0[2] = __uint_as_float(r.y << 16); b0[3] = __uint_as_float(r.y & 0xffff0000u);
                    b1[0] = __uint_as_float(r.z << 16); b1[1] = __uint_as_float(r.z & 0xffff0000u); b1[2] = __uint_as_float(r.w << 16); b1[3] = __uint_as_float(r.w & 0xffff0000u);
                    const f32x4 v0 = acc[ai][bj][m][0] * (1.0f / 512.0f) + b0, v1 = acc[ai][bj][m][1] * (1.0f / 512.0f) + b1;
                    acc[ai][bj][m][0] = v0; acc[ai][bj][m][1] = v1;
                    ss += (v0[0] * v0[0] + v0[1] * v0[1]) + (v0[2] * v0[2] + v0[3] * v0[3]) + (v1[0] * v1[0] + v1[1] * v1[1]) + (v1[2] * v1[2] + v1[3] * v1[3]); }
                ss += __shfl_xor(ss, 16); ss += __shfl_xor(ss, 32);
                if (fq == 0) atomicAdd(sumsq + row, ss);
            }
        const bool t0 = (wr == 0 && wc == 0 && fr == 0 && fq == 0);
        asm volatile("s_waitcnt vmcnt(0)" ::: "memory");
        __builtin_amdgcn_s_barrier();
        if (t0) {
            unsigned* pc = pcnt + 64 * u.pm;
            __hip_atomic_fetch_add(pc, 1u, __ATOMIC_RELAXED, __HIP_MEMORY_SCOPE_AGENT);
            unsigned sp = 0;
            while (__hip_atomic_load(pc, __ATOMIC_RELAXED, __HIP_MEMORY_SCOPE_AGENT) < 4u) { __builtin_amdgcn_s_sleep(2); if (++sp > (1u << 22)) break; }
            __builtin_amdgcn_fence(__ATOMIC_ACQUIRE, "agent");
            asm volatile("s_waitcnt vmcnt(0)" ::: "memory");
        }
        __builtin_amdgcn_s_barrier(); asm volatile("" ::: "memory");
#pragma unroll
        for (int ai = 0; ai < 2; ++ai)
#pragma unroll
            for (int m = 0; m < 4; ++m) {
                const int row = row0 + ai * HALF + m * 16;
                const float rinv = __builtin_amdgcn_rsqf(__hip_atomic_load(sumsq + row, __ATOMIC_RELAXED, __HIP_MEMORY_SCOPE_AGENT) * (1.0f / 1024.0f) + 1e-6f);
#pragma unroll
                for (int bj = 0; bj < 2; ++bj) { const int c = col0 + bj * HALF; float* op = out + (size_t)row * 1024 + c;
                    *(f32x4*)(op) = acc[ai][bj][m][0] * rinv * *(const f32x4*)(gfin + c); *(f32x4*)(op + 4) = acc[ai][bj][m][1] * rinv * *(const f32x4*)(gfin + c + 4); }
            }
    }
};

typedef int v8i_t __attribute__((ext_vector_type(8)));
typedef int v4i_t __attribute__((ext_vector_type(4)));
template <bool F8> struct Frag;
template <> struct Frag<false> { bf16x8 k[2]; };
template <> struct Frag<true>  { v8i_t v; };
template <bool F8> __device__ __forceinline__ void ld_frag(Frag<F8>& d, const PG8_LAS unsigned char* p) {
    if constexpr (F8) { const v4i_t lo = *(const PG8_LAS v4i_t*)p, hi = *(const PG8_LAS v4i_t*)(p + 1024); d.v = __builtin_shufflevector(lo, hi, 0, 1, 2, 3, 4, 5, 6, 7); }
    else { d.k[0] = *(const PG8_LAS bf16x8*)p; d.k[1] = *(const PG8_LAS bf16x8*)(p + 1024); }
}
template <bool F8> __device__ __forceinline__ f32x4 mma_frag(const Frag<F8>& b, const Frag<F8>& a, f32x4 c) {
    if constexpr (F8) {
        const int one = 0x7f7f7f7f;
#if defined(__HIP_DEVICE_COMPILE__)
        asm volatile("v_mfma_scale_f32_16x16x128_f8f6f4 %0, %1, %2, %0, %3, %3 op_sel_hi:[0,0,0]" : "+v"(c) : "v"(b.v), "v"(a.v), "v"(one));
#else
        (void)one;
#endif
        return c; }
    else { c = __builtin_amdgcn_mfma_f32_16x16x32_bf16(b.k[0], a.k[0], c, 0, 0, 0); return __builtin_amdgcn_mfma_f32_16x16x32_bf16(b.k[1], a.k[1], c, 0, 0, 0); }
}
template <class Epi, class Sched, bool ALIGN_EPI = false, bool SP2 = false, bool F8 = false>
__device__ __forceinline__ void gemm_phase(PG8_LAS unsigned char* lds, const Gemm g, const Sched& S, const Epi& E, const int tid) {
    const int wid = __builtin_amdgcn_readfirstlane(tid >> 6), lane = tid & 63, wr = wid >> 2, wc = wid & 3, fr = lane & 15, fq = lane >> 4;
    const int K = g.K, nt = K / BK;
    unsigned voffA[2], voffB[2];
#pragma unroll
    for (int i = 0; i < 2; ++i) { int R, C; stage_rc(tid * 16 + i * 8192, R, C); const int Rb = Epi::PERM ? ((R & ~31) + perm32(R & 31)) : R;
        voffA[i] = (unsigned)(R * K + C) * 2u; voffB[i] = (unsigned)(Rb * K + C) * 2u; }
    const size_t kstep = (size_t)(BK * 2);
    const size_t hstep = (size_t)HALF * K * 2;
    const size_t tstep = 2 * hstep;
    const unsigned ldsw = (unsigned)wid * 1024u;
    const int aoff = lds_byte(wr * 64 + fr, fq * 8), boff = lds_byte(wc * 32 + fr, fq * 8);
#define PG8_SA(b, h) (((b) * 2 + (h)) * HTB)
#define PG8_SB(b, h) ((4 + (b) * 2 + (h)) * HTB)
#define PG8_STAGE(bufoff, gbase, voff) do { _Pragma("unroll") for (int _i = 0; _i < 2; ++_i) \
        __builtin_amdgcn_global_load_lds((const unsigned*)((const char*)(gbase) + (voff)[_i]), (PG8_LAS unsigned*)(lds + (bufoff) + ldsw + _i * 8192), 16, 0, 0); } while (0)
#define PG8_LDA(dst, b, h) do { _Pragma("unroll") for (int m = 0; m < 4; ++m) ld_frag<F8>(dst[m], lds + PG8_SA(b, h) + aoff + m * 2048); } while (0)
#define PG8_LDB(dst, b, h) do { _Pragma("unroll") for (int n = 0; n < 2; ++n) ld_frag<F8>(dst[n], lds + PG8_SB(b, h) + boff + n * 2048); } while (0)
#define PG8_MMA(ai, bj, At, Bt) do { __builtin_amdgcn_s_setprio(1); _Pragma("unroll") for (int m = 0; m < 4; ++m) _Pragma("unroll") for (int n = 0; n < 2; ++n) \
        acc[ai][bj][m][n] = mma_frag<F8>(Bt[n], At[m], acc[ai][bj][m][n]); __builtin_amdgcn_s_setprio(0); } while (0)
#define PG8_WAIT_V(n) asm volatile("s_waitcnt vmcnt(" #n ")" ::: "memory")
#define PG8_WAIT_L(n) asm volatile("s_waitcnt lgkmcnt(" #n ")" ::: "memory")
#define PG8_BAR __builtin_amdgcn_s_barrier()
#define PG8_SCHED __builtin_amdgcn_sched_barrier(0)
    Unit cur, nxt; int ui = 0;
    if (!S.next(0, cur)) return;
    f32x4 acc[2][2][4][2];
#pragma unroll
    for (int a = 0; a < 2; ++a)
#pragma unroll
        for (int b = 0; b < 2; ++b)
#pragma unroll
            for (int m = 0; m < 4; ++m)
#pragma unroll
                for (int n = 0; n < 2; ++n) acc[a][b][m][n] = (f32x4){0.f, 0.f, 0.f, 0.f};
    Frag<F8> At[4], B0[2], B1[2];
    const char* cA = (const char*)g.A + (size_t)cur.pm * tstep; const char* cB = (const char*)g.Bt + (size_t)cur.pn * tstep;
    S.a_ready(cur);
    if constexpr (SP2) {
        PG8_STAGE(PG8_SB(0, 0), cB, voffB); PG8_STAGE(PG8_SB(0, 1), cB + hstep, voffB); PG8_STAGE(PG8_SA(0, 0), cA, voffA); PG8_STAGE(PG8_SA(0, 1), cA + hstep, voffA);
        if (wr == 1) PG8_BAR;
        PG8_WAIT_V(2); PG8_BAR;
        PG8_STAGE(PG8_SB(1, 0), cB + kstep, voffB); PG8_STAGE(PG8_SA(1, 0), cA + kstep, voffA); PG8_STAGE(PG8_SB(1, 1), cB + hstep + kstep, voffB);
        PG8_WAIT_V(6); PG8_BAR;
    } else {
        PG8_STAGE(PG8_SB(0, 0), cB, voffB); PG8_STAGE(PG8_SA(0, 0), cA, voffA); PG8_STAGE(PG8_SB(0, 1), cB + hstep, voffB); PG8_STAGE(PG8_SA(0, 1), cA + hstep, voffA);
        if (wr == 1) PG8_BAR;
        PG8_WAIT_V(4); PG8_BAR;
        PG8_STAGE(PG8_SB(1, 0), cB + kstep, voffB); PG8_STAGE(PG8_SA(1, 0), cA + kstep, voffA); PG8_STAGE(PG8_SB(1, 1), cB + hstep + kstep, voffB);
        PG8_WAIT_V(6); PG8_BAR;
    }
    for (;;) {
        const bool has_next = S.next(ui + 1, nxt);
        const char* nA = has_next ? (const char*)g.A + (size_t)nxt.pm * tstep : cA; const char* nB = has_next ? (const char*)g.Bt + (size_t)nxt.pn * tstep : cB;
        for (int t = 0; t < nt; t += 2) {
            const bool last = (t == nt - 2);
            const char* a1 = cA + (size_t)(t + 1) * kstep;
            const char* a2 = last ? nA : cA + (size_t)(t + 2) * kstep; const char* b2 = last ? nB : cB + (size_t)(t + 2) * kstep;
            const char* a3 = a2 + kstep; const char* b3 = b2 + kstep;
            if (last && has_next) S.a_ready(nxt);
            if constexpr (SP2) {
            PG8_LDB(B0, 0, 0); PG8_LDB(B1, 0, 1); PG8_SCHED; PG8_LDA(At, 0, 0); PG8_STAGE(PG8_SA(1, 1), a1 + hstep, voffA);
            PG8_WAIT_V(8); PG8_WAIT_L(0); PG8_BAR; PG8_MMA(0, 0, At, B0); PG8_MMA(0, 1, At, B1); PG8_BAR; PG8_SCHED;
            PG8_LDA(At, 0, 1); PG8_STAGE(PG8_SB(0, 0), b2, voffB); PG8_STAGE(PG8_SB(0, 1), b2 + hstep, voffB); PG8_STAGE(PG8_SA(0, 0), a2, voffA);
            PG8_WAIT_V(8); PG8_WAIT_L(0); PG8_BAR; PG8_MMA(1, 0, At, B0); PG8_MMA(1, 1, At, B1); PG8_BAR; PG8_SCHED;
            PG8_LDB(B0, 1, 0); PG8_LDB(B1, 1, 1); PG8_SCHED; PG8_LDA(At, 1, 0); PG8_STAGE(PG8_SA(0, 1), a2 + hstep, voffA);
            PG8_WAIT_V(8); PG8_WAIT_L(0); PG8_BAR; PG8_MMA(0, 0, At, B0); PG8_MMA(0, 1, At, B1); PG8_BAR; PG8_SCHED;
            PG8_LDA(At, 1, 1); PG8_STAGE(PG8_SB(1, 0), b3, voffB); PG8_STAGE(PG8_SB(1, 1), b3 + hstep, voffB); PG8_STAGE(PG8_SA(1, 0), a3, voffA);
            PG8_WAIT_V(8); PG8_WAIT_L(0); PG8_BAR; PG8_MMA(1, 0, At, B0); PG8_MMA(1, 1, At, B1); PG8_BAR; PG8_SCHED;
            } else {
            PG8_LDB(B0, 0, 0); PG8_SCHED; PG8_LDA(At, 0, 0); PG8_STAGE(PG8_SA(1, 1), a1 + hstep, voffA);
            PG8_WAIT_L(8); PG8_BAR; PG8_WAIT_L(0); PG8_MMA(0, 0, At, B0); PG8_BAR; PG8_SCHED;
            PG8_LDB(B1, 0, 1); PG8_STAGE(PG8_SB(0, 0), b2, voffB);
            PG8_BAR; PG8_WAIT_L(0); PG8_MMA(0, 1, At, B1); PG8_BAR;
            PG8_LDA(At, 0, 1); PG8_STAGE(PG8_SA(0, 0), a2, voffA);
            PG8_BAR; PG8_WAIT_L(0); PG8_MMA(1, 0, At, B0); PG8_BAR; PG8_SCHED;
            PG8_STAGE(PG8_SB(0, 1), b2 + hstep, voffB);
            PG8_WAIT_V(6); PG8_BAR; PG8_MMA(1, 1, At, B1); PG8_BAR;
            PG8_LDB(B0, 1, 0); PG8_SCHED; PG8_LDA(At, 1, 0); PG8_STAGE(PG8_SA(0, 1), a2 + hstep, voffA);
            PG8_WAIT_L(8); PG8_BAR; PG8_WAIT_L(0); PG8_MMA(0, 0, At, B0); PG8_BAR; PG8_SCHED;
            PG8_LDB(B1, 1, 1); PG8_STAGE(PG8_SB(1, 0), b3, voffB);
            PG8_BAR; PG8_WAIT_L(0); PG8_MMA(0, 1, At, B1); PG8_BAR;
            PG8_LDA(At, 1, 1); PG8_STAGE(PG8_SA(1, 0), a3, voffA);
            PG8_BAR; PG8_WAIT_L(0); PG8_MMA(1, 0, At, B0); PG8_BAR; PG8_SCHED;
            PG8_STAGE(PG8_SB(1, 1), b3 + hstep, voffB);
            PG8_WAIT_V(6); PG8_BAR; PG8_MMA(1, 1, At, B1); PG8_BAR;
            }
        }
        if constexpr (ALIGN_EPI) { if (wr == 0) PG8_BAR; }
        if constexpr (F8) asm volatile("s_nop 15\n\ts_nop 15\n\ts_nop 15\n\ts_nop 15" ::: "memory");
        if constexpr (!Epi::AFTER_DRAIN) { E(acc, cur, wr, wc, fr, fq); S.done(cur); }
        if (!has_next) break;
#pragma unroll
        for (int a = 0; a < 2; ++a)
#pragma unroll
            for (int b = 0; b < 2; ++b)
#pragma unroll
                for (int m = 0; m < 4; ++m)
#pragma unroll
                    for (int n = 0; n < 2; ++n) acc[a][b][m][n] = (f32x4){0.f, 0.f, 0.f, 0.f};
        cur = nxt; cA = nA; cB = nB; ++ui;
        if constexpr (ALIGN_EPI) { if (wr == 1) PG8_BAR; }
    }
    PG8_WAIT_V(0);
    if constexpr (!ALIGN_EPI) { if (wr == 0) PG8_BAR; }
    PG8_BAR;
#undef PG8_SA
#undef PG8_SB
#undef PG8_STAGE
#undef PG8_LDA
#undef PG8_LDB
#undef PG8_MMA
#undef PG8_WAIT_V
#undef PG8_WAIT_L
#undef PG8_BAR
#undef PG8_SCHED
}
}

constexpr int NWAVES = 8;
constexpr int BATCH = 32, SEQ = 2048, DM = 1024, NTOK = BATCH * SEQ;
constexpr int IN_COLS = 1736;
constexpr int N1 = 1792, K2 = 1024, FF = 2816, N3 = 2 * FF;
constexpr int OFF_Q = 0, OFF_QI = 512, OFF_U = 1024, OFF_C = 1536, OFF_KI = 1664, OFF_WI = 1728;
constexpr float EPS = 1e-6f;
constexpr float WI_SCALE = 0.044194173824159216f;

constexpr size_t MiB = 1u << 20;
constexpr size_t WS_CTL = 0, CTL_ZERO_BYTES = 1 * MiB;
constexpr size_t WS_W1T = 1 * MiB, WS_W2T = 6 * MiB, WS_W3T = 9 * MiB, WS_W4T = 20 * MiB, WS_CONVP = 26 * MiB, WS_ZT = 27 * MiB, WS_WUKT = 28 * MiB, WS_WUVT = 28 * MiB + 128 * 1024;
constexpr size_t WS_HB = 32 * MiB;
constexpr size_t WS_RS = 27 * MiB + 64 * 1024;
constexpr size_t WS_P1 = 160 * MiB;
constexpr size_t WS_HF = 32 * MiB, WS_HL = 44 * MiB;
constexpr size_t WS_X2 = 64 * MiB;
constexpr size_t WS_MIX = 448 * MiB;
constexpr size_t WS_CN = 640 * MiB;
constexpr size_t WS_CT8 = 672 * MiB;
constexpr size_t WS_ACT = 448 * MiB;
constexpr size_t WS_X1B = 800 * MiB;
constexpr size_t WS_X1F8 = 928 * MiB;
constexpr size_t WS_END = 992 * MiB;

constexpr int LDS_BYTES = 147456;
constexpr int XB_LDS_OFF = 131072 + 1024;
constexpr int HALO_LDS_OFF = 131072 + 2048;
constexpr size_t XB_CTL_OFF = 512 * 1024;
constexpr size_t PCNT_CTL_OFF = 640 * 1024;

#define GAS __attribute__((address_space(1)))
#define LAS __attribute__((address_space(3)))
typedef unsigned short bf16;
typedef unsigned v4u __attribute__((ext_vector_type(4)));
typedef unsigned v2u __attribute__((ext_vector_type(2)));
typedef float f32x4 __attribute__((ext_vector_type(4)));

__device__ __forceinline__ unsigned f2bf(float f) { unsigned u = __builtin_bit_cast(unsigned, f); return (u + 0x7fffu + ((u >> 16) & 1u)) >> 16; }
__device__ __forceinline__ unsigned pk2(float lo, float hi) { return f2bf(lo) | (f2bf(hi) << 16); }
__device__ __forceinline__ float bflo(unsigned u) { return __uint_as_float(u << 16); }
__device__ __forceinline__ float bfhi(unsigned u) { return __uint_as_float(u & 0xffff0000u); }
__device__ __forceinline__ float wave_sum(float v) {
#define WS_DPP(x, ctl) __int_as_float(__builtin_amdgcn_update_dpp(0, __float_as_int(x), ctl, 0xf, 0xf, true))
    v += WS_DPP(v, 0xB1); v += WS_DPP(v, 0x4E); v += WS_DPP(v, 0x141); v += WS_DPP(v, 0x140);
#undef WS_DPP
    { auto rr = __builtin_amdgcn_permlane16_swap(__float_as_uint(v), __float_as_uint(v), false, false); v = __uint_as_float(rr[0]) + __uint_as_float(rr[1]); }
    { auto rr = __builtin_amdgcn_permlane32_swap(__float_as_uint(v), __float_as_uint(v), false, false); v = __uint_as_float(rr[0]) + __uint_as_float(rr[1]); }
    return v;
}
__device__ __forceinline__ float wave_max(float v) {
#pragma unroll
    for (int o = 1; o < 64; o <<= 1) v = fmaxf(v, __shfl_xor(v, o));
    return v;
}
#define WAVE_LDS_SYNC() do { asm volatile("s_waitcnt lgkmcnt(0)" ::: "memory"); __builtin_amdgcn_wave_barrier(); } while (0)

struct Args {
    const float* x; const float* g_mix; const float* w_in; const float* g_kv; const float* w_uk; const float* w_uv; const float* w_pool; const float* pool_scale;
    const float* w_o; const float* g_ffn; const float* w_up; const float* conv_w; const float* conv_b; const float* w_down; const float* g_final;
    float* out; unsigned char* ws; int ph_lo, ph_hi, li, pad;
};

typedef const void __attribute__((address_space(4)))* kargp_t;
template <int OFF> __device__ __forceinline__ void* karg_ptr(kargp_t kp) { __attribute__((address_space(1))) void* p; asm volatile("s_load_dwordx2 %0, %1, %2\n\ts_waitcnt lgkmcnt(0)" : "=s"(p) : "s"(kp), "i"(OFF)); return (void*)p; }
template <int OFF> __device__ __forceinline__ int karg_int(kargp_t kp) { int v; asm volatile("s_load_dword %0, %1, %2\n\ts_waitcnt lgkmcnt(0)" : "=s"(v) : "s"(kp), "i"(OFF)); return v; }
__device__ __forceinline__ Args load_args(kargp_t kp) {
    Args a;
    a.x = (const float*)karg_ptr<0>(kp); a.g_mix = (const float*)karg_ptr<8>(kp); a.w_in = (const float*)karg_ptr<16>(kp); a.g_kv = (const float*)karg_ptr<24>(kp);
    a.w_uk = (const float*)karg_ptr<32>(kp); a.w_uv = (const float*)karg_ptr<40>(kp); a.w_pool = (const float*)karg_ptr<48>(kp); a.pool_scale = (const float*)karg_ptr<56>(kp);
    a.w_o = (const float*)karg_ptr<64>(kp); a.g_ffn = (const float*)karg_ptr<72>(kp); a.w_up = (const float*)karg_ptr<80>(kp); a.conv_w = (const float*)karg_ptr<88>(kp);
    a.conv_b = (const float*)karg_ptr<96>(kp); a.w_down = (const float*)karg_ptr<104>(kp); a.g_final = (const float*)karg_ptr<112>(kp);
    a.out = (float*)karg_ptr<120>(kp); a.ws = (unsigned char*)karg_ptr<128>(kp); a.ph_lo = 0; a.ph_hi = 0; a.li = karg_int<144>(kp); a.pad = 0;
    return a;
}
static_assert(sizeof(Args) == 152, "Args layout (kernarg offsets above)");
__device__ __forceinline__ void tr_item(const float* __restrict__ W, int ldw, int k0, int srccol0, int valid, float colscale, const float* __restrict__ kscale,
                                        bf16* __restrict__ WT, int ldt, int nrow0, LAS float* scr, int lane) {
    const int jq = (lane & 7) * 4, kr = lane >> 3;
    f32x4 vv[8];
#pragma unroll
    for (int i = 0; i < 8; ++i) vv[i] = __builtin_nontemporal_load((const f32x4*)(W + (size_t)(k0 + 8 * i + kr) * ldw + srccol0 + jq));
#pragma unroll
    for (int i = 0; i < 8; ++i) { const int kk = 8 * i + kr; float ks = colscale; if (kscale) ks *= kscale[k0 + kk];
#pragma unroll
        for (int e = 0; e < 4; ++e) scr[kk * 33 + jq + e] = (jq + e < valid) ? vv[i][e] * ks : 0.f; }
    asm volatile("s_waitcnt lgkmcnt(0)" ::: "memory"); __builtin_amdgcn_wave_barrier();
    const int c = lane & 7;
#pragma unroll
    for (int jj = 0; jj < 4; ++jj) { const int n = (lane >> 3) + 8 * jj; const LAS float* s = scr + (8 * c) * 33 + n;
        v4u o; o.x = pk2(s[0 * 33], s[1 * 33]); o.y = pk2(s[2 * 33], s[3 * 33]); o.z = pk2(s[4 * 33], s[5 * 33]); o.w = pk2(s[6 * 33], s[7 * 33]);
        *(v4u*)(WT + (size_t)(nrow0 + n) * ldt + k0 + 8 * c) = o; }
    asm volatile("s_waitcnt lgkmcnt(0)" ::: "memory"); __builtin_amdgcn_wave_barrier();
}
__device__ __forceinline__ void tr_item_f8(const float* __restrict__ W, int ldw, int k0, int srccol0, float colscale, const float* __restrict__ kscale,
                                           unsigned char* __restrict__ WT8, int ldt, int nrow0, LAS float* scr, int lane) {
    const int jq = (lane & 7) * 4, kr = lane >> 3;
    f32x4 vv[8];
#pragma unroll
    for (int i = 0; i < 8; ++i) vv[i] = __builtin_nontemporal_load((const f32x4*)(W + (size_t)(k0 + 8 * i + kr) * ldw + srccol0 + jq));
#pragma unroll
    for (int i = 0; i < 8; ++i) { const int kk = 8 * i + kr; float ks = colscale; if (kscale) ks *= kscale[k0 + kk];
#pragma unroll
        for (int e = 0; e < 4; ++e) scr[kk * 33 + jq + e] = fminf(fmaxf(vv[i][e] * ks, -448.f), 448.f); }
    asm volatile("s_waitcnt lgkmcnt(0)" ::: "memory"); __builtin_amdgcn_wave_barrier();
    const int c = lane & 7;
#pragma unroll
    for (int jj = 0; jj < 4; ++jj) { const int n = (lane >> 3) + 8 * jj; const LAS float* s = scr + (8 * c) * 33 + n;
        v2u o; int t_;
        t_ = __builtin_amdgcn_cvt_pk_fp8_f32(s[0 * 33], s[1 * 33], 0, false); o.x = (unsigned)__builtin_amdgcn_cvt_pk_fp8_f32(s[2 * 33], s[3 * 33], t_, true);
        t_ = __builtin_amdgcn_cvt_pk_fp8_f32(s[4 * 33], s[5 * 33], 0, false); o.y = (unsigned)__builtin_amdgcn_cvt_pk_fp8_f32(s[6 * 33], s[7 * 33], t_, true);
        *(v2u*)(WT8 + (size_t)(nrow0 + n) * ldt + k0 + 8 * c) = o; }
    asm volatile("s_waitcnt lgkmcnt(0)" ::: "memory"); __builtin_amdgcn_wave_barrier();
}
__device__ __forceinline__ void ph_prologue(const Args& a, LAS unsigned char* lds, const int tid, int gtid, int gthreads, int gw, int ngw, int lane) {
    unsigned char* ws = a.ws;
    bf16* W1T = (bf16*)(ws + WS_W1T); bf16* W2T = (bf16*)(ws + WS_W2T); bf16* W3T = (bf16*)(ws + WS_W3T); bf16* W4T = (bf16*)(ws + WS_W4T);
    float* CONVP = (float*)(ws + WS_CONVP);
    LAS float* L0 = (LAS float*)lds;
    for (int it = blockIdx.x; it < 256; it += gridDim.x) {
        {
            const int g = it >> 6, n0 = ((it >> 1) & 31) * 32, ci0 = (it & 1) * 64;
            LAS float* Wp = L0; LAS float* Wo = L0 + 16384;
#pragma unroll
            for (int t = 0; t < 16; ++t) Wp[tid + 512 * t] = a.w_pool[g * 16384 + ci0 * 128 + tid + 512 * t];
#pragma unroll
            for (int t = 0; t < 8; ++t) { const int idx = tid + 512 * t, dd = idx >> 5; Wo[idx] = a.pool_scale[g * 128 + dd] * a.w_o[(size_t)(512 + g * 128 + dd) * DM + n0 + (idx & 31)]; }
            __syncthreads();
            const int nn = tid & 31, cg_ = tid >> 5; float acc[4];
#pragma unroll
            for (int j = 0; j < 4; ++j) acc[j] = 0.f;
            for (int dd = 0; dd < 128; ++dd) { const float wo = Wo[dd * 32 + nn];
#pragma unroll
                for (int j = 0; j < 4; ++j) acc[j] += Wp[(cg_ * 4 + j) * 128 + dd] * wo; }
#pragma unroll
            for (int j = 0; j < 4; ++j) acc[j] = fminf(fmaxf(acc[j] * 64.0f, -448.f), 448.f);
            const int t_ = __builtin_amdgcn_cvt_pk_fp8_f32(acc[0], acc[1], 0, false);
            *(unsigned*)((unsigned char*)W2T + (size_t)(n0 + nn) * K2 + 512 + g * 128 + ci0 + cg_ * 4) = (unsigned)__builtin_amdgcn_cvt_pk_fp8_f32(acc[2], acc[3], t_, true);
        }
        __syncthreads();
    }
    { bf16* WUKT = (bf16*)(ws + WS_WUKT); bf16* WUVT = (bf16*)(ws + WS_WUVT);
      for (int i = gtid; i < 8 * 128 * 64; i += gthreads) {
          { const int hd = i >> 13, c = (i >> 6) & 127, d = i & 63; WUKT[i] = (bf16)f2bf(a.w_uk[(hd * 64 + d) * 128 + c]); }
          { const int hd = i >> 13, d = (i >> 7) & 63, c = i & 127; WUVT[i] = (bf16)f2bf(a.w_uv[(hd * 128 + c) * 64 + d]); } } }
    LAS float* scr = (LAS float*)(lds + (tid >> 6) * 16384);
    constexpr int I1 = 56 * 16, I3 = 176 * 16, I4 = 32 * 44, I2 = 32 * 8;
    for (int it = gw; it < I1 + I3 + I4 + I2; it += ngw) {
        if (it >= I1 + I3 + I4) {
            const int i4 = it - (I1 + I3 + I4), nb = i4 >> 3, k0 = (i4 & 7) * 64;
            tr_item_f8(a.w_o, DM, k0, nb * 32, 64.f, nullptr, (unsigned char*)W2T, K2, nb * 32, scr, lane);
        } else if (it < I1) {
            const int nb = it >> 4, k0 = (it & 15) * 64, n0 = nb * 32; int sc0, valid = 32; float cs = 1.f;
            if (n0 < 512) sc0 = n0; else if (n0 < 1024) sc0 = 640 + (n0 - 512); else if (n0 < 1536) sc0 = 1224 + (n0 - 1024); else if (n0 < 1664) sc0 = 512 + (n0 - 1536); else if (n0 < 1728) sc0 = 1152 + (n0 - 1664);
            else if (n0 == 1728) { sc0 = 1216; valid = 8; cs = WI_SCALE; } else { sc0 = 0; valid = 0; }
            tr_item(a.w_in, IN_COLS, k0, sc0, valid, cs, nullptr, W1T, DM, n0, scr, lane);
        } else if (it < I1 + I3) {
            const int i2 = it - I1, nb = i2 >> 4, k0 = (i2 & 15) * 64, r0 = nb * 32, j = r0 >> 8, ii = r0 & 255;
            const int sc0 = (ii < 128) ? (128 * j + ii) : (FF + 128 * j + (ii - 128));
            tr_item_f8(a.w_up, N3, k0, sc0, 64.f, a.g_ffn, (unsigned char*)W3T, DM, r0, scr, lane);
        } else {
            const int i3 = it - I1 - I3, nb = i3 / 44, k0 = (i3 - nb * 44) * 64;
            tr_item_f8(a.w_down, DM, k0, nb * 32, 64.f, nullptr, (unsigned char*)W4T, FF, nb * 32, scr, lane);
        }
    }
    if (gtid < 32) {
        float* ZT = (float*)(ws + WS_ZT); const float nn = 64.0f * (float)(gtid + 1); float z = 0.f;
        if (nn > 256.f) { const float p = 256.0f / nn, pt = (p < 0.5f) ? p : 1.0f - p, t = sqrtf(-2.0f * logf(pt));
            const float zz = t - (2.515517f + t * (0.802853f + t * 0.010328f)) / (1.0f + t * (1.432788f + t * (0.189269f + t * 0.001308f))); z = (p < 0.5f) ? zz : -zz; }
        ZT[gtid] = z; ZT[32 + gtid] = nn * 0.3989423f * expf(-0.5f * z * z);
    }
    for (int r = gtid; r < N3; r += gthreads) {
        const int j = r >> 8, ii = r & 255; const int col = (ii < 128) ? (128 * j + ii) : (FF + 128 * j + (ii - 128));
        CONVP[r] = a.conv_w[col]; CONVP[N3 + r] = a.conv_w[N3 + col]; CONVP[2 * N3 + r] = a.conv_w[2 * N3 + col]; CONVP[3 * N3 + r] = a.conv_b[col];
    }
    bf16* HB = (bf16*)(ws + WS_HB);
    for (int m0 = gw; m0 < NTOK; m0 += 4 * ngw) {
        f32x4 v[4][4]; float s[4];
#pragma unroll
        for (int r = 0; r < 4; ++r) { const f32x4* xr = (const f32x4*)(a.x + (size_t)(m0 + r * ngw) * DM) + lane;
#pragma unroll
            for (int j = 0; j < 4; ++j) v[r][j] = __builtin_nontemporal_load(xr + 64 * j); }
        f32x4 g[4];
#pragma unroll
        for (int j = 0; j < 4; ++j) g[j] = ((const f32x4*)a.g_mix)[lane + 64 * j];
#pragma unroll
        for (int r = 0; r < 4; ++r) { s[r] = 0.f;
#pragma unroll
            for (int j = 0; j < 4; ++j) s[r] += (v[r][j].x * v[r][j].x + v[r][j].y * v[r][j].y) + (v[r][j].z * v[r][j].z + v[r][j].w * v[r][j].w); }
#pragma unroll
        for (int r = 0; r < 4; ++r) {
            const float rs_ = sqrtf(wave_sum(s[r]) * (1.0f / DM) + EPS), rinv = 1.0f / rs_;
            if (lane == 0) ((float*)(ws + WS_RS))[m0 + r * ngw] = rs_;
            unsigned long long* o8 = (unsigned long long*)(HB + (size_t)(m0 + r * ngw) * DM) + lane;
#pragma unroll
            for (int j = 0; j < 4; ++j)
                o8[64 * j] = (unsigned long long)pk2(v[r][j].x * rinv * g[j].x, v[r][j].y * rinv * g[j].y) | ((unsigned long long)pk2(v[r][j].z * rinv * g[j].z, v[r][j].w * rinv * g[j].w) << 32);
        }
    }
}

__device__ __forceinline__ void ph_cnorm_pool(const Args& a, int gw, int ngw, int lane) {
    const bf16* P1 = (const bf16*)(a.ws + WS_P1); unsigned char* CN = a.ws + WS_CN; unsigned char* MIX = a.ws + WS_MIX;
    unsigned char* CT8 = a.ws + WS_CT8;
    const float gk0 = a.g_kv[2 * lane], gk1 = a.g_kv[2 * lane + 1];
    const int win = 2 << (lane >> 4);
    for (int run = gw; run < NTOK / 32; run += ngw) {
        const int tok0 = run * 32, pos0 = tok0 & (SEQ - 1);
        const bf16* ub = P1 + (size_t)tok0 * N1 + OFF_U + 8 * lane;
        float s[8];
#pragma unroll
        for (int j = 0; j < 8; ++j) s[j] = 0.f;
#pragma unroll
        for (int j = 1; j < 16; ++j) {
            if (j < win && pos0 - j >= 0) { const v4u u = *(const v4u*)(ub - (size_t)j * N1);
                s[0] += bflo(u.x); s[1] += bfhi(u.x); s[2] += bflo(u.y); s[3] += bfhi(u.y); s[4] += bflo(u.z); s[5] += bfhi(u.z); s[6] += bflo(u.w); s[7] += bfhi(u.w); }
        }
#pragma unroll 1
        for (int tb = 0; tb < 32; tb += 8) {
        v4u ub_[8], udb_[8]; unsigned cwb_[8]; float cn0_[8], cn1_[8];
#pragma unroll
        for (int t8 = 0; t8 < 8; ++t8) {
            const bf16* prow = P1 + (size_t)(tok0 + tb + t8) * N1;
            ub_[t8] = *(const v4u*)(prow + OFF_U + 8 * lane);
            cwb_[t8] = *(const unsigned*)(prow + OFF_C + 2 * lane);
            udb_[t8] = (v4u){0u, 0u, 0u, 0u};
            if (pos0 + tb + t8 - win + 1 >= 0) udb_[t8] = *(const v4u*)(prow - (size_t)(win - 1) * N1 + OFF_U + 8 * lane);
        }
#pragma unroll
        for (int t8 = 0; t8 < 8; ++t8) {
            const int t = tb + t8;
            const int tok = tok0 + t, pos = pos0 + t;
            const v4u u = ub_[t8];
            const unsigned cw = cwb_[t8];
            const v4u ud = udb_[t8];
            const bool drop = (pos - win + 1 >= 0);
            const float c0 = bflo(cw), c1 = bfhi(cw);
            const float rinv = 1.0f / sqrtf(wave_sum(c0 * c0 + c1 * c1) * (1.0f / 128.0f) + EPS);
            cn0_[t8] = c0 * rinv * gk0; cn1_[t8] = c1 * rinv * gk1;
            *(unsigned short*)(CN + (size_t)tok * 128 + 2 * lane) = (unsigned short)__builtin_amdgcn_cvt_pk_fp8_f32(fminf(fmaxf(cn0_[t8] * 16.0f, -448.f), 448.f), fminf(fmaxf(cn1_[t8] * 16.0f, -448.f), 448.f), 0, false);
            const float uf[8] = {bflo(u.x), bfhi(u.x), bflo(u.y), bfhi(u.y), bflo(u.z), bfhi(u.z), bflo(u.w), bfhi(u.w)};
#pragma unroll
            for (int j = 0; j < 8; ++j) s[j] += uf[j];
            const int cnt = (pos + 1 < win) ? pos + 1 : win; const float ic = 1.0f / (float)cnt;
            float pv_[8];
#pragma unroll
            for (int j = 0; j < 8; ++j) pv_[j] = fminf(fmaxf((s[j] * ic - uf[j]) * 16.0f, -448.f), 448.f);
            v2u o; int t_;
            t_ = __builtin_amdgcn_cvt_pk_fp8_f32(pv_[0], pv_[1], 0, false); o.x = (unsigned)__builtin_amdgcn_cvt_pk_fp8_f32(pv_[2], pv_[3], t_, true);
            t_ = __builtin_amdgcn_cvt_pk_fp8_f32(pv_[4], pv_[5], 0, false); o.y = (unsigned)__builtin_amdgcn_cvt_pk_fp8_f32(pv_[6], pv_[7], t_, true);
            *(v2u*)(MIX + (size_t)tok * K2 + 512 + 8 * lane) = o;
            if (drop) { s[0] -= bflo(ud.x); s[1] -= bfhi(ud.x); s[2] -= bflo(ud.y); s[3] -= bfhi(ud.y); s[4] -= bflo(ud.z); s[5] -= bfhi(ud.z); s[6] -= bflo(ud.w); s[7] -= bfhi(ud.w); }
        }
        {
            unsigned char* ctp = CT8 + ((size_t)(tok0 >> 6) * 128 + 2 * lane) * 64 + 16 * ((pos0 >> 5) & 1) + (tb >> 1);
#pragma unroll
            for (int hh = 0; hh < 2; ++hh) {
                float q0[4], q1[4];
#pragma unroll
                for (int e = 0; e < 4; ++e) { q0[e] = fminf(fmaxf(cn0_[4 * hh + e] * 16.0f, -448.f), 448.f); q1[e] = fminf(fmaxf(cn1_[4 * hh + e] * 16.0f, -448.f), 448.f); }
                int t_ = __builtin_amdgcn_cvt_pk_fp8_f32(q0[0], q0[1], 0, false); *(unsigned*)(ctp + 32 * hh) = (unsigned)__builtin_amdgcn_cvt_pk_fp8_f32(q0[2], q0[3], t_, true);
                t_ = __builtin_amdgcn_cvt_pk_fp8_f32(q1[0], q1[1], 0, false); *(unsigned*)(ctp + 64 + 32 * hh) = (unsigned)__builtin_amdgcn_cvt_pk_fp8_f32(q1[2], q1[3], t_, true);
            }
        }
        }
    }
}

namespace dsa {
using bf16x8 = __attribute__((ext_vector_type(8))) short;
using s16x4  = __attribute__((ext_vector_type(4))) short;
using f32x16 = __attribute__((ext_vector_type(16))) float;
using u32x4  = __attribute__((ext_vector_type(4))) unsigned;
constexpr int NW = 8, KVBLK = 64;
constexpr float SCALE = 0.125f, LOG2E = 1.4426950408889634f, THR = 4.f, PSH = 3.f;
typedef int v8i __attribute__((ext_vector_type(8)));
typedef int v4i __attribute__((ext_vector_type(4)));
constexpr int SHM_V = KVBLK * 128 * 2, SHM_K = KVBLK * 128 * 2, SHM_ATTN = 2 * SHM_V + 2 * SHM_K + NW * 64 * 4;
constexpr unsigned NEG2 = 0xCAEACAEAu;
#define KSWZ(row, colB) ((row) * 256 + ((colB) ^ (((row) & 7) << 4)))
#define SBAR() __builtin_amdgcn_sched_barrier(0)
__device__ __forceinline__ int crow(int r, int hi) { return (r & 3) + 8 * (r >> 2) + 4 * hi; }
__device__ __forceinline__ unsigned cvtpk(float lo, float hi) { unsigned r; asm volatile("v_cvt_pk_bf16_f32 %0, %1, %2" : "=v"(r) : "v"(lo), "v"(hi)); return r; }
typedef float f32x2_t __attribute__((ext_vector_type(2))); typedef __bf16 bf16x2_t __attribute__((ext_vector_type(2)));
__device__ __forceinline__ unsigned cvtpk_s(float lo, float hi) { f32x2_t v = {lo, hi}; bf16x2_t b = __builtin_convertvector(v, bf16x2_t); return __builtin_bit_cast(unsigned, b); }

template <int CTRL> __device__ __forceinline__ unsigned dppu(unsigned x) { return (unsigned)__builtin_amdgcn_update_dpp(0, (int)x, CTRL, 0xf, 0xf, true); }
__device__ __forceinline__ unsigned half_sum(unsigned x, int) {
    x += dppu<0xB1>(x); x += dppu<0x4E>(x); x += dppu<0x141>(x); x += dppu<0x140>(x);
    auto rr = __builtin_amdgcn_permlane16_swap(x, x, false, false); return rr[0] + rr[1];
}
__device__ __forceinline__ unsigned half_min(unsigned x, int) {
    x = min(x, dppu<0xB1>(x)); x = min(x, dppu<0x4E>(x)); x = min(x, dppu<0x141>(x)); x = min(x, dppu<0x140>(x));
    auto rr = __builtin_amdgcn_permlane16_swap(x, x, false, false); return min(rr[0], rr[1]);
}
__device__ __forceinline__ unsigned half_max(unsigned x, int) {
    x = max(x, dppu<0xB1>(x)); x = max(x, dppu<0x4E>(x)); x = max(x, dppu<0x141>(x)); x = max(x, dppu<0x140>(x));
    auto rr = __builtin_amdgcn_permlane16_swap(x, x, false, false); return max(rr[0], rr[1]);
}

template <int CTRL> __device__ __forceinline__ float dppf(float x) { return __int_as_float(__builtin_amdgcn_update_dpp(0, __float_as_int(x), CTRL, 0xf, 0xf, true)); }
__device__ __forceinline__ float half_minf(float x, int) {
    x = fminf(x, dppf<0xB1>(x)); x = fminf(x, dppf<0x4E>(x)); x = fminf(x, dppf<0x141>(x)); x = fminf(x, dppf<0x140>(x));
    auto rr = __builtin_amdgcn_permlane16_swap(__float_as_uint(x), __float_as_uint(x), false, false); return fminf(__uint_as_float(rr[0]), __uint_as_float(rr[1]));
}
__device__ __forceinline__ float half_maxf(float x, int) {
    x = fmaxf(x, dppf<0xB1>(x)); x = fmaxf(x, dppf<0x4E>(x)); x = fmaxf(x, dppf<0x141>(x)); x = fmaxf(x, dppf<0x140>(x));
    auto rr = __builtin_amdgcn_permlane16_swap(__float_as_uint(x), __float_as_uint(x), false, false); return fmaxf(__uint_as_float(rr[0]), __uint_as_float(rr[1]));
}
__device__ __forceinline__ float half_sumf(float x, int) {
    x += dppf<0xB1>(x); x += dppf<0x4E>(x); x += dppf<0x141>(x); x += dppf<0x140>(x);
    auto rr = __builtin_amdgcn_permlane16_swap(__float_as_uint(x), __float_as_uint(x), false, false); return __uint_as_float(rr[0]) + __uint_as_float(rr[1]);
}
__device__ __forceinline__ unsigned f2key(float f) { const unsigned u = __float_as_uint(f); return (u & 0x80000000u) ? ~u : (u | 0x80000000u); }
__device__ __forceinline__ float key2f(unsigned k) { return __uint_as_float((k & 0x80000000u) ? (k & 0x7fffffffu) : ~k); }

template <int PROBE> __device__ __forceinline__ void idx_select(const bf16* __restrict__ P1, int b, int tokw, int n, int tid_in, LAS char* lds, const float* __restrict__ ZT, unsigned& W0lo, unsigned& W0hi, unsigned& W1lo, unsigned& W1hi) {
    if (n <= 256) { W0lo = W0hi = W1lo = W1hi = 0xffffffffu; return; }
    int tid = tid_in; asm volatile("" : "+v"(tid));
    const int lane = tid & 63, wid = __builtin_amdgcn_readfirstlane(tid >> 6), c = lane & 31, h = lane >> 5;
    const int nt = n >> 5, nch = (n + 255) >> 8;
    const bf16* kb = P1 + (size_t)b * SEQ * N1 + OFF_KI;
    unsigned dsrc[4];
#pragma unroll
    for (int ii = 0; ii < 4; ++ii) { const int q = wid * 4 + ii, keyl = q * 8 + (lane >> 3), pc = lane & 7; dsrc[ii] = (unsigned)(keyl * N1 + ((pc ^ ((keyl >> 1) & 7)) << 3)); }
#define KI_DMA(cc) do { _Pragma("unroll") for (int ii = 0; ii < 4; ++ii) { const int q_ = wid * 4 + ii; if (256 * (cc) + 8 * q_ < n) \
        __builtin_amdgcn_global_load_lds((const unsigned*)(kb + (size_t)(256 * (cc)) * N1 + dsrc[ii]), (LAS unsigned*)(lds + ((cc) & 1) * 32768 + q_ * 1024), 16, 0, 0); } } while (0)
    KI_DMA(0);
    const int qa = 2 * ((c >> 2) & 1) + (c >> 4), ih = (c & 3) + 4 * ((c >> 3) & 1);
    const bf16* qip = P1 + (size_t)(tokw + qa) * N1 + OFF_QI + ih * 64 + 8 * h;
    bf16x8 af[4];
#pragma unroll
    for (int s = 0; s < 4; ++s) af[s] = *(const bf16x8*)(qip + 16 * s);
    float wq0[8], wq1[8];
    { const u32x4 t = *(const u32x4*)(P1 + (size_t)(tokw + 2 * h) * N1 + OFF_WI), u = *(const u32x4*)(P1 + (size_t)(tokw + 2 * h + 1) * N1 + OFF_WI);
      wq0[0] = bflo(t.x); wq0[1] = bfhi(t.x); wq0[2] = bflo(t.y); wq0[3] = bfhi(t.y); wq0[4] = bflo(t.z); wq0[5] = bfhi(t.z); wq0[6] = bflo(t.w); wq0[7] = bfhi(t.w);
      wq1[0] = bflo(u.x); wq1[1] = bfhi(u.x); wq1[2] = bflo(u.y); wq1[3] = bfhi(u.y); wq1[4] = bflo(u.z); wq1[5] = bfhi(u.z); wq1[6] = bflo(u.w); wq1[7] = bfhi(u.w); }
    const int rdoff = c * 128, rsw = (c >> 1) & 7;
    float sc0[64], sc1[64];
    float mn0 = __builtin_inff(), mx0 = -__builtin_inff(), mn1 = __builtin_inff(), mx1 = -__builtin_inff();
    float sm0 = 0.f, sq0 = 0.f, sm1 = 0.f, sq1 = 0.f;
#pragma unroll
    for (int cc = 0; cc < 8; ++cc) {
        if (cc < nch) {
            __syncthreads();
            if (cc + 1 < nch) KI_DMA(cc + 1);
            const LAS char* cb = lds + (cc & 1) * 32768 + rdoff;
#pragma unroll
            for (int t = 0; t < 8; ++t) {
                const int i = cc * 8 + t;
                if (i < nt) {
                    f32x16 acc = {};
#pragma unroll
                    for (int s = 0; s < 4; ++s) { const bf16x8 kf = *(const LAS bf16x8*)(cb + t * 4096 + (((2 * s + h) ^ rsw) << 4));
                        acc = __builtin_amdgcn_mfma_f32_32x32x16_bf16(af[s], kf, acc, 0, 0, 0); }
                    float s0 = 0.f, s1 = 0.f;
#pragma unroll
                    for (int j = 0; j < 8; ++j) {
                        s0 = fmaf(wq0[j], __int_as_float(max(__float_as_int(acc[j]), 0)), s0); s1 = fmaf(wq1[j], __int_as_float(max(__float_as_int(acc[8 + j]), 0)), s1); }
                    sc0[i] = s0; sc1[i] = s1; mn0 = fminf(mn0, s0); mx0 = fmaxf(mx0, s0); mn1 = fminf(mn1, s1); mx1 = fmaxf(mx1, s1);
                    sm0 += s0; sq0 = fmaf(s0, s0, sq0); sm1 += s1; sq1 = fmaf(s1, s1, sq1);
                } else { sc0[i] = -__builtin_inff(); sc1[i] = -__builtin_inff(); }
            }
        } else {
#pragma unroll
            for (int t = 0; t < 8; ++t) { sc0[cc * 8 + t] = -__builtin_inff(); sc1[cc * 8 + t] = -__builtin_inff(); }
        }
    }
#undef KI_DMA
    __syncthreads();
    unsigned klo0 = f2key(half_minf(mn0, h)), khi0 = f2key(half_maxf(mx0, h)) + 1u, klo1 = f2key(half_minf(mn1, h)), khi1 = f2key(half_maxf(mx1, h)) + 1u;
    unsigned cl0 = (unsigned)n, cl1 = (unsigned)n, ch0 = 0u, ch1 = 0u;
    bool fin0 = (khi0 - klo0 <= 1u), fin1 = (khi1 - klo1 <= 1u);
    const float rn = 1.0f / (float)n;
    const float mu0 = half_sumf(sm0, h) * rn, mu1 = half_sumf(sm1, h) * rn;
    const float sd0 = sqrtf(fmaxf(half_sumf(sq0, h) * rn - mu0 * mu0, 1e-30f)), sd1 = sqrtf(fmaxf(half_sumf(sq1, h) * rn - mu1 * mu1, 1e-30f));
    const float zq = ZT[(n >> 6) - 1], rdphi = __builtin_amdgcn_rcpf(ZT[32 + (n >> 6) - 1]);
    bool np0 = false, np1 = false;
    for (int it = 0; it < (PROBE == 3 ? 0 : 96); ++it) {
        unsigned km0, km1;
        if (it < 48) {
            const float lo0f = key2f(klo0), hi0f = key2f(khi0), lo1f = key2f(klo1), hi1f = key2f(khi1);
            float f0 = 0.5f, f1 = 0.5f;
            if (!(it & 1)) { f0 = ((float)cl0 - 255.5f) * __builtin_amdgcn_rcpf((float)(cl0 - ch0)); f1 = ((float)cl1 - 255.5f) * __builtin_amdgcn_rcpf((float)(cl1 - ch1)); }
            float m0 = fmaf(hi0f - lo0f, f0, lo0f), m1 = fmaf(hi1f - lo1f, f1, lo1f);
            if (it == 0) { m0 = fmaf(zq, sd0, mu0); m1 = fmaf(zq, sd1, mu1); }
            else if (it == 1) {
                m0 = (cl0 != (unsigned)n) ? lo0f + (1.5f * ((float)cl0 - 255.5f) + 4.0f) * sd0 * rdphi : hi0f - (1.5f * (255.5f - (float)ch0) + 4.0f) * sd0 * rdphi;
                m1 = (cl1 != (unsigned)n) ? lo1f + (1.5f * ((float)cl1 - 255.5f) + 4.0f) * sd1 * rdphi : hi1f - (1.5f * (255.5f - (float)ch1) + 4.0f) * sd1 * rdphi;
            }
            km0 = f2key(m0 + 0.0f); km1 = f2key(m1 + 0.0f);
            if (!(m0 == m0)) km0 = klo0 + ((khi0 - klo0) >> 1);
            if (!(m1 == m1)) km1 = klo1 + ((khi1 - klo1) >> 1);
        } else { km0 = klo0 + ((khi0 - klo0) >> 1); km1 = klo1 + ((khi1 - klo1) >> 1); }
        constexpr unsigned EG = 3u;
        const unsigned rb0 = 256u - ch0, ra0 = cl0 - 256u, rb1 = 256u - ch1, ra1 = cl1 - 256u;
        const bool sp0 = !fin0 && ((rb0 <= EG && rb0 <= ra0) || np0), sp1 = !fin1 && ((rb1 <= EG && rb1 <= ra1) || np1);
        const bool sa0 = !fin0 && !sp0 && ra0 <= EG, sa1 = !fin1 && !sp1 && ra1 <= EG;
        if (__any(sp0 || sp1)) {
            const float hf0 = key2f(khi0), hf1 = key2f(khi1); float b0 = -__builtin_inff(), b1 = -__builtin_inff();
#pragma unroll
            for (int g = 0; g < 8; ++g) {
                if (g * 8 < nt) {
#pragma unroll
                    for (int i = g * 8; i < g * 8 + 8; ++i) { b0 = fmaxf(b0, (sc0[i] < hf0) ? sc0[i] : -__builtin_inff()); b1 = fmaxf(b1, (sc1[i] < hf1) ? sc1[i] : -__builtin_inff()); }
                }
            }
            b0 = half_maxf(b0, h); b1 = half_maxf(b1, h);
            if (sp0) km0 = f2key(b0); if (sp1) km1 = f2key(b1);
        }
        if (__any(sa0 || sa1)) {
            const float lf0 = key2f(klo0), lf1 = key2f(klo1); float a0 = __builtin_inff(), a1 = __builtin_inff();
#pragma unroll
            for (int g = 0; g < 8; ++g) {
                if (g * 8 < nt) {
#pragma unroll
                    for (int i = g * 8; i < g * 8 + 8; ++i) { a0 = fminf(a0, (sc0[i] >= lf0) ? sc0[i] : __builtin_inff()); a1 = fminf(a1, (sc1[i] >= lf1) ? sc1[i] : __builtin_inff()); }
                }
            }
            a0 = half_minf(a0, h); a1 = half_minf(a1, h);
            if (sa0) km0 = f2key(a0) + 1u; if (sa1) km1 = f2key(a1) + 1u;
        }
        km0 = min(max(km0, klo0 + 1u), khi0 - 1u); km1 = min(max(km1, klo1 + 1u), khi1 - 1u);
        const float t0 = key2f(km0), t1 = key2f(km1);
        unsigned c0 = 0u, c1 = 0u, c0b = 0u, c1b = 0u;
#pragma unroll
        for (int g = 0; g < 8; ++g) {
            if (g * 8 < nt) {
#pragma unroll
                for (int i = g * 8; i < g * 8 + 8; i += 2)
                    asm volatile("v_cmp_ge_f32_e64 s[36:37], %4, %8\n\tv_cmp_ge_f32_e64 s[38:39], %5, %9\n\tv_cmp_ge_f32_e64 s[40:41], %6, %8\n\tv_cmp_ge_f32_e64 s[42:43], %7, %9\n\t"
                                 "v_addc_co_u32_e64 %0, vcc, 0, %0, s[36:37]\n\tv_addc_co_u32_e64 %1, vcc, 0, %1, s[38:39]\n\tv_addc_co_u32_e64 %2, vcc, 0, %2, s[40:41]\n\tv_addc_co_u32_e64 %3, vcc, 0, %3, s[42:43]"
                                 : "+v"(c0), "+v"(c1), "+v"(c0b), "+v"(c1b) : "v"(sc0[i]), "v"(sc1[i]), "v"(sc0[i + 1]), "v"(sc1[i + 1]), "v"(t0), "v"(t1) : "vcc", "s36", "s37", "s38", "s39", "s40", "s41", "s42", "s43");
            }
        }
        { const unsigned cs = half_sum((c0 + c0b) | ((c1 + c1b) << 16), h); c0 = cs & 0xffffu; c1 = cs >> 16; }
        if (!fin0) { np0 = (it >= 2) && (c0 == cl0 || c0 == ch0);
            if (c0 >= 256u) { klo0 = km0; cl0 = c0; if (sp0) khi0 = km0 + 1u; } else { khi0 = km0; ch0 = c0; if (sa0) klo0 = km0 - 1u; } fin0 = (c0 == 256u) || (khi0 - klo0 <= 1u); }
        if (!fin1) { np1 = (it >= 2) && (c1 == cl1 || c1 == ch1);
            if (c1 >= 256u) { klo1 = km1; cl1 = c1; if (sp1) khi1 = km1 + 1u; } else { khi1 = km1; ch1 = c1; if (sa1) klo1 = km1 - 1u; } fin1 = (c1 == 256u) || (khi1 - klo1 <= 1u); }
        if (__all(fin0 && fin1)) break;
    }
    const float lo0 = key2f(klo0), lo1 = key2f(klo1);
    unsigned w0l = 0u, w0h = 0u, w1l = 0u, w1h = 0u;
#define BITOF(cond) ({ unsigned t__ = (cond) ? 1u : 0u; asm volatile("" : "+v"(t__)); t__; })
    if (__all(cl0 == 256u && cl1 == 256u)) {
#pragma unroll
        for (int g = 0; g < 8; ++g) {
            if (g * 8 < nt) {
#pragma unroll
                for (int i = g * 8; i < g * 8 + 8; ++i) {
                    if (i < 32) { w0l |= BITOF(sc0[i] >= lo0) << i; w1l |= BITOF(sc1[i] >= lo1) << i; } else { w0h |= BITOF(sc0[i] >= lo0) << (i - 32); w1h |= BITOF(sc1[i] >= lo1) << (i - 32); }
                }
            }
        }
    } else {
        unsigned g0 = 0u, g1 = 0u;
#pragma unroll
        for (int i = 0; i < 64; ++i) { g0 += (sc0[i] > lo0) ? 1u : 0u; g1 += (sc1[i] > lo1) ? 1u : 0u; }
        g0 = half_sum(g0, h); g1 = half_sum(g1, h);
        const unsigned need0 = 256u - g0, need1 = 256u - g1, ltm = (1u << c) - 1u;
        unsigned run0 = 0u, run1 = 0u;
#pragma unroll
        for (int i = 0; i < 64; ++i) {
            const bool e0 = (sc0[i] == lo0), e1 = (sc1[i] == lo1);
            const unsigned long long m0 = __ballot(e0), m1 = __ballot(e1);
            const unsigned hb0 = h ? (unsigned)(m0 >> 32) : (unsigned)m0, hb1 = h ? (unsigned)(m1 >> 32) : (unsigned)m1;
            const bool s0 = (sc0[i] > lo0) || (e0 && (run0 + __popc(hb0 & ltm) < need0));
            const bool s1 = (sc1[i] > lo1) || (e1 && (run1 + __popc(hb1 & ltm) < need1));
            run0 += __popc(hb0); run1 += __popc(hb1);
            if (i < 32) { w0l |= BITOF(s0) << i; w1l |= BITOF(s1) << i; } else { w0h |= BITOF(s0) << (i - 32); w1h |= BITOF(s1) << (i - 32); }
        }
    }
#undef BITOF
    W0lo = w0l; W0hi = w0h; W1lo = w1l; W1hi = w1h;
}

__device__ __forceinline__ void partialSM(f32x16& p0, f32x16& p1, float b0, float& m_reg, float& mn, float& alpha) {
    constexpr float C = SCALE * LOG2E * (1.0f / 256.0f);
    float pmax = p0[0];
#pragma unroll
    for (int r = 1; r < 16; ++r) pmax = fmaxf(pmax, p0[r]);
#pragma unroll
    for (int r = 0; r < 16; ++r) pmax = fmaxf(pmax, p1[r]);
    { auto rr = __builtin_amdgcn_permlane32_swap(__float_as_uint(pmax), __float_as_uint(pmax), false, false);
      pmax = fmaxf(__uint_as_float(rr[0]), __uint_as_float(rr[1])); }
    const float pm = fmaf(pmax, C, b0);
    if (__builtin_expect(__all(pm - m_reg <= THR * LOG2E), 1)) { mn = m_reg; alpha = 1.f; }
    else { mn = fmaxf(m_reg, pm); alpha = __builtin_amdgcn_exp2f(m_reg - mn); m_reg = mn; }
    const float off = b0 - mn + PSH;
#pragma unroll
    for (int r = 0; r < 16; ++r) p0[r] = fmaf(p0[r], C, off);
#pragma unroll
    for (int r = 0; r < 16; ++r) p1[r] = fmaf(p1[r], C, off);
#pragma unroll
    for (int r = 0; r < 16; ++r) p0[r] = __builtin_amdgcn_exp2f(p0[r]);
}
__device__ __forceinline__ void finishSM(f32x16& p0, f32x16& p1, float alpha, float& l_reg, v8i& P8) {
#pragma unroll
    for (int r = 0; r < 16; ++r) p1[r] = __builtin_amdgcn_exp2f(p1[r]);
    float ps = 0;
#pragma unroll
    for (int r = 0; r < 16; ++r) ps += p0[r];
#pragma unroll
    for (int r = 0; r < 16; ++r) ps += p1[r];
    { auto rr = __builtin_amdgcn_permlane32_swap(__float_as_uint(ps), __float_as_uint(ps), false, false);
      ps = __uint_as_float(rr[0]) + __uint_as_float(rr[1]); }
    l_reg = l_reg * alpha + ps;
#pragma unroll
    for (int g = 0; g < 4; ++g) { const int t_ = __builtin_amdgcn_cvt_pk_fp8_f32(p0[4 * g], p0[4 * g + 1], __float_as_int(p0[4 * g]), false); P8[g] = __builtin_amdgcn_cvt_pk_fp8_f32(p0[4 * g + 2], p0[4 * g + 3], t_, true); }
#pragma unroll
    for (int g = 0; g < 4; ++g) { const int t_ = __builtin_amdgcn_cvt_pk_fp8_f32(p1[4 * g], p1[4 * g + 1], __float_as_int(p1[4 * g]), false); P8[4 + g] = __builtin_amdgcn_cvt_pk_fp8_f32(p1[4 * g + 2], p1[4 * g + 3], t_, true); }
}
__device__ __forceinline__ void qkt(f32x16& p0, f32x16& p1, const LAS char* Ks, const v8i* qr8, bf16x8 ax0, bf16x8 ax1, bf16x8 ef, int r32, int hi) {
    const LAS char* kr = Ks + r32 * 128; const int sw = (r32 >> 1) & 7;
    v8i kf[2][2];
#pragma unroll
    for (int kb = 0; kb < 2; ++kb)
#pragma unroll
        for (int sx = 0; sx < 2; ++sx) { const int pc = 4 * sx + 2 * hi;
            const v4i lo = *(const LAS v4i*)(kr + kb * 4096 + ((pc ^ sw) << 4)), hi_ = *(const LAS v4i*)(kr + kb * 4096 + (((pc + 1) ^ sw) << 4));
            kf[kb][sx] = __builtin_shufflevector(lo, hi_, 0, 1, 2, 3, 4, 5, 6, 7); }
    const int one = 0x7f7f7f7f;
#if defined(__HIP_DEVICE_COMPILE__)
    asm volatile("s_nop 1\n\tv_mfma_f32_32x32x16_bf16 %0, %1, %2, 0" : "=&v"(p0) : "v"(ax0), "v"(ef));
    asm volatile("s_nop 1\n\tv_mfma_f32_32x32x16_bf16 %0, %1, %2, 0" : "=&v"(p1) : "v"(ax1), "v"(ef));
    asm volatile("s_nop 1\n\tv_mfma_scale_f32_32x32x64_f8f6f4 %0, %1, %2, %0, %3, %3 op_sel_hi:[0,0,0]" : "+v"(p0) : "v"(kf[0][0]), "v"(qr8[0]), "v"(one));
    asm volatile("s_nop 1\n\tv_mfma_scale_f32_32x32x64_f8f6f4 %0, %1, %2, %0, %3, %3 op_sel_hi:[0,0,0]" : "+v"(p1) : "v"(kf[1][0]), "v"(qr8[0]), "v"(one));
    asm volatile("s_nop 1\n\tv_mfma_scale_f32_32x32x64_f8f6f4 %0, %1, %2, %0, %3, %3 op_sel_hi:[0,0,0]" : "+v"(p0) : "v"(kf[0][1]), "v"(qr8[1]), "v"(one));
    asm volatile("s_nop 1\n\tv_mfma_scale_f32_32x32x64_f8f6f4 %0, %1, %2, %0, %3, %3 op_sel_hi:[0,0,0]\n\ts_nop 3" : "+v"(p1) : "v"(kf[1][1]), "v"(qr8[1]), "v"(one));
    asm volatile("" :: "v"(kf[0][0]), "v"(kf[1][0]), "v"(kf[0][1]), "v"(kf[1][1]), "v"(ax0), "v"(ax1), "v"(ef), "v"(one));
#else
    (void)one; (void)ax0; (void)ax1; (void)ef; (void)kf; (void)qr8; p0 = f32x16{}; p1 = f32x16{};
#endif
}
constexpr int VT_PITCH = 80;
__device__ __forceinline__ void pv_d0(f32x16* o, const LAS char* vb, const v8i P8) {
    v8i bf[4];
#pragma unroll
    for (int d0 = 0; d0 < 4; ++d0) { const v4i lo = *(const LAS v4i*)(vb + d0 * 32 * VT_PITCH), hi_ = *(const LAS v4i*)(vb + d0 * 32 * VT_PITCH + 16); bf[d0] = __builtin_shufflevector(lo, hi_, 0, 1, 2, 3, 4, 5, 6, 7); }
    const int one = 0x7f7f7f7f;
#pragma unroll
    for (int d0 = 0; d0 < 4; ++d0) {
#if defined(__HIP_DEVICE_COMPILE__)
        asm volatile("s_nop 1\n\tv_mfma_scale_f32_32x32x64_f8f6f4 %0, %1, %2, %0, %3, %3 op_sel_hi:[0,0,0]" : "+v"(o[d0]) : "v"(P8), "v"(bf[d0]), "v"(one));
#else
        (void)one;
#endif
    }
#if defined(__HIP_DEVICE_COMPILE__)
    asm volatile("s_nop 3" :: "v"(P8), "v"(bf[0]), "v"(bf[1]), "v"(bf[2]), "v"(bf[3]), "v"(one));
#endif
}
#define PTOUCH(a, b) asm volatile("" : "+v"(a), "+v"(b))
#define MFMA_DRAIN() asm volatile("s_nop 15\n\ts_nop 15\n\ts_nop 15\n\ts_nop 15\n\ts_nop 15" ::: "memory")

__device__ __forceinline__ void qlat_stage(const bf16* __restrict__ P1, const bf16* __restrict__ WUKT, int tok0, LAS char* lds, int tid_in) {
    int tid = tid_in; asm volatile("" : "+v"(tid));
    const int hd = tid >> 6, lane = tid & 63, r32 = lane & 31, hi = lane >> 5;
    bf16x8 bq[4];
    { const bf16* qp = P1 + (size_t)(tok0 + r32) * N1 + OFF_Q + hd * 64 + 8 * hi;
#pragma unroll
      for (int s = 0; s < 4; ++s) bq[s] = *(const bf16x8*)(qp + 16 * s); }
    const bf16* wp = WUKT + (size_t)hd * 8192 + (size_t)r32 * 64 + 8 * hi;
#pragma unroll
    for (int mt = 0; mt < 4; ++mt) {
        f32x16 acc = {};
#pragma unroll
        for (int s = 0; s < 4; ++s) { const bf16x8 af = *(const bf16x8*)(wp + mt * 2048 + 16 * s); acc = __builtin_amdgcn_mfma_f32_32x32x16_bf16(af, bq[s], acc, 0, 0, 0); }
#pragma unroll
        for (int r4 = 0; r4 < 4; ++r4) { float q_[4];
#pragma unroll
            for (int e = 0; e < 4; ++e) q_[e] = fminf(fmaxf(acc[4 * r4 + e] * 16.0f, -448.f), 448.f);
            const int t_ = __builtin_amdgcn_cvt_pk_fp8_f32(q_[0], q_[1], 0, false);
            *(LAS unsigned*)(lds + (r32 * 8 + hd) * 128 + 32 * mt + 8 * r4 + 4 * hi) = (unsigned)__builtin_amdgcn_cvt_pk_fp8_f32(q_[2], q_[3], t_, true); }
    }
}

__device__ __forceinline__ void attn_item(const bf16* __restrict__ P1, const bf16* __restrict__ WUKT, const unsigned char* __restrict__ Cb, const unsigned char* __restrict__ CT8b, unsigned char* __restrict__ MIXp, const bf16* __restrict__ WUVT, int tok0, int pos0, int n, LAS char* lds, const int tid_in) {
    int tid = tid_in; asm volatile("" : "+v"(tid));
    const int wid = tid >> 6, lane = tid & 63, r32 = lane & 31, hi = lane >> 5;
    LAS char* V_lds = lds; LAS char* K_lds = lds + 2 * SHM_V;
    LAS float* wsl = (LAS float*)(lds + 2 * SHM_V + 2 * SHM_K) + wid * 64; LAS float* li_l = wsl; LAS float* al_l = wsl + 32;
    const LAS u32x4* mwl = (const LAS u32x4*)(lds + SHM_ATTN) + tid;
    float m_reg = -1e30f, l_reg = 0; f32x16 o[4] = {}; v8i qr8[2];
    const int ql_ = r32 >> 3, hd = r32 & 7;
    const int NT = n >> 6, NTP = (NT + 1) & ~1;
#define TILE_K0(j) (((j) < NT) ? (NT - 1 - (j)) * KVBLK : 0)
    const int vtw = (tid >> 2) * VT_PITCH + (tid & 3) * 16;
    const int kgo = (tid >> 3) * 128 + (tid & 7) * 16, kwo = (tid >> 3) * 128 + (((tid & 7) ^ ((tid >> 4) & 7)) << 4);
    struct { u32x4 k8, vt; } sr_[2];
#define SLOAD(i, k0) do { sr_[i].k8 = *(const u32x4*)(Cb + (size_t)(k0) * 128 + kgo); sr_[i].vt = *(const u32x4*)(CT8b + (size_t)((k0) >> 6) * 8192 + tid * 16); } while (0)
    constexpr int SE = 0, SO = 1;
    SLOAD(SE, TILE_K0(0)); SLOAD(SO, TILE_K0(1));
    qlat_stage(P1, WUKT, tok0, lds, tid);
    __syncthreads();
    { const LAS char* Qw = lds + ((4 * wid + ql_) * 8 + hd) * 128 + hi * 32;
#pragma unroll
      for (int sx = 0; sx < 2; ++sx) { const v4i lo = *(const LAS v4i*)(Qw + 64 * sx), hi_ = *(const LAS v4i*)(Qw + 64 * sx + 16); qr8[sx] = __builtin_shufflevector(lo, hi_, 0, 1, 2, 3, 4, 5, 6, 7); } }
    const float qposf = (float)(pos0 + 4 * wid + ql_);
    bf16x8 ef; { u32x4 w = {0u, 0u, 0u, 0u}; w.x = ((ql_ == 2 * hi) ? 0x3F80u : 0u) | ((ql_ == 2 * hi + 1) ? 0x3F800000u : 0u); w.y = (hi == 0) ? ((unsigned)(137 - hd) << 7) : 0u; ef = *reinterpret_cast<bf16x8*>(&w); }
#define MASKW(s_) 0
#define MKAX(j, ax0, ax1) do { const unsigned klw0 = (hi == 0) ? (__float_as_uint((float)r32) >> 16) : 0u, klw1 = (hi == 0) ? (__float_as_uint((float)(32 + r32)) >> 16) : 0u;   \
        u32x4 w0_ = {NEG2, klw0, 0u, 0u}, w1_ = {NEG2, klw1, 0u, 0u}; if ((j) < NT) { const u32x4 Wv_ = *mwl; const int sh_ = 2 * (NT - 1 - (j)); \
            const unsigned v0_ = (unsigned)((((unsigned long long)Wv_.y << 32) | Wv_.x) >> sh_), v1_ = (unsigned)((((unsigned long long)Wv_.w << 32) | Wv_.z) >> sh_); \
            const unsigned mA_ = (v0_ & 1u) | ((v1_ & 1u) << 16), mB_ = ((v0_ >> 1) & 1u) | ((v1_ & 2u) << 15); \
            w0_.x = NEG2 & ~(mA_ * 0xffffu); w1_.x = NEG2 & ~(mB_ * 0xffffu); } \
        ax0 = *reinterpret_cast<bf16x8*>(&w0_); ax1 = *reinterpret_cast<bf16x8*>(&w1_); } while (0)
#define TILE_B0(j) ({ int r__ = r32; asm volatile("" : "+v"(r__)); const float sl__ = __uint_as_float((unsigned)(126 - (r__ & 7)) << 23) * LOG2E; \
        sl__ * ((float)TILE_K0(j) - (float)(pos0 + 4 * wid + (r__ >> 3))); })
    const LAS char* vb0 = V_lds + r32 * VT_PITCH + 32 * hi;
    constexpr int VSL = 128 * VT_PITCH, KSL = 64 * 128;
#define SWRITE(slot, i) do { *(LAS u32x4*)(V_lds + (slot) * VSL + vtw) = sr_[i].vt; *(LAS u32x4*)(K_lds + (slot) * KSL + kwo) = sr_[i].k8; } while (0)
#define SWAIT() asm volatile("s_waitcnt vmcnt(2)" ::: "memory")
#define RESC(a) do { if (__any((a) < 1.f)) { MFMA_DRAIN(); if (hi == 0) al_l[r32] = (a); asm volatile("s_waitcnt lgkmcnt(0)" ::: "memory"); \
    _Pragma("unroll") for (int d = 0; d < 4; ++d) _Pragma("unroll") for (int r = 0; r < 16; ++r) o[d][r] *= al_l[crow(r, hi)]; } } while (0)
    f32x16 pA0, pA1, pB0, pB1; float mnA, mnB, alA, alB; v8i P8; bf16x8 ax0, ax1;
    asm volatile("s_waitcnt vmcnt(0) lgkmcnt(0)" ::: "memory"); __syncthreads();
    SWRITE(0, SE); __syncthreads();
    MKAX(0, ax0, ax1); qkt(pA0, pA1, K_lds, qr8, ax0, ax1, ef, r32, hi);
    asm volatile("s_nop 15\n\ts_nop 15\n\ts_nop 15\n\ts_nop 15\n\ts_nop 15" : "+v"(pA0), "+v"(pA1));
    {
        const float base = (float)TILE_K0(0) - qposf + (float)(4 * hi), s16 = -2.0f * __uint_as_float((unsigned)(137 - hd) << 23);
#pragma unroll
        for (int r = 0; r < 16; ++r) { const float cr = (float)((r & 3) + 8 * (r >> 2));
            pA0[r] = fmaf(s16, fmaxf(base + cr, 0.f), pA0[r]); pA1[r] = fmaf(s16, fmaxf(base + cr + 32.f, 0.f), pA1[r]); }
    }
    partialSM(pA0, pA1, TILE_B0(0), m_reg, mnA, alA);
    if (2 < NTP) SLOAD(SE, TILE_K0(2));
    SWAIT(); SWRITE(1, SO); __syncthreads();
    int rp = 0, rc = 1, rn = 2;
#define RING_STEP() do { const int t__ = rp; rp = rc; rc = rn; rn = t__; } while (0)
    for (int j = 1; j + 1 < NTP; j += 2) {
        SBAR(); MKAX(j, ax0, ax1); qkt(pB0, pB1, K_lds + rc * KSL, qr8, ax0, ax1, ef, r32, hi);
        finishSM(pA0, pA1, alA, l_reg, P8); SBAR();
        SLOAD(SO, TILE_K0(j + 2)); SBAR();
        pv_d0(o, vb0 + rp * VSL, P8); PTOUCH(pB0, pB1); partialSM(pB0, pB1, TILE_B0(j), m_reg, mnB, alB);
        SWAIT(); SWRITE(rn, SE);
        RESC(alB); __syncthreads(); RING_STEP();
        SBAR(); MKAX(j + 1, ax0, ax1); qkt(pA0, pA1, K_lds + rc * KSL, qr8, ax0, ax1, ef, r32, hi);
        finishSM(pB0, pB1, alB, l_reg, P8); SBAR();
        if (j + 3 < NTP) SLOAD(SE, TILE_K0(j + 3)); SBAR();
        pv_d0(o, vb0 + rp * VSL, P8); PTOUCH(pA0, pA1); partialSM(pA0, pA1, TILE_B0(j + 1), m_reg, mnA, alA);
        SWAIT(); SWRITE(rn, SO);
        RESC(alA); __syncthreads(); RING_STEP();
    }
    const bool lastreal = !(NT & 1);
    SBAR(); if (lastreal) { MKAX(NTP - 1, ax0, ax1); qkt(pB0, pB1, K_lds + rc * KSL, qr8, ax0, ax1, ef, r32, hi); }
    finishSM(pA0, pA1, alA, l_reg, P8); SBAR();
    pv_d0(o, vb0 + rp * VSL, P8);
    if (lastreal) {
        PTOUCH(pB0, pB1); partialSM(pB0, pB1, TILE_B0(NTP - 1), m_reg, mnB, alB);
        RESC(alB);
        finishSM(pB0, pB1, alB, l_reg, P8); SBAR();
        pv_d0(o, vb0 + rc * VSL, P8);
    }
#undef RING_STEP
    MFMA_DRAIN();
    if (hi == 0) li_l[r32] = l_reg; asm volatile("s_waitcnt lgkmcnt(0)" ::: "memory");
    float rli[16];
#pragma unroll
    for (int r = 0; r < 16; ++r) rli[r] = __builtin_amdgcn_rcpf(li_l[crow(r, hi)]) * (1.0f / 16.0f);
    __syncthreads();
#pragma unroll
    for (int r = 0; r < 16; ++r) { const int orow = crow(r, hi);
        LAS bf16* zp = (LAS bf16*)lds + ((4 * wid + (orow >> 3)) * 8 + (orow & 7)) * 128 + r32;
#pragma unroll
        for (int d0 = 0; d0 < 4; ++d0) zp[d0 * 32] = (bf16)f2bf(o[d0][r] * rli[r]); }
    __syncthreads();
    {
        typedef unsigned u32x2 __attribute__((ext_vector_type(2)));
        bf16x8 bo[8];
        { const LAS char* zq = lds + ((r32 * 8 + wid) * 128 + 8 * hi) * 2;
#pragma unroll
          for (int s = 0; s < 8; ++s) bo[s] = *(const LAS bf16x8*)(zq + s * 32); }
        const bf16* wv = WUVT + (size_t)wid * 8192 + (size_t)r32 * 128 + 8 * hi;
#pragma unroll
        for (int mt = 0; mt < 2; ++mt) {
            f32x16 acc = {};
#pragma unroll
            for (int s = 0; s < 8; ++s) { const bf16x8 af = *(const bf16x8*)(wv + mt * 4096 + 16 * s); acc = __builtin_amdgcn_mfma_f32_32x32x16_bf16(af, bo[s], acc, 0, 0, 0); }
            unsigned char* op = MIXp + (size_t)(tok0 + r32) * K2 + wid * 64 + 32 * mt + 4 * hi;
#pragma unroll
            for (int r4 = 0; r4 < 4; ++r4) { float q_[4];
#pragma unroll
                for (int e = 0; e < 4; ++e) q_[e] = fminf(fmaxf(acc[4 * r4 + e] * 16.0f, -448.f), 448.f);
                const int t_ = __builtin_amdgcn_cvt_pk_fp8_f32(q_[0], q_[1], 0, false); *(unsigned*)(op + 8 * r4) = (unsigned)__builtin_amdgcn_cvt_pk_fp8_f32(q_[2], q_[3], t_, true); }
        }
    }
    __syncthreads();
#undef SLOAD
#undef SWRITE
#undef SWAIT
#undef RESC
#undef TILE_K0
#undef MASKW
#undef MKAX
#undef TILE_B0
}
}

__device__ __forceinline__ int tid_from(const int wid6) { int l; asm volatile("v_mbcnt_lo_u32_b32 %0, -1, 0\n\tv_mbcnt_hi_u32_b32 %0, -1, %0" : "=v"(l)); return wid6 | l; }
__device__ __forceinline__ void ph_attn_fast(const Args& a, LAS unsigned char* lds, const int variant, const int wid6) {
    const bf16* P1 = (const bf16*)(a.ws + WS_P1); unsigned char* MIX = a.ws + WS_MIX;
    const int G = gridDim.x;
    for (int it = blockIdx.x; it < BATCH * 64; it += G) {
        const int tid = tid_from(wid6);
        const int lane = tid & 63, wid = tid >> 6;
        const int gg = it & 255, m = it >> 8;
        const int b = (gg & 7) + 8 * (gg >> 6), jg = (gg >> 3) & 7, qb = (m & 1) ? (63 - jg - 8 * (m >> 1)) : (jg + 8 * (m >> 1));
        const int pos0 = qb * 32, tok0 = b * SEQ + pos0, n = ((pos0 >> 6) + 1) << 6;
        { unsigned w0l, w0h, w1l, w1h;
          if (variant == 2) { w0l = w0h = w1l = w1h = 0xffffffffu; }
          else if (ATT_VARIANT == 3 && variant == 3) dsa::idx_select<3>(P1, b, tok0 + 4 * wid, n, tid, (LAS char*)lds, (const float*)(a.ws + WS_ZT), w0l, w0h, w1l, w1h);
          else dsa::idx_select<0>(P1, b, tok0 + 4 * wid, n, tid, (LAS char*)lds, (const float*)(a.ws + WS_ZT), w0l, w0h, w1l, w1h);
          ((LAS dsa::u32x4*)(lds + dsa::SHM_ATTN))[tid] = (dsa::u32x4){w0l, w0h, w1l, w1h};
          asm volatile("s_waitcnt lgkmcnt(0)" ::: "memory");
          if (ATT_VARIANT && (variant == 1 || variant == 3)) { __syncthreads(); continue; } }
        dsa::attn_item(P1, (const bf16*)(a.ws + WS_WUKT), a.ws + WS_CN + (size_t)b * SEQ * 128, a.ws + WS_CT8 + (size_t)b * (SEQ / 64) * 8192, variant ? ((a.ws + WS_END) - (size_t)tok0 * K2 + (size_t)(tok0 & 4095) * K2) : MIX, (const bf16*)(a.ws + WS_WUVT), tok0, pos0, n, (LAS char*)lds, tid);
    }
}

__device__ __forceinline__ void ph_fixup(const Args& a, int gtid, int gthreads) {
    const float* HF = (const float*)(a.ws + WS_HF); const float* HL = (const float*)(a.ws + WS_HL); const float* CONVP = (const float*)(a.ws + WS_CONVP); unsigned char* ACT = a.ws + WS_ACT;
    constexpr int CH = FF / 4;
    for (int i = gtid; i < (NTOK / 256) * 2 * CH; i += gthreads) {
        const int pm = i / (2 * CH), rem = i - pm * (2 * CH), t = rem / CH, ch = rem - t * CH;
        if ((pm & 7) == 0) continue;
        const int jc = ch * 4, j = jc >> 7, ii = jc & 127, cg_ = 256 * j + ii;
        float r[4];
        f32x4 v[2];
#pragma unroll
        for (int half = 0; half < 2; ++half) {
            const int c = cg_ + half * 128;
            const f32x4 lm2 = *(const f32x4*)(HL + (size_t)((pm - 1) * 2 + 0) * N3 + c), lm1 = *(const f32x4*)(HL + (size_t)((pm - 1) * 2 + 1) * N3 + c);
            const f32x4 f0 = *(const f32x4*)(HF + (size_t)(pm * 2 + 0) * N3 + c), f1 = *(const f32x4*)(HF + (size_t)(pm * 2 + 1) * N3 + c);
            const f32x4 w0 = *(const f32x4*)(CONVP + c), w1 = *(const f32x4*)(CONVP + N3 + c), w2 = *(const f32x4*)(CONVP + 2 * N3 + c), bb = *(const f32x4*)(CONVP + 3 * N3 + c);
            v[half] = (t == 0) ? (bb + w0 * lm2 + w1 * lm1 + w2 * f0) : (bb + w0 * lm1 + w1 * f0 + w2 * f1);
        }
#pragma unroll
        for (int e = 0; e < 4; ++e) r[e] = v[0][e] / (1.0f + __expf(-v[0][e])) * v[1][e];
#pragma unroll
        for (int e = 0; e < 4; ++e) r[e] = fminf(fmaxf(r[e] * 8.0f, -448.f), 448.f);
        const int t_ = __builtin_amdgcn_cvt_pk_fp8_f32(r[0], r[1], 0, false);
        *(unsigned*)(ACT + (size_t)(pm * 256 + t) * FF + jc) = (unsigned)__builtin_amdgcn_cvt_pk_fp8_f32(r[2], r[3], t_, true);
    }
}

__device__ __forceinline__ void ph_final(const Args& a, int gw, int ngw, int lane) {
    const bf16* X2 = (const bf16*)(a.ws + WS_X2); const float* ss3 = (const float*)(a.ws + WS_CTL + 256 * 1024);
    for (int m = gw; m < NTOK; m += ngw) {
        const float rinv = 1.0f / sqrtf(ss3[m] * (1.0f / DM) + EPS);
#pragma unroll
        for (int h2 = 0; h2 < 2; ++h2) {
            const int c0 = h2 * 512 + 8 * lane;
            const v4u t = *(const v4u*)(X2 + (size_t)m * DM + c0);
            const f32x4 g0 = *(const f32x4*)(a.g_final + c0), g1 = *(const f32x4*)(a.g_final + c0 + 4);
            f32x4 o0, o1;
            o0.x = bflo(t.x) * rinv * g0.x; o0.y = bfhi(t.x) * rinv * g0.y; o0.z = bflo(t.y) * rinv * g0.z; o0.w = bfhi(t.y) * rinv * g0.w;
            o1.x = bflo(t.z) * rinv * g1.x; o1.y = bfhi(t.z) * rinv * g1.y; o1.z = bflo(t.w) * rinv * g1.z; o1.w = bfhi(t.w) * rinv * g1.w;
            *(f32x4*)(a.out + (size_t)m * DM + c0) = o0; *(f32x4*)(a.out + (size_t)m * DM + c0 + 4) = o1;
        }
    }
}

#define XB_TMO      128
#define XB_XCNT(j)  (256  + 64 * (j))
#define XB_XSUB(j)  (1280 + 64 * (j))
#define XB_XGEN(j)  (2304 + 64 * (j))
#define XB_TOP      3328
#define XB_TOPGEN   3392
#define XCD_BAR_WORDS 3456
#define XB_SPIN_CAP (1u << 18)
__device__ __forceinline__ unsigned xb_ld(unsigned* p)              { return __hip_atomic_load(p, __ATOMIC_RELAXED, __HIP_MEMORY_SCOPE_AGENT); }
__device__ __forceinline__ unsigned xb_add(unsigned* p, unsigned v) { return __hip_atomic_fetch_add(p, v, __ATOMIC_RELAXED, __HIP_MEMORY_SCOPE_AGENT); }
__device__ __forceinline__ unsigned xb_xcc_id() { return (unsigned)__builtin_amdgcn_s_getreg((3 << 11) | 20) & 0xFu; }
#define XB_SPIN(cond, bar) do { unsigned _sp = 0; while (cond) { __builtin_amdgcn_s_sleep(1); \
    if ((++_sp & 255u) == 0u) { if (xb_ld(&(bar)[XB_TMO])) break; if (_sp > XB_SPIN_CAP) { atomicAdd(&(bar)[XB_TMO], 1u); break; } } } } while (0)
struct XcdBarrier { unsigned* bar; unsigned x; volatile LAS unsigned* st; };
__device__ __forceinline__ XcdBarrier xcd_barrier_post(unsigned* bar, volatile LAS unsigned* st, const int tid) {
    XcdBarrier b; b.bar = bar; b.x = xb_xcc_id(); b.st = st;
    if (tid == 0) (void)xb_add(&bar[XB_XCNT(b.x)], 1u);
    return b;
}
__device__ __forceinline__ void xcd_barrier_complete(unsigned* bar, unsigned x, unsigned& nloc, unsigned& nx) {
    const unsigned G = gridDim.x * gridDim.y * gridDim.z;
    unsigned sum, cnt, mine, sp = 0u;
    for (;;) {
        sum = 0u; cnt = 0u; mine = 0u;
#pragma unroll
        for (unsigned j = 0; j < 16; ++j) { const unsigned c = xb_ld(&bar[XB_XCNT(j)]); sum += c; cnt += (c > 0u) ? 1u : 0u; mine = (j == x) ? c : mine; }
        if (sum == G) break;
        __builtin_amdgcn_s_sleep(1);
        if ((++sp & 255u) == 0u) { if (xb_ld(&bar[XB_TMO])) break; if (sp > XB_SPIN_CAP) { atomicAdd(&bar[XB_TMO], 1u); break; } }
    }
    nloc = mine > 0u ? mine : 1u; nx = cnt > 0u ? cnt : 1u;
}
__device__ __forceinline__ void xcd_barrier(const XcdBarrier& b, const int tid) {
    asm volatile("s_waitcnt vmcnt(0)" ::: "memory");
    __syncthreads();
    if (tid == 0) {
        unsigned* bar = b.bar;
        __builtin_amdgcn_s_waitcnt(0);
        unsigned nloc = b.st[0], nx = b.st[1];
        if (nloc == 0u) { xcd_barrier_complete(bar, b.x, nloc, nx); b.st[0] = nloc; b.st[1] = nx; }
        const unsigned old = xb_add(&bar[XB_XSUB(b.x)], 1u);
        const unsigned gen = old / nloc;
        if (old + 1u == (gen + 1u) * nloc) {
            __builtin_amdgcn_fence(__ATOMIC_RELEASE, "agent");
            asm volatile("s_waitcnt vmcnt(0)" ::: "memory");
            const unsigned og = xb_add(&bar[XB_TOP], 1u);
            const unsigned tg = og / nx;
            if (og + 1u == (tg + 1u) * nx) xb_add(&bar[XB_TOPGEN], 1u);
            else XB_SPIN(xb_ld(&bar[XB_TOPGEN]) == tg, bar);
            __builtin_amdgcn_fence(__ATOMIC_ACQUIRE, "agent");
            xb_add(&bar[XB_XGEN(b.x)], 1u);
            asm volatile("s_waitcnt vmcnt(0)" ::: "memory");
        } else {
            XB_SPIN(xb_ld(&bar[XB_XGEN(b.x)]) == gen, bar);
            __builtin_amdgcn_fence(__ATOMIC_ACQUIRE, "agent");
            asm volatile("s_waitcnt vmcnt(0)" ::: "memory");
        }
    }
    __syncthreads();
}

constexpr int NPHASE = 8;
#define IDS() const int tid = TIDK, lane = tid & 63, wave = __builtin_amdgcn_readfirstlane(tid >> 6); const int G = gridDim.x; \
    const int gtid = blockIdx.x * (NWAVES * 64) + tid, gthreads = G * NWAVES * 64, gw = blockIdx.x * NWAVES + wave, ngw = G * NWAVES; (void)lane; (void)wave; (void)gtid; (void)gthreads; (void)gw; (void)ngw;
__global__ void __launch_bounds__(NWAVES * 64, 2) fwd_kernel(Args a_unused) {
    extern __shared__ __attribute__((aligned(16))) unsigned char lds_raw[];
    LAS unsigned char* lds = (LAS unsigned char*)lds_raw;
    const kargp_t kp = (kargp_t)__builtin_amdgcn_kernarg_segment_ptr();
    const int lo = karg_int<136>(kp), hi = karg_int<140>(kp);
#define LOADA() const Args a = load_args(kp)
    volatile LAS unsigned* xb_st = (volatile LAS unsigned*)(lds + XB_LDS_OFF);
    const int wid6 = __builtin_amdgcn_readfirstlane((int)threadIdx.x) & ~63;
#define TIDK tid_from(wid6)
    { const int t0 = TIDK; if (t0 < 4) xb_st[t0] = 0u;
      __syncthreads();
      (void)xcd_barrier_post((unsigned*)((unsigned char*)karg_ptr<128>(kp) + WS_CTL + XB_CTL_OFF) + karg_int<144>(kp) * XCD_BAR_WORDS, xb_st, t0); }
    if (lo < 0) cg::this_grid().sync();
#define IN(k) (lo <= (k) && (k) < hi)
#define SEAM(k) do { if (IN(k) && IN((k) + 1)) { { XcdBarrier xb_; xb_.bar = (unsigned*)((unsigned char*)karg_ptr<128>(kp) + WS_CTL + XB_CTL_OFF) + karg_int<144>(kp) * XCD_BAR_WORDS; xb_.x = xb_xcc_id(); \
        xb_.st = (volatile LAS unsigned*)(lds + XB_LDS_OFF); xcd_barrier(xb_, TIDK); } } } while (0)
    if (IN(0)) { LOADA(); IDS(); ph_prologue(a, lds, tid, gtid, gthreads, gw, ngw, lane); }
    SEAM(0);
    if (IN(1)) {
        unsigned char* ws = (unsigned char*)karg_ptr<128>(kp);
        pg8::Gemm g{(const bf16*)(ws + WS_HB), (const bf16*)(ws + WS_W1T), NTOK, N1, DM}; pg8::StaticOrder S; S.init(NTOK, N1, (int)gridDim.x, (int)blockIdx.x);
        pg8::EpiStore E{(bf16*)(ws + WS_P1), N1, nullptr};
        pg8::gemm_phase<pg8::EpiStore, pg8::StaticOrder, true, true>(lds, g, S, E, TIDK);
    }
    SEAM(1);
    if (IN(2)) { LOADA(); IDS(); ph_cnorm_pool(a, gw, ngw, lane); }
    SEAM(2);
    if (IN(3)) { LOADA(); ph_attn_fast(a, lds, (ATT_VARIANT && a.li == 1) ? ATT_VARIANT : 0, wid6); }
    SEAM(3);
    if (IN(4)) {
        unsigned char* ws = (unsigned char*)karg_ptr<128>(kp);
        pg8::Gemm g{(const bf16*)(ws + WS_MIX), (const bf16*)(ws + WS_W2T), NTOK, DM, K2 / 2}; pg8::StaticOrder S; S.init(NTOK, DM, (int)gridDim.x, (int)blockIdx.x);
        pg8::EpiResid<false> E{(const void*)(ws + WS_HB), (bf16*)(ws + WS_X1B), (float*)(ws + WS_CTL), ws + WS_X1F8, 1.0f / 1024.0f, (const float*)(ws + WS_RS), (const float*)karg_ptr<8>(kp)};
        pg8::gemm_phase<pg8::EpiResid<false>, pg8::StaticOrder, true, true, true>(lds, g, S, E, TIDK);
    }
    SEAM(4);
    if (IN(5)) {
        unsigned char* ws = (unsigned char*)karg_ptr<128>(kp);
        pg8::Gemm g{(const bf16*)(ws + WS_X1F8), (const bf16*)(ws + WS_W3T), NTOK, N3, DM / 2}; pg8::StaticOrder S; S.init(NTOK, N3, (int)gridDim.x, (int)blockIdx.x);
        pg8::EpiConvGlu E{ws + WS_ACT, (const float*)(ws + WS_CTL), (const float*)(ws + WS_CONVP), (float*)(ws + WS_HF), (float*)(ws + WS_HL), (LAS float*)(lds + HALO_LDS_OFF)};
        pg8::gemm_phase<pg8::EpiConvGlu, pg8::StaticOrder, true, true, true>(lds, g, S, E, TIDK);
    }
    SEAM(5);
    if (IN(6)) { LOADA(); IDS(); ph_fixup(a, gtid, gthreads); }
    SEAM(6);
    if (IN(7)) {
        unsigned char* ws = (unsigned char*)karg_ptr<128>(kp);
        pg8::Gemm g{(const bf16*)(ws + WS_ACT), (const bf16*)(ws + WS_W4T), NTOK, DM, FF / 2}; pg8::StaticOrder S; S.init(NTOK, DM, (int)gridDim.x, (int)blockIdx.x);
        pg8::EpiFinal E{(const bf16*)(ws + WS_X1B), (float*)karg_ptr<120>(kp), (float*)(ws + WS_CTL + 256 * 1024), (unsigned*)(ws + WS_CTL + PCNT_CTL_OFF), (const float*)karg_ptr<112>(kp)};
        pg8::gemm_phase<pg8::EpiFinal, pg8::StaticOrder, true, true, true>(lds, g, S, E, TIDK);
    }
#undef IN
#undef SEAM
}

extern "C" void kernel_launch(void* const* d_in, const int* in_sizes, int n_in, void* d_out, int out_size, void* d_ws, size_t ws_size, hipStream_t stream) {
    static int grid = 0;
    if (grid == 0) {
        if (n_in != 15 || in_sizes[0] != NTOK * DM || out_size != NTOK * DM || ws_size < WS_END) { fprintf(stderr, "kernel_launch: unexpected shapes / workspace (n_in %d, ws %zu)\n", n_in, ws_size); grid = -1; return; }
        int dev = 0, cus = 0, per_cu = 0;
        hipGetDevice(&dev); hipDeviceGetAttribute(&cus, hipDeviceAttributeMultiprocessorCount, dev);
        if (hipFuncSetAttribute((const void*)fwd_kernel, hipFuncAttributeMaxDynamicSharedMemorySize, LDS_BYTES) != hipSuccess) { fprintf(stderr, "kernel_launch: hipFuncSetAttribute failed\n"); grid = -1; return; }
        if (hipOccupancyMaxActiveBlocksPerMultiprocessor(&per_cu, (const void*)fwd_kernel, NWAVES * 64, LDS_BYTES) != hipSuccess || per_cu < 1) { fprintf(stderr, "kernel_launch: occupancy query says %d\n", per_cu); per_cu = 1; }
        (void)hipGetLastError();
        grid = cus;
        if (grid != 256) fprintf(stderr, "kernel_launch: %d CUs (tuned for 256)\n", grid);
    }
    if (grid < 0) return;
    hipMemsetAsync((char*)d_ws + WS_CTL, 0, CTL_ZERO_BYTES, stream);
    Args a{};
    a.x = (const float*)d_in[0]; a.g_mix = (const float*)d_in[1]; a.w_in = (const float*)d_in[2]; a.g_kv = (const float*)d_in[3]; a.w_uk = (const float*)d_in[4]; a.w_uv = (const float*)d_in[5];
    a.w_pool = (const float*)d_in[6]; a.pool_scale = (const float*)d_in[7]; a.w_o = (const float*)d_in[8]; a.g_ffn = (const float*)d_in[9]; a.w_up = (const float*)d_in[10];
    a.conv_w = (const float*)d_in[11]; a.conv_b = (const float*)d_in[12]; a.w_down = (const float*)d_in[13]; a.g_final = (const float*)d_in[14];
    a.out = (float*)d_out; a.ws = (unsigned char*)d_ws;
#if REP_PH >= 0
    { void* args[] = {&a};
      if (REP_PH >= 100) {
        a.ph_lo = 0; a.ph_hi = NPHASE; a.li = 0; hipLaunchCooperativeKernel((const void*)fwd_kernel, dim3(grid), dim3(NWAVES * 64), args, LDS_BYTES, stream);
        a.ph_lo = 0; a.ph_hi = REP_PH - 100; a.li = 1; hipLaunchCooperativeKernel((const void*)fwd_kernel, dim3(grid), dim3(NWAVES * 64), args, LDS_BYTES, stream);
      } else if (REP_PH == 4 || REP_PH == 7) {
        a.ph_lo = 0; a.ph_hi = NPHASE; a.li = 0; hipLaunchCooperativeKernel((const void*)fwd_kernel, dim3(grid), dim3(NWAVES * 64), args, LDS_BYTES, stream);
        a.ph_lo = REP_PH; a.ph_hi = REP_PH + 1; a.li = 1; hipLaunchCooperativeKernel((const void*)fwd_kernel, dim3(grid), dim3(NWAVES * 64), args, LDS_BYTES, stream);
      } else {
      a.ph_lo = 0; a.ph_hi = REP_PH + 1; a.li = 0; hipLaunchCooperativeKernel((const void*)fwd_kernel, dim3(grid), dim3(NWAVES * 64), args, LDS_BYTES, stream);
      a.ph_lo = REP_PH; a.ph_hi = REP_PH + 1; a.li = 1; hipLaunchCooperativeKernel((const void*)fwd_kernel, dim3(grid), dim3(NWAVES * 64), args, LDS_BYTES, stream);
      if (REP_PH + 1 < NPHASE) { a.ph_lo = REP_PH + 1; a.ph_hi = NPHASE; a.li = 2; hipLaunchCooperativeKernel((const void*)fwd_kernel, dim3(grid), dim3(NWAVES * 64), args, LDS_BYTES, stream); } } }
#elif MK_ONE_LAUNCH
    a.ph_lo = 0; a.ph_hi = NPHASE;
    void* args[] = {&a};
    hipError_t e = hipLaunchCooperativeKernel((const void*)fwd_kernel, dim3(grid), dim3(NWAVES * 64), args, LDS_BYTES, stream);
    if (e != hipSuccess) fprintf(stderr, "cooperative launch failed: %s (grid %d)\n", hipGetErrorString(e), grid);
#else
    for (int ph = 0; ph < NPHASE; ++ph) {
        a.ph_lo = ph; a.ph_hi = ph + 1;
        hipLaunchKernelGGL(fwd_kernel, dim3(grid), dim3(NWAVES * 64), LDS_BYTES, stream, a);
    }
#endif
}
```

```cpp
#include <hip/hip_runtime.h>
#include <hip/hip_cooperative_groups.h>
#include <cstdio>
#include <cstdint>
namespace cg = cooperative_groups;

#ifndef USE_NAIVE_ATTN
#define USE_NAIVE_ATTN 0
#endif
#ifndef REP_PH
#define REP_PH -1
#endif
#ifndef ATT_VARIANT
#define ATT_VARIANT 0
#endif
#ifndef MK_ONE_LAUNCH
#define MK_ONE_LAUNCH 1
#endif

namespace pg8 {
#define PG8_LAS __attribute__((address_space(3)))
typedef unsigned short bf16_t;
typedef short bf16x8 __attribute__((ext_vector_type(8)));
typedef float f32x4 __attribute__((ext_vector_type(4)));
typedef unsigned u32x4 __attribute__((ext_vector_type(4)));
constexpr int BM = 256, BK = 64, HALF = 128, HTB = HALF * BK * 2, STAGE_BYTES = 8 * HTB, NXCD = 8, WGM = 8;

__host__ __device__ __forceinline__ int lds_byte(int r, int c) { const int st = (r >> 4) * 2 + (c >> 5), rr = r & 15, cc = c & 31, ob = rr * 64 + cc * 2; return st * 1024 + (ob ^ (((ob >> 9) & 1) << 5)); }
__host__ __device__ __forceinline__ void stage_rc(int b, int& R, int& C) { const int st = b / 1024, sb = b % 1024, swz = sb ^ (((sb >> 9) & 1) << 5); R = (st >> 1) * 16 + swz / 64; C = (st & 1) * 32 + (swz % 64) / 2; }
__host__ __device__ __forceinline__ int perm32(int rho) { const int n = rho >> 4, i = rho & 15; return 8 * (i >> 2) + 4 * n + (i & 3); }

struct Unit { int pm, pn; };
struct Gemm { const bf16_t* A; const bf16_t* Bt; int M, N, K; };

struct StaticOrder {
    int nM, nN, nwg, G, c;
    __host__ __device__ void init(int M, int N, int G_, int c_) { nM = M / BM; nN = N / BM; nwg = nM * nN; G = G_; c = c_; }
    __host__ __device__ bool next(int i, Unit& u) const {
        const long L = (long)i * G + c; if (L >= nwg) return false;
        int wgid = (int)L; { const int q = nwg / NXCD, r = nwg % NXCD, xcd = wgid % NXCD, off = wgid / NXCD; wgid = (xcd < r ? xcd * (q + 1) : r * (q + 1) + (xcd - r) * q) + off; }
        const int nig = WGM * nN, gid = wgid / nig, fm = gid * WGM, gsz = (nM - fm) < WGM ? (nM - fm) : WGM;
        u.pm = fm + ((wgid % nig) % gsz); u.pn = (wgid % nig) / gsz; return true;
    }
    __device__ __forceinline__ void a_ready(const Unit&) const {}
    __device__ __forceinline__ void done(const Unit&) const {}
};

__device__ __forceinline__ unsigned cvt_pk_bf16(float lo, float hi) { unsigned r; asm volatile("v_cvt_pk_bf16_f32 %0, %1, %2" : "=v"(r) : "v"(lo), "v"(hi)); return r; }


struct EpiStore {
    static constexpr bool PERM = true, AFTER_DRAIN = false;
    bf16_t* O; int ldc; const float* sumsq; unsigned char* Q8; unsigned char* U8;
    __device__ __forceinline__ void operator()(const f32x4 (&acc)[2][2][4][2], const Unit& u, int wr, int wc, int fr, int fq) const {
        const int row0 = u.pm * BM + wr * 64 + fr, col0 = u.pn * BM + wc * 32 + 8 * fq;
        if (Q8 && (u.pn < 2 || (u.pn & 6) == 4)) {
            unsigned char* dst = (u.pn < 2 ? Q8 : U8) + (u.pn & 1) * BM + wc * 32 + 8 * fq;
#pragma unroll
            for (int ai = 0; ai < 2; ++ai)
#pragma unroll
                for (int m = 0; m < 4; ++m) {
                    unsigned char* rowp8 = dst + (size_t)(row0 + ai * HALF + m * 16) * 512;
#pragma unroll
                    for (int bj = 0; bj < 2; ++bj) { typedef unsigned u32x2_ __attribute__((ext_vector_type(2))); u32x2_ q; int t_; float z[8];
#pragma unroll
                        for (int e = 0; e < 4; ++e) { z[e] = fminf(fmaxf(acc[ai][bj][m][0][e] * 16.f, -448.f), 448.f); z[4 + e] = fminf(fmaxf(acc[ai][bj][m][1][e] * 16.f, -448.f), 448.f); }
                        t_ = __builtin_amdgcn_cvt_pk_fp8_f32(z[0], z[1], 0, false); q.x = (unsigned)__builtin_amdgcn_cvt_pk_fp8_f32(z[2], z[3], t_, true);
                        t_ = __builtin_amdgcn_cvt_pk_fp8_f32(z[4], z[5], 0, false); q.y = (unsigned)__builtin_amdgcn_cvt_pk_fp8_f32(z[6], z[7], t_, true);
                        *(u32x2_*)(rowp8 + bj * HALF) = q; } }
            return;
        }
#pragma unroll
        for (int ai = 0; ai < 2; ++ai)
#pragma unroll
            for (int m = 0; m < 4; ++m) {
                const int row = row0 + ai * HALF + m * 16;
                float sc = 1.f; if (sumsq) sc = 1.0f / sqrtf(sumsq[row] * (1.0f / 1024.0f) + 1e-6f);
                bf16_t* rowp = O + (size_t)row * ldc + col0;
#pragma unroll
                for (int bj = 0; bj < 2; ++bj) { f32x4 v0 = acc[ai][bj][m][0] * sc, v1 = acc[ai][bj][m][1] * sc;
                    u32x4 w; w.x = cvt_pk_bf16(v0[0], v0[1]); w.y = cvt_pk_bf16(v0[2], v0[3]); w.z = cvt_pk_bf16(v1[0], v1[1]); w.w = cvt_pk_bf16(v1[2], v1[3]);
                    *(u32x4*)(rowp + bj * HALF) = w; } }
    }
};
template <bool BASE_F32> struct EpiResid {
    static constexpr bool PERM = true, AFTER_DRAIN = false;
    const void* base; bf16_t* O; float* sumsq; unsigned char* O8; float accscale; const float* rowfac; const float* colg;
    __device__ __forceinline__ void operator()(const f32x4 (&acc)[2][2][4][2], const Unit& u, int wr, int wc, int fr, int fq) const {
        const int row0 = u.pm * BM + wr * 64 + fr, col0 = u.pn * BM + wc * 32 + 8 * fq;
        f32x4 gi[2][2];
        if (!BASE_F32) {
#pragma unroll
            for (int bj = 0; bj < 2; ++bj)
#pragma unroll
                for (int q = 0; q < 2; ++q) { const f32x4 g_ = *(const f32x4*)(colg + col0 + bj * HALF + 4 * q);
#pragma unroll
                    for (int e = 0; e < 4; ++e) gi[bj][q][e] = __builtin_amdgcn_rcpf(g_[e]); }
        }
#pragma unroll
        for (int ai = 0; ai < 2; ++ai)
#pragma unroll
            for (int m = 0; m < 4; ++m) {
                const int row = row0 + ai * HALF + m * 16; float ss = 0.f;
                float rf = 1.f; if (!BASE_F32) rf = rowfac[row];
#pragma unroll
                for (int bj = 0; bj < 2; ++bj) {
                    const size_t off = (size_t)row * 1024 + col0 + bj * HALF;
                    f32x4 b0, b1;
                    if (BASE_F32) { b0 = *(const f32x4*)((const float*)base + off); b1 = *(const f32x4*)((const float*)base + off + 4); }
                    else { const u32x4 r = *(const u32x4*)((const bf16_t*)base + off);
                        b0[0] = __uint_as_float(r.x << 16); b0[1] = __uint_as_float(r.x & 0xffff0000u); b0[2] = __uint_as_float(r.y << 16); b0[3] = __uint_as_float(r.y & 0xffff0000u);
                        b1[0] = __uint_as_float(r.z << 16); b1[1] = __uint_as_float(r.z & 0xffff0000u); b1[2] = __uint_as_float(r.w << 16); b1[3] = __uint_as_float(r.w & 0xffff0000u);
                        b0 = b0 * rf * gi[bj][0]; b1 = b1 * rf * gi[bj][1]; }
                    const f32x4 v0 = acc[ai][bj][m][0] * accscale + b0, v1 = acc[ai][bj][m][1] * accscale + b1;
                    ss += (v0[0] * v0[0] + v0[1] * v0[1]) + (v0[2] * v0[2] + v0[3] * v0[3]) + (v1[0] * v1[0] + v1[1] * v1[1]) + (v1[2] * v1[2] + v1[3] * v1[3]);
                    u32x4 w; w.x = cvt_pk_bf16(v0[0], v0[1]); w.y = cvt_pk_bf16(v0[2], v0[3]); w.z = cvt_pk_bf16(v1[0], v1[1]); w.w = cvt_pk_bf16(v1[2], v1[3]);
                    *(u32x4*)(O + off) = w;
                    if (O8) { typedef unsigned u32x2_ __attribute__((ext_vector_type(2))); u32x2_ q; int t_;
                        t_ = __builtin_amdgcn_cvt_pk_fp8_f32(v0[0] * 16.f, v0[1] * 16.f, 0, false); q.x = (unsigned)__builtin_amdgcn_cvt_pk_fp8_f32(v0[2] * 16.f, v0[3] * 16.f, t_, true);
                        t_ = __builtin_amdgcn_cvt_pk_fp8_f32(v1[0] * 16.f, v1[1] * 16.f, 0, false); q.y = (unsigned)__builtin_amdgcn_cvt_pk_fp8_f32(v1[2] * 16.f, v1[3] * 16.f, t_, true);
                        *(u32x2_*)(O8 + off) = q; } }
                ss += __shfl_xor(ss, 16); ss += __shfl_xor(ss, 32);
                if (fq == 0) atomicAdd(sumsq + row, ss);
            }
    }
};


struct EpiConvGlu {
    static constexpr bool PERM = true, AFTER_DRAIN = false;
    unsigned char* ACT; const float* sumsq; const float* convp; float* hfirst; float* hlast; PG8_LAS float* halo;
    __device__ __forceinline__ void operator()(f32x4 (&acc)[2][2][4][2], const Unit& u, int wr, int wc, int fr, int fq) const {
        constexpr int N3_ = 5632, FF_ = 2816;
        const int row0 = u.pm * BM + wr * 64 + fr, cq = wc * 32 + 8 * fq;
        f32x4 cpar[2][8];
#pragma unroll
        for (int n = 0; n < 2; ++n) { const float* cp = convp + u.pn * BM + cq + 4 * n;
#pragma unroll
            for (int q = 0; q < 4; ++q) { cpar[n][q] = *(const f32x4*)(cp + q * N3_); cpar[n][4 + q] = *(const f32x4*)(cp + HALF + q * N3_); } }
#pragma unroll
        for (int ai = 0; ai < 2; ++ai)
#pragma unroll
            for (int m = 0; m < 4; ++m) { const float sc = __builtin_amdgcn_rsqf(sumsq[row0 + ai * HALF + m * 16] * (1.0f / 1024.0f) + 1e-6f) * (1.0f / 1024.0f);
#pragma unroll
                for (int bj = 0; bj < 2; ++bj) { acc[ai][bj][m][0] *= sc; acc[ai][bj][m][1] *= sc; } }
#pragma unroll
        for (int ai = 0; ai < 2; ++ai)
#pragma unroll
            for (int bj = 0; bj < 2; ++bj)
#pragma unroll
                for (int m = 0; m < 4; ++m) { asm volatile("" : "+v"(acc[ai][bj][m][0])); asm volatile("" : "+v"(acc[ai][bj][m][1])); }
        __builtin_amdgcn_sched_barrier(0);
        if (fr >= 14) {
#pragma unroll
            for (int ai = 0; ai < 2; ++ai)
#pragma unroll
                for (int bj = 0; bj < 2; ++bj)
#pragma unroll
                    for (int n = 0; n < 2; ++n) *(PG8_LAS f32x4*)(halo + ((2 * ai + wr) * 2 + (fr - 14)) * 256 + bj * HALF + cq + 4 * n) = acc[ai][bj][3][n];
            if (wr == 1) {
#pragma unroll
                for (int bj = 0; bj < 2; ++bj)
#pragma unroll
                    for (int n = 0; n < 2; ++n) *(f32x4*)(hlast + (size_t)(u.pm * 2 + (fr - 14)) * N3_ + u.pn * BM + bj * HALF + cq + 4 * n) = acc[1][bj][3][n];
            }
        }
        if (fr < 2 && wr == 0) {
#pragma unroll
            for (int bj = 0; bj < 2; ++bj)
#pragma unroll
                for (int n = 0; n < 2; ++n) *(f32x4*)(hfirst + (size_t)(u.pm * 2 + fr) * N3_ + u.pn * BM + bj * HALF + cq + 4 * n) = acc[0][bj][0][n];
        }
        asm volatile("s_waitcnt lgkmcnt(0)" ::: "memory"); __builtin_amdgcn_s_barrier(); asm volatile("s_nop 1" ::: "memory");
#define CONV_DPP(cv, src, w, ctl) asm("v_fmac_f32_dpp %0, %1, %2 " ctl " row_mask:0xf bank_mask:0xf" : "+v"(cv) : "v"(src), "v"(w))
#pragma unroll
        for (int n = 0; n < 2; ++n) {
            const f32x4 g0 = cpar[n][0], g1 = cpar[n][1], g2 = cpar[n][2], gb = cpar[n][3];
            const f32x4 u0 = cpar[n][4], u1 = cpar[n][5], u2 = cpar[n][6], ub = cpar[n][7];
#pragma unroll
            for (int ai = 0; ai < 2; ++ai) {
                const int pred = 2 * ai + wr - 1;
                f32x4 hg1 = {0.f, 0.f, 0.f, 0.f}, hg2 = hg1, hu1 = hg1, hu2 = hg1;
                if (pred >= 0) { const PG8_LAS float* hp = halo + pred * 512 + cq + 4 * n;
                    hg2 = *(const PG8_LAS f32x4*)(hp); hg1 = *(const PG8_LAS f32x4*)(hp + 256); hu2 = *(const PG8_LAS f32x4*)(hp + HALF); hu1 = *(const PG8_LAS f32x4*)(hp + 256 + HALF); }
#pragma unroll
                for (int m = 3; m >= 0; --m) {
                    f32x4 cg, cu;
#pragma unroll
                    for (int j = 0; j < 4; ++j) {
                        const float ag = acc[ai][0][m][n][j], au = acc[ai][1][m][n][j];
                        float vg = fmaf(g2[j], ag, gb[j]), vu = fmaf(u2[j], au, ub[j]);
                        CONV_DPP(vg, ag, g1[j], "row_shr:1"); CONV_DPP(vg, ag, g0[j], "row_shr:2");
                        CONV_DPP(vu, au, u1[j], "row_shr:1"); CONV_DPP(vu, au, u0[j], "row_shr:2");
                        if (m > 0) { const float pg = acc[ai][0][m - 1][n][j], pu = acc[ai][1][m - 1][n][j];
                            CONV_DPP(vg, pg, g1[j], "row_shl:15"); CONV_DPP(vg, pg, g0[j], "row_shl:14");
                            CONV_DPP(vu, pu, u1[j], "row_shl:15"); CONV_DPP(vu, pu, u0[j], "row_shl:14");
                        } else {
                            const float c1g = (fr == 0) ? hg1[j] : 0.f, c2g = (fr == 0) ? hg2[j] : ((fr == 1) ? hg1[j] : 0.f);
                            const float c1u = (fr == 0) ? hu1[j] : 0.f, c2u = (fr == 0) ? hu2[j] : ((fr == 1) ? hu1[j] : 0.f);
                            vg = fmaf(g1[j], c1g, vg); vg = fmaf(g0[j], c2g, vg); vu = fmaf(u1[j], c1u, vu); vu = fmaf(u0[j], c2u, vu);
                        }
                        cg[j] = vg; cu[j] = vu;
                    }
                    float r[4];
#pragma unroll
                    for (int j = 0; j < 4; ++j) r[j] = cg[j] * __builtin_amdgcn_rcpf(1.0f + __builtin_amdgcn_exp2f(-1.4426950408889634f * cg[j])) * cu[j];
#pragma unroll
                    for (int j = 0; j < 4; ++j) r[j] = fminf(fmaxf(r[j] * 8.0f, -448.f), 448.f);
                    const int t_ = __builtin_amdgcn_cvt_pk_fp8_f32(r[0], r[1], 0, false); const unsigned w4 = (unsigned)__builtin_amdgcn_cvt_pk_fp8_f32(r[2], r[3], t_, true);
                    *(unsigned*)(ACT + (size_t)(row0 + ai * HALF + m * 16) * FF_ + u.pn * HALF + cq + 4 * n) = w4;
                }
            }
        }
#undef CONV_DPP
    }
};


struct EpiFinal {
    static constexpr bool PERM = true, AFTER_DRAIN = false;
    const bf16_t* base; float* out; float* sumsq; unsigned* pcnt; const float* gfin;
    __device__ __forceinline__ void operator()(f32x4 (&acc)[2][2][4][2], const Unit& u, int wr, int wc, int fr, int fq) const {
        const int row0 = u.pm * BM + wr * 64 + fr, col0 = u.pn * BM + wc * 32 + 8 * fq;
#pragma unroll
        for (int ai = 0; ai < 2; ++ai)
#pragma unroll
            for (int m = 0; m < 4; ++m) {
                const int row = row0 + ai * HALF + m * 16; float ss = 0.f;
#pragma unroll
                for (int bj = 0; bj < 2; ++bj) {
                    const u32x4 r = *(const u32x4*)(base + (size_t)row * 1024 + col0 + bj * HALF);
                    f32x4 b0, b1;
                    b0[0] = __uint_as_float(r.x << 16); b0[1] = __uint_as_float(r.x & 0xffff0000u); b0[2] = __uint_as_float(r.y << 16); b0[3] = __uint_as_float(r.y & 0xffff0000u);
                    b1[0] = __uint_as_float(r.z << 16); b1[1] = __uint_as_float(r.z & 0xffff0000u); b1[2] = __uint_as_float(r.w << 16); b1[3] = __uint_as_float(r.w & 0xffff0000u);
                    const f32x4 v0 = acc[ai][bj][m][0] * (1.0f / 512.0f) + b0, v1 = acc[ai][bj][m][1] * (1.0f / 512.0f) + b1;
                    acc[ai][bj][m][0] = v0; acc[ai][bj][m][1] = v1;
                    ss += (v0[0] * v0[0] + v0[1] * v0[1]) + (v0[2] * v0[2] + v0[3] * v0[3]) + (v1[0] * v1[0] + v1[1] * v1[1]) + (v1[2] * v1[2] + v1[3] * v1[3]); }
                ss += __shfl_xor(ss, 16); ss += __shfl_xor(ss, 32);
                if (fq == 0) atomicAdd(sumsq + row, ss);
            }
        const bool t0 = (wr == 0 && wc == 0 && fr == 0 && fq == 0);
        asm volatile("s_waitcnt vmcnt(0)" ::: "memory");
        __builtin_amdgcn_s_barrier();
        if (t0) {
            unsigned* pc = pcnt + 64 * u.pm;
            __hip_atomic_fetch_add(pc, 1u, __ATOMIC_RELAXED, __HIP_MEMORY_SCOPE_AGENT);
            unsigned sp = 0;
            while (__hip_atomic_load(pc, __ATOMIC_RELAXED, __HIP_MEMORY_SCOPE_AGENT) < 4u) { __builtin_amdgcn_s_sleep(2); if (++sp > (1u << 22)) break; }
            __builtin_amdgcn_fence(__ATOMIC_ACQUIRE, "agent");
            asm volatile("s_waitcnt vmcnt(0)" ::: "memory");
        }
        __builtin_amdgcn_s_barrier(); asm volatile("" ::: "memory");
#pragma unroll
        for (int ai = 0; ai < 2; ++ai)
#pragma unroll
            for (int m = 0; m < 4; ++m) {
                const int row = row0 + ai * HALF + m * 16;
                const float rinv = __builtin_amdgcn_rsqf(__hip_atomic_load(sumsq + row, __ATOMIC_RELAXED, __HIP_MEMORY_SCOPE_AGENT) * (1.0f / 1024.0f) + 1e-6f);
#pragma unroll
                for (int bj = 0; bj < 2; ++bj) { const int c = col0 + bj * HALF; float* op = out + (size_t)row * 1024 + c;
                    *(f32x4*)(op) = acc[ai][bj][m][0] * rinv * *(const f32x4*)(gfin + c); *(f32x4*)(op + 4) = acc[ai][bj][m][1] * rinv * *(const f32x4*)(gfin + c + 4); }
            }
    }
};

typedef int v8i_t __attribute__((ext_vector_type(8)));
typedef int v4i_t __attribute__((ext_vector_type(4)));
template <bool F8> struct Frag;
template <> struct Frag<false> { bf16x8 k[2]; };
template <> struct Frag<true>  { v8i_t v; };
template <bool F8> __device__ __forceinline__ void ld_frag(Frag<F8>& d, const PG8_LAS unsigned char* p) {
    if constexpr (F8) { const v4i_t lo = *(const PG8_LAS v4i_t*)p, hi = *(const PG8_LAS v4i_t*)(p + 1024); d.v = __builtin_shufflevector(lo, hi, 0, 1, 2, 3, 4, 5, 6, 7); }
    else { d.k[0] = *(const PG8_LAS bf16x8*)p; d.k[1] = *(const PG8_LAS bf16x8*)(p + 1024); }
}
template <bool F8> __device__ __forceinline__ f32x4 mma_frag(const Frag<F8>& b, const Frag<F8>& a, f32x4 c) {
    if constexpr (F8) {
        const int one = 0x7f7f7f7f;
#if defined(__HIP_DEVICE_COMPILE__)
        asm volatile("v_mfma_scale_f32_16x16x128_f8f6f4 %0, %1, %2, %0, %3, %3 op_sel_hi:[0,0,0]" : "+v"(c) : "v"(b.v), "v"(a.v), "v"(one));
#else
        (void)one;
#endif
        return c; }
    else { c = __builtin_amdgcn_mfma_f32_16x16x32_bf16(b.k[0], a.k[0], c, 0, 0, 0); return __builtin_amdgcn_mfma_f32_16x16x32_bf16(b.k[1], a.k[1], c, 0, 0, 0); }
}
template <class Epi, class Sched, bool ALIGN_EPI = false, bool SP2 = false, bool F8 = false>
__device__ __forceinline__ void gemm_phase(PG8_LAS unsigned char* lds, const Gemm g, const Sched& S, const Epi& E, const int tid) {
    const int wid = __builtin_amdgcn_readfirstlane(tid >> 6), lane = tid & 63, wr = wid >> 2, wc = wid & 3, fr = lane & 15, fq = lane >> 4;
    const int K = g.K, nt = K / BK;
    unsigned voffA[2], voffB[2];
#pragma unroll
    for (int i = 0; i < 2; ++i) { int R, C; stage_rc(tid * 16 + i * 8192, R, C); const int Rb = Epi::PERM ? ((R & ~31) + perm32(R & 31)) : R;
        voffA[i] = (unsigned)(R * K + C) * 2u; voffB[i] = (unsigned)(Rb * K + C) * 2u; }
    const size_t kstep = (size_t)(BK * 2);
    const size_t hstep = (size_t)HALF * K * 2;
    const size_t tstep = 2 * hstep;
    const unsigned ldsw = (unsigned)wid * 1024u;
    const int aoff = lds_byte(wr * 64 + fr, fq * 8), boff = lds_byte(wc * 32 + fr, fq * 8);
#define PG8_SA(b, h) (((b) * 2 + (h)) * HTB)
#define PG8_SB(b, h) ((4 + (b) * 2 + (h)) * HTB)
#define PG8_STAGE(bufoff, gbase, voff) do { _Pragma("unroll") for (int _i = 0; _i < 2; ++_i) \
        __builtin_amdgcn_global_load_lds((const unsigned*)((const char*)(gbase) + (voff)[_i]), (PG8_LAS unsigned*)(lds + (bufoff) + ldsw + _i * 8192), 16, 0, 0); } while (0)
#define PG8_LDA(dst, b, h) do { _Pragma("unroll") for (int m = 0; m < 4; ++m) ld_frag<F8>(dst[m], lds + PG8_SA(b, h) + aoff + m * 2048); } while (0)
#define PG8_LDB(dst, b, h) do { _Pragma("unroll") for (int n = 0; n < 2; ++n) ld_frag<F8>(dst[n], lds + PG8_SB(b, h) + boff + n * 2048); } while (0)
#define PG8_MMA(ai, bj, At, Bt) do { __builtin_amdgcn_s_setprio(1); _Pragma("unroll") for (int m = 0; m < 4; ++m) _Pragma("unroll") for (int n = 0; n < 2; ++n) \
        acc[ai][bj][m][n] = mma_frag<F8>(Bt[n], At[m], acc[ai][bj][m][n]); __builtin_amdgcn_s_setprio(0); } while (0)
#define PG8_WAIT_V(n) asm volatile("s_waitcnt vmcnt(" #n ")" ::: "memory")
#define PG8_WAIT_L(n) asm volatile("s_waitcnt lgkmcnt(" #n ")" ::: "memory")
#define PG8_BAR __builtin_amdgcn_s_barrier()
#define PG8_SCHED __builtin_amdgcn_sched_barrier(0)
    Unit cur, nxt; int ui = 0;
    if (!S.next(0, cur)) return;
    f32x4 acc[2][2][4][2];
#pragma unroll
    for (int a = 0; a < 2; ++a)
#pragma unroll
        for (int b = 0; b < 2; ++b)
#pragma unroll
            for (int m = 0; m < 4; ++m)
#pragma unroll
                for (int n = 0; n < 2; ++n) acc[a][b][m][n] = (f32x4){0.f, 0.f, 0.f, 0.f};
    Frag<F8> At[4], B0[2], B1[2];
    const char* cA = (const char*)g.A + (size_t)cur.pm * tstep; const char* cB = (const char*)g.Bt + (size_t)cur.pn * tstep;
    S.a_ready(cur);
    if constexpr (SP2) {
        PG8_STAGE(PG8_SB(0, 0), cB, voffB); PG8_STAGE(PG8_SB(0, 1), cB + hstep, voffB); PG8_STAGE(PG8_SA(0, 0), cA, voffA); PG8_STAGE(PG8_SA(0, 1), cA + hstep, voffA);
        if (wr == 1) PG8_BAR;
        PG8_WAIT_V(2); PG8_BAR;
        PG8_STAGE(PG8_SB(1, 0), cB + kstep, voffB); PG8_STAGE(PG8_SA(1, 0), cA + kstep, voffA); PG8_STAGE(PG8_SB(1, 1), cB + hstep + kstep, voffB);
        PG8_WAIT_V(6); PG8_BAR;
    } else {
        PG8_STAGE(PG8_SB(0, 0), cB, voffB); PG8_STAGE(PG8_SA(0, 0), cA, voffA); PG8_STAGE(PG8_SB(0, 1), cB + hstep, voffB); PG8_STAGE(PG8_SA(0, 1), cA + hstep, voffA);
        if (wr == 1) PG8_BAR;
        PG8_WAIT_V(4); PG8_BAR;
        PG8_STAGE(PG8_SB(1, 0), cB + kstep, voffB); PG8_STAGE(PG8_SA(1, 0), cA + kstep, voffA); PG8_STAGE(PG8_SB(1, 1), cB + hstep + kstep, voffB);
        PG8_WAIT_V(6); PG8_BAR;
    }
    for (;;) {
        const bool has_next = S.next(ui + 1, nxt);
        const char* nA = has_next ? (const char*)g.A + (size_t)nxt.pm * tstep : cA; const char* nB = has_next ? (const char*)g.Bt + (size_t)nxt.pn * tstep : cB;
        for (int t = 0; t < nt; t += 2) {
            const bool last = (t == nt - 2);
            const char* a1 = cA + (size_t)(t + 1) * kstep;
            const char* a2 = last ? nA : cA + (size_t)(t + 2) * kstep; const char* b2 = last ? nB : cB + (size_t)(t + 2) * kstep;
            const char* a3 = a2 + kstep; const char* b3 = b2 + kstep;
            if (last && has_next) S.a_ready(nxt);
            if constexpr (SP2) {
            PG8_LDB(B0, 0, 0); PG8_LDB(B1, 0, 1); PG8_SCHED; PG8_LDA(At, 0, 0); PG8_STAGE(PG8_SA(1, 1), a1 + hstep, voffA);
            PG8_WAIT_V(8); PG8_WAIT_L(0); PG8_BAR; PG8_MMA(0, 0, At, B0); PG8_MMA(0, 1, At, B1); PG8_BAR; PG8_SCHED;
            PG8_LDA(At, 0, 1); PG8_STAGE(PG8_SB(0, 0), b2, voffB); PG8_STAGE(PG8_SB(0, 1), b2 + hstep, voffB); PG8_STAGE(PG8_SA(0, 0), a2, voffA);
            PG8_WAIT_V(8); PG8_WAIT_L(0); PG8_BAR; PG8_MMA(1, 0, At, B0); PG8_MMA(1, 1, At, B1); PG8_BAR; PG8_SCHED;
            PG8_LDB(B0, 1, 0); PG8_LDB(B1, 1, 1); PG8_SCHED; PG8_LDA(At, 1, 0); PG8_STAGE(PG8_SA(0, 1), a2 + hstep, voffA);
            PG8_WAIT_V(8); PG8_WAIT_L(0); PG8_BAR; PG8_MMA(0, 0, At, B0); PG8_MMA(0, 1, At, B1); PG8_BAR; PG8_SCHED;
            PG8_LDA(At, 1, 1); PG8_STAGE(PG8_SB(1, 0), b3, voffB); PG8_STAGE(PG8_SB(1, 1), b3 + hstep, voffB); PG8_STAGE(PG8_SA(1, 0), a3, voffA);
            PG8_WAIT_V(8); PG8_WAIT_L(0); PG8_BAR; PG8_MMA(1, 0, At, B0); PG8_MMA(1, 1, At, B1); PG8_BAR; PG8_SCHED;
            } else {
            PG8_LDB(B0, 0, 0); PG8_SCHED; PG8_LDA(At, 0, 0); PG8_STAGE(PG8_SA(1, 1), a1 + hstep, voffA);
            PG8_WAIT_L(8); PG8_BAR; PG8_WAIT_L(0); PG8_MMA(0, 0, At, B0); PG8_BAR; PG8_SCHED;
            PG8_LDB(B1, 0, 1); PG8_STAGE(PG8_SB(0, 0), b2, voffB);
            PG8_BAR; PG8_WAIT_L(0); PG8_MMA(0, 1, At, B1); PG8_BAR;
            PG8_LDA(At, 0, 1); PG8_STAGE(PG8_SA(0, 0), a2, voffA);
            PG8_BAR; PG8_WAIT_L(0); PG8_MMA(1, 0, At, B0); PG8_BAR; PG8_SCHED;
            PG8_STAGE(PG8_SB(0, 1), b2 + hstep, voffB);
            PG8_WAIT_V(6); PG8_BAR; PG8_MMA(1, 1, At, B1); PG8_BAR;
            PG8_LDB(B0, 1, 0); PG8_SCHED; PG8_LDA(At, 1, 0); PG8_STAGE(PG8_SA(0, 1), a2 + hstep, voffA);
            PG8_WAIT_L(8); PG8_BAR; PG8_WAIT_L(0); PG8_MMA(0, 0, At, B0); PG8_BAR; PG8_SCHED;
            PG8_LDB(B1, 1, 1); PG8_STAGE(PG8_SB(1, 0), b3, voffB);
            PG8_BAR; PG8_WAIT_L(0); PG8_MMA(0, 1, At, B1); PG8_BAR;
            PG8_LDA(At, 1, 1); PG8_STAGE(PG8_SA(1, 0), a3, voffA);
            PG8_BAR; PG8_WAIT_L(0); PG8_MMA(1, 0, At, B0); PG8_BAR; PG8_SCHED;
            PG8_STAGE(PG8_SB(1, 1), b3 + hstep, voffB);
            PG8_WAIT_V(6); PG8_BAR; PG8_MMA(1, 1, At, B1); PG8_BAR;
            }
        }
        if constexpr (ALIGN_EPI) { if (wr == 0) PG8_BAR; }
        if constexpr (F8) asm volatile("s_nop 15\n\ts_nop 15\n\ts_nop 15\n\ts_nop 15" ::: "memory");
        if constexpr (!Epi::AFTER_DRAIN) { E(acc, cur, wr, wc, fr, fq); S.done(cur); }
        if (!has_next) break;
#pragma unroll
        for (int a = 0; a < 2; ++a)
#pragma unroll
            for (int b = 0; b < 2; ++b)
#pragma unroll
                for (int m = 0; m < 4; ++m)
#pragma unroll
                    for (int n = 0; n < 2; ++n) acc[a][b][m][n] = (f32x4){0.f, 0.f, 0.f, 0.f};
        cur = nxt; cA = nA; cB = nB; ++ui;
        if constexpr (ALIGN_EPI) { if (wr == 1) PG8_BAR; }
    }
    PG8_WAIT_V(0);
    if constexpr (!ALIGN_EPI) { if (wr == 0) PG8_BAR; }
    PG8_BAR;
#undef PG8_SA
#undef PG8_SB
#undef PG8_STAGE
#undef PG8_LDA
#undef PG8_LDB
#undef PG8_MMA
#undef PG8_WAIT_V
#undef PG8_WAIT_L
#undef PG8_BAR
#undef PG8_SCHED
}
}

constexpr int NWAVES = 8;
constexpr int BATCH = 32, SEQ = 2048, DM = 1024, NTOK = BATCH * SEQ;
constexpr int IN_COLS = 1736;
constexpr int N1 = 1792, K2 = 1024, FF = 2816, N3 = 2 * FF;
constexpr int OFF_Q = 0, OFF_QI = 512, OFF_U = 1024, OFF_C = 1536, OFF_KI = 1664, OFF_WI = 1728;
constexpr float EPS = 1e-6f;
constexpr float WI_SCALE = 0.044194173824159216f;

constexpr size_t MiB = 1u << 20;
constexpr size_t WS_CTL = 0, CTL_ZERO_BYTES = 1 * MiB;
constexpr size_t WS_W1T = 1 * MiB, WS_W2T = 6 * MiB, WS_W3T = 9 * MiB, WS_W4T = 20 * MiB, WS_CONVP = 26 * MiB, WS_ZT = 27 * MiB, WS_WUKT = 28 * MiB, WS_WUVT = 28 * MiB + 128 * 1024;
constexpr size_t WS_HB = 32 * MiB;
constexpr size_t WS_Q8 = 384 * MiB, WS_U8 = 416 * MiB;
constexpr size_t WS_RS = 27 * MiB + 64 * 1024;
constexpr size_t WS_P1 = 160 * MiB;
constexpr size_t WS_HF = 32 * MiB, WS_HL = 44 * MiB;
constexpr size_t WS_X2 = 64 * MiB;
constexpr size_t WS_MIX = 448 * MiB;
constexpr size_t WS_CN = 640 * MiB;
constexpr size_t WS_CT8 = 672 * MiB;
constexpr size_t WS_ACT = 448 * MiB;
constexpr size_t WS_X1B = 800 * MiB;
constexpr size_t WS_X1F8 = 928 * MiB;
constexpr size_t WS_END = 992 * MiB;

constexpr int LDS_BYTES = 147456;
constexpr int XB_LDS_OFF = 131072 + 1024;
constexpr int HALO_LDS_OFF = 131072 + 2048;
constexpr size_t XB_CTL_OFF = 512 * 1024;
constexpr size_t PCNT_CTL_OFF = 640 * 1024;

#define GAS __attribute__((address_space(1)))
#define LAS __attribute__((address_space(3)))
typedef unsigned short bf16;
typedef unsigned v4u __attribute__((ext_vector_type(4)));
typedef unsigned v2u __attribute__((ext_vector_type(2)));
typedef float f32x4 __attribute__((ext_vector_type(4)));

__device__ __forceinline__ unsigned f2bf(float f) { unsigned u = __builtin_bit_cast(unsigned, f); return (u + 0x7fffu + ((u >> 16) & 1u)) >> 16; }
__device__ __forceinline__ unsigned pk2(float lo, float hi) { return f2bf(lo) | (f2bf(hi) << 16); }
__device__ __forceinline__ float bflo(unsigned u) { return __uint_as_float(u << 16); }
__device__ __forceinline__ float bfhi(unsigned u) { return __uint_as_float(u & 0xffff0000u); }
__device__ __forceinline__ void unpack8_f8(v2u w, float (&f)[8]) {
    const auto a = __builtin_amdgcn_cvt_pk_f32_fp8((int)w.x, false), b = __builtin_amdgcn_cvt_pk_f32_fp8((int)w.x, true), c = __builtin_amdgcn_cvt_pk_f32_fp8((int)w.y, false), d = __builtin_amdgcn_cvt_pk_f32_fp8((int)w.y, true);
    f[0] = a[0]; f[1] = a[1]; f[2] = b[0]; f[3] = b[1]; f[4] = c[0]; f[5] = c[1]; f[6] = d[0]; f[7] = d[1];
}
__device__ __forceinline__ float wave_sum(float v) {
#define WS_DPP(x, ctl) __int_as_float(__builtin_amdgcn_update_dpp(0, __float_as_int(x), ctl, 0xf, 0xf, true))
    v += WS_DPP(v, 0xB1); v += WS_DPP(v, 0x4E); v += WS_DPP(v, 0x141); v += WS_DPP(v, 0x140);
#undef WS_DPP
    { auto rr = __builtin_amdgcn_permlane16_swap(__float_as_uint(v), __float_as_uint(v), false, false); v = __uint_as_float(rr[0]) + __uint_as_float(rr[1]); }
    { auto rr = __builtin_amdgcn_permlane32_swap(__float_as_uint(v), __float_as_uint(v), false, false); v = __uint_as_float(rr[0]) + __uint_as_float(rr[1]); }
    return v;
}
__device__ __forceinline__ float wave_max(float v) {
#pragma unroll
    for (int o = 1; o < 64; o <<= 1) v = fmaxf(v, __shfl_xor(v, o));
    return v;
}
#define WAVE_LDS_SYNC() do { asm volatile("s_waitcnt lgkmcnt(0)" ::: "memory"); __builtin_amdgcn_wave_barrier(); } while (0)

struct Args {
    const float* x; const float* g_mix; const float* w_in; const float* g_kv; const float* w_uk; const float* w_uv; const float* w_pool; const float* pool_scale;
    const float* w_o; const float* g_ffn; const float* w_up; const float* conv_w; const float* conv_b; const float* w_down; const float* g_final;
    float* out; unsigned char* ws; int ph_lo, ph_hi, li, pad;
};

typedef const void __attribute__((address_space(4)))* kargp_t;
template <int OFF> __device__ __forceinline__ void* karg_ptr(kargp_t kp) { __attribute__((address_space(1))) void* p; asm volatile("s_load_dwordx2 %0, %1, %2\n\ts_waitcnt lgkmcnt(0)" : "=s"(p) : "s"(kp), "i"(OFF)); return (void*)p; }
template <int OFF> __device__ __forceinline__ int karg_int(kargp_t kp) { int v; asm volatile("s_load_dword %0, %1, %2\n\ts_waitcnt lgkmcnt(0)" : "=s"(v) : "s"(kp), "i"(OFF)); return v; }
__device__ __forceinline__ Args load_args(kargp_t kp) {
    Args a;
    a.x = (const float*)karg_ptr<0>(kp); a.g_mix = (const float*)karg_ptr<8>(kp); a.w_in = (const float*)karg_ptr<16>(kp); a.g_kv = (const float*)karg_ptr<24>(kp);
    a.w_uk = (const float*)karg_ptr<32>(kp); a.w_uv = (const float*)karg_ptr<40>(kp); a.w_pool = (const float*)karg_ptr<48>(kp); a.pool_scale = (const float*)karg_ptr<56>(kp);
    a.w_o = (const float*)karg_ptr<64>(kp); a.g_ffn = (const float*)karg_ptr<72>(kp); a.w_up = (const float*)karg_ptr<80>(kp); a.conv_w = (const float*)karg_ptr<88>(kp);
    a.conv_b = (const float*)karg_ptr<96>(kp); a.w_down = (const float*)karg_ptr<104>(kp); a.g_final = (const float*)karg_ptr<112>(kp);
    a.out = (float*)karg_ptr<120>(kp); a.ws = (unsigned char*)karg_ptr<128>(kp); a.ph_lo = 0; a.ph_hi = 0; a.li = karg_int<144>(kp); a.pad = 0;
    return a;
}
static_assert(sizeof(Args) == 152, "Args layout (kernarg offsets above)");
__device__ __forceinline__ void tr_item(const float* __restrict__ W, int ldw, int k0, int srccol0, int valid, float colscale, const float* __restrict__ kscale,
                                        bf16* __restrict__ WT, int ldt, int nrow0, LAS float* scr, int lane) {
    const int jq = (lane & 7) * 4, kr = lane >> 3;
    f32x4 vv[8];
#pragma unroll
    for (int i = 0; i < 8; ++i) vv[i] = __builtin_nontemporal_load((const f32x4*)(W + (size_t)(k0 + 8 * i + kr) * ldw + srccol0 + jq));
#pragma unroll
    for (int i = 0; i < 8; ++i) { const int kk = 8 * i + kr; float ks = colscale; if (kscale) ks *= kscale[k0 + kk];
#pragma unroll
        for (int e = 0; e < 4; ++e) scr[kk * 33 + jq + e] = (jq + e < valid) ? vv[i][e] * ks : 0.f; }
    asm volatile("s_waitcnt lgkmcnt(0)" ::: "memory"); __builtin_amdgcn_wave_barrier();
    const int c = lane & 7;
#pragma unroll
    for (int jj = 0; jj < 4; ++jj) { const int n = (lane >> 3) + 8 * jj; const LAS float* s = scr + (8 * c) * 33 + n;
        v4u o; o.x = pk2(s[0 * 33], s[1 * 33]); o.y = pk2(s[2 * 33], s[3 * 33]); o.z = pk2(s[4 * 33], s[5 * 33]); o.w = pk2(s[6 * 33], s[7 * 33]);
        *(v4u*)(WT + (size_t)(nrow0 + n) * ldt + k0 + 8 * c) = o; }
    asm volatile("s_waitcnt lgkmcnt(0)" ::: "memory"); __builtin_amdgcn_wave_barrier();
}
__device__ __forceinline__ void tr_item_f8(const float* __restrict__ W, int ldw, int k0, int srccol0, float colscale, const float* __restrict__ kscale,
                                           unsigned char* __restrict__ WT8, int ldt, int nrow0, LAS float* scr, int lane) {
    const int jq = (lane & 7) * 4, kr = lane >> 3;
    f32x4 vv[8];
#pragma unroll
    for (int i = 0; i < 8; ++i) vv[i] = __builtin_nontemporal_load((const f32x4*)(W + (size_t)(k0 + 8 * i + kr) * ldw + srccol0 + jq));
#pragma unroll
    for (int i = 0; i < 8; ++i) { const int kk = 8 * i + kr; float ks = colscale; if (kscale) ks *= kscale[k0 + kk];
#pragma unroll
        for (int e = 0; e < 4; ++e) scr[kk * 33 + jq + e] = fminf(fmaxf(vv[i][e] * ks, -448.f), 448.f); }
    asm volatile("s_waitcnt lgkmcnt(0)" ::: "memory"); __builtin_amdgcn_wave_barrier();
    const int c = lane & 7;
#pragma unroll
    for (int jj = 0; jj < 4; ++jj) { const int n = (lane >> 3) + 8 * jj; const LAS float* s = scr + (8 * c) * 33 + n;
        v2u o; int t_;
        t_ = __builtin_amdgcn_cvt_pk_fp8_f32(s[0 * 33], s[1 * 33], 0, false); o.x = (unsigned)__builtin_amdgcn_cvt_pk_fp8_f32(s[2 * 33], s[3 * 33], t_, true);
        t_ = __builtin_amdgcn_cvt_pk_fp8_f32(s[4 * 33], s[5 * 33], 0, false); o.y = (unsigned)__builtin_amdgcn_cvt_pk_fp8_f32(s[6 * 33], s[7 * 33], t_, true);
        *(v2u*)(WT8 + (size_t)(nrow0 + n) * ldt + k0 + 8 * c) = o; }
    asm volatile("s_waitcnt lgkmcnt(0)" ::: "memory"); __builtin_amdgcn_wave_barrier();
}
__device__ __forceinline__ void ph_prologue(const Args& a, LAS unsigned char* lds, const int tid, int gtid, int gthreads, int gw, int ngw, int lane) {
    unsigned char* ws = a.ws;
    bf16* W1T = (bf16*)(ws + WS_W1T); bf16* W2T = (bf16*)(ws + WS_W2T); bf16* W3T = (bf16*)(ws + WS_W3T); bf16* W4T = (bf16*)(ws + WS_W4T);
    float* CONVP = (float*)(ws + WS_CONVP);
    LAS float* L0 = (LAS float*)lds;
    for (int it = blockIdx.x; it < 256; it += gridDim.x) {
        {
            const int g = it >> 6, n0 = ((it >> 1) & 31) * 32, ci0 = (it & 1) * 64;
            LAS float* Wp = L0; LAS float* Wo = L0 + 16384;
#pragma unroll
            for (int t = 0; t < 16; ++t) Wp[tid + 512 * t] = a.w_pool[g * 16384 + ci0 * 128 + tid + 512 * t];
#pragma unroll
            for (int t = 0; t < 8; ++t) { const int idx = tid + 512 * t, dd = idx >> 5; Wo[idx] = a.pool_scale[g * 128 + dd] * a.w_o[(size_t)(512 + g * 128 + dd) * DM + n0 + (idx & 31)]; }
            __syncthreads();
            const int nn = tid & 31, cg_ = tid >> 5; float acc[4];
#pragma unroll
            for (int j = 0; j < 4; ++j) acc[j] = 0.f;
            for (int dd = 0; dd < 128; ++dd) { const float wo = Wo[dd * 32 + nn];
#pragma unroll
                for (int j = 0; j < 4; ++j) acc[j] += Wp[(cg_ * 4 + j) * 128 + dd] * wo; }
#pragma unroll
            for (int j = 0; j < 4; ++j) acc[j] = fminf(fmaxf(acc[j] * 64.0f, -448.f), 448.f);
            const int t_ = __builtin_amdgcn_cvt_pk_fp8_f32(acc[0], acc[1], 0, false);
            *(unsigned*)((unsigned char*)W2T + (size_t)(n0 + nn) * K2 + 512 + g * 128 + ci0 + cg_ * 4) = (unsigned)__builtin_amdgcn_cvt_pk_fp8_f32(acc[2], acc[3], t_, true);
        }
        __syncthreads();
    }
    { bf16* WUKT = (bf16*)(ws + WS_WUKT); bf16* WUVT = (bf16*)(ws + WS_WUVT);
      for (int i = gtid; i < 8 * 128 * 64; i += gthreads) {
          { const int hd = i >> 13, c = (i >> 6) & 127, d = i & 63; WUKT[i] = (bf16)f2bf(a.w_uk[(hd * 64 + d) * 128 + c]); }
          { const int hd = i >> 13, d = (i >> 7) & 63, c = i & 127; WUVT[i] = (bf16)f2bf(a.w_uv[(hd * 128 + c) * 64 + d]); } } }
    LAS float* scr = (LAS float*)(lds + (tid >> 6) * 16384);
    constexpr int I1 = 56 * 16, I3 = 176 * 16, I4 = 32 * 44, I2 = 32 * 8;
    for (int it = gw; it < I1 + I3 + I4 + I2; it += ngw) {
        if (it >= I1 + I3 + I4) {
            const int i4 = it - (I1 + I3 + I4), nb = i4 >> 3, k0 = (i4 & 7) * 64;
            tr_item_f8(a.w_o, DM, k0, nb * 32, 64.f, nullptr, (unsigned char*)W2T, K2, nb * 32, scr, lane);
        } else if (it < I1) {
            const int nb = it >> 4, k0 = (it & 15) * 64, n0 = nb * 32; int sc0, valid = 32; float cs = 1.f;
            if (n0 < 512) sc0 = n0; else if (n0 < 1024) sc0 = 640 + (n0 - 512); else if (n0 < 1536) sc0 = 1224 + (n0 - 1024); else if (n0 < 1664) sc0 = 512 + (n0 - 1536); else if (n0 < 1728) sc0 = 1152 + (n0 - 1664);
            else if (n0 == 1728) { sc0 = 1216; valid = 8; cs = WI_SCALE; } else { sc0 = 0; valid = 0; }
            tr_item(a.w_in, IN_COLS, k0, sc0, valid, cs, nullptr, W1T, DM, n0, scr, lane);
        } else if (it < I1 + I3) {
            const int i2 = it - I1, nb = i2 >> 4, k0 = (i2 & 15) * 64, r0 = nb * 32, j = r0 >> 8, ii = r0 & 255;
            const int sc0 = (ii < 128) ? (128 * j + ii) : (FF + 128 * j + (ii - 128));
            tr_item_f8(a.w_up, N3, k0, sc0, 64.f, a.g_ffn, (unsigned char*)W3T, DM, r0, scr, lane);
        } else {
            const int i3 = it - I1 - I3, nb = i3 / 44, k0 = (i3 - nb * 44) * 64;
            tr_item_f8(a.w_down, DM, k0, nb * 32, 64.f, nullptr, (unsigned char*)W4T, FF, nb * 32, scr, lane);
        }
    }
    if (gtid < 32) {
        float* ZT = (float*)(ws + WS_ZT); const float nn = 64.0f * (float)(gtid + 1); float z = 0.f;
        if (nn > 256.f) { const float p = 256.0f / nn, pt = (p < 0.5f) ? p : 1.0f - p, t = sqrtf(-2.0f * logf(pt));
            const float zz = t - (2.515517f + t * (0.802853f + t * 0.010328f)) / (1.0f + t * (1.432788f + t * (0.189269f + t * 0.001308f))); z = (p < 0.5f) ? zz : -zz; }
        ZT[gtid] = z; ZT[32 + gtid] = nn * 0.3989423f * expf(-0.5f * z * z);
    }
    for (int r = gtid; r < N3; r += gthreads) {
        const int j = r >> 8, ii = r & 255; const int col = (ii < 128) ? (128 * j + ii) : (FF + 128 * j + (ii - 128));
        CONVP[r] = a.conv_w[col]; CONVP[N3 + r] = a.conv_w[N3 + col]; CONVP[2 * N3 + r] = a.conv_w[2 * N3 + col]; CONVP[3 * N3 + r] = a.conv_b[col];
    }
    bf16* HB = (bf16*)(ws + WS_HB);
    for (int m0 = gw; m0 < NTOK; m0 += 4 * ngw) {
        f32x4 v[4][4]; float s[4];
#pragma unroll
        for (int r = 0; r < 4; ++r) { const f32x4* xr = (const f32x4*)(a.x + (size_t)(m0 + r * ngw) * DM) + lane;
#pragma unroll
            for (int j = 0; j < 4; ++j) v[r][j] = __builtin_nontemporal_load(xr + 64 * j); }
        f32x4 g[4];
#pragma unroll
        for (int j = 0; j < 4; ++j) g[j] = ((const f32x4*)a.g_mix)[lane + 64 * j];
#pragma unroll
        for (int r = 0; r < 4; ++r) { s[r] = 0.f;
#pragma unroll
            for (int j = 0; j < 4; ++j) s[r] += (v[r][j].x * v[r][j].x + v[r][j].y * v[r][j].y) + (v[r][j].z * v[r][j].z + v[r][j].w * v[r][j].w); }
#pragma unroll
        for (int r = 0; r < 4; ++r) {
            const float rs_ = sqrtf(wave_sum(s[r]) * (1.0f / DM) + EPS), rinv = 1.0f / rs_;
            if (lane == 0) ((float*)(ws + WS_RS))[m0 + r * ngw] = rs_;
            unsigned long long* o8 = (unsigned long long*)(HB + (size_t)(m0 + r * ngw) * DM) + lane;
#pragma unroll
            for (int j = 0; j < 4; ++j)
                o8[64 * j] = (unsigned long long)pk2(v[r][j].x * rinv * g[j].x, v[r][j].y * rinv * g[j].y) | ((unsigned long long)pk2(v[r][j].z * rinv * g[j].z, v[r][j].w * rinv * g[j].w) << 32);
        }
    }
}

__device__ __forceinline__ void ph_cnorm_pool(const Args& a, int gw, int ngw, int lane) {
    const bf16* P1 = (const bf16*)(a.ws + WS_P1); unsigned char* CN = a.ws + WS_CN; unsigned char* MIX = a.ws + WS_MIX;
    unsigned char* CT8 = a.ws + WS_CT8; const unsigned char* U8 = a.ws + WS_U8;
    const float gk0 = a.g_kv[2 * lane], gk1 = a.g_kv[2 * lane + 1];
    const int win = 2 << (lane >> 4);
    for (int run = gw; run < NTOK / 32; run += ngw) {
        const int tok0 = run * 32, pos0 = tok0 & (SEQ - 1);
        const unsigned char* ub = U8 + (size_t)tok0 * 512 + 8 * lane;
        float s[8];
#pragma unroll
        for (int j = 0; j < 8; ++j) s[j] = 0.f;
#pragma unroll
        for (int j = 1; j < 16; ++j) {
            if (j < win && pos0 - j >= 0) { float f_[8]; unpack8_f8(*(const v2u*)(ub - (size_t)j * 512), f_);
#pragma unroll
                for (int e = 0; e < 8; ++e) s[e] += f_[e]; }
        }
#pragma unroll 1
        for (int tb = 0; tb < 32; tb += 8) {
        v2u ub_[8], udb_[8]; unsigned cwb_[8]; float cn0_[8], cn1_[8];
#pragma unroll
        for (int t8 = 0; t8 < 8; ++t8) {
            const bf16* prow = P1 + (size_t)(tok0 + tb + t8) * N1;
            ub_[t8] = *(const v2u*)(ub + (size_t)(tb + t8) * 512);
            cwb_[t8] = *(const unsigned*)(prow + OFF_C + 2 * lane);
            udb_[t8] = (v2u){0u, 0u};
            if (pos0 + tb + t8 - win + 1 >= 0) udb_[t8] = *(const v2u*)(ub + (size_t)(tb + t8) * 512 - (size_t)(win - 1) * 512);
        }
#pragma unroll
        for (int t8 = 0; t8 < 8; ++t8) {
            const int t = tb + t8;
            const int tok = tok0 + t, pos = pos0 + t;
            const v2u u = ub_[t8];
            const unsigned cw = cwb_[t8];
            const v2u ud = udb_[t8];
            const bool drop = (pos - win + 1 >= 0);
            const float c0 = bflo(cw), c1 = bfhi(cw);
            const float rinv = 1.0f / sqrtf(wave_sum(c0 * c0 + c1 * c1) * (1.0f / 128.0f) + EPS);
            cn0_[t8] = c0 * rinv * gk0; cn1_[t8] = c1 * rinv * gk1;
            *(unsigned short*)(CN + (size_t)tok * 128 + 2 * lane) = (unsigned short)__builtin_amdgcn_cvt_pk_fp8_f32(fminf(fmaxf(cn0_[t8] * 16.0f, -448.f), 448.f), fminf(fmaxf(cn1_[t8] * 16.0f, -448.f), 448.f), 0, false);
            float uf[8]; unpack8_f8(u, uf);
#pragma unroll
            for (int j = 0; j < 8; ++j) s[j] += uf[j];
            const int cnt = (pos + 1 < win) ? pos + 1 : win; const float ic = 1.0f / (float)cnt;
            float pv_[8];
#pragma unroll
            for (int j = 0; j < 8; ++j) pv_[j] = fminf(fmaxf(s[j] * ic - uf[j], -448.f), 448.f);
            v2u o; int t_;
            t_ = __builtin_amdgcn_cvt_pk_fp8_f32(pv_[0], pv_[1], 0, false); o.x = (unsigned)__builtin_amdgcn_cvt_pk_fp8_f32(pv_[2], pv_[3], t_, true);
            t_ = __builtin_amdgcn_cvt_pk_fp8_f32(pv_[4], pv_[5], 0, false); o.y = (unsigned)__builtin_amdgcn_cvt_pk_fp8_f32(pv_[6], pv_[7], t_, true);
            *(v2u*)(MIX + (size_t)tok * K2 + 512 + 8 * lane) = o;
            if (drop) { float fd_[8]; unpack8_f8(ud, fd_);
#pragma unroll
                for (int e = 0; e < 8; ++e) s[e] -= fd_[e]; }
        }
        {
            unsigned char* ctp = CT8 + ((size_t)(tok0 >> 6) * 128 + 2 * lane) * 64 + 16 * ((pos0 >> 5) & 1) + (tb >> 1);
#pragma unroll
            for (int hh = 0; hh < 2; ++hh) {
                float q0[4], q1[4];
#pragma unroll
                for (int e = 0; e < 4; ++e) { q0[e] = fminf(fmaxf(cn0_[4 * hh + e] * 16.0f, -448.f), 448.f); q1[e] = fminf(fmaxf(cn1_[4 * hh + e] * 16.0f, -448.f), 448.f); }
                int t_ = __builtin_amdgcn_cvt_pk_fp8_f32(q0[0], q0[1], 0, false); *(unsigned*)(ctp + 32 * hh) = (unsigned)__builtin_amdgcn_cvt_pk_fp8_f32(q0[2], q0[3], t_, true);
                t_ = __builtin_amdgcn_cvt_pk_fp8_f32(q1[0], q1[1], 0, false); *(unsigned*)(ctp + 64 + 32 * hh) = (unsigned)__builtin_amdgcn_cvt_pk_fp8_f32(q1[2], q1[3], t_, true);
            }
        }
        }
    }
}

namespace dsa {
using bf16x8 = __attribute__((ext_vector_type(8))) short;
using s16x4  = __attribute__((ext_vector_type(4))) short;
using f32x16 = __attribute__((ext_vector_type(16))) float;
using u32x4  = __attribute__((ext_vector_type(4))) unsigned;
constexpr int NW = 8, KVBLK = 64;
constexpr float SCALE = 0.125f, LOG2E = 1.4426950408889634f, THR = 4.f, PSH = 3.f;
typedef int v8i __attribute__((ext_vector_type(8)));
typedef int v4i __attribute__((ext_vector_type(4)));
constexpr int SHM_V = KVBLK * 128 * 2, SHM_K = KVBLK * 128 * 2, SHM_ATTN = 2 * SHM_V + 2 * SHM_K + NW * 64 * 4;
constexpr unsigned NEG2 = 0xCAEACAEAu;
#define KSWZ(row, colB) ((row) * 256 + ((colB) ^ (((row) & 7) << 4)))
#define SBAR() __builtin_amdgcn_sched_barrier(0)
__device__ __forceinline__ int crow(int r, int hi) { return (r & 3) + 8 * (r >> 2) + 4 * hi; }
__device__ __forceinline__ unsigned cvtpk(float lo, float hi) { unsigned r; asm volatile("v_cvt_pk_bf16_f32 %0, %1, %2" : "=v"(r) : "v"(lo), "v"(hi)); return r; }
typedef float f32x2_t __attribute__((ext_vector_type(2))); typedef __bf16 bf16x2_t __attribute__((ext_vector_type(2)));
__device__ __forceinline__ unsigned cvtpk_s(float lo, float hi) { f32x2_t v = {lo, hi}; bf16x2_t b = __builtin_convertvector(v, bf16x2_t); return __builtin_bit_cast(unsigned, b); }

template <int CTRL> __device__ __forceinline__ unsigned dppu(unsigned x) { return (unsigned)__builtin_amdgcn_update_dpp(0, (int)x, CTRL, 0xf, 0xf, true); }
__device__ __forceinline__ unsigned half_sum(unsigned x, int) {
    x += dppu<0xB1>(x); x += dppu<0x4E>(x); x += dppu<0x141>(x); x += dppu<0x140>(x);
    auto rr = __builtin_amdgcn_permlane16_swap(x, x, false, false); return rr[0] + rr[1];
}
__device__ __forceinline__ unsigned half_min(unsigned x, int) {
    x = min(x, dppu<0xB1>(x)); x = min(x, dppu<0x4E>(x)); x = min(x, dppu<0x141>(x)); x = min(x, dppu<0x140>(x));
    auto rr = __builtin_amdgcn_permlane16_swap(x, x, false, false); return min(rr[0], rr[1]);
}
__device__ __forceinline__ unsigned half_max(unsigned x, int) {
    x = max(x, dppu<0xB1>(x)); x = max(x, dppu<0x4E>(x)); x = max(x, dppu<0x141>(x)); x = max(x, dppu<0x140>(x));
    auto rr = __builtin_amdgcn_permlane16_swap(x, x, false, false); return max(rr[0], rr[1]);
}

template <int CTRL> __device__ __forceinline__ float dppf(float x) { return __int_as_float(__builtin_amdgcn_update_dpp(0, __float_as_int(x), CTRL, 0xf, 0xf, true)); }
__device__ __forceinline__ float half_minf(float x, int) {
    x = fminf(x, dppf<0xB1>(x)); x = fminf(x, dppf<0x4E>(x)); x = fminf(x, dppf<0x141>(x)); x = fminf(x, dppf<0x140>(x));
    auto rr = __builtin_amdgcn_permlane16_swap(__float_as_uint(x), __float_as_uint(x), false, false); return fminf(__uint_as_float(rr[0]), __uint_as_float(rr[1]));
}
__device__ __forceinline__ float half_maxf(float x, int) {
    x = fmaxf(x, dppf<0xB1>(x)); x = fmaxf(x, dppf<0x4E>(x)); x = fmaxf(x, dppf<0x141>(x)); x = fmaxf(x, dppf<0x140>(x));
    auto rr = __builtin_amdgcn_permlane16_swap(__float_as_uint(x), __float_as_uint(x), false, false); return fmaxf(__uint_as_float(rr[0]), __uint_as_float(rr[1]));
}
__device__ __forceinline__ float half_sumf(float x, int) {
    x += dppf<0xB1>(x); x += dppf<0x4E>(x); x += dppf<0x141>(x); x += dppf<0x140>(x);
    auto rr = __builtin_amdgcn_permlane16_swap(__float_as_uint(x), __float_as_uint(x), false, false); return __uint_as_float(rr[0]) + __uint_as_float(rr[1]);
}
__device__ __forceinline__ unsigned f2key(float f) { const unsigned u = __float_as_uint(f); return (u & 0x80000000u) ? ~u : (u | 0x80000000u); }
__device__ __forceinline__ float key2f(unsigned k) { return __uint_as_float((k & 0x80000000u) ? (k & 0x7fffffffu) : ~k); }

template <int PROBE> __device__ __forceinline__ void idx_select(const bf16* __restrict__ P1, int b, int tokw, int n, int tid_in, LAS char* lds, const float* __restrict__ ZT, unsigned& W0lo, unsigned& W0hi, unsigned& W1lo, unsigned& W1hi) {
    if (n <= 256) { W0lo = W0hi = W1lo = W1hi = 0xffffffffu; return; }
    int tid = tid_in; asm volatile("" : "+v"(tid));
    const int lane = tid & 63, wid = __builtin_amdgcn_readfirstlane(tid >> 6), c = lane & 31, h = lane >> 5;
    const int nt = n >> 5, nch = (n + 255) >> 8;
    const bf16* kb = P1 + (size_t)b * SEQ * N1 + OFF_KI;
    unsigned dsrc[4];
#pragma unroll
    for (int ii = 0; ii < 4; ++ii) { const int q = wid * 4 + ii, keyl = q * 8 + (lane >> 3), pc = lane & 7; dsrc[ii] = (unsigned)(keyl * N1 + ((pc ^ ((keyl >> 1) & 7)) << 3)); }
#define KI_DMA(cc) do { _Pragma("unroll") for (int ii = 0; ii < 4; ++ii) { const int q_ = wid * 4 + ii; if (256 * (cc) + 8 * q_ < n) \
        __builtin_amdgcn_global_load_lds((const unsigned*)(kb + (size_t)(256 * (cc)) * N1 + dsrc[ii]), (LAS unsigned*)(lds + ((cc) & 1) * 32768 + q_ * 1024), 16, 0, 0); } } while (0)
    KI_DMA(0);
    const int qa = 2 * ((c >> 2) & 1) + (c >> 4), ih = (c & 3) + 4 * ((c >> 3) & 1);
    const bf16* qip = P1 + (size_t)(tokw + qa) * N1 + OFF_QI + ih * 64 + 8 * h;
    bf16x8 af[4];
#pragma unroll
    for (int s = 0; s < 4; ++s) af[s] = *(const bf16x8*)(qip + 16 * s);
    float wq0[8], wq1[8];
    { const u32x4 t = *(const u32x4*)(P1 + (size_t)(tokw + 2 * h) * N1 + OFF_WI), u = *(const u32x4*)(P1 + (size_t)(tokw + 2 * h + 1) * N1 + OFF_WI);
      wq0[0] = bflo(t.x); wq0[1] = bfhi(t.x); wq0[2] = bflo(t.y); wq0[3] = bfhi(t.y); wq0[4] = bflo(t.z); wq0[5] = bfhi(t.z); wq0[6] = bflo(t.w); wq0[7] = bfhi(t.w);
      wq1[0] = bflo(u.x); wq1[1] = bfhi(u.x); wq1[2] = bflo(u.y); wq1[3] = bfhi(u.y); wq1[4] = bflo(u.z); wq1[5] = bfhi(u.z); wq1[6] = bflo(u.w); wq1[7] = bfhi(u.w); }
    const int rdoff = c * 128, rsw = (c >> 1) & 7;
    float sc0[64], sc1[64];
    float mn0 = __builtin_inff(), mx0 = -__builtin_inff(), mn1 = __builtin_inff(), mx1 = -__builtin_inff();
    float sm0 = 0.f, sq0 = 0.f, sm1 = 0.f, sq1 = 0.f;
#pragma unroll
    for (int cc = 0; cc < 8; ++cc) {
        if (cc < nch) {
            __syncthreads();
            if (cc + 1 < nch) KI_DMA(cc + 1);
            const LAS char* cb = lds + (cc & 1) * 32768 + rdoff;
#pragma unroll
            for (int t = 0; t < 8; ++t) {
                const int i = cc * 8 + t;
                if (i < nt) {
                    f32x16 acc = {};
#pragma unroll
                    for (int s = 0; s < 4; ++s) { const bf16x8 kf = *(const LAS bf16x8*)(cb + t * 4096 + (((2 * s + h) ^ rsw) << 4));
                        acc = __builtin_amdgcn_mfma_f32_32x32x16_bf16(af[s], kf, acc, 0, 0, 0); }
                    float s0 = 0.f, s1 = 0.f;
#pragma unroll
                    for (int j = 0; j < 8; ++j) {
                        s0 = fmaf(wq0[j], __int_as_float(max(__float_as_int(acc[j]), 0)), s0); s1 = fmaf(wq1[j], __int_as_float(max(__float_as_int(acc[8 + j]), 0)), s1); }
                    sc0[i] = s0; sc1[i] = s1; mn0 = fminf(mn0, s0); mx0 = fmaxf(mx0, s0); mn1 = fminf(mn1, s1); mx1 = fmaxf(mx1, s1);
                    sm0 += s0; sq0 = fmaf(s0, s0, sq0); sm1 += s1; sq1 = fmaf(s1, s1, sq1);
                } else { sc0[i] = -__builtin_inff(); sc1[i] = -__builtin_inff(); }
            }
        } else {
#pragma unroll
            for (int t = 0; t < 8; ++t) { sc0[cc * 8 + t] = -__builtin_inff(); sc1[cc * 8 + t] = -__builtin_inff(); }
        }
    }
#undef KI_DMA
    __syncthreads();
    unsigned klo0 = f2key(half_minf(mn0, h)), khi0 = f2key(half_maxf(mx0, h)) + 1u, klo1 = f2key(half_minf(mn1, h)), khi1 = f2key(half_maxf(mx1, h)) + 1u;
    unsigned cl0 = (unsigned)n, cl1 = (unsigned)n, ch0 = 0u, ch1 = 0u;
    bool fin0 = (khi0 - klo0 <= 1u), fin1 = (khi1 - klo1 <= 1u);
    const float rn = 1.0f / (float)n;
    const float mu0 = half_sumf(sm0, h) * rn, mu1 = half_sumf(sm1, h) * rn;
    const float sd0 = sqrtf(fmaxf(half_sumf(sq0, h) * rn - mu0 * mu0, 1e-30f)), sd1 = sqrtf(fmaxf(half_sumf(sq1, h) * rn - mu1 * mu1, 1e-30f));
    const float zq = ZT[(n >> 6) - 1], rdphi = __builtin_amdgcn_rcpf(ZT[32 + (n >> 6) - 1]);
    bool np0 = false, np1 = false;
    for (int it = 0; it < (PROBE == 3 ? 0 : 96); ++it) {
        unsigned km0, km1;
        if (it < 48) {
            const float lo0f = key2f(klo0), hi0f = key2f(khi0), lo1f = key2f(klo1), hi1f = key2f(khi1);
            float f0 = 0.5f, f1 = 0.5f;
            if (!(it & 1)) { f0 = ((float)cl0 - 255.5f) * __builtin_amdgcn_rcpf((float)(cl0 - ch0)); f1 = ((float)cl1 - 255.5f) * __builtin_amdgcn_rcpf((float)(cl1 - ch1)); }
            float m0 = fmaf(hi0f - lo0f, f0, lo0f), m1 = fmaf(hi1f - lo1f, f1, lo1f);
            if (it == 0) { m0 = fmaf(zq, sd0, mu0); m1 = fmaf(zq, sd1, mu1); }
            else if (it == 1) {
                m0 = (cl0 != (unsigned)n) ? lo0f + (1.5f * ((float)cl0 - 255.5f) + 4.0f) * sd0 * rdphi : hi0f - (1.5f * (255.5f - (float)ch0) + 4.0f) * sd0 * rdphi;
                m1 = (cl1 != (unsigned)n) ? lo1f + (1.5f * ((float)cl1 - 255.5f) + 4.0f) * sd1 * rdphi : hi1f - (1.5f * (255.5f - (float)ch1) + 4.0f) * sd1 * rdphi;
            }
            km0 = f2key(m0 + 0.0f); km1 = f2key(m1 + 0.0f);
            if (!(m0 == m0)) km0 = klo0 + ((khi0 - klo0) >> 1);
            if (!(m1 == m1)) km1 = klo1 + ((khi1 - klo1) >> 1);
        } else { km0 = klo0 + ((khi0 - klo0) >> 1); km1 = klo1 + ((khi1 - klo1) >> 1); }
        constexpr unsigned EG = 3u;
        const unsigned rb0 = 256u - ch0, ra0 = cl0 - 256u, rb1 = 256u - ch1, ra1 = cl1 - 256u;
        const bool sp0 = !fin0 && ((rb0 <= EG && rb0 <= ra0) || np0), sp1 = !fin1 && ((rb1 <= EG && rb1 <= ra1) || np1);
        const bool sa0 = !fin0 && !sp0 && ra0 <= EG, sa1 = !fin1 && !sp1 && ra1 <= EG;
        if (__any(sp0 || sp1)) {
            const float hf0 = key2f(khi0), hf1 = key2f(khi1); float b0 = -__builtin_inff(), b1 = -__builtin_inff();
#pragma unroll
            for (int g = 0; g < 8; ++g) {
                if (g * 8 < nt) {
#pragma unroll
                    for (int i = g * 8; i < g * 8 + 8; ++i) { b0 = fmaxf(b0, (sc0[i] < hf0) ? sc0[i] : -__builtin_inff()); b1 = fmaxf(b1, (sc1[i] < hf1) ? sc1[i] : -__builtin_inff()); }
                }
            }
            b0 = half_maxf(b0, h); b1 = half_maxf(b1, h);
            if (sp0) km0 = f2key(b0); if (sp1) km1 = f2key(b1);
        }
        if (__any(sa0 || sa1)) {
            const float lf0 = key2f(klo0), lf1 = key2f(klo1); float a0 = __builtin_inff(), a1 = __builtin_inff();
#pragma unroll
            for (int g = 0; g < 8; ++g) {
                if (g * 8 < nt) {
#pragma unroll
                    for (int i = g * 8; i < g * 8 + 8; ++i) { a0 = fminf(a0, (sc0[i] >= lf0) ? sc0[i] : __builtin_inff()); a1 = fminf(a1, (sc1[i] >= lf1) ? sc1[i] : __builtin_inff()); }
                }
            }
            a0 = half_minf(a0, h); a1 = half_minf(a1, h);
            if (sa0) km0 = f2key(a0) + 1u; if (sa1) km1 = f2key(a1) + 1u;
        }
        km0 = min(max(km0, klo0 + 1u), khi0 - 1u); km1 = min(max(km1, klo1 + 1u), khi1 - 1u);
        const float t0 = key2f(km0), t1 = key2f(km1);
        unsigned c0 = 0u, c1 = 0u, c0b = 0u, c1b = 0u;
#pragma unroll
        for (int g = 0; g < 8; ++g) {
            if (g * 8 < nt) {
#pragma unroll
                for (int i = g * 8; i < g * 8 + 8; i += 2)
                    asm volatile("v_cmp_ge_f32_e64 s[36:37], %4, %8\n\tv_cmp_ge_f32_e64 s[38:39], %5, %9\n\tv_cmp_ge_f32_e64 s[40:41], %6, %8\n\tv_cmp_ge_f32_e64 s[42:43], %7, %9\n\t"
                                 "v_addc_co_u32_e64 %0, vcc, 0, %0, s[36:37]\n\tv_addc_co_u32_e64 %1, vcc, 0, %1, s[38:39]\n\tv_addc_co_u32_e64 %2, vcc, 0, %2, s[40:41]\n\tv_addc_co_u32_e64 %3, vcc, 0, %3, s[42:43]"
                                 : "+v"(c0), "+v"(c1), "+v"(c0b), "+v"(c1b) : "v"(sc0[i]), "v"(sc1[i]), "v"(sc0[i + 1]), "v"(sc1[i + 1]), "v"(t0), "v"(t1) : "vcc", "s36", "s37", "s38", "s39", "s40", "s41", "s42", "s43");
            }
        }
        { const unsigned cs = half_sum((c0 + c0b) | ((c1 + c1b) << 16), h); c0 = cs & 0xffffu; c1 = cs >> 16; }
        if (!fin0) { np0 = (it >= 2) && (c0 == cl0 || c0 == ch0);
            if (c0 >= 256u) { klo0 = km0; cl0 = c0; if (sp0) khi0 = km0 + 1u; } else { khi0 = km0; ch0 = c0; if (sa0) klo0 = km0 - 1u; } fin0 = (c0 == 256u) || (khi0 - klo0 <= 1u); }
        if (!fin1) { np1 = (it >= 2) && (c1 == cl1 || c1 == ch1);
            if (c1 >= 256u) { klo1 = km1; cl1 = c1; if (sp1) khi1 = km1 + 1u; } else { khi1 = km1; ch1 = c1; if (sa1) klo1 = km1 - 1u; } fin1 = (c1 == 256u) || (khi1 - klo1 <= 1u); }
        if (__all(fin0 && fin1)) break;
    }
    const float lo0 = key2f(klo0), lo1 = key2f(klo1);
    unsigned w0l = 0u, w0h = 0u, w1l = 0u, w1h = 0u;
#define BITOF(cond) ({ unsigned t__ = (cond) ? 1u : 0u; asm volatile("" : "+v"(t__)); t__; })
    if (__all(cl0 == 256u && cl1 == 256u)) {
#pragma unroll
        for (int g = 0; g < 8; ++g) {
            if (g * 8 < nt) {
#pragma unroll
                for (int i = g * 8; i < g * 8 + 8; ++i) {
                    if (i < 32) { w0l |= BITOF(sc0[i] >= lo0) << i; w1l |= BITOF(sc1[i] >= lo1) << i; } else { w0h |= BITOF(sc0[i] >= lo0) << (i - 32); w1h |= BITOF(sc1[i] >= lo1) << (i - 32); }
                }
            }
        }
    } else {
        unsigned g0 = 0u, g1 = 0u;
#pragma unroll
        for (int i = 0; i < 64; ++i) { g0 += (sc0[i] > lo0) ? 1u : 0u; g1 += (sc1[i] > lo1) ? 1u : 0u; }
        g0 = half_sum(g0, h); g1 = half_sum(g1, h);
        const unsigned need0 = 256u - g0, need1 = 256u - g1, ltm = (1u << c) - 1u;
        unsigned run0 = 0u, run1 = 0u;
#pragma unroll
        for (int i = 0; i < 64; ++i) {
            const bool e0 = (sc0[i] == lo0), e1 = (sc1[i] == lo1);
            const unsigned long long m0 = __ballot(e0), m1 = __ballot(e1);
            const unsigned hb0 = h ? (unsigned)(m0 >> 32) : (unsigned)m0, hb1 = h ? (unsigned)(m1 >> 32) : (unsigned)m1;
            const bool s0 = (sc0[i] > lo0) || (e0 && (run0 + __popc(hb0 & ltm) < need0));
            const bool s1 = (sc1[i] > lo1) || (e1 && (run1 + __popc(hb1 & ltm) < need1));
            run0 += __popc(hb0); run1 += __popc(hb1);
            if (i < 32) { w0l |= BITOF(s0) << i; w1l |= BITOF(s1) << i; } else { w0h |= BITOF(s0) << (i - 32); w1h |= BITOF(s1) << (i - 32); }
        }
    }
#undef BITOF
    W0lo = w0l; W0hi = w0h; W1lo = w1l; W1hi = w1h;
}

__device__ __forceinline__ void partialSM(f32x16& p0, f32x16& p1, float b0, float& m_reg, float& mn, float& alpha) {
    constexpr float C = SCALE * LOG2E * (1.0f / 256.0f);
    float pmax = p0[0];
#pragma unroll
    for (int r = 1; r < 16; ++r) pmax = fmaxf(pmax, p0[r]);
#pragma unroll
    for (int r = 0; r < 16; ++r) pmax = fmaxf(pmax, p1[r]);
    { auto rr = __builtin_amdgcn_permlane32_swap(__float_as_uint(pmax), __float_as_uint(pmax), false, false);
      pmax = fmaxf(__uint_as_float(rr[0]), __uint_as_float(rr[1])); }
    const float pm = fmaf(pmax, C, b0);
    if (__builtin_expect(__all(pm - m_reg <= THR * LOG2E), 1)) { mn = m_reg; alpha = 1.f; }
    else { mn = fmaxf(m_reg, pm); alpha = __builtin_amdgcn_exp2f(m_reg - mn); m_reg = mn; }
    const float off = b0 - mn + PSH;
#pragma unroll
    for (int r = 0; r < 16; ++r) p0[r] = fmaf(p0[r], C, off);
#pragma unroll
    for (int r = 0; r < 16; ++r) p1[r] = fmaf(p1[r], C, off);
#pragma unroll
    for (int r = 0; r < 16; ++r) p0[r] = __builtin_amdgcn_exp2f(p0[r]);
}
__device__ __forceinline__ void finishSM(f32x16& p0, f32x16& p1, float alpha, float& l_reg, v8i& P8) {
#pragma unroll
    for (int r = 0; r < 16; ++r) p1[r] = __builtin_amdgcn_exp2f(p1[r]);
    float ps = 0;
#pragma unroll
    for (int r = 0; r < 16; ++r) ps += p0[r];
#pragma unroll
    for (int r = 0; r < 16; ++r) ps += p1[r];
    { auto rr = __builtin_amdgcn_permlane32_swap(__float_as_uint(ps), __float_as_uint(ps), false, false);
      ps = __uint_as_float(rr[0]) + __uint_as_float(rr[1]); }
    l_reg = l_reg * alpha + ps;
#pragma unroll
    for (int g = 0; g < 4; ++g) { const int t_ = __builtin_amdgcn_cvt_pk_fp8_f32(p0[4 * g], p0[4 * g + 1], __float_as_int(p0[4 * g]), false); P8[g] = __builtin_amdgcn_cvt_pk_fp8_f32(p0[4 * g + 2], p0[4 * g + 3], t_, true); }
#pragma unroll
    for (int g = 0; g < 4; ++g) { const int t_ = __builtin_amdgcn_cvt_pk_fp8_f32(p1[4 * g], p1[4 * g + 1], __float_as_int(p1[4 * g]), false); P8[4 + g] = __builtin_amdgcn_cvt_pk_fp8_f32(p1[4 * g + 2], p1[4 * g + 3], t_, true); }
}
__device__ __forceinline__ void qkt(f32x16& p0, f32x16& p1, const LAS char* Ks, const v8i* qr8, bf16x8 ax0, bf16x8 ax1, bf16x8 ef, int r32, int hi) {
    const LAS char* kr = Ks + r32 * 128; const int sw = (r32 >> 1) & 7;
    v8i kf[2][2];
#pragma unroll
    for (int kb = 0; kb < 2; ++kb)
#pragma unroll
        for (int sx = 0; sx < 2; ++sx) { const int pc = 4 * sx + 2 * hi;
            const v4i lo = *(const LAS v4i*)(kr + kb * 4096 + ((pc ^ sw) << 4)), hi_ = *(const LAS v4i*)(kr + kb * 4096 + (((pc + 1) ^ sw) << 4));
            kf[kb][sx] = __builtin_shufflevector(lo, hi_, 0, 1, 2, 3, 4, 5, 6, 7); }
    const int one = 0x7f7f7f7f;
#if defined(__HIP_DEVICE_COMPILE__)
    asm volatile("s_nop 1\n\tv_mfma_f32_32x32x16_bf16 %0, %1, %2, 0" : "=&v"(p0) : "v"(ax0), "v"(ef));
    asm volatile("s_nop 1\n\tv_mfma_f32_32x32x16_bf16 %0, %1, %2, 0" : "=&v"(p1) : "v"(ax1), "v"(ef));
    asm volatile("s_nop 1\n\tv_mfma_scale_f32_32x32x64_f8f6f4 %0, %1, %2, %0, %3, %3 op_sel_hi:[0,0,0]" : "+v"(p0) : "v"(kf[0][0]), "v"(qr8[0]), "v"(one));
    asm volatile("s_nop 1\n\tv_mfma_scale_f32_32x32x64_f8f6f4 %0, %1, %2, %0, %3, %3 op_sel_hi:[0,0,0]" : "+v"(p1) : "v"(kf[1][0]), "v"(qr8[0]), "v"(one));
    asm volatile("s_nop 1\n\tv_mfma_scale_f32_32x32x64_f8f6f4 %0, %1, %2, %0, %3, %3 op_sel_hi:[0,0,0]" : "+v"(p0) : "v"(kf[0][1]), "v"(qr8[1]), "v"(one));
    asm volatile("s_nop 1\n\tv_mfma_scale_f32_32x32x64_f8f6f4 %0, %1, %2, %0, %3, %3 op_sel_hi:[0,0,0]\n\ts_nop 3" : "+v"(p1) : "v"(kf[1][1]), "v"(qr8[1]), "v"(one));
    asm volatile("" :: "v"(kf[0][0]), "v"(kf[1][0]), "v"(kf[0][1]), "v"(kf[1][1]), "v"(ax0), "v"(ax1), "v"(ef), "v"(one));
#else
    (void)one; (void)ax0; (void)ax1; (void)ef; (void)kf; (void)qr8; p0 = f32x16{}; p1 = f32x16{};
#endif
}
constexpr int VT_PITCH = 80;
__device__ __forceinline__ void pv_d0(f32x16* o, const LAS char* vb, const v8i P8) {
    v8i bf[4];
#pragma unroll
    for (int d0 = 0; d0 < 4; ++d0) { const v4i lo = *(const LAS v4i*)(vb + d0 * 32 * VT_PITCH), hi_ = *(const LAS v4i*)(vb + d0 * 32 * VT_PITCH + 16); bf[d0] = __builtin_shufflevector(lo, hi_, 0, 1, 2, 3, 4, 5, 6, 7); }
    const int one = 0x7f7f7f7f;
#pragma unroll
    for (int d0 = 0; d0 < 4; ++d0) {
#if defined(__HIP_DEVICE_COMPILE__)
        asm volatile("s_nop 1\n\tv_mfma_scale_f32_32x32x64_f8f6f4 %0, %1, %2, %0, %3, %3 op_sel_hi:[0,0,0]" : "+v"(o[d0]) : "v"(P8), "v"(bf[d0]), "v"(one));
#else
        (void)one;
#endif
    }
#if defined(__HIP_DEVICE_COMPILE__)
    asm volatile("s_nop 3" :: "v"(P8), "v"(bf[0]), "v"(bf[1]), "v"(bf[2]), "v"(bf[3]), "v"(one));
#endif
}
#define PTOUCH(a, b) asm volatile("" : "+v"(a), "+v"(b))
#define MFMA_DRAIN() asm volatile("s_nop 15\n\ts_nop 15\n\ts_nop 15\n\ts_nop 15\n\ts_nop 15" ::: "memory")

__device__ __forceinline__ void qlat_stage(const unsigned char* __restrict__ Q8, const bf16* __restrict__ WUKT, int tok0, LAS char* lds, int tid_in) {
    int tid = tid_in; asm volatile("" : "+v"(tid));
    const int hd = tid >> 6, lane = tid & 63, r32 = lane & 31, hi = lane >> 5;
    bf16x8 bq[4];
    { const unsigned char* qp = Q8 + (size_t)(tok0 + r32) * 512 + hd * 64 + 8 * hi;
      typedef unsigned u32x2_ __attribute__((ext_vector_type(2)));
#pragma unroll
      for (int s = 0; s < 4; ++s) { const u32x2_ w = *(const u32x2_*)(qp + 16 * s);
          const auto a_ = __builtin_amdgcn_cvt_pk_f32_fp8((int)w.x, false), b_ = __builtin_amdgcn_cvt_pk_f32_fp8((int)w.x, true), c_ = __builtin_amdgcn_cvt_pk_f32_fp8((int)w.y, false), d_ = __builtin_amdgcn_cvt_pk_f32_fp8((int)w.y, true);
          u32x4 o_; o_.x = (__float_as_uint(a_[1]) & 0xffff0000u) | (__float_as_uint(a_[0]) >> 16); o_.y = (__float_as_uint(b_[1]) & 0xffff0000u) | (__float_as_uint(b_[0]) >> 16);
          o_.z = (__float_as_uint(c_[1]) & 0xffff0000u) | (__float_as_uint(c_[0]) >> 16); o_.w = (__float_as_uint(d_[1]) & 0xffff0000u) | (__float_as_uint(d_[0]) >> 16);
          bq[s] = *reinterpret_cast<bf16x8*>(&o_); } }
    const bf16* wp = WUKT + (size_t)hd * 8192 + (size_t)r32 * 64 + 8 * hi;
#pragma unroll
    for (int mt = 0; mt < 4; ++mt) {
        f32x16 acc = {};
#pragma unroll
        for (int s = 0; s < 4; ++s) { const bf16x8 af = *(const bf16x8*)(wp + mt * 2048 + 16 * s); acc = __builtin_amdgcn_mfma_f32_32x32x16_bf16(af, bq[s], acc, 0, 0, 0); }
#pragma unroll
        for (int r4 = 0; r4 < 4; ++r4) { float q_[4];
#pragma unroll
            for (int e = 0; e < 4; ++e) q_[e] = fminf(fmaxf(acc[4 * r4 + e], -448.f), 448.f);
            const int t_ = __builtin_amdgcn_cvt_pk_fp8_f32(q_[0], q_[1], 0, false);
            *(LAS unsigned*)(lds + (r32 * 8 + hd) * 128 + 32 * mt + 8 * r4 + 4 * hi) = (unsigned)__builtin_amdgcn_cvt_pk_fp8_f32(q_[2], q_[3], t_, true); }
    }
}

__device__ __forceinline__ void attn_item(const unsigned char* __restrict__ Q8, const bf16* __restrict__ WUKT, const unsigned char* __restrict__ Cb, const unsigned char* __restrict__ CT8b, unsigned char* __restrict__ MIXp, const bf16* __restrict__ WUVT, int tok0, int pos0, int n, LAS char* lds, const int tid_in) {
    int tid = tid_in; asm volatile("" : "+v"(tid));
    const int wid = tid >> 6, lane = tid & 63, r32 = lane & 31, hi = lane >> 5;
    LAS char* V_lds = lds; LAS char* K_lds = lds + 2 * SHM_V;
    LAS float* wsl = (LAS float*)(lds + 2 * SHM_V + 2 * SHM_K) + wid * 64; LAS float* li_l = wsl; LAS float* al_l = wsl + 32;
    const LAS u32x4* mwl = (const LAS u32x4*)(lds + SHM_ATTN) + tid;
    float m_reg = -1e30f, l_reg = 0; f32x16 o[4] = {}; v8i qr8[2];
    const int ql_ = r32 >> 3, hd = r32 & 7;
    const int NT = n >> 6, NTP = (NT + 1) & ~1;
#define TILE_K0(j) (((j) < NT) ? (NT - 1 - (j)) * KVBLK : 0)
    const int vtw = (tid >> 2) * VT_PITCH + (tid & 3) * 16;
    const int kgo = (tid >> 3) * 128 + (tid & 7) * 16, kwo = (tid >> 3) * 128 + (((tid & 7) ^ ((tid >> 4) & 7)) << 4);
    struct { u32x4 k8, vt; } sr_[2];
#define SLOAD(i, k0) do { sr_[i].k8 = *(const u32x4*)(Cb + (size_t)(k0) * 128 + kgo); sr_[i].vt = *(const u32x4*)(CT8b + (size_t)((k0) >> 6) * 8192 + tid * 16); } while (0)
    constexpr int SE = 0, SO = 1;
    SLOAD(SE, TILE_K0(0)); SLOAD(SO, TILE_K0(1));
    qlat_stage(Q8, WUKT, tok0, lds, tid);
    __syncthreads();
    { const LAS char* Qw = lds + ((4 * wid + ql_) * 8 + hd) * 128 + hi * 32;
#pragma unroll
      for (int sx = 0; sx < 2; ++sx) { const v4i lo = *(const LAS v4i*)(Qw + 64 * sx), hi_ = *(const LAS v4i*)(Qw + 64 * sx + 16); qr8[sx] = __builtin_shufflevector(lo, hi_, 0, 1, 2, 3, 4, 5, 6, 7); } }
    const float qposf = (float)(pos0 + 4 * wid + ql_);
    bf16x8 ef; { u32x4 w = {0u, 0u, 0u, 0u}; w.x = ((ql_ == 2 * hi) ? 0x3F80u : 0u) | ((ql_ == 2 * hi + 1) ? 0x3F800000u : 0u); w.y = (hi == 0) ? ((unsigned)(137 - hd) << 7) : 0u; ef = *reinterpret_cast<bf16x8*>(&w); }
#define MASKW(s_) 0
#define MKAX(j, ax0, ax1) do { const unsigned klw0 = (hi == 0) ? (__float_as_uint((float)r32) >> 16) : 0u, klw1 = (hi == 0) ? (__float_as_uint((float)(32 + r32)) >> 16) : 0u;   \
        u32x4 w0_ = {NEG2, klw0, 0u, 0u}, w1_ = {NEG2, klw1, 0u, 0u}; if ((j) < NT) { const u32x4 Wv_ = *mwl; const int sh_ = 2 * (NT - 1 - (j)); \
            const unsigned v0_ = (unsigned)((((unsigned long long)Wv_.y << 32) | Wv_.x) >> sh_), v1_ = (unsigned)((((unsigned long long)Wv_.w << 32) | Wv_.z) >> sh_); \
            const unsigned mA_ = (v0_ & 1u) | ((v1_ & 1u) << 16), mB_ = ((v0_ >> 1) & 1u) | ((v1_ & 2u) << 15); \
            w0_.x = NEG2 & ~(mA_ * 0xffffu); w1_.x = NEG2 & ~(mB_ * 0xffffu); } \
        ax0 = *reinterpret_cast<bf16x8*>(&w0_); ax1 = *reinterpret_cast<bf16x8*>(&w1_); } while (0)
#define TILE_B0(j) ({ int r__ = r32; asm volatile("" : "+v"(r__)); const float sl__ = __uint_as_float((unsigned)(126 - (r__ & 7)) << 23) * LOG2E; \
        sl__ * ((float)TILE_K0(j) - (float)(pos0 + 4 * wid + (r__ >> 3))); })
    const LAS char* vb0 = V_lds + r32 * VT_PITCH + 32 * hi;
    constexpr int VSL = 128 * VT_PITCH, KSL = 64 * 128;
#define SWRITE(slot, i) do { *(LAS u32x4*)(V_lds + (slot) * VSL + vtw) = sr_[i].vt; *(LAS u32x4*)(K_lds + (slot) * KSL + kwo) = sr_[i].k8; } while (0)
#define SWAIT() asm volatile("s_waitcnt vmcnt(2)" ::: "memory")
#define RESC(a) do { if (__any((a) < 1.f)) { MFMA_DRAIN(); if (hi == 0) al_l[r32] = (a); asm volatile("s_waitcnt lgkmcnt(0)" ::: "memory"); \
    _Pragma("unroll") for (int d = 0; d < 4; ++d) _Pragma("unroll") for (int r = 0; r < 16; ++r) o[d][r] *= al_l[crow(r, hi)]; } } while (0)
    f32x16 pA0, pA1, pB0, pB1; float mnA, mnB, alA, alB; v8i P8; bf16x8 ax0, ax1;
    asm volatile("s_waitcnt vmcnt(0) lgkmcnt(0)" ::: "memory"); __syncthreads();
    SWRITE(0, SE); __syncthreads();
    MKAX(0, ax0, ax1); qkt(pA0, pA1, K_lds, qr8, ax0, ax1, ef, r32, hi);
    asm volatile("s_nop 15\n\ts_nop 15\n\ts_nop 15\n\ts_nop 15\n\ts_nop 15" : "+v"(pA0), "+v"(pA1));
    {
        const float base = (float)TILE_K0(0) - qposf + (float)(4 * hi), s16 = -2.0f * __uint_as_float((unsigned)(137 - hd) << 23);
#pragma unroll
        for (int r = 0; r < 16; ++r) { const float cr = (float)((r & 3) + 8 * (r >> 2));
            pA0[r] = fmaf(s16, fmaxf(base + cr, 0.f), pA0[r]); pA1[r] = fmaf(s16, fmaxf(base + cr + 32.f, 0.f), pA1[r]); }
    }
    partialSM(pA0, pA1, TILE_B0(0), m_reg, mnA, alA);
    if (2 < NTP) SLOAD(SE, TILE_K0(2));
    SWAIT(); SWRITE(1, SO); __syncthreads();
    int rp = 0, rc = 1, rn = 2;
#define RING_STEP() do { const int t__ = rp; rp = rc; rc = rn; rn = t__; } while (0)
    for (int j = 1; j + 1 < NTP; j += 2) {
        SBAR(); MKAX(j, ax0, ax1); qkt(pB0, pB1, K_lds + rc * KSL, qr8, ax0, ax1, ef, r32, hi);
        finishSM(pA0, pA1, alA, l_reg, P8); SBAR();
        SLOAD(SO, TILE_K0(j + 2)); SBAR();
        pv_d0(o, vb0 + rp * VSL, P8); PTOUCH(pB0, pB1); partialSM(pB0, pB1, TILE_B0(j), m_reg, mnB, alB);
        SWAIT(); SWRITE(rn, SE);
        RESC(alB); __syncthreads(); RING_STEP();
        SBAR(); MKAX(j + 1, ax0, ax1); qkt(pA0, pA1, K_lds + rc * KSL, qr8, ax0, ax1, ef, r32, hi);
        finishSM(pB0, pB1, alB, l_reg, P8); SBAR();
        if (j + 3 < NTP) SLOAD(SE, TILE_K0(j + 3)); SBAR();
        pv_d0(o, vb0 + rp * VSL, P8); PTOUCH(pA0, pA1); partialSM(pA0, pA1, TILE_B0(j + 1), m_reg, mnA, alA);
        SWAIT(); SWRITE(rn, SO);
        RESC(alA); __syncthreads(); RING_STEP();
    }
    const bool lastreal = !(NT & 1);
    SBAR(); if (lastreal) { MKAX(NTP - 1, ax0, ax1); qkt(pB0, pB1, K_lds + rc * KSL, qr8, ax0, ax1, ef, r32, hi); }
    finishSM(pA0, pA1, alA, l_reg, P8); SBAR();
    pv_d0(o, vb0 + rp * VSL, P8);
    if (lastreal) {
        PTOUCH(pB0, pB1); partialSM(pB0, pB1, TILE_B0(NTP - 1), m_reg, mnB, alB);
        RESC(alB);
        finishSM(pB0, pB1, alB, l_reg, P8); SBAR();
        pv_d0(o, vb0 + rc * VSL, P8);
    }
#undef RING_STEP
    MFMA_DRAIN();
    if (hi == 0) li_l[r32] = l_reg; asm volatile("s_waitcnt lgkmcnt(0)" ::: "memory");
    float rli[16];
#pragma unroll
    for (int r = 0; r < 16; ++r) rli[r] = __builtin_amdgcn_rcpf(li_l[crow(r, hi)]) * (1.0f / 16.0f);
    __syncthreads();
#pragma unroll
    for (int r = 0; r < 16; ++r) { const int orow = crow(r, hi);
        LAS bf16* zp = (LAS bf16*)lds + ((4 * wid + (orow >> 3)) * 8 + (orow & 7)) * 128 + r32;
#pragma unroll
        for (int d0 = 0; d0 < 4; ++d0) zp[d0 * 32] = (bf16)f2bf(o[d0][r] * rli[r]); }
    __syncthreads();
    {
        typedef unsigned u32x2 __attribute__((ext_vector_type(2)));
        bf16x8 bo[8];
        { const LAS char* zq = lds + ((r32 * 8 + wid) * 128 + 8 * hi) * 2;
#pragma unroll
          for (int s = 0; s < 8; ++s) bo[s] = *(const LAS bf16x8*)(zq + s * 32); }
        const bf16* wv = WUVT + (size_t)wid * 8192 + (size_t)r32 * 128 + 8 * hi;
#pragma unroll
        for (int mt = 0; mt < 2; ++mt) {
            f32x16 acc = {};
#pragma unroll
            for (int s = 0; s < 8; ++s) { const bf16x8 af = *(const bf16x8*)(wv + mt * 4096 + 16 * s); acc = __builtin_amdgcn_mfma_f32_32x32x16_bf16(af, bo[s], acc, 0, 0, 0); }
            unsigned char* op = MIXp + (size_t)(tok0 + r32) * K2 + wid * 64 + 32 * mt + 4 * hi;
#pragma unroll
            for (int r4 = 0; r4 < 4; ++r4) { float q_[4];
#pragma unroll
                for (int e = 0; e < 4; ++e) q_[e] = fminf(fmaxf(acc[4 * r4 + e] * 16.0f, -448.f), 448.f);
                const int t_ = __builtin_amdgcn_cvt_pk_fp8_f32(q_[0], q_[1], 0, false); *(unsigned*)(op + 8 * r4) = (unsigned)__builtin_amdgcn_cvt_pk_fp8_f32(q_[2], q_[3], t_, true); }
        }
    }
    __syncthreads();
#undef SLOAD
#undef SWRITE
#undef SWAIT
#undef RESC
#undef TILE_K0
#undef MASKW
#undef MKAX
#undef TILE_B0
}
}

__device__ __forceinline__ int tid_from(const int wid6) { int l; asm volatile("v_mbcnt_lo_u32_b32 %0, -1, 0\n\tv_mbcnt_hi_u32_b32 %0, -1, %0" : "=v"(l)); return wid6 | l; }
__device__ __forceinline__ void ph_attn_fast(const Args& a, LAS unsigned char* lds, const int variant, const int wid6) {
    const bf16* P1 = (const bf16*)(a.ws + WS_P1); unsigned char* MIX = a.ws + WS_MIX;
    const int G = gridDim.x;
    for (int it = blockIdx.x; it < BATCH * 64; it += G) {
        const int tid = tid_from(wid6);
        const int lane = tid & 63, wid = tid >> 6;
        const int gg = it & 255, m = it >> 8;
        const int b = (gg & 7) + 8 * (gg >> 6), jg = (gg >> 3) & 7, qb = (m & 1) ? (63 - jg - 8 * (m >> 1)) : (jg + 8 * (m >> 1));
        const int pos0 = qb * 32, tok0 = b * SEQ + pos0, n = ((pos0 >> 6) + 1) << 6;
        { unsigned w0l, w0h, w1l, w1h;
          if (variant == 2) { w0l = w0h = w1l = w1h = 0xffffffffu; }
          else if (ATT_VARIANT == 3 && variant == 3) dsa::idx_select<3>(P1, b, tok0 + 4 * wid, n, tid, (LAS char*)lds, (const float*)(a.ws + WS_ZT), w0l, w0h, w1l, w1h);
          else dsa::idx_select<0>(P1, b, tok0 + 4 * wid, n, tid, (LAS char*)lds, (const float*)(a.ws + WS_ZT), w0l, w0h, w1l, w1h);
          ((LAS dsa::u32x4*)(lds + dsa::SHM_ATTN))[tid] = (dsa::u32x4){w0l, w0h, w1l, w1h};
          asm volatile("s_waitcnt lgkmcnt(0)" ::: "memory");
          if (ATT_VARIANT && (variant == 1 || variant == 3)) { __syncthreads(); continue; } }
        dsa::attn_item(a.ws + WS_Q8, (const bf16*)(a.ws + WS_WUKT), a.ws + WS_CN + (size_t)b * SEQ * 128, a.ws + WS_CT8 + (size_t)b * (SEQ / 64) * 8192, variant ? ((a.ws + WS_END) - (size_t)tok0 * K2 + (size_t)(tok0 & 4095) * K2) : MIX, (const bf16*)(a.ws + WS_WUVT), tok0, pos0, n, (LAS char*)lds, tid);
    }
}

__device__ __forceinline__ void ph_fixup(const Args& a, int gtid, int gthreads) {
    const float* HF = (const float*)(a.ws + WS_HF); const float* HL = (const float*)(a.ws + WS_HL); const float* CONVP = (const float*)(a.ws + WS_CONVP); unsigned char* ACT = a.ws + WS_ACT;
    constexpr int CH = FF / 4;
    for (int i = gtid; i < (NTOK / 256) * 2 * CH; i += gthreads) {
        const int pm = i / (2 * CH), rem = i - pm * (2 * CH), t = rem / CH, ch = rem - t * CH;
        if ((pm & 7) == 0) continue;
        const int jc = ch * 4, j = jc >> 7, ii = jc & 127, cg_ = 256 * j + ii;
        float r[4];
        f32x4 v[2];
#pragma unroll
        for (int half = 0; half < 2; ++half) {
            const int c = cg_ + half * 128;
            const f32x4 lm2 = *(const f32x4*)(HL + (size_t)((pm - 1) * 2 + 0) * N3 + c), lm1 = *(const f32x4*)(HL + (size_t)((pm - 1) * 2 + 1) * N3 + c);
            const f32x4 f0 = *(const f32x4*)(HF + (size_t)(pm * 2 + 0) * N3 + c), f1 = *(const f32x4*)(HF + (size_t)(pm * 2 + 1) * N3 + c);
            const f32x4 w0 = *(const f32x4*)(CONVP + c), w1 = *(const f32x4*)(CONVP + N3 + c), w2 = *(const f32x4*)(CONVP + 2 * N3 + c), bb = *(const f32x4*)(CONVP + 3 * N3 + c);
            v[half] = (t == 0) ? (bb + w0 * lm2 + w1 * lm1 + w2 * f0) : (bb + w0 * lm1 + w1 * f0 + w2 * f1);
        }
#pragma unroll
        for (int e = 0; e < 4; ++e) r[e] = v[0][e] / (1.0f + __expf(-v[0][e])) * v[1][e];
#pragma unroll
        for (int e = 0; e < 4; ++e) r[e] = fminf(fmaxf(r[e] * 8.0f, -448.f), 448.f);
        const int t_ = __builtin_amdgcn_cvt_pk_fp8_f32(r[0], r[1], 0, false);
        *(unsigned*)(ACT + (size_t)(pm * 256 + t) * FF + jc) = (unsigned)__builtin_amdgcn_cvt_pk_fp8_f32(r[2], r[3], t_, true);
    }
}

__device__ __forceinline__ void ph_final(const Args& a, int gw, int ngw, int lane) {
    const bf16* X2 = (const bf16*)(a.ws + WS_X2); const float* ss3 = (const float*)(a.ws + WS_CTL + 256 * 1024);
    for (int m = gw; m < NTOK; m += ngw) {
        const float rinv = 1.0f / sqrtf(ss3[m] * (1.0f / DM) + EPS);
#pragma unroll
        for (int h2 = 0; h2 < 2; ++h2) {
            const int c0 = h2 * 512 + 8 * lane;
            const v4u t = *(const v4u*)(X2 + (size_t)m * DM + c0);
            const f32x4 g0 = *(const f32x4*)(a.g_final + c0), g1 = *(const f32x4*)(a.g_final + c0 + 4);
            f32x4 o0, o1;
            o0.x = bflo(t.x) * rinv * g0.x; o0.y = bfhi(t.x) * rinv * g0.y; o0.z = bflo(t.y) * rinv * g0.z; o0.w = bfhi(t.y) * rinv * g0.w;
            o1.x = bflo(t.z) * rinv * g1.x; o1.y = bfhi(t.z) * rinv * g1.y; o1.z = bflo(t.w) * rinv * g1.z; o1.w = bfhi(t.w) * rinv * g1.w;
            *(f32x4*)(a.out + (size_t)m * DM + c0) = o0; *(f32x4*)(a.out + (size_t)m * DM + c0 + 4) = o1;
        }
    }
}

#define XB_TMO      128
#define XB_XCNT(j)  (256  + 64 * (j))
#define XB_XSUB(j)  (1280 + 64 * (j))
#define XB_XGEN(j)  (2304 + 64 * (j))
#define XB_TOP      3328
#define XB_TOPGEN   3392
#define XCD_BAR_WORDS 3456
#define XB_SPIN_CAP (1u << 18)
__device__ __forceinline__ unsigned xb_ld(unsigned* p)              { return __hip_atomic_load(p, __ATOMIC_RELAXED, __HIP_MEMORY_SCOPE_AGENT); }
__device__ __forceinline__ unsigned xb_add(unsigned* p, unsigned v) { return __hip_atomic_fetch_add(p, v, __ATOMIC_RELAXED, __HIP_MEMORY_SCOPE_AGENT); }
__device__ __forceinline__ unsigned xb_xcc_id() { return (unsigned)__builtin_amdgcn_s_getreg((3 << 11) | 20) & 0xFu; }
#define XB_SPIN(cond, bar) do { unsigned _sp = 0; while (cond) { __builtin_amdgcn_s_sleep(1); \
    if ((++_sp & 255u) == 0u) { if (xb_ld(&(bar)[XB_TMO])) break; if (_sp > XB_SPIN_CAP) { atomicAdd(&(bar)[XB_TMO], 1u); break; } } } } while (0)
struct XcdBarrier { unsigned* bar; unsigned x; volatile LAS unsigned* st; };
__device__ __forceinline__ XcdBarrier xcd_barrier_post(unsigned* bar, volatile LAS unsigned* st, const int tid) {
    XcdBarrier b; b.bar = bar; b.x = xb_xcc_id(); b.st = st;
    if (tid == 0) (void)xb_add(&bar[XB_XCNT(b.x)], 1u);
    return b;
}
__device__ __forceinline__ void xcd_barrier_complete(unsigned* bar, unsigned x, unsigned& nloc, unsigned& nx) {
    const unsigned G = gridDim.x * gridDim.y * gridDim.z;
    unsigned sum, cnt, mine, sp = 0u;
    for (;;) {
        sum = 0u; cnt = 0u; mine = 0u;
#pragma unroll
        for (unsigned j = 0; j < 16; ++j) { const unsigned c = xb_ld(&bar[XB_XCNT(j)]); sum += c; cnt += (c > 0u) ? 1u : 0u; mine = (j == x) ? c : mine; }
        if (sum == G) break;
        __builtin_amdgcn_s_sleep(1);
        if ((++sp & 255u) == 0u) { if (xb_ld(&bar[XB_TMO])) break; if (sp > XB_SPIN_CAP) { atomicAdd(&bar[XB_TMO], 1u); break; } }
    }
    nloc = mine > 0u ? mine : 1u; nx = cnt > 0u ? cnt : 1u;
}
__device__ __forceinline__ void xcd_barrier(const XcdBarrier& b, const int tid) {
    asm volatile("s_waitcnt vmcnt(0)" ::: "memory");
    __syncthreads();
    if (tid == 0) {
        unsigned* bar = b.bar;
        __builtin_amdgcn_s_waitcnt(0);
        unsigned nloc = b.st[0], nx = b.st[1];
        if (nloc == 0u) { xcd_barrier_complete(bar, b.x, nloc, nx); b.st[0] = nloc; b.st[1] = nx; }
        const unsigned old = xb_add(&bar[XB_XSUB(b.x)], 1u);
        const unsigned gen = old / nloc;
        if (old + 1u == (gen + 1u) * nloc) {
            __builtin_amdgcn_fence(__ATOMIC_RELEASE, "agent");
            asm volatile("s_waitcnt vmcnt(0)" ::: "memory");
            const unsigned og = xb_add(&bar[XB_TOP], 1u);
            const unsigned tg = og / nx;
            if (og + 1u == (tg + 1u) * nx) xb_add(&bar[XB_TOPGEN], 1u);
            else XB_SPIN(xb_ld(&bar[XB_TOPGEN]) == tg, bar);
            __builtin_amdgcn_fence(__ATOMIC_ACQUIRE, "agent");
            xb_add(&bar[XB_XGEN(b.x)], 1u);
            asm volatile("s_waitcnt vmcnt(0)" ::: "memory");
        } else {
            XB_SPIN(xb_ld(&bar[XB_XGEN(b.x)]) == gen, bar);
            __builtin_amdgcn_fence(__ATOMIC_ACQUIRE, "agent");
            asm volatile("s_waitcnt vmcnt(0)" ::: "memory");
        }
    }
    __syncthreads();
}

constexpr int NPHASE = 8;
#define IDS() const int tid = TIDK, lane = tid & 63, wave = __builtin_amdgcn_readfirstlane(tid >> 6); const int G = gridDim.x; \
    const int gtid = blockIdx.x * (NWAVES * 64) + tid, gthreads = G * NWAVES * 64, gw = blockIdx.x * NWAVES + wave, ngw = G * NWAVES; (void)lane; (void)wave; (void)gtid; (void)gthreads; (void)gw; (void)ngw;
__global__ void __launch_bounds__(NWAVES * 64, 2) fwd_kernel(Args a_unused) {
    extern __shared__ __attribute__((aligned(16))) unsigned char lds_raw[];
    LAS unsigned char* lds = (LAS unsigned char*)lds_raw;
    const kargp_t kp = (kargp_t)__builtin_amdgcn_kernarg_segment_ptr();
    const int lo = karg_int<136>(kp), hi = karg_int<140>(kp);
#define LOADA() const Args a = load_args(kp)
    volatile LAS unsigned* xb_st = (volatile LAS unsigned*)(lds + XB_LDS_OFF);
    const int wid6 = __builtin_amdgcn_readfirstlane((int)threadIdx.x) & ~63;
#define TIDK tid_from(wid6)
    { const int t0 = TIDK; if (t0 < 4) xb_st[t0] = 0u;
      __syncthreads();
      (void)xcd_barrier_post((unsigned*)((unsigned char*)karg_ptr<128>(kp) + WS_CTL + XB_CTL_OFF) + karg_int<144>(kp) * XCD_BAR_WORDS, xb_st, t0); }
    if (lo < 0) cg::this_grid().sync();
#define IN(k) (lo <= (k) && (k) < hi)
#define SEAM(k) do { if (IN(k) && IN((k) + 1)) { { XcdBarrier xb_; xb_.bar = (unsigned*)((unsigned char*)karg_ptr<128>(kp) + WS_CTL + XB_CTL_OFF) + karg_int<144>(kp) * XCD_BAR_WORDS; xb_.x = xb_xcc_id(); \
        xb_.st = (volatile LAS unsigned*)(lds + XB_LDS_OFF); xcd_barrier(xb_, TIDK); } } } while (0)
    if (IN(0)) { LOADA(); IDS(); ph_prologue(a, lds, tid, gtid, gthreads, gw, ngw, lane); }
    SEAM(0);
    if (IN(1)) {
        unsigned char* ws = (unsigned char*)karg_ptr<128>(kp);
        pg8::Gemm g{(const bf16*)(ws + WS_HB), (const bf16*)(ws + WS_W1T), NTOK, N1, DM}; pg8::StaticOrder S; S.init(NTOK, N1, (int)gridDim.x, (int)blockIdx.x);
        pg8::EpiStore E{(bf16*)(ws + WS_P1), N1, nullptr, ws + WS_Q8, ws + WS_U8};
        pg8::gemm_phase<pg8::EpiStore, pg8::StaticOrder, true, true>(lds, g, S, E, TIDK);
    }
    SEAM(1);
    if (IN(2)) { LOADA(); IDS(); ph_cnorm_pool(a, gw, ngw, lane); }
    SEAM(2);
    if (IN(3)) { LOADA(); ph_attn_fast(a, lds, (ATT_VARIANT && a.li == 1) ? ATT_VARIANT : 0, wid6); }
    SEAM(3);
    if (IN(4)) {
        unsigned char* ws = (unsigned char*)karg_ptr<128>(kp);
        pg8::Gemm g{(const bf16*)(ws + WS_MIX), (const bf16*)(ws + WS_W2T), NTOK, DM, K2 / 2}; pg8::StaticOrder S; S.init(NTOK, DM, (int)gridDim.x, (int)blockIdx.x);
        pg8::EpiResid<false> E{(const void*)(ws + WS_HB), (bf16*)(ws + WS_X1B), (float*)(ws + WS_CTL), ws + WS_X1F8, 1.0f / 1024.0f, (const float*)(ws + WS_RS), (const float*)karg_ptr<8>(kp)};
        pg8::gemm_phase<pg8::EpiResid<false>, pg8::StaticOrder, true, true, true>(lds, g, S, E, TIDK);
    }
    SEAM(4);
    if (IN(5)) {
        unsigned char* ws = (unsigned char*)karg_ptr<128>(kp);
        pg8::Gemm g{(const bf16*)(ws + WS_X1F8), (const bf16*)(ws + WS_W3T), NTOK, N3, DM / 2}; pg8::StaticOrder S; S.init(NTOK, N3, (int)gridDim.x, (int)blockIdx.x);
        pg8::EpiConvGlu E{ws + WS_ACT, (const float*)(ws + WS_CTL), (const float*)(ws + WS_CONVP), (float*)(ws + WS_HF), (float*)(ws + WS_HL), (LAS float*)(lds + HALO_LDS_OFF)};
        pg8::gemm_phase<pg8::EpiConvGlu, pg8::StaticOrder, true, true, true>(lds, g, S, E, TIDK);
    }
    SEAM(5);
    if (IN(6)) { LOADA(); IDS(); ph_fixup(a, gtid, gthreads); }
    SEAM(6);
    if (IN(7)) {
        unsigned char* ws = (unsigned char*)karg_ptr<128>(kp);
        pg8::Gemm g{(const bf16*)(ws + WS_ACT), (const bf16*)(ws + WS_W4T), NTOK, DM, FF / 2}; pg8::StaticOrder S; S.init(NTOK, DM, (int)gridDim.x, (int)blockIdx.x);
        pg8::EpiFinal E{(const bf16*)(ws + WS_X1B), (float*)karg_ptr<120>(kp), (float*)(ws + WS_CTL + 256 * 1024), (unsigned*)(ws + WS_CTL + PCNT_CTL_OFF), (const float*)karg_ptr<112>(kp)};
        pg8::gemm_phase<pg8::EpiFinal, pg8::StaticOrder, true, true, true>(lds, g, S, E, TIDK);
    }
#undef IN
#undef SEAM
}

extern "C" void kernel_launch(void* const* d_in, const int* in_sizes, int n_in, void* d_out, int out_size, void* d_ws, size_t ws_size, hipStream_t stream) {
    static int grid = 0;
    if (grid == 0) {
        if (n_in != 15 || in_sizes[0] != NTOK * DM || out_size != NTOK * DM || ws_size < WS_END) { fprintf(stderr, "kernel_launch: unexpected shapes / workspace (n_in %d, ws %zu)\n", n_in, ws_size); grid = -1; return; }
        int dev = 0, cus = 0, per_cu = 0;
        hipGetDevice(&dev); hipDeviceGetAttribute(&cus, hipDeviceAttributeMultiprocessorCount, dev);
        if (hipFuncSetAttribute((const void*)fwd_kernel, hipFuncAttributeMaxDynamicSharedMemorySize, LDS_BYTES) != hipSuccess) { fprintf(stderr, "kernel_launch: hipFuncSetAttribute failed\n"); grid = -1; return; }
        if (hipOccupancyMaxActiveBlocksPerMultiprocessor(&per_cu, (const void*)fwd_kernel, NWAVES * 64, LDS_BYTES) != hipSuccess || per_cu < 1) { fprintf(stderr, "kernel_launch: occupancy query says %d\n", per_cu); per_cu = 1; }
        (void)hipGetLastError();
        grid = cus;
        if (grid != 256) fprintf(stderr, "kernel_launch: %d CUs (tuned for 256)\n", grid);
    }
    if (grid < 0) return;
    hipMemsetAsync((char*)d_ws + WS_CTL, 0, CTL_ZERO_BYTES, stream);
    Args a{};
    a.x = (const float*)d_in[0]; a.g_mix = (const float*)d_in[1]; a.w_in = (const float*)d_in[2]; a.g_kv = (const float*)d_in[3]; a.w_uk = (const float*)d_in[4]; a.w_uv = (const float*)d_in[5];
    a.w_pool = (const float*)d_in[6]; a.pool_scale = (const float*)d_in[7]; a.w_o = (const float*)d_in[8]; a.g_ffn = (const float*)d_in[9]; a.w_up = (const float*)d_in[10];
    a.conv_w = (const float*)d_in[11]; a.conv_b = (const float*)d_in[12]; a.w_down = (const float*)d_in[13]; a.g_final = (const float*)d_in[14];
    a.out = (float*)d_out; a.ws = (unsigned char*)d_ws;
#if REP_PH >= 0
    { void* args[] = {&a};
      if (REP_PH >= 100) {
        a.ph_lo = 0; a.ph_hi = NPHASE; a.li = 0; hipLaunchCooperativeKernel((const void*)fwd_kernel, dim3(grid), dim3(NWAVES * 64), args, LDS_BYTES, stream);
        a.ph_lo = 0; a.ph_hi = REP_PH - 100; a.li = 1; hipLaunchCooperativeKernel((const void*)fwd_kernel, dim3(grid), dim3(NWAVES * 64), args, LDS_BYTES, stream);
      } else if (REP_PH == 4 || REP_PH == 7) {
        a.ph_lo = 0; a.ph_hi = NPHASE; a.li = 0; hipLaunchCooperativeKernel((const void*)fwd_kernel, dim3(grid), dim3(NWAVES * 64), args, LDS_BYTES, stream);
        a.ph_lo = REP_PH; a.ph_hi = REP_PH + 1; a.li = 1; hipLaunchCooperativeKernel((const void*)fwd_kernel, dim3(grid), dim3(NWAVES * 64), args, LDS_BYTES, stream);
      } else {
      a.ph_lo = 0; a.ph_hi = REP_PH + 1; a.li = 0; hipLaunchCooperativeKernel((const void*)fwd_kernel, dim3(grid), dim3(NWAVES * 64), args, LDS_BYTES, stream);
      a.ph_lo = REP_PH; a.ph_hi = REP_PH + 1; a.li = 1; hipLaunchCooperativeKernel((const void*)fwd_kernel, dim3(grid), dim3(NWAVES * 64), args, LDS_BYTES, stream);
      if (REP_PH + 1 < NPHASE) { a.ph_lo = REP_PH + 1; a.ph_hi = NPHASE; a.li = 2; hipLaunchCooperativeKernel((const void*)fwd_kernel, dim3(grid), dim3(NWAVES * 64), args, LDS_BYTES, stream); } } }
#elif MK_ONE_LAUNCH
    a.ph_lo = 0; a.ph_hi = NPHASE;
    void* args[] = {&a};
    hipError_t e = hipLaunchCooperativeKernel((const void*)fwd_kernel, dim3(grid), dim3(NWAVES * 64), args, LDS_BYTES, stream);
    if (e != hipSuccess) fprintf(stderr, "cooperative launch failed: %s (grid %d)\n", hipGetErrorString(e), grid);
#else
    for (int ph = 0; ph < NPHASE; ++ph) {
        a.ph_lo = ph; a.ph_hi = ph + 1;
        hipLaunchKernelGGL(fwd_kernel, dim3(grid), dim3(NWAVES * 64), LDS_BYTES, stream, a);
    }
#endif
}
```

```cpp
#include <hip/hip_runtime.h>
#include <hip/hip_cooperative_groups.h>
#include <cstdio>
#include <cstdint>
namespace cg = cooperative_groups;

#ifndef USE_NAIVE_ATTN
#define USE_NAIVE_ATTN 0
#endif
#ifndef REP_PH
#define REP_PH -1
#endif
#ifndef ATT_VARIANT
#define ATT_VARIANT 0
#endif
#ifndef MK_ONE_LAUNCH
#define MK_ONE_LAUNCH 1
#endif

namespace pg8 {
#define PG8_LAS __attribute__((address_space(3)))
typedef unsigned short bf16_t;
typedef short bf16x8 __attribute__((ext_vector_type(8)));
typedef float f32x4 __attribute__((ext_vector_type(4)));
typedef unsigned u32x4 __attribute__((ext_vector_type(4)));
constexpr int BM = 256, BK = 64, HALF = 128, HTB = HALF * BK * 2, STAGE_BYTES = 8 * HTB, NXCD = 8, WGM = 8;

__host__ __device__ __forceinline__ int lds_byte(int r, int c) { const int st = (r >> 4) * 2 + (c >> 5), rr = r & 15, cc = c & 31, ob = rr * 64 + cc * 2; return st * 1024 + (ob ^ (((ob >> 9) & 1) << 5)); }
__host__ __device__ __forceinline__ void stage_rc(int b, int& R, int& C) { const int st = b / 1024, sb = b % 1024, swz = sb ^ (((sb >> 9) & 1) << 5); R = (st >> 1) * 16 + swz / 64; C = (st & 1) * 32 + (swz % 64) / 2; }
__host__ __device__ __forceinline__ int perm32(int rho) { const int n = rho >> 4, i = rho & 15; return 8 * (i >> 2) + 4 * n + (i & 3); }

struct Unit { int pm, pn; };
struct Gemm { const bf16_t* A; const bf16_t* Bt; int M, N, K; };

struct StaticOrder {
    int nM, nN, nwg, G, c;
    __host__ __device__ void init(int M, int N, int G_, int c_) { nM = M / BM; nN = N / BM; nwg = nM * nN; G = G_; c = c_; }
    __host__ __device__ bool next(int i, Unit& u) const {
        const long L = (long)i * G + c; if (L >= nwg) return false;
        int wgid = (int)L; { const int q = nwg / NXCD, r = nwg % NXCD, xcd = wgid % NXCD, off = wgid / NXCD; wgid = (xcd < r ? xcd * (q + 1) : r * (q + 1) + (xcd - r) * q) + off; }
        const int nig = WGM * nN, gid = wgid / nig, fm = gid * WGM, gsz = (nM - fm) < WGM ? (nM - fm) : WGM;
        u.pm = fm + ((wgid % nig) % gsz); u.pn = (wgid % nig) / gsz; return true;
    }
    __device__ __forceinline__ void a_ready(const Unit&) const {}
    __device__ __forceinline__ void done(const Unit&) const {}
};

__device__ __forceinline__ unsigned cvt_pk_bf16(float lo, float hi) { unsigned r; asm volatile("v_cvt_pk_bf16_f32 %0, %1, %2" : "=v"(r) : "v"(lo), "v"(hi)); return r; }


struct EpiStore {
    static constexpr bool PERM = true, AFTER_DRAIN = false, ROWPERM = false, PRELOAD = false;
    bf16_t* O; int ldc; const float* sumsq; unsigned char* Q8; unsigned char* U8;
    __device__ __forceinline__ void operator()(const f32x4 (&acc)[2][2][4][2], const Unit& u, int wr, int wc, int fr, int fq) const {
        const int row0 = u.pm * BM + wr * 64 + fr, col0 = u.pn * BM + wc * 32 + 8 * fq;
        if (Q8 && (u.pn < 2 || (u.pn & 6) == 4)) {
            unsigned char* dst = (u.pn < 2 ? Q8 : U8) + (u.pn & 1) * BM + wc * 32 + 8 * fq;
#pragma unroll
            for (int ai = 0; ai < 2; ++ai)
#pragma unroll
                for (int m = 0; m < 4; ++m) {
                    unsigned char* rowp8 = dst + (size_t)(row0 + ai * HALF + m * 16) * 512;
#pragma unroll
                    for (int bj = 0; bj < 2; ++bj) { typedef unsigned u32x2_ __attribute__((ext_vector_type(2))); u32x2_ q; int t_; float z[8];
#pragma unroll
                        for (int e = 0; e < 4; ++e) { z[e] = fminf(fmaxf(acc[ai][bj][m][0][e] * 16.f, -448.f), 448.f); z[4 + e] = fminf(fmaxf(acc[ai][bj][m][1][e] * 16.f, -448.f), 448.f); }
                        t_ = __builtin_amdgcn_cvt_pk_fp8_f32(z[0], z[1], 0, false); q.x = (unsigned)__builtin_amdgcn_cvt_pk_fp8_f32(z[2], z[3], t_, true);
                        t_ = __builtin_amdgcn_cvt_pk_fp8_f32(z[4], z[5], 0, false); q.y = (unsigned)__builtin_amdgcn_cvt_pk_fp8_f32(z[6], z[7], t_, true);
                        *(u32x2_*)(rowp8 + bj * HALF) = q; } }
            return;
        }
#pragma unroll
        for (int ai = 0; ai < 2; ++ai)
#pragma unroll
            for (int m = 0; m < 4; ++m) {
                const int row = row0 + ai * HALF + m * 16;
                float sc = 1.f; if (sumsq) sc = 1.0f / sqrtf(sumsq[row] * (1.0f / 1024.0f) + 1e-6f);
                bf16_t* rowp = O + (size_t)row * ldc + col0;
#pragma unroll
                for (int bj = 0; bj < 2; ++bj) { f32x4 v0 = acc[ai][bj][m][0] * sc, v1 = acc[ai][bj][m][1] * sc;
                    u32x4 w; w.x = cvt_pk_bf16(v0[0], v0[1]); w.y = cvt_pk_bf16(v0[2], v0[3]); w.z = cvt_pk_bf16(v1[0], v1[1]); w.w = cvt_pk_bf16(v1[2], v1[3]);
                    *(u32x4*)(rowp + bj * HALF) = w; } }
    }
};
template <bool BASE_F32> struct EpiResid {
    static constexpr bool PERM = true, AFTER_DRAIN = false, ROWPERM = false, PRELOAD = false;
    const void* base; bf16_t* O; float* sumsq; unsigned char* O8; float accscale; const float* rowfac; const float* colg;
    __device__ __forceinline__ void operator()(const f32x4 (&acc)[2][2][4][2], const Unit& u, int wr, int wc, int fr, int fq) const {
        const int row0 = u.pm * BM + wr * 64 + fr, col0 = u.pn * BM + wc * 32 + 8 * fq;
        f32x4 gi[2][2];
        if (!BASE_F32) {
#pragma unroll
            for (int bj = 0; bj < 2; ++bj)
#pragma unroll
                for (int q = 0; q < 2; ++q) { const f32x4 g_ = *(const f32x4*)(colg + col0 + bj * HALF + 4 * q);
#pragma unroll
                    for (int e = 0; e < 4; ++e) gi[bj][q][e] = __builtin_amdgcn_rcpf(g_[e]); }
        }
#pragma unroll
        for (int ai = 0; ai < 2; ++ai)
#pragma unroll
            for (int m = 0; m < 4; ++m) {
                const int row = row0 + ai * HALF + m * 16; float ss = 0.f;
                float rf = 1.f; if (!BASE_F32) rf = rowfac[row];
#pragma unroll
                for (int bj = 0; bj < 2; ++bj) {
                    const size_t off = (size_t)row * 1024 + col0 + bj * HALF;
                    f32x4 b0, b1;
                    if (BASE_F32) { b0 = *(const f32x4*)((const float*)base + off); b1 = *(const f32x4*)((const float*)base + off + 4); }
                    else { const u32x4 r = *(const u32x4*)((const bf16_t*)base + off);
                        b0[0] = __uint_as_float(r.x << 16); b0[1] = __uint_as_float(r.x & 0xffff0000u); b0[2] = __uint_as_float(r.y << 16); b0[3] = __uint_as_float(r.y & 0xffff0000u);
                        b1[0] = __uint_as_float(r.z << 16); b1[1] = __uint_as_float(r.z & 0xffff0000u); b1[2] = __uint_as_float(r.w << 16); b1[3] = __uint_as_float(r.w & 0xffff0000u);
                        b0 = b0 * rf * gi[bj][0]; b1 = b1 * rf * gi[bj][1]; }
                    const f32x4 v0 = acc[ai][bj][m][0] * accscale + b0, v1 = acc[ai][bj][m][1] * accscale + b1;
                    ss += (v0[0] * v0[0] + v0[1] * v0[1]) + (v0[2] * v0[2] + v0[3] * v0[3]) + (v1[0] * v1[0] + v1[1] * v1[1]) + (v1[2] * v1[2] + v1[3] * v1[3]);
                    u32x4 w; w.x = cvt_pk_bf16(v0[0], v0[1]); w.y = cvt_pk_bf16(v0[2], v0[3]); w.z = cvt_pk_bf16(v1[0], v1[1]); w.w = cvt_pk_bf16(v1[2], v1[3]);
                    *(u32x4*)(O + off) = w;
                    if (O8) { typedef unsigned u32x2_ __attribute__((ext_vector_type(2))); u32x2_ q; int t_;
                        t_ = __builtin_amdgcn_cvt_pk_fp8_f32(v0[0] * 16.f, v0[1] * 16.f, 0, false); q.x = (unsigned)__builtin_amdgcn_cvt_pk_fp8_f32(v0[2] * 16.f, v0[3] * 16.f, t_, true);
                        t_ = __builtin_amdgcn_cvt_pk_fp8_f32(v1[0] * 16.f, v1[1] * 16.f, 0, false); q.y = (unsigned)__builtin_amdgcn_cvt_pk_fp8_f32(v1[2] * 16.f, v1[3] * 16.f, t_, true);
                        *(u32x2_*)(O8 + off) = q; } }
                ss += __shfl_xor(ss, 16); ss += __shfl_xor(ss, 32);
                if (fq == 0) atomicAdd(sumsq + row, ss);
            }
    }
};


struct EpiConvGlu {
    static constexpr bool PERM = true, AFTER_DRAIN = false, ROWPERM = true, PRELOAD = true;
    unsigned char* ACT; const float* sumsq; const float* convp; float* hfirst; float* hlast; PG8_LAS float* halo; int buf;
    __device__ __forceinline__ void operator()(f32x4 (&acc)[2][2][4][2], const Unit& u, int wr, int wc, int fr, int fq) const {
        constexpr int N3_ = 5632, FF_ = 2816;
        typedef float f32x2 __attribute__((ext_vector_type(2)));
        const int cq = wc * 32 + 8 * fq;
        int frp = fr, cqp = cq, fqp = fq; asm volatile("" : "+v"(frp), "+v"(cqp), "+v"(fqp));
        const int rowb = u.pm * BM + wr * 64 + 4 * frp;
        f32x4 ssq[2];
#pragma unroll
        for (int ai = 0; ai < 2; ++ai) ssq[ai] = *(const PG8_LAS f32x4*)(halo + 3840 + buf * 1280 + 1024 + ai * HALF + wr * 64 + 4 * frp);
        PG8_LAS float* par = halo + 3840 + buf * 1280;
#pragma unroll
        for (int ai = 0; ai < 2; ++ai)
#pragma unroll
            for (int m = 0; m < 4; ++m) { const float sc = __builtin_amdgcn_rsqf(ssq[ai][m] * (1.0f / 1024.0f) + 1e-6f) * (1.0f / 1024.0f);
#pragma unroll
                for (int bj = 0; bj < 2; ++bj) { acc[ai][bj][m][0] *= sc; acc[ai][bj][m][1] *= sc; } }
#pragma unroll
        for (int ai = 0; ai < 2; ++ai)
#pragma unroll
            for (int bj = 0; bj < 2; ++bj)
#pragma unroll
                for (int m = 0; m < 4; ++m) { asm volatile("" : "+v"(acc[ai][bj][m][0])); asm volatile("" : "+v"(acc[ai][bj][m][1])); }
        __builtin_amdgcn_sched_barrier(0);
        if (fr == 15) {
            PG8_LAS float* hw = halo + (wr + 1) * 768 + cqp; asm volatile("" : "+v"(hw));
#pragma unroll
            for (int ai = 0; ai < 2; ++ai)
#pragma unroll
                for (int r = 0; r < 2; ++r)
#pragma unroll
                    for (int bj = 0; bj < 2; ++bj)
#pragma unroll
                        for (int n = 0; n < 2; ++n) *(PG8_LAS f32x4*)(hw + ai * 1536 + r * 256 + bj * HALF + 4 * n) = acc[ai][bj][2 + r][n];
            if (wr == 1) {
#pragma unroll
                for (int r = 0; r < 2; ++r)
#pragma unroll
                    for (int bj = 0; bj < 2; ++bj)
#pragma unroll
                        for (int n = 0; n < 2; ++n) *(f32x4*)(hlast + (size_t)(u.pm * 2 + r) * N3_ + u.pn * BM + bj * HALF + cq + 4 * n) = acc[1][bj][2 + r][n];
            }
        }
        if (fr == 0 && wr == 0) {
#pragma unroll
            for (int r = 0; r < 2; ++r)
#pragma unroll
                for (int bj = 0; bj < 2; ++bj)
#pragma unroll
                    for (int n = 0; n < 2; ++n) *(f32x4*)(hfirst + (size_t)(u.pm * 2 + r) * N3_ + u.pn * BM + bj * HALF + cq + 4 * n) = acc[0][bj][r][n];
        }
        { const int w_ = wr * 4 + wc;
          float zz = 0.f; asm volatile("" : "+v"(zz));
          if (w_ < 7) *(PG8_LAS f32x4*)(halo + (w_ < 3 ? w_ * 256 : (w_ - 2) * 768 + 512) + 4 * (frp + 16 * fqp)) = f32x4{zz, zz, zz, zz}; }
        asm volatile("s_waitcnt lgkmcnt(0)" ::: "memory"); __builtin_amdgcn_s_barrier(); asm volatile("s_nop 1" ::: "memory");
        const PG8_LAS float* ha1 = halo + wr * 768 + (frp == 0 ? 256 : 512) + cqp; const PG8_LAS float* ha2 = halo + wr * 768 + (frp == 0 ? 0 : 512) + cqp;
        const PG8_LAS float* parl = par + cqp;
        asm volatile("" : "+v"(ha1), "+v"(ha2), "+v"(parl));
#define CONV_DPP(cv, src, w, ctl) asm("v_fmac_f32_dpp %0, %1, %2 " ctl " row_mask:0xf bank_mask:0xf" : "+v"(cv) : "v"(src), "v"(w))
#define P2(v, j0_) f32x2{(v)[j0_], (v)[(j0_) + 1]}
        unsigned wkeep[2][4];
#pragma unroll
        for (int n = 0; n < 2; ++n) {
            const PG8_LAS float* pp = parl + 4 * n;
            const f32x4 g0 = *(const PG8_LAS f32x4*)(pp), g1 = *(const PG8_LAS f32x4*)(pp + 128), g2 = *(const PG8_LAS f32x4*)(pp + 256), gb = *(const PG8_LAS f32x4*)(pp + 384);
            const f32x4 u0 = *(const PG8_LAS f32x4*)(pp + 512), u1 = *(const PG8_LAS f32x4*)(pp + 640), u2 = *(const PG8_LAS f32x4*)(pp + 768), ub = *(const PG8_LAS f32x4*)(pp + 896);
#pragma unroll
            for (int ai = 0; ai < 2; ++ai) {
                const PG8_LAS float* h1 = ha1 + ai * 1536 + 4 * n; const PG8_LAS float* h2 = ha2 + ai * 1536 + 4 * n;
                const f32x4 c1g = *(const PG8_LAS f32x4*)(h1), c1u = *(const PG8_LAS f32x4*)(h1 + HALF), c2g = *(const PG8_LAS f32x4*)(h2), c2u = *(const PG8_LAS f32x4*)(h2 + HALF);
#pragma unroll
                for (int m = 3; m >= 0; --m) {
                    float r[4];
#pragma unroll
                    for (int jp = 0; jp < 2; ++jp) {
                        const int j0 = 2 * jp, j1 = 2 * jp + 1;
                        f32x2 vg2 = P2(acc[ai][0][m][n], j0) * P2(g2, j0) + P2(gb, j0), vu2 = P2(acc[ai][1][m][n], j0) * P2(u2, j0) + P2(ub, j0);
                        if (m >= 1) { vg2 = P2(acc[ai][0][m - 1][n], j0) * P2(g1, j0) + vg2; vu2 = P2(acc[ai][1][m - 1][n], j0) * P2(u1, j0) + vu2; }
                        if (m >= 2) { vg2 = P2(acc[ai][0][m - 2][n], j0) * P2(g0, j0) + vg2; vu2 = P2(acc[ai][1][m - 2][n], j0) * P2(u0, j0) + vu2; }
                        if (m == 1) { vg2 = P2(c1g, j0) * P2(g0, j0) + vg2; vu2 = P2(c1u, j0) * P2(u0, j0) + vu2; }
                        if (m == 0) { vg2 = P2(c1g, j0) * P2(g1, j0) + vg2; vg2 = P2(c2g, j0) * P2(g0, j0) + vg2; vu2 = P2(c1u, j0) * P2(u1, j0) + vu2; vu2 = P2(c2u, j0) * P2(u0, j0) + vu2; }
                        float vg[2] = {vg2.x, vg2.y}, vu[2] = {vu2.x, vu2.y};
                        if (m < 2) {
#pragma unroll
                            for (int e = 0; e < 2; ++e) { const int j = j0 + e;
                                if (m == 1) { CONV_DPP(vg[e], acc[ai][0][3][n][j], g0[j], "row_shr:1"); CONV_DPP(vu[e], acc[ai][1][3][n][j], u0[j], "row_shr:1"); }
                                else { CONV_DPP(vg[e], acc[ai][0][3][n][j], g1[j], "row_shr:1"); CONV_DPP(vg[e], acc[ai][0][2][n][j], g0[j], "row_shr:1");
                                       CONV_DPP(vu[e], acc[ai][1][3][n][j], u1[j], "row_shr:1"); CONV_DPP(vu[e], acc[ai][1][2][n][j], u0[j], "row_shr:1"); }
                            }
                        }
                        const f32x2 cg2 = {vg[0], vg[1]}, cu2 = {vu[0], vu[1]};
                        const f32x2 d2 = f32x2{__builtin_amdgcn_exp2f(-vg[0]), __builtin_amdgcn_exp2f(-vg[1])} + 1.0f;
                        const f32x2 r2 = cg2 * f32x2{__builtin_amdgcn_rcpf(d2.x), __builtin_amdgcn_rcpf(d2.y)} * cu2;
                        r[j0] = fminf(fmaxf(r2.x, -448.f), 448.f); r[j1] = fminf(fmaxf(r2.y, -448.f), 448.f);
                    }
                    const int t_ = __builtin_amdgcn_cvt_pk_fp8_f32(r[0], r[1], 0, false); const unsigned w4 = (unsigned)__builtin_amdgcn_cvt_pk_fp8_f32(r[2], r[3], t_, true);
                    if (n == 0) wkeep[ai][m] = w4;
                    else { typedef unsigned u32x2_ __attribute__((ext_vector_type(2))); *(u32x2_*)(ACT + (size_t)(rowb + ai * HALF + m) * FF_ + u.pn * HALF + cq) = u32x2_{wkeep[ai][m], w4}; }
                }
            }
        }
#undef P2
#undef CONV_DPP
    }
};


struct EpiFinal {
    static constexpr bool PERM = false, AFTER_DRAIN = false, ROWPERM = false, PRELOAD = false;
    const bf16_t* base; float* out; float* sumsq; unsigned* pcnt; const float* gfin;
    __device__ __forceinline__ void operator()(f32x4 (&acc)[2][2][4][2], const Unit& u, int wr, int wc, int fr, int fq) const {
        const int row0 = u.pm * BM + wr * 64 + fr, col0 = u.pn * BM + wc * 32 + 4 * fq;
        typedef unsigned u32x2_ __attribute__((ext_vector_type(2)));
#pragma unroll
        for (int ai = 0; ai < 2; ++ai)
#pragma unroll
            for (int m = 0; m < 4; ++m) {
                const int row = row0 + ai * HALF + m * 16; float ss = 0.f;
#pragma unroll
                for (int bj = 0; bj < 2; ++bj)
#pragma unroll
                    for (int n = 0; n < 2; ++n) {
                        const u32x2_ r = *(const u32x2_*)(base + (size_t)row * 1024 + col0 + bj * HALF + 16 * n);
                        f32x4 b0;
                        b0[0] = __uint_as_float(r.x << 16); b0[1] = __uint_as_float(r.x & 0xffff0000u); b0[2] = __uint_as_float(r.y << 16); b0[3] = __uint_as_float(r.y & 0xffff0000u);
                        const f32x4 v0 = acc[ai][bj][m][n] * (1.0f / 512.0f) + b0;
                        acc[ai][bj][m][n] = v0;
                        ss += (v0[0] * v0[0] + v0[1] * v0[1]) + (v0[2] * v0[2] + v0[3] * v0[3]); }
                ss += __shfl_xor(ss, 16); ss += __shfl_xor(ss, 32);
                if (fq == 0) atomicAdd(sumsq + row, ss);
            }
        const bool t0 = (wr == 0 && wc == 0 && fr == 0 && fq == 0);
        asm volatile("s_waitcnt vmcnt(0)" ::: "memory");
        __builtin_amdgcn_s_barrier();
        if (t0) {
            unsigned* pc = pcnt + 64 * u.pm;
            __hip_atomic_fetch_add(pc, 1u, __ATOMIC_RELAXED, __HIP_MEMORY_SCOPE_AGENT);
            unsigned sp = 0;
            while (__hip_atomic_load(pc, __ATOMIC_RELAXED, __HIP_MEMORY_SCOPE_AGENT) < 4u) { __builtin_amdgcn_s_sleep(2); if (++sp > (1u << 22)) break; }
            __builtin_amdgcn_fence(__ATOMIC_ACQUIRE, "agent");
            asm volatile("s_waitcnt vmcnt(0)" ::: "memory");
        }
        __builtin_amdgcn_s_barrier(); asm volatile("" ::: "memory");
#pragma unroll
        for (int ai = 0; ai < 2; ++ai)
#pragma unroll
            for (int m = 0; m < 4; ++m) {
                const int row = row0 + ai * HALF + m * 16;
                const float rinv = __builtin_amdgcn_rsqf(__hip_atomic_load(sumsq + row, __ATOMIC_RELAXED, __HIP_MEMORY_SCOPE_AGENT) * (1.0f / 1024.0f) + 1e-6f);
#pragma unroll
                for (int bj = 0; bj < 2; ++bj)
#pragma unroll
                    for (int n = 0; n < 2; ++n) { const int c = col0 + bj * HALF + 16 * n; *(f32x4*)(out + (size_t)row * 1024 + c) = acc[ai][bj][m][n] * rinv * *(const f32x4*)(gfin + c); }
            }
    }
};

typedef int v8i_t __attribute__((ext_vector_type(8)));
typedef int v4i_t __attribute__((ext_vector_type(4)));
template <bool F8> struct Frag;
template <> struct Frag<false> { bf16x8 k[2]; };
template <> struct Frag<true>  { v8i_t v; };
template <bool F8> __device__ __forceinline__ void ld_frag(Frag<F8>& d, const PG8_LAS unsigned char* p) {
    if constexpr (F8) { const v4i_t lo = *(const PG8_LAS v4i_t*)p, hi = *(const PG8_LAS v4i_t*)(p + 1024); d.v = __builtin_shufflevector(lo, hi, 0, 1, 2, 3, 4, 5, 6, 7); }
    else { d.k[0] = *(const PG8_LAS bf16x8*)p; d.k[1] = *(const PG8_LAS bf16x8*)(p + 1024); }
}
template <bool F8> __device__ __forceinline__ f32x4 mma_frag(const Frag<F8>& b, const Frag<F8>& a, f32x4 c) {
    if constexpr (F8) {
        const int one = 0x7f7f7f7f;
#if defined(__HIP_DEVICE_COMPILE__)
        asm volatile("v_mfma_scale_f32_16x16x128_f8f6f4 %0, %1, %2, %0, %3, %3 op_sel_hi:[0,0,0]" : "+v"(c) : "v"(b.v), "v"(a.v), "v"(one));
#else
        (void)one;
#endif
        return c; }
    else { c = __builtin_amdgcn_mfma_f32_16x16x32_bf16(b.k[0], a.k[0], c, 0, 0, 0); return __builtin_amdgcn_mfma_f32_16x16x32_bf16(b.k[1], a.k[1], c, 0, 0, 0); }
}
template <class Epi, class Sched, bool ALIGN_EPI = false, bool SP2 = false, bool F8 = false>
__device__ __forceinline__ void gemm_phase(PG8_LAS unsigned char* lds, const Gemm g, const Sched& S, const Epi& E, const int tid) {
    const int wid = __builtin_amdgcn_readfirstlane(tid >> 6), lane = tid & 63, wr = wid >> 2, wc = wid & 3, fr = lane & 15, fq = lane >> 4;
    const int K = g.K, nt = K / BK;
    unsigned voffA[2], voffB[2];
#pragma unroll
    for (int i = 0; i < 2; ++i) { int R, C; stage_rc(tid * 16 + i * 8192, R, C); const int Rb = Epi::PERM ? ((R & ~31) + perm32(R & 31)) : R;
        const int Ra = Epi::ROWPERM ? ((R & ~63) | ((R & 15) << 2) | ((R >> 4) & 3)) : R;
        voffA[i] = (unsigned)(Ra * K + C) * 2u; voffB[i] = (unsigned)(Rb * K + C) * 2u; }
    const size_t kstep = (size_t)(BK * 2);
    const size_t hstep = (size_t)HALF * K * 2;
    const size_t tstep = 2 * hstep;
    const unsigned ldsw = (unsigned)wid * 1024u;
    const int aoff = lds_byte(wr * 64 + fr, fq * 8), boff = lds_byte(wc * 32 + fr, fq * 8);
#define PG8_SA(b, h) (((b) * 2 + (h)) * HTB)
#define PG8_SB(b, h) ((4 + (b) * 2 + (h)) * HTB)
#define PG8_STAGE(bufoff, gbase, voff) do { _Pragma("unroll") for (int _i = 0; _i < 2; ++_i) \
        __builtin_amdgcn_global_load_lds((const unsigned*)((const char*)(gbase) + (voff)[_i]), (PG8_LAS unsigned*)(lds + (bufoff) + ldsw + _i * 8192), 16, 0, 0); } while (0)
#define PG8_LDA(dst, b, h) do { _Pragma("unroll") for (int m = 0; m < 4; ++m) ld_frag<F8>(dst[m], lds + PG8_SA(b, h) + aoff + m * 2048); } while (0)
#define PG8_LDB(dst, b, h) do { _Pragma("unroll") for (int n = 0; n < 2; ++n) ld_frag<F8>(dst[n], lds + PG8_SB(b, h) + boff + n * 2048); } while (0)
#define PG8_MMA(ai, bj, At, Bt) do { __builtin_amdgcn_s_setprio(1); _Pragma("unroll") for (int m = 0; m < 4; ++m) _Pragma("unroll") for (int n = 0; n < 2; ++n) \
        acc[ai][bj][m][n] = mma_frag<F8>(Bt[n], At[m], acc[ai][bj][m][n]); __builtin_amdgcn_s_setprio(0); } while (0)
#define PG8_WAIT_V(n) asm volatile("s_waitcnt vmcnt(" #n ")" ::: "memory")
#define PG8_WAIT_L(n) asm volatile("s_waitcnt lgkmcnt(" #n ")" ::: "memory")
#define PG8_BAR __builtin_amdgcn_s_barrier()
#define PG8_SCHED __builtin_amdgcn_sched_barrier(0)
    Unit cur, nxt; int ui = 0;
    if (!S.next(0, cur)) return;
    auto stage_par = [&](const Unit& uu, int b) {
        if constexpr (Epi::PRELOAD) {
            if (wr == 0) { const int l = wc * 64 + lane, prow = l >> 5;
                const float* src = E.convp + (size_t)(prow & 3) * 5632 + uu.pn * BM + (prow >> 2) * HALF + (l & 31) * 4;
                __builtin_amdgcn_global_load_lds((const unsigned*)src, (PG8_LAS unsigned*)(E.halo + 3840 + b * 1280 + wc * 256), 16, 0, 0); }
            else { const float* src = E.sumsq + uu.pm * BM + wc * 64 + lane;
                __builtin_amdgcn_global_load_lds((const unsigned*)src, (PG8_LAS unsigned*)(E.halo + 3840 + b * 1280 + 1024 + wc * 64), 4, 0, 0); }
        }
    };
    stage_par(cur, 0);
    f32x4 acc[2][2][4][2];
#pragma unroll
    for (int a = 0; a < 2; ++a)
#pragma unroll
        for (int b = 0; b < 2; ++b)
#pragma unroll
            for (int m = 0; m < 4; ++m)
#pragma unroll
                for (int n = 0; n < 2; ++n) acc[a][b][m][n] = (f32x4){0.f, 0.f, 0.f, 0.f};
    Frag<F8> At[4], B0[2], B1[2];
    const char* cA = (const char*)g.A + (size_t)cur.pm * tstep; const char* cB = (const char*)g.Bt + (size_t)cur.pn * tstep;
    S.a_ready(cur);
    if constexpr (SP2) {
        PG8_STAGE(PG8_SB(0, 0), cB, voffB); PG8_STAGE(PG8_SB(0, 1), cB + hstep, voffB); PG8_STAGE(PG8_SA(0, 0), cA, voffA); PG8_STAGE(PG8_SA(0, 1), cA + hstep, voffA);
        if (wr == 1) PG8_BAR;
        PG8_WAIT_V(2); PG8_BAR;
        PG8_STAGE(PG8_SB(1, 0), cB + kstep, voffB); PG8_STAGE(PG8_SA(1, 0), cA + kstep, voffA); PG8_STAGE(PG8_SB(1, 1), cB + hstep + kstep, voffB);
        PG8_WAIT_V(6); PG8_BAR;
    } else {
        PG8_STAGE(PG8_SB(0, 0), cB, voffB); PG8_STAGE(PG8_SA(0, 0), cA, voffA); PG8_STAGE(PG8_SB(0, 1), cB + hstep, voffB); PG8_STAGE(PG8_SA(0, 1), cA + hstep, voffA);
        if (wr == 1) PG8_BAR;
        PG8_WAIT_V(4); PG8_BAR;
        PG8_STAGE(PG8_SB(1, 0), cB + kstep, voffB); PG8_STAGE(PG8_SA(1, 0), cA + kstep, voffA); PG8_STAGE(PG8_SB(1, 1), cB + hstep + kstep, voffB);
        PG8_WAIT_V(6); PG8_BAR;
    }
    for (;;) {
        const bool has_next = S.next(ui + 1, nxt);
        const char* nA = has_next ? (const char*)g.A + (size_t)nxt.pm * tstep : cA; const char* nB = has_next ? (const char*)g.Bt + (size_t)nxt.pn * tstep : cB;
        for (int t = 0; t < nt; t += 2) {
            const bool last = (t == nt - 2);
            const char* a1 = cA + (size_t)(t + 1) * kstep;
            const char* a2 = last ? nA : cA + (size_t)(t + 2) * kstep; const char* b2 = last ? nB : cB + (size_t)(t + 2) * kstep;
            const char* a3 = a2 + kstep; const char* b3 = b2 + kstep;
            if (last && has_next) S.a_ready(nxt);
            if constexpr (SP2) {
            PG8_LDB(B0, 0, 0); PG8_LDB(B1, 0, 1); PG8_SCHED; PG8_LDA(At, 0, 0); PG8_STAGE(PG8_SA(1, 1), a1 + hstep, voffA);
            PG8_WAIT_V(8); PG8_WAIT_L(0); PG8_BAR; PG8_MMA(0, 0, At, B0); PG8_MMA(0, 1, At, B1); PG8_BAR; PG8_SCHED;
            PG8_LDA(At, 0, 1); PG8_STAGE(PG8_SB(0, 0), b2, voffB); PG8_STAGE(PG8_SB(0, 1), b2 + hstep, voffB); PG8_STAGE(PG8_SA(0, 0), a2, voffA);
            PG8_WAIT_V(8); PG8_WAIT_L(0); PG8_BAR; PG8_MMA(1, 0, At, B0); PG8_MMA(1, 1, At, B1); PG8_BAR; PG8_SCHED;
            PG8_LDB(B0, 1, 0); PG8_LDB(B1, 1, 1); PG8_SCHED; PG8_LDA(At, 1, 0); PG8_STAGE(PG8_SA(0, 1), a2 + hstep, voffA);
            PG8_WAIT_V(8); PG8_WAIT_L(0); PG8_BAR; PG8_MMA(0, 0, At, B0); PG8_MMA(0, 1, At, B1); PG8_BAR; PG8_SCHED;
            PG8_LDA(At, 1, 1); PG8_STAGE(PG8_SB(1, 0), b3, voffB); PG8_STAGE(PG8_SB(1, 1), b3 + hstep, voffB); PG8_STAGE(PG8_SA(1, 0), a3, voffA);
            PG8_WAIT_V(8); PG8_WAIT_L(0); PG8_BAR; PG8_MMA(1, 0, At, B0); PG8_MMA(1, 1, At, B1); PG8_BAR; PG8_SCHED;
            } else {
            PG8_LDB(B0, 0, 0); PG8_SCHED; PG8_LDA(At, 0, 0); PG8_STAGE(PG8_SA(1, 1), a1 + hstep, voffA);
            PG8_WAIT_L(8); PG8_BAR; PG8_WAIT_L(0); PG8_MMA(0, 0, At, B0); PG8_BAR; PG8_SCHED;
            PG8_LDB(B1, 0, 1); PG8_STAGE(PG8_SB(0, 0), b2, voffB);
            PG8_BAR; PG8_WAIT_L(0); PG8_MMA(0, 1, At, B1); PG8_BAR;
            PG8_LDA(At, 0, 1); PG8_STAGE(PG8_SA(0, 0), a2, voffA);
            PG8_BAR; PG8_WAIT_L(0); PG8_MMA(1, 0, At, B0); PG8_BAR; PG8_SCHED;
            PG8_STAGE(PG8_SB(0, 1), b2 + hstep, voffB);
            PG8_WAIT_V(6); PG8_BAR; PG8_MMA(1, 1, At, B1); PG8_BAR;
            PG8_LDB(B0, 1, 0); PG8_SCHED; PG8_LDA(At, 1, 0); PG8_STAGE(PG8_SA(0, 1), a2 + hstep, voffA);
            PG8_WAIT_L(8); PG8_BAR; PG8_WAIT_L(0); PG8_MMA(0, 0, At, B0); PG8_BAR; PG8_SCHED;
            PG8_LDB(B1, 1, 1); PG8_STAGE(PG8_SB(1, 0), b3, voffB);
            PG8_BAR; PG8_WAIT_L(0); PG8_MMA(0, 1, At, B1); PG8_BAR;
            PG8_LDA(At, 1, 1); PG8_STAGE(PG8_SA(1, 0), a3, voffA);
            PG8_BAR; PG8_WAIT_L(0); PG8_MMA(1, 0, At, B0); PG8_BAR; PG8_SCHED;
            PG8_STAGE(PG8_SB(1, 1), b3 + hstep, voffB);
            PG8_WAIT_V(6); PG8_BAR; PG8_MMA(1, 1, At, B1); PG8_BAR;
            }
        }
        if constexpr (ALIGN_EPI) { if (wr == 0) PG8_BAR; }
        if constexpr (F8) asm volatile("s_nop 15\n\ts_nop 15\n\ts_nop 15\n\ts_nop 15" ::: "memory");
        if constexpr (!Epi::AFTER_DRAIN) {
            if constexpr (Epi::PRELOAD) { Epi Eb = E; Eb.buf = ui & 1; Eb(acc, cur, wr, wc, fr, fq); if (has_next) stage_par(nxt, (ui + 1) & 1); }
            else E(acc, cur, wr, wc, fr, fq);
            S.done(cur); }
        if (!has_next) break;
#pragma unroll
        for (int a = 0; a < 2; ++a)
#pragma unroll
            for (int b = 0; b < 2; ++b)
#pragma unroll
                for (int m = 0; m < 4; ++m)
#pragma unroll
                    for (int n = 0; n < 2; ++n) acc[a][b][m][n] = (f32x4){0.f, 0.f, 0.f, 0.f};
        cur = nxt; cA = nA; cB = nB; ++ui;
        if constexpr (ALIGN_EPI) { if (wr == 1) PG8_BAR; }
    }
    PG8_WAIT_V(0);
    if constexpr (!ALIGN_EPI) { if (wr == 0) PG8_BAR; }
    PG8_BAR;
#undef PG8_SA
#undef PG8_SB
#undef PG8_STAGE
#undef PG8_LDA
#undef PG8_LDB
#undef PG8_MMA
#undef PG8_WAIT_V
#undef PG8_WAIT_L
#undef PG8_BAR
#undef PG8_SCHED
}
}

constexpr int NWAVES = 8;
constexpr int BATCH = 32, SEQ = 2048, DM = 1024, NTOK = BATCH * SEQ;
constexpr int IN_COLS = 1736;
constexpr int N1 = 1792, K2 = 1024, FF = 2816, N3 = 2 * FF;
constexpr int OFF_Q = 0, OFF_QI = 512, OFF_U = 1024, OFF_C = 1536, OFF_KI = 1664, OFF_WI = 1728;
constexpr float EPS = 1e-6f;
constexpr float WI_SCALE = 0.044194173824159216f;

constexpr size_t MiB = 1u << 20;
constexpr size_t WS_CTL = 0, CTL_ZERO_BYTES = 1 * MiB;
constexpr size_t WS_W1T = 1 * MiB, WS_W2T = 6 * MiB, WS_W3T = 9 * MiB, WS_W4T = 20 * MiB, WS_CONVP = 26 * MiB, WS_ZT = 27 * MiB, WS_WUKT = 28 * MiB, WS_WUVT = 28 * MiB + 128 * 1024;
constexpr size_t WS_HB = 32 * MiB;
constexpr size_t WS_Q8 = 384 * MiB, WS_U8 = 416 * MiB;
constexpr size_t WS_RS = 27 * MiB + 64 * 1024;
constexpr size_t WS_P1 = 160 * MiB;
constexpr size_t WS_HF = 32 * MiB, WS_HL = 44 * MiB;
constexpr size_t WS_X2 = 64 * MiB;
constexpr size_t WS_MIX = 448 * MiB;
constexpr size_t WS_CN = 640 * MiB;
constexpr size_t WS_CT8 = 672 * MiB;
constexpr size_t WS_ACT = 448 * MiB;
constexpr size_t WS_X1B = 800 * MiB;
constexpr size_t WS_X1F8 = 928 * MiB;
constexpr size_t WS_END = 992 * MiB;

constexpr int LDS_BYTES = 158720;
constexpr int XB_LDS_OFF = 131072 + 1024;
constexpr int HALO_LDS_OFF = 131072 + 2048;
constexpr size_t XB_CTL_OFF = 512 * 1024;
constexpr size_t PCNT_CTL_OFF = 640 * 1024;

#define GAS __attribute__((address_space(1)))
#define LAS __attribute__((address_space(3)))
typedef unsigned short bf16;
typedef unsigned v4u __attribute__((ext_vector_type(4)));
typedef unsigned v2u __attribute__((ext_vector_type(2)));
typedef float f32x4 __attribute__((ext_vector_type(4)));

__device__ __forceinline__ unsigned f2bf(float f) { unsigned u = __builtin_bit_cast(unsigned, f); return (u + 0x7fffu + ((u >> 16) & 1u)) >> 16; }
__device__ __forceinline__ unsigned pk2(float lo, float hi) { return f2bf(lo) | (f2bf(hi) << 16); }
__device__ __forceinline__ float bflo(unsigned u) { return __uint_as_float(u << 16); }
__device__ __forceinline__ float bfhi(unsigned u) { return __uint_as_float(u & 0xffff0000u); }
__device__ __forceinline__ void unpack8_f8(v2u w, float (&f)[8]) {
    const auto a = __builtin_amdgcn_cvt_pk_f32_fp8((int)w.x, false), b = __builtin_amdgcn_cvt_pk_f32_fp8((int)w.x, true), c = __builtin_amdgcn_cvt_pk_f32_fp8((int)w.y, false), d = __builtin_amdgcn_cvt_pk_f32_fp8((int)w.y, true);
    f[0] = a[0]; f[1] = a[1]; f[2] = b[0]; f[3] = b[1]; f[4] = c[0]; f[5] = c[1]; f[6] = d[0]; f[7] = d[1];
}
__device__ __forceinline__ float wave_sum(float v) {
#define WS_DPP(x, ctl) __int_as_float(__builtin_amdgcn_update_dpp(0, __float_as_int(x), ctl, 0xf, 0xf, true))
    v += WS_DPP(v, 0xB1); v += WS_DPP(v, 0x4E); v += WS_DPP(v, 0x141); v += WS_DPP(v, 0x140);
#undef WS_DPP
    { auto rr = __builtin_amdgcn_permlane16_swap(__float_as_uint(v), __float_as_uint(v), false, false); v = __uint_as_float(rr[0]) + __uint_as_float(rr[1]); }
    { auto rr = __builtin_amdgcn_permlane32_swap(__float_as_uint(v), __float_as_uint(v), false, false); v = __uint_as_float(rr[0]) + __uint_as_float(rr[1]); }
    return v;
}
__device__ __forceinline__ float wave_max(float v) {
#pragma unroll
    for (int o = 1; o < 64; o <<= 1) v = fmaxf(v, __shfl_xor(v, o));
    return v;
}
#define WAVE_LDS_SYNC() do { asm volatile("s_waitcnt lgkmcnt(0)" ::: "memory"); __builtin_amdgcn_wave_barrier(); } while (0)

struct Args {
    const float* x; const float* g_mix; const float* w_in; const float* g_kv; const float* w_uk; const float* w_uv; const float* w_pool; const float* pool_scale;
    const float* w_o; const float* g_ffn; const float* w_up; const float* conv_w; const float* conv_b; const float* w_down; const float* g_final;
    float* out; unsigned char* ws; int ph_lo, ph_hi, li, pad;
};

typedef const void __attribute__((address_space(4)))* kargp_t;
template <int OFF> __device__ __forceinline__ void* karg_ptr(kargp_t kp) { __attribute__((address_space(1))) void* p; asm volatile("s_load_dwordx2 %0, %1, %2\n\ts_waitcnt lgkmcnt(0)" : "=s"(p) : "s"(kp), "i"(OFF)); return (void*)p; }
template <int OFF> __device__ __forceinline__ int karg_int(kargp_t kp) { int v; asm volatile("s_load_dword %0, %1, %2\n\ts_waitcnt lgkmcnt(0)" : "=s"(v) : "s"(kp), "i"(OFF)); return v; }
__device__ __forceinline__ Args load_args(kargp_t kp) {
    Args a;
    a.x = (const float*)karg_ptr<0>(kp); a.g_mix = (const float*)karg_ptr<8>(kp); a.w_in = (const float*)karg_ptr<16>(kp); a.g_kv = (const float*)karg_ptr<24>(kp);
    a.w_uk = (const float*)karg_ptr<32>(kp); a.w_uv = (const float*)karg_ptr<40>(kp); a.w_pool = (const float*)karg_ptr<48>(kp); a.pool_scale = (const float*)karg_ptr<56>(kp);
    a.w_o = (const float*)karg_ptr<64>(kp); a.g_ffn = (const float*)karg_ptr<72>(kp); a.w_up = (const float*)karg_ptr<80>(kp); a.conv_w = (const float*)karg_ptr<88>(kp);
    a.conv_b = (const float*)karg_ptr<96>(kp); a.w_down = (const float*)karg_ptr<104>(kp); a.g_final = (const float*)karg_ptr<112>(kp);
    a.out = (float*)karg_ptr<120>(kp); a.ws = (unsigned char*)karg_ptr<128>(kp); a.ph_lo = 0; a.ph_hi = 0; a.li = karg_int<144>(kp); a.pad = 0;
    return a;
}
static_assert(sizeof(Args) == 152, "Args layout (kernarg offsets above)");
__device__ __forceinline__ void tr_item(const float* __restrict__ W, int ldw, int k0, int srccol0, int valid, float colscale, const float* __restrict__ kscale,
                                        bf16* __restrict__ WT, int ldt, int nrow0, LAS float* scr, int lane) {
    const int jq = (lane & 7) * 4, kr = lane >> 3;
    f32x4 vv[8];
#pragma unroll
    for (int i = 0; i < 8; ++i) vv[i] = __builtin_nontemporal_load((const f32x4*)(W + (size_t)(k0 + 8 * i + kr) * ldw + srccol0 + jq));
#pragma unroll
    for (int i = 0; i < 8; ++i) { const int kk = 8 * i + kr; float ks = colscale; if (kscale) ks *= kscale[k0 + kk];
#pragma unroll
        for (int e = 0; e < 4; ++e) scr[kk * 33 + jq + e] = (jq + e < valid) ? vv[i][e] * ks : 0.f; }
    asm volatile("s_waitcnt lgkmcnt(0)" ::: "memory"); __builtin_amdgcn_wave_barrier();
    const int c = lane & 7;
#pragma unroll
    for (int jj = 0; jj < 4; ++jj) { const int n = (lane >> 3) + 8 * jj; const LAS float* s = scr + (8 * c) * 33 + n;
        v4u o; o.x = pk2(s[0 * 33], s[1 * 33]); o.y = pk2(s[2 * 33], s[3 * 33]); o.z = pk2(s[4 * 33], s[5 * 33]); o.w = pk2(s[6 * 33], s[7 * 33]);
        *(v4u*)(WT + (size_t)(nrow0 + n) * ldt + k0 + 8 * c) = o; }
    asm volatile("s_waitcnt lgkmcnt(0)" ::: "memory"); __builtin_amdgcn_wave_barrier();
}
__device__ __forceinline__ void tr_item_f8(const float* __restrict__ W, int ldw, int k0, int srccol0, float colscale, const float* __restrict__ kscale,
                                           unsigned char* __restrict__ WT8, int ldt, int nrow0, LAS float* scr, int lane) {
    const int jq = (lane & 7) * 4, kr = lane >> 3;
    f32x4 vv[8];
#pragma unroll
    for (int i = 0; i < 8; ++i) vv[i] = __builtin_nontemporal_load((const f32x4*)(W + (size_t)(k0 + 8 * i + kr) * ldw + srccol0 + jq));
#pragma unroll
    for (int i = 0; i < 8; ++i) { const int kk = 8 * i + kr; float ks = colscale; if (kscale) ks *= kscale[k0 + kk];
#pragma unroll
        for (int e = 0; e < 4; ++e) scr[kk * 33 + jq + e] = fminf(fmaxf(vv[i][e] * ks, -448.f), 448.f); }
    asm volatile("s_waitcnt lgkmcnt(0)" ::: "memory"); __builtin_amdgcn_wave_barrier();
    const int c = lane & 7;
#pragma unroll
    for (int jj = 0; jj < 4; ++jj) { const int n = (lane >> 3) + 8 * jj; const LAS float* s = scr + (8 * c) * 33 + n;
        v2u o; int t_;
        t_ = __builtin_amdgcn_cvt_pk_fp8_f32(s[0 * 33], s[1 * 33], 0, false); o.x = (unsigned)__builtin_amdgcn_cvt_pk_fp8_f32(s[2 * 33], s[3 * 33], t_, true);
        t_ = __builtin_amdgcn_cvt_pk_fp8_f32(s[4 * 33], s[5 * 33], 0, false); o.y = (unsigned)__builtin_amdgcn_cvt_pk_fp8_f32(s[6 * 33], s[7 * 33], t_, true);
        *(v2u*)(WT8 + (size_t)(nrow0 + n) * ldt + k0 + 8 * c) = o; }
    asm volatile("s_waitcnt lgkmcnt(0)" ::: "memory"); __builtin_amdgcn_wave_barrier();
}
__device__ __forceinline__ void ph_prologue(const Args& a, LAS unsigned char* lds, const int tid, int gtid, int gthreads, int gw, int ngw, int lane) {
    unsigned char* ws = a.ws;
    bf16* W1T = (bf16*)(ws + WS_W1T); bf16* W2T = (bf16*)(ws + WS_W2T); bf16* W3T = (bf16*)(ws + WS_W3T); bf16* W4T = (bf16*)(ws + WS_W4T);
    float* CONVP = (float*)(ws + WS_CONVP);
    LAS float* L0 = (LAS float*)lds;
    for (int it = blockIdx.x; it < 256; it += gridDim.x) {
        {
            const int g = it >> 6, n0 = ((it >> 1) & 31) * 32, ci0 = (it & 1) * 64;
            LAS float* Wp = L0; LAS float* Wo = L0 + 16384;
#pragma unroll
            for (int t = 0; t < 16; ++t) Wp[tid + 512 * t] = a.w_pool[g * 16384 + ci0 * 128 + tid + 512 * t];
#pragma unroll
            for (int t = 0; t < 8; ++t) { const int idx = tid + 512 * t, dd = idx >> 5; Wo[idx] = a.pool_scale[g * 128 + dd] * a.w_o[(size_t)(512 + g * 128 + dd) * DM + n0 + (idx & 31)]; }
            __syncthreads();
            const int nn = tid & 31, cg_ = tid >> 5; float acc[4];
#pragma unroll
            for (int j = 0; j < 4; ++j) acc[j] = 0.f;
            for (int dd = 0; dd < 128; ++dd) { const float wo = Wo[dd * 32 + nn];
#pragma unroll
                for (int j = 0; j < 4; ++j) acc[j] += Wp[(cg_ * 4 + j) * 128 + dd] * wo; }
#pragma unroll
            for (int j = 0; j < 4; ++j) acc[j] = fminf(fmaxf(acc[j] * 64.0f, -448.f), 448.f);
            const int t_ = __builtin_amdgcn_cvt_pk_fp8_f32(acc[0], acc[1], 0, false);
            *(unsigned*)((unsigned char*)W2T + (size_t)(n0 + nn) * K2 + 512 + g * 128 + ci0 + cg_ * 4) = (unsigned)__builtin_amdgcn_cvt_pk_fp8_f32(acc[2], acc[3], t_, true);
        }
        __syncthreads();
    }
    { bf16* WUKT = (bf16*)(ws + WS_WUKT); bf16* WUVT = (bf16*)(ws + WS_WUVT);
      for (int i = gtid; i < 8 * 128 * 64; i += gthreads) {
          { const int hd = i >> 13, c = (i >> 6) & 127, d = i & 63; WUKT[i] = (bf16)f2bf(a.w_uk[(hd * 64 + d) * 128 + c]); }
          { const int hd = i >> 13, d = (i >> 7) & 63, c = i & 127; WUVT[i] = (bf16)f2bf(a.w_uv[(hd * 128 + c) * 64 + d]); } } }
    LAS float* scr = (LAS float*)(lds + (tid >> 6) * 16384);
    constexpr int I1 = 56 * 16, I3 = 176 * 16, I4 = 32 * 44, I2 = 32 * 8;
    for (int it = gw; it < I1 + I3 + I4 + I2; it += ngw) {
        if (it >= I1 + I3 + I4) {
            const int i4 = it - (I1 + I3 + I4), nb = i4 >> 3, k0 = (i4 & 7) * 64;
            tr_item_f8(a.w_o, DM, k0, nb * 32, 64.f, nullptr, (unsigned char*)W2T, K2, nb * 32, scr, lane);
        } else if (it < I1) {
            const int nb = it >> 4, k0 = (it & 15) * 64, n0 = nb * 32; int sc0, valid = 32; float cs = 1.f;
            if (n0 < 512) sc0 = n0; else if (n0 < 1024) sc0 = 640 + (n0 - 512); else if (n0 < 1536) sc0 = 1224 + (n0 - 1024); else if (n0 < 1664) sc0 = 512 + (n0 - 1536); else if (n0 < 1728) sc0 = 1152 + (n0 - 1664);
            else if (n0 == 1728) { sc0 = 1216; valid = 8; cs = WI_SCALE; } else { sc0 = 0; valid = 0; }
            tr_item(a.w_in, IN_COLS, k0, sc0, valid, cs, nullptr, W1T, DM, n0, scr, lane);
        } else if (it < I1 + I3) {
            const int i2 = it - I1, nb = i2 >> 4, k0 = (i2 & 15) * 64, r0 = nb * 32, j = r0 >> 8, ii = r0 & 255;
            const int sc0 = (ii < 128) ? (128 * j + ii) : (FF + 128 * j + (ii - 128));
            tr_item_f8(a.w_up, N3, k0, sc0, 64.f, a.g_ffn, (unsigned char*)W3T, DM, r0, scr, lane);
        } else {
            const int i3 = it - I1 - I3, nb = i3 / 44, k0 = (i3 - nb * 44) * 64;
            tr_item_f8(a.w_down, DM, k0, nb * 32, 64.f, nullptr, (unsigned char*)W4T, FF, nb * 32, scr, lane);
        }
    }
    if (gtid < 32) {
        float* ZT = (float*)(ws + WS_ZT); const float nn = 64.0f * (float)(gtid + 1); float z = 0.f;
        if (nn > 256.f) { const float p = 256.0f / nn, pt = (p < 0.5f) ? p : 1.0f - p, t = sqrtf(-2.0f * logf(pt));
            const float zz = t - (2.515517f + t * (0.802853f + t * 0.010328f)) / (1.0f + t * (1.432788f + t * (0.189269f + t * 0.001308f))); z = (p < 0.5f) ? zz : -zz; }
        ZT[gtid] = z; ZT[32 + gtid] = nn * 0.3989423f * expf(-0.5f * z * z);
    }
    for (int r = gtid; r < N3; r += gthreads) {
        const int j = r >> 8, ii = r & 255; const int col = (ii < 128) ? (128 * j + ii) : (FF + 128 * j + (ii - 128));
        const float ps_ = (ii < 128) ? 1.4426950408889634f : (8.0f / 1.4426950408889634f);
        CONVP[r] = a.conv_w[col] * ps_; CONVP[N3 + r] = a.conv_w[N3 + col] * ps_; CONVP[2 * N3 + r] = a.conv_w[2 * N3 + col] * ps_; CONVP[3 * N3 + r] = a.conv_b[col] * ps_;
    }
    bf16* HB = (bf16*)(ws + WS_HB);
    for (int m0 = gw; m0 < NTOK; m0 += 4 * ngw) {
        f32x4 v[4][4]; float s[4];
#pragma unroll
        for (int r = 0; r < 4; ++r) { const f32x4* xr = (const f32x4*)(a.x + (size_t)(m0 + r * ngw) * DM) + lane;
#pragma unroll
            for (int j = 0; j < 4; ++j) v[r][j] = __builtin_nontemporal_load(xr + 64 * j); }
        f32x4 g[4];
#pragma unroll
        for (int j = 0; j < 4; ++j) g[j] = ((const f32x4*)a.g_mix)[lane + 64 * j];
#pragma unroll
        for (int r = 0; r < 4; ++r) { s[r] = 0.f;
#pragma unroll
            for (int j = 0; j < 4; ++j) s[r] += (v[r][j].x * v[r][j].x + v[r][j].y * v[r][j].y) + (v[r][j].z * v[r][j].z + v[r][j].w * v[r][j].w); }
#pragma unroll
        for (int r = 0; r < 4; ++r) {
            const float rs_ = sqrtf(wave_sum(s[r]) * (1.0f / DM) + EPS), rinv = 1.0f / rs_;
            if (lane == 0) ((float*)(ws + WS_RS))[m0 + r * ngw] = rs_;
            unsigned long long* o8 = (unsigned long long*)(HB + (size_t)(m0 + r * ngw) * DM) + lane;
#pragma unroll
            for (int j = 0; j < 4; ++j)
                o8[64 * j] = (unsigned long long)pk2(v[r][j].x * rinv * g[j].x, v[r][j].y * rinv * g[j].y) | ((unsigned long long)pk2(v[r][j].z * rinv * g[j].z, v[r][j].w * rinv * g[j].w) << 32);
        }
    }
}

__device__ __forceinline__ void ph_cnorm_pool(const Args& a, int gw, int ngw, int lane) {
    const bf16* P1 = (const bf16*)(a.ws + WS_P1); unsigned char* CN = a.ws + WS_CN; unsigned char* MIX = a.ws + WS_MIX;
    unsigned char* CT8 = a.ws + WS_CT8; const unsigned char* U8 = a.ws + WS_U8;
    const float gk0 = a.g_kv[2 * lane], gk1 = a.g_kv[2 * lane + 1];
    const int win = 2 << (lane >> 4);
    for (int run = gw; run < NTOK / 32; run += ngw) {
        const int tok0 = run * 32, pos0 = tok0 & (SEQ - 1);
        const unsigned char* ub = U8 + (size_t)tok0 * 512 + 8 * lane;
        float s[8];
#pragma unroll
        for (int j = 0; j < 8; ++j) s[j] = 0.f;
#pragma unroll
        for (int j = 1; j < 16; ++j) {
            if (j < win && pos0 - j >= 0) { float f_[8]; unpack8_f8(*(const v2u*)(ub - (size_t)j * 512), f_);
#pragma unroll
                for (int e = 0; e < 8; ++e) s[e] += f_[e]; }
        }
#pragma unroll 1
        for (int tb = 0; tb < 32; tb += 8) {
        v2u ub_[8], udb_[8]; unsigned cwb_[8]; float cn0_[8], cn1_[8];
#pragma unroll
        for (int t8 = 0; t8 < 8; ++t8) {
            const bf16* prow = P1 + (size_t)(tok0 + tb + t8) * N1;
            ub_[t8] = *(const v2u*)(ub + (size_t)(tb + t8) * 512);
            cwb_[t8] = *(const unsigned*)(prow + OFF_C + 2 * lane);
            udb_[t8] = (v2u){0u, 0u};
            if (pos0 + tb + t8 - win + 1 >= 0) udb_[t8] = *(const v2u*)(ub + (size_t)(tb + t8) * 512 - (size_t)(win - 1) * 512);
        }
#pragma unroll
        for (int t8 = 0; t8 < 8; ++t8) {
            const int t = tb + t8;
            const int tok = tok0 + t, pos = pos0 + t;
            const v2u u = ub_[t8];
            const unsigned cw = cwb_[t8];
            const v2u ud = udb_[t8];
            const bool drop = (pos - win + 1 >= 0);
            const float c0 = bflo(cw), c1 = bfhi(cw);
            const float rinv = 1.0f / sqrtf(wave_sum(c0 * c0 + c1 * c1) * (1.0f / 128.0f) + EPS);
            cn0_[t8] = c0 * rinv * gk0; cn1_[t8] = c1 * rinv * gk1;
            *(unsigned short*)(CN + (size_t)tok * 128 + 2 * lane) = (unsigned short)__builtin_amdgcn_cvt_pk_fp8_f32(fminf(fmaxf(cn0_[t8] * 16.0f, -448.f), 448.f), fminf(fmaxf(cn1_[t8] * 16.0f, -448.f), 448.f), 0, false);
            float uf[8]; unpack8_f8(u, uf);
#pragma unroll
            for (int j = 0; j < 8; ++j) s[j] += uf[j];
            const int cnt = (pos + 1 < win) ? pos + 1 : win; const float ic = 1.0f / (float)cnt;
            float pv_[8];
#pragma unroll
            for (int j = 0; j < 8; ++j) pv_[j] = fminf(fmaxf(s[j] * ic - uf[j], -448.f), 448.f);
            v2u o; int t_;
            t_ = __builtin_amdgcn_cvt_pk_fp8_f32(pv_[0], pv_[1], 0, false); o.x = (unsigned)__builtin_amdgcn_cvt_pk_fp8_f32(pv_[2], pv_[3], t_, true);
            t_ = __builtin_amdgcn_cvt_pk_fp8_f32(pv_[4], pv_[5], 0, false); o.y = (unsigned)__builtin_amdgcn_cvt_pk_fp8_f32(pv_[6], pv_[7], t_, true);
            *(v2u*)(MIX + (size_t)tok * K2 + 512 + 8 * lane) = o;
            if (drop) { float fd_[8]; unpack8_f8(ud, fd_);
#pragma unroll
                for (int e = 0; e < 8; ++e) s[e] -= fd_[e]; }
        }
        {
            unsigned char* ctp = CT8 + ((size_t)(tok0 >> 6) * 128 + 2 * lane) * 64 + 16 * ((pos0 >> 5) & 1) + (tb >> 1);
#pragma unroll
            for (int hh = 0; hh < 2; ++hh) {
                float q0[4], q1[4];
#pragma unroll
                for (int e = 0; e < 4; ++e) { q0[e] = fminf(fmaxf(cn0_[4 * hh + e] * 16.0f, -448.f), 448.f); q1[e] = fminf(fmaxf(cn1_[4 * hh + e] * 16.0f, -448.f), 448.f); }
                int t_ = __builtin_amdgcn_cvt_pk_fp8_f32(q0[0], q0[1], 0, false); *(unsigned*)(ctp + 32 * hh) = (unsigned)__builtin_amdgcn_cvt_pk_fp8_f32(q0[2], q0[3], t_, true);
                t_ = __builtin_amdgcn_cvt_pk_fp8_f32(q1[0], q1[1], 0, false); *(unsigned*)(ctp + 64 + 32 * hh) = (unsigned)__builtin_amdgcn_cvt_pk_fp8_f32(q1[2], q1[3], t_, true);
            }
        }
        }
    }
}

namespace dsa {
using bf16x8 = __attribute__((ext_vector_type(8))) short;
using s16x4  = __attribute__((ext_vector_type(4))) short;
using f32x16 = __attribute__((ext_vector_type(16))) float;
using u32x4  = __attribute__((ext_vector_type(4))) unsigned;
constexpr int NW = 8, KVBLK = 64;
constexpr float SCALE = 0.125f, LOG2E = 1.4426950408889634f, THR = 4.f, PSH = 3.f;
typedef int v8i __attribute__((ext_vector_type(8)));
typedef int v4i __attribute__((ext_vector_type(4)));
constexpr int SHM_V = KVBLK * 128 * 2, SHM_K = KVBLK * 128 * 2, SHM_ATTN = 2 * SHM_V + 2 * SHM_K + NW * 64 * 4;
constexpr unsigned NEG2 = 0xCAEACAEAu;
#define KSWZ(row, colB) ((row) * 256 + ((colB) ^ (((row) & 7) << 4)))
#define SBAR() __builtin_amdgcn_sched_barrier(0)
__device__ __forceinline__ int crow(int r, int hi) { return (r & 3) + 8 * (r >> 2) + 4 * hi; }
__device__ __forceinline__ unsigned cvtpk(float lo, float hi) { unsigned r; asm volatile("v_cvt_pk_bf16_f32 %0, %1, %2" : "=v"(r) : "v"(lo), "v"(hi)); return r; }
typedef float f32x2_t __attribute__((ext_vector_type(2))); typedef __bf16 bf16x2_t __attribute__((ext_vector_type(2)));
__device__ __forceinline__ unsigned cvtpk_s(float lo, float hi) { f32x2_t v = {lo, hi}; bf16x2_t b = __builtin_convertvector(v, bf16x2_t); return __builtin_bit_cast(unsigned, b); }

template <int CTRL> __device__ __forceinline__ unsigned dppu(unsigned x) { return (unsigned)__builtin_amdgcn_update_dpp(0, (int)x, CTRL, 0xf, 0xf, true); }
__device__ __forceinline__ unsigned half_sum(unsigned x, int) {
    x += dppu<0xB1>(x); x += dppu<0x4E>(x); x += dppu<0x141>(x); x += dppu<0x140>(x);
    auto rr = __builtin_amdgcn_permlane16_swap(x, x, false, false); return rr[0] + rr[1];
}
__device__ __forceinline__ unsigned half_min(unsigned x, int) {
    x = min(x, dppu<0xB1>(x)); x = min(x, dppu<0x4E>(x)); x = min(x, dppu<0x141>(x)); x = min(x, dppu<0x140>(x));
    auto rr = __builtin_amdgcn_permlane16_swap(x, x, false, false); return min(rr[0], rr[1]);
}
__device__ __forceinline__ unsigned half_max(unsigned x, int) {
    x = max(x, dppu<0xB1>(x)); x = max(x, dppu<0x4E>(x)); x = max(x, dppu<0x141>(x)); x = max(x, dppu<0x140>(x));
    auto rr = __builtin_amdgcn_permlane16_swap(x, x, false, false); return max(rr[0], rr[1]);
}

template <int CTRL> __device__ __forceinline__ float dppf(float x) { return __int_as_float(__builtin_amdgcn_update_dpp(0, __float_as_int(x), CTRL, 0xf, 0xf, true)); }
__device__ __forceinline__ float half_minf(float x, int) {
    x = fminf(x, dppf<0xB1>(x)); x = fminf(x, dppf<0x4E>(x)); x = fminf(x, dppf<0x141>(x)); x = fminf(x, dppf<0x140>(x));
    auto rr = __builtin_amdgcn_permlane16_swap(__float_as_uint(x), __float_as_uint(x), false, false); return fminf(__uint_as_float(rr[0]), __uint_as_float(rr[1]));
}
__device__ __forceinline__ float half_maxf(float x, int) {
    x = fmaxf(x, dppf<0xB1>(x)); x = fmaxf(x, dppf<0x4E>(x)); x = fmaxf(x, dppf<0x141>(x)); x = fmaxf(x, dppf<0x140>(x));
    auto rr = __builtin_amdgcn_permlane16_swap(__float_as_uint(x), __float_as_uint(x), false, false); return fmaxf(__uint_as_float(rr[0]), __uint_as_float(rr[1]));
}
__device__ __forceinline__ float half_sumf(float x, int) {
    x += dppf<0xB1>(x); x += dppf<0x4E>(x); x += dppf<0x141>(x); x += dppf<0x140>(x);
    auto rr = __builtin_amdgcn_permlane16_swap(__float_as_uint(x), __float_as_uint(x), false, false); return __uint_as_float(rr[0]) + __uint_as_float(rr[1]);
}
__device__ __forceinline__ unsigned f2key(float f) { const unsigned u = __float_as_uint(f); return (u & 0x80000000u) ? ~u : (u | 0x80000000u); }
__device__ __forceinline__ float key2f(unsigned k) { return __uint_as_float((k & 0x80000000u) ? (k & 0x7fffffffu) : ~k); }

template <int PROBE> __device__ __forceinline__ void idx_select(const bf16* __restrict__ P1, int b, int tokw, int n, int tid_in, LAS char* lds, const float* __restrict__ ZT, unsigned& W0lo, unsigned& W0hi, unsigned& W1lo, unsigned& W1hi) {
    if (n <= 256) { W0lo = W0hi = W1lo = W1hi = 0xffffffffu; return; }
    int tid = tid_in; asm volatile("" : "+v"(tid));
    const int lane = tid & 63, wid = __builtin_amdgcn_readfirstlane(tid >> 6), c = lane & 31, h = lane >> 5;
    const int nt = n >> 5, nch = (n + 255) >> 8;
    const bf16* kb = P1 + (size_t)b * SEQ * N1 + OFF_KI;
    unsigned dsrc[4];
#pragma unroll
    for (int ii = 0; ii < 4; ++ii) { const int q = wid * 4 + ii, keyl = q * 8 + (lane >> 3), pc = lane & 7; dsrc[ii] = (unsigned)(keyl * N1 + ((pc ^ ((keyl >> 1) & 7)) << 3)); }
#define KI_DMA(cc) do { _Pragma("unroll") for (int ii = 0; ii < 4; ++ii) { const int q_ = wid * 4 + ii; if (256 * (cc) + 8 * q_ < n) \
        __builtin_amdgcn_global_load_lds((const unsigned*)(kb + (size_t)(256 * (cc)) * N1 + dsrc[ii]), (LAS unsigned*)(lds + ((cc) & 1) * 32768 + q_ * 1024), 16, 0, 0); } } while (0)
    KI_DMA(0);
    const int qa = 2 * ((c >> 2) & 1) + (c >> 4), ih = (c & 3) + 4 * ((c >> 3) & 1);
    const bf16* qip = P1 + (size_t)(tokw + qa) * N1 + OFF_QI + ih * 64 + 8 * h;
    bf16x8 af[4];
#pragma unroll
    for (int s = 0; s < 4; ++s) af[s] = *(const bf16x8*)(qip + 16 * s);
    float wq0[8], wq1[8];
    { const u32x4 t = *(const u32x4*)(P1 + (size_t)(tokw + 2 * h) * N1 + OFF_WI), u = *(const u32x4*)(P1 + (size_t)(tokw + 2 * h + 1) * N1 + OFF_WI);
      wq0[0] = bflo(t.x); wq0[1] = bfhi(t.x); wq0[2] = bflo(t.y); wq0[3] = bfhi(t.y); wq0[4] = bflo(t.z); wq0[5] = bfhi(t.z); wq0[6] = bflo(t.w); wq0[7] = bfhi(t.w);
      wq1[0] = bflo(u.x); wq1[1] = bfhi(u.x); wq1[2] = bflo(u.y); wq1[3] = bfhi(u.y); wq1[4] = bflo(u.z); wq1[5] = bfhi(u.z); wq1[6] = bflo(u.w); wq1[7] = bfhi(u.w); }
    const int rdoff = c * 128, rsw = (c >> 1) & 7;
    float sc0[64], sc1[64];
    float mn0 = __builtin_inff(), mx0 = -__builtin_inff(), mn1 = __builtin_inff(), mx1 = -__builtin_inff();
    float sm0 = 0.f, sq0 = 0.f, sm1 = 0.f, sq1 = 0.f;
#pragma unroll
    for (int cc = 0; cc < 8; ++cc) {
        if (cc < nch) {
            __syncthreads();
            if (cc + 1 < nch) KI_DMA(cc + 1);
            const LAS char* cb = lds + (cc & 1) * 32768 + rdoff;
#pragma unroll
            for (int t = 0; t < 8; ++t) {
                const int i = cc * 8 + t;
                if (i < nt) {
                    f32x16 acc = {};
#pragma unroll
                    for (int s = 0; s < 4; ++s) { const bf16x8 kf = *(const LAS bf16x8*)(cb + t * 4096 + (((2 * s + h) ^ rsw) << 4));
                        acc = __builtin_amdgcn_mfma_f32_32x32x16_bf16(af[s], kf, acc, 0, 0, 0); }
                    float s0 = 0.f, s1 = 0.f;
#pragma unroll
                    for (int j = 0; j < 8; ++j) {
                        s0 = fmaf(wq0[j], __int_as_float(max(__float_as_int(acc[j]), 0)), s0); s1 = fmaf(wq1[j], __int_as_float(max(__float_as_int(acc[8 + j]), 0)), s1); }
                    sc0[i] = s0; sc1[i] = s1; mn0 = fminf(mn0, s0); mx0 = fmaxf(mx0, s0); mn1 = fminf(mn1, s1); mx1 = fmaxf(mx1, s1);
                    sm0 += s0; sq0 = fmaf(s0, s0, sq0); sm1 += s1; sq1 = fmaf(s1, s1, sq1);
                } else { sc0[i] = -__builtin_inff(); sc1[i] = -__builtin_inff(); }
            }
        } else {
#pragma unroll
            for (int t = 0; t < 8; ++t) { sc0[cc * 8 + t] = -__builtin_inff(); sc1[cc * 8 + t] = -__builtin_inff(); }
        }
    }
#undef KI_DMA
    __syncthreads();
    unsigned klo0 = f2key(half_minf(mn0, h)), khi0 = f2key(half_maxf(mx0, h)) + 1u, klo1 = f2key(half_minf(mn1, h)), khi1 = f2key(half_maxf(mx1, h)) + 1u;
    unsigned cl0 = (unsigned)n, cl1 = (unsigned)n, ch0 = 0u, ch1 = 0u;
    bool fin0 = (khi0 - klo0 <= 1u), fin1 = (khi1 - klo1 <= 1u);
    const float rn = 1.0f / (float)n;
    const float mu0 = half_sumf(sm0, h) * rn, mu1 = half_sumf(sm1, h) * rn;
    const float sd0 = sqrtf(fmaxf(half_sumf(sq0, h) * rn - mu0 * mu0, 1e-30f)), sd1 = sqrtf(fmaxf(half_sumf(sq1, h) * rn - mu1 * mu1, 1e-30f));
    const float zq = ZT[(n >> 6) - 1], rdphi = __builtin_amdgcn_rcpf(ZT[32 + (n >> 6) - 1]);
    bool np0 = false, np1 = false;
    for (int it = 0; it < (PROBE == 3 ? 0 : 96); ++it) {
        unsigned km0, km1;
        if (it < 48) {
            const float lo0f = key2f(klo0), hi0f = key2f(khi0), lo1f = key2f(klo1), hi1f = key2f(khi1);
            float f0 = 0.5f, f1 = 0.5f;
            if (!(it & 1)) { f0 = ((float)cl0 - 255.5f) * __builtin_amdgcn_rcpf((float)(cl0 - ch0)); f1 = ((float)cl1 - 255.5f) * __builtin_amdgcn_rcpf((float)(cl1 - ch1)); }
            float m0 = fmaf(hi0f - lo0f, f0, lo0f), m1 = fmaf(hi1f - lo1f, f1, lo1f);
            if (it == 0) { m0 = fmaf(zq, sd0, mu0); m1 = fmaf(zq, sd1, mu1); }
            else if (it == 1) {
                m0 = (cl0 != (unsigned)n) ? lo0f + (1.5f * ((float)cl0 - 255.5f) + 4.0f) * sd0 * rdphi : hi0f - (1.5f * (255.5f - (float)ch0) + 4.0f) * sd0 * rdphi;
                m1 = (cl1 != (unsigned)n) ? lo1f + (1.5f * ((float)cl1 - 255.5f) + 4.0f) * sd1 * rdphi : hi1f - (1.5f * (255.5f - (float)ch1) + 4.0f) * sd1 * rdphi;
            }
            km0 = f2key(m0 + 0.0f); km1 = f2key(m1 + 0.0f);
            if (!(m0 == m0)) km0 = klo0 + ((khi0 - klo0) >> 1);
            if (!(m1 == m1)) km1 = klo1 + ((khi1 - klo1) >> 1);
        } else { km0 = klo0 + ((khi0 - klo0) >> 1); km1 = klo1 + ((khi1 - klo1) >> 1); }
        constexpr unsigned EG = 3u;
        const unsigned rb0 = 256u - ch0, ra0 = cl0 - 256u, rb1 = 256u - ch1, ra1 = cl1 - 256u;
        const bool sp0 = !fin0 && ((rb0 <= EG && rb0 <= ra0) || np0), sp1 = !fin1 && ((rb1 <= EG && rb1 <= ra1) || np1);
        const bool sa0 = !fin0 && !sp0 && ra0 <= EG, sa1 = !fin1 && !sp1 && ra1 <= EG;
        if (__any(sp0 || sp1)) {
            const float hf0 = key2f(khi0), hf1 = key2f(khi1); float b0 = -__builtin_inff(), b1 = -__builtin_inff();
#pragma unroll
            for (int g = 0; g < 8; ++g) {
                if (g * 8 < nt) {
#pragma unroll
                    for (int i = g * 8; i < g * 8 + 8; ++i) { b0 = fmaxf(b0, (sc0[i] < hf0) ? sc0[i] : -__builtin_inff()); b1 = fmaxf(b1, (sc1[i] < hf1) ? sc1[i] : -__builtin_inff()); }
                }
            }
            b0 = half_maxf(b0, h); b1 = half_maxf(b1, h);
            if (sp0) km0 = f2key(b0); if (sp1) km1 = f2key(b1);
        }
        if (__any(sa0 || sa1)) {
            const float lf0 = key2f(klo0), lf1 = key2f(klo1); float a0 = __builtin_inff(), a1 = __builtin_inff();
#pragma unroll
            for (int g = 0; g < 8; ++g) {
                if (g * 8 < nt) {
#pragma unroll
                    for (int i = g * 8; i < g * 8 + 8; ++i) { a0 = fminf(a0, (sc0[i] >= lf0) ? sc0[i] : __builtin_inff()); a1 = fminf(a1, (sc1[i] >= lf1) ? sc1[i] : __builtin_inff()); }
                }
            }
            a0 = half_minf(a0, h); a1 = half_minf(a1, h);
            if (sa0) km0 = f2key(a0) + 1u; if (sa1) km1 = f2key(a1) + 1u;
        }
        km0 = min(max(km0, klo0 + 1u), khi0 - 1u); km1 = min(max(km1, klo1 + 1u), khi1 - 1u);
        const float t0 = key2f(km0), t1 = key2f(km1);
        unsigned c0 = 0u, c1 = 0u, c0b = 0u, c1b = 0u;
#pragma unroll
        for (int g = 0; g < 8; ++g) {
            if (g * 8 < nt) {
#pragma unroll
                for (int i = g * 8; i < g * 8 + 8; i += 2)
                    asm volatile("v_cmp_ge_f32_e64 s[36:37], %4, %8\n\tv_cmp_ge_f32_e64 s[38:39], %5, %9\n\tv_cmp_ge_f32_e64 s[40:41], %6, %8\n\tv_cmp_ge_f32_e64 s[42:43], %7, %9\n\t"
                                 "v_addc_co_u32_e64 %0, vcc, 0, %0, s[36:37]\n\tv_addc_co_u32_e64 %1, vcc, 0, %1, s[38:39]\n\tv_addc_co_u32_e64 %2, vcc, 0, %2, s[40:41]\n\tv_addc_co_u32_e64 %3, vcc, 0, %3, s[42:43]"
                                 : "+v"(c0), "+v"(c1), "+v"(c0b), "+v"(c1b) : "v"(sc0[i]), "v"(sc1[i]), "v"(sc0[i + 1]), "v"(sc1[i + 1]), "v"(t0), "v"(t1) : "vcc", "s36", "s37", "s38", "s39", "s40", "s41", "s42", "s43");
            }
        }
        { const unsigned cs = half_sum((c0 + c0b) | ((c1 + c1b) << 16), h); c0 = cs & 0xffffu; c1 = cs >> 16; }
        if (!fin0) { np0 = (it >= 2) && (c0 == cl0 || c0 == ch0);
            if (c0 >= 256u) { klo0 = km0; cl0 = c0; if (sp0) khi0 = km0 + 1u; } else { khi0 = km0; ch0 = c0; if (sa0) klo0 = km0 - 1u; } fin0 = (c0 == 256u) || (khi0 - klo0 <= 1u); }
        if (!fin1) { np1 = (it >= 2) && (c1 == cl1 || c1 == ch1);
            if (c1 >= 256u) { klo1 = km1; cl1 = c1; if (sp1) khi1 = km1 + 1u; } else { khi1 = km1; ch1 = c1; if (sa1) klo1 = km1 - 1u; } fin1 = (c1 == 256u) || (khi1 - klo1 <= 1u); }
        if (__all(fin0 && fin1)) break;
    }
    const float lo0 = key2f(klo0), lo1 = key2f(klo1);
    unsigned w0l = 0u, w0h = 0u, w1l = 0u, w1h = 0u;
#define BITOF(cond) ({ unsigned t__ = (cond) ? 1u : 0u; asm volatile("" : "+v"(t__)); t__; })
    if (__all(cl0 == 256u && cl1 == 256u)) {
#pragma unroll
        for (int g = 7; g >= 0; --g) {
            if (g * 8 < nt) {
#pragma unroll
                for (int i = g * 8 + 7; i > g * 8; i -= 2) {
                    if (g >= 4) asm volatile("v_cmp_ge_f32_e64 s[36:37], %2, %6\n\tv_cmp_ge_f32_e64 s[38:39], %3, %7\n\tv_cmp_ge_f32_e64 s[40:41], %4, %6\n\tv_cmp_ge_f32_e64 s[42:43], %5, %7\n\t"
                                             "v_addc_co_u32_e64 %0, vcc, %0, %0, s[36:37]\n\tv_addc_co_u32_e64 %1, vcc, %1, %1, s[38:39]\n\tv_addc_co_u32_e64 %0, vcc, %0, %0, s[40:41]\n\tv_addc_co_u32_e64 %1, vcc, %1, %1, s[42:43]"
                                             : "+v"(w0h), "+v"(w1h) : "v"(sc0[i]), "v"(sc1[i]), "v"(sc0[i - 1]), "v"(sc1[i - 1]), "v"(lo0), "v"(lo1) : "vcc", "s36", "s37", "s38", "s39", "s40", "s41", "s42", "s43");
                    else        asm volatile("v_cmp_ge_f32_e64 s[36:37], %2, %6\n\tv_cmp_ge_f32_e64 s[38:39], %3, %7\n\tv_cmp_ge_f32_e64 s[40:41], %4, %6\n\tv_cmp_ge_f32_e64 s[42:43], %5, %7\n\t"
                                             "v_addc_co_u32_e64 %0, vcc, %0, %0, s[36:37]\n\tv_addc_co_u32_e64 %1, vcc, %1, %1, s[38:39]\n\tv_addc_co_u32_e64 %0, vcc, %0, %0, s[40:41]\n\tv_addc_co_u32_e64 %1, vcc, %1, %1, s[42:43]"
                                             : "+v"(w0l), "+v"(w1l) : "v"(sc0[i]), "v"(sc1[i]), "v"(sc0[i - 1]), "v"(sc1[i - 1]), "v"(lo0), "v"(lo1) : "vcc", "s36", "s37", "s38", "s39", "s40", "s41", "s42", "s43");
                }
            }
        }
    } else {
        unsigned g0 = 0u, g1 = 0u;
#pragma unroll
        for (int i = 0; i < 64; ++i) { g0 += (sc0[i] > lo0) ? 1u : 0u; g1 += (sc1[i] > lo1) ? 1u : 0u; }
        g0 = half_sum(g0, h); g1 = half_sum(g1, h);
        const unsigned need0 = 256u - g0, need1 = 256u - g1, ltm = (1u << c) - 1u;
        unsigned run0 = 0u, run1 = 0u;
#pragma unroll
        for (int i = 0; i < 64; ++i) {
            const bool e0 = (sc0[i] == lo0), e1 = (sc1[i] == lo1);
            const unsigned long long m0 = __ballot(e0), m1 = __ballot(e1);
            const unsigned hb0 = h ? (unsigned)(m0 >> 32) : (unsigned)m0, hb1 = h ? (unsigned)(m1 >> 32) : (unsigned)m1;
            const bool s0 = (sc0[i] > lo0) || (e0 && (run0 + __popc(hb0 & ltm) < need0));
            const bool s1 = (sc1[i] > lo1) || (e1 && (run1 + __popc(hb1 & ltm) < need1));
            run0 += __popc(hb0); run1 += __popc(hb1);
            if (i < 32) { w0l |= BITOF(s0) << i; w1l |= BITOF(s1) << i; } else { w0h |= BITOF(s0) << (i - 32); w1h |= BITOF(s1) << (i - 32); }
        }
    }
#undef BITOF
    W0lo = w0l; W0hi = w0h; W1lo = w1l; W1hi = w1h;
}

__device__ __forceinline__ void partialSM(f32x16& p0, f32x16& p1, float b0, float& m_reg, float& mn, float& alpha) {
    constexpr float C = SCALE * LOG2E * (1.0f / 256.0f);
    float pmax = p0[0];
#pragma unroll
    for (int r = 1; r < 16; ++r) pmax = fmaxf(pmax, p0[r]);
#pragma unroll
    for (int r = 0; r < 16; ++r) pmax = fmaxf(pmax, p1[r]);
    { auto rr = __builtin_amdgcn_permlane32_swap(__float_as_uint(pmax), __float_as_uint(pmax), false, false);
      pmax = fmaxf(__uint_as_float(rr[0]), __uint_as_float(rr[1])); }
    const float pm = fmaf(pmax, C, b0);
    if (__builtin_expect(__all(pm - m_reg <= THR * LOG2E), 1)) { mn = m_reg; alpha = 1.f; }
    else { mn = fmaxf(m_reg, pm); alpha = __builtin_amdgcn_exp2f(m_reg - mn); m_reg = mn; }
    const float off = b0 - mn + PSH;
#pragma unroll
    for (int r = 0; r < 16; ++r) p0[r] = fmaf(p0[r], C, off);
#pragma unroll
    for (int r = 0; r < 16; ++r) p1[r] = fmaf(p1[r], C, off);
#pragma unroll
    for (int r = 0; r < 16; ++r) p0[r] = __builtin_amdgcn_exp2f(p0[r]);
}
__device__ __forceinline__ void finishSM(f32x16& p0, f32x16& p1, float alpha, float& l_reg, v8i& P8) {
#pragma unroll
    for (int r = 0; r < 16; ++r) p1[r] = __builtin_amdgcn_exp2f(p1[r]);
    float ps = 0;
#pragma unroll
    for (int r = 0; r < 16; ++r) ps += p0[r];
#pragma unroll
    for (int r = 0; r < 16; ++r) ps += p1[r];
    { auto rr = __builtin_amdgcn_permlane32_swap(__float_as_uint(ps), __float_as_uint(ps), false, false);
      ps = __uint_as_float(rr[0]) + __uint_as_float(rr[1]); }
    l_reg = l_reg * alpha + ps;
#pragma unroll
    for (int g = 0; g < 4; ++g) { const int t_ = __builtin_amdgcn_cvt_pk_fp8_f32(p0[4 * g], p0[4 * g + 1], __float_as_int(p0[4 * g]), false); P8[g] = __builtin_amdgcn_cvt_pk_fp8_f32(p0[4 * g + 2], p0[4 * g + 3], t_, true); }
#pragma unroll
    for (int g = 0; g < 4; ++g) { const int t_ = __builtin_amdgcn_cvt_pk_fp8_f32(p1[4 * g], p1[4 * g + 1], __float_as_int(p1[4 * g]), false); P8[4 + g] = __builtin_amdgcn_cvt_pk_fp8_f32(p1[4 * g + 2], p1[4 * g + 3], t_, true); }
}
__device__ __forceinline__ void qkt(f32x16& p0, f32x16& p1, const LAS char* Ks, const v8i* qr8, bf16x8 ax0, bf16x8 ax1, bf16x8 ef, int r32, int hi) {
    const LAS char* kr = Ks + r32 * 128; const int sw = (r32 >> 1) & 7;
    v8i kf[2][2];
#pragma unroll
    for (int kb = 0; kb < 2; ++kb)
#pragma unroll
        for (int sx = 0; sx < 2; ++sx) { const int pc = 4 * sx + 2 * hi;
            const v4i lo = *(const LAS v4i*)(kr + kb * 4096 + ((pc ^ sw) << 4)), hi_ = *(const LAS v4i*)(kr + kb * 4096 + (((pc + 1) ^ sw) << 4));
            kf[kb][sx] = __builtin_shufflevector(lo, hi_, 0, 1, 2, 3, 4, 5, 6, 7); }
    const int one = 0x7f7f7f7f;
#if defined(__HIP_DEVICE_COMPILE__)
    asm volatile("s_nop 1\n\tv_mfma_f32_32x32x16_bf16 %0, %1, %2, 0" : "=&v"(p0) : "v"(ax0), "v"(ef));
    asm volatile("s_nop 1\n\tv_mfma_f32_32x32x16_bf16 %0, %1, %2, 0" : "=&v"(p1) : "v"(ax1), "v"(ef));
    asm volatile("s_nop 1\n\tv_mfma_scale_f32_32x32x64_f8f6f4 %0, %1, %2, %0, %3, %3 op_sel_hi:[0,0,0]" : "+v"(p0) : "v"(kf[0][0]), "v"(qr8[0]), "v"(one));
    asm volatile("s_nop 1\n\tv_mfma_scale_f32_32x32x64_f8f6f4 %0, %1, %2, %0, %3, %3 op_sel_hi:[0,0,0]" : "+v"(p1) : "v"(kf[1][0]), "v"(qr8[0]), "v"(one));
    asm volatile("s_nop 1\n\tv_mfma_scale_f32_32x32x64_f8f6f4 %0, %1, %2, %0, %3, %3 op_sel_hi:[0,0,0]" : "+v"(p0) : "v"(kf[0][1]), "v"(qr8[1]), "v"(one));
    asm volatile("s_nop 1\n\tv_mfma_scale_f32_32x32x64_f8f6f4 %0, %1, %2, %0, %3, %3 op_sel_hi:[0,0,0]\n\ts_nop 3" : "+v"(p1) : "v"(kf[1][1]), "v"(qr8[1]), "v"(one));
    asm volatile("" :: "v"(kf[0][0]), "v"(kf[1][0]), "v"(kf[0][1]), "v"(kf[1][1]), "v"(ax0), "v"(ax1), "v"(ef), "v"(one));
#else
    (void)one; (void)ax0; (void)ax1; (void)ef; (void)kf; (void)qr8; p0 = f32x16{}; p1 = f32x16{};
#endif
}
constexpr int VT_PITCH = 80;
__device__ __forceinline__ void pv_d0(f32x16* o, const LAS char* vb, const v8i P8) {
    v8i bf[4];
#pragma unroll
    for (int d0 = 0; d0 < 4; ++d0) { const v4i lo = *(const LAS v4i*)(vb + d0 * 32 * VT_PITCH), hi_ = *(const LAS v4i*)(vb + d0 * 32 * VT_PITCH + 16); bf[d0] = __builtin_shufflevector(lo, hi_, 0, 1, 2, 3, 4, 5, 6, 7); }
    const int one = 0x7f7f7f7f;
#pragma unroll
    for (int d0 = 0; d0 < 4; ++d0) {
#if defined(__HIP_DEVICE_COMPILE__)
        asm volatile("s_nop 1\n\tv_mfma_scale_f32_32x32x64_f8f6f4 %0, %1, %2, %0, %3, %3 op_sel_hi:[0,0,0]" : "+v"(o[d0]) : "v"(P8), "v"(bf[d0]), "v"(one));
#else
        (void)one;
#endif
    }
#if defined(__HIP_DEVICE_COMPILE__)
    asm volatile("s_nop 3" :: "v"(P8), "v"(bf[0]), "v"(bf[1]), "v"(bf[2]), "v"(bf[3]), "v"(one));
#endif
}
#define PTOUCH(a, b) asm volatile("" : "+v"(a), "+v"(b))
#define MFMA_DRAIN() asm volatile("s_nop 15\n\ts_nop 15\n\ts_nop 15\n\ts_nop 15\n\ts_nop 15" ::: "memory")

__device__ __forceinline__ void qlat_stage(const unsigned char* __restrict__ Q8, const bf16* __restrict__ WUKT, int tok0, LAS char* lds, int tid_in) {
    int tid = tid_in; asm volatile("" : "+v"(tid));
    const int hd = tid >> 6, lane = tid & 63, r32 = lane & 31, hi = lane >> 5;
    bf16x8 bq[4];
    { const unsigned char* qp = Q8 + (size_t)(tok0 + r32) * 512 + hd * 64 + 8 * hi;
      typedef unsigned u32x2_ __attribute__((ext_vector_type(2)));
#pragma unroll
      for (int s = 0; s < 4; ++s) { const u32x2_ w = *(const u32x2_*)(qp + 16 * s);
          const auto a_ = __builtin_amdgcn_cvt_pk_f32_fp8((int)w.x, false), b_ = __builtin_amdgcn_cvt_pk_f32_fp8((int)w.x, true), c_ = __builtin_amdgcn_cvt_pk_f32_fp8((int)w.y, false), d_ = __builtin_amdgcn_cvt_pk_f32_fp8((int)w.y, true);
          u32x4 o_; o_.x = (__float_as_uint(a_[1]) & 0xffff0000u) | (__float_as_uint(a_[0]) >> 16); o_.y = (__float_as_uint(b_[1]) & 0xffff0000u) | (__float_as_uint(b_[0]) >> 16);
          o_.z = (__float_as_uint(c_[1]) & 0xffff0000u) | (__float_as_uint(c_[0]) >> 16); o_.w = (__float_as_uint(d_[1]) & 0xffff0000u) | (__float_as_uint(d_[0]) >> 16);
          bq[s] = *reinterpret_cast<bf16x8*>(&o_); } }
    const bf16* wp = WUKT + (size_t)hd * 8192 + (size_t)r32 * 64 + 8 * hi;
#pragma unroll
    for (int mt = 0; mt < 4; ++mt) {
        f32x16 acc = {};
#pragma unroll
        for (int s = 0; s < 4; ++s) { const bf16x8 af = *(const bf16x8*)(wp + mt * 2048 + 16 * s); acc = __builtin_amdgcn_mfma_f32_32x32x16_bf16(af, bq[s], acc, 0, 0, 0); }
#pragma unroll
        for (int r4 = 0; r4 < 4; ++r4) { float q_[4];
#pragma unroll
            for (int e = 0; e < 4; ++e) q_[e] = fminf(fmaxf(acc[4 * r4 + e], -448.f), 448.f);
            const int t_ = __builtin_amdgcn_cvt_pk_fp8_f32(q_[0], q_[1], 0, false);
            *(LAS unsigned*)(lds + (r32 * 8 + hd) * 128 + 32 * mt + 8 * r4 + 4 * hi) = (unsigned)__builtin_amdgcn_cvt_pk_fp8_f32(q_[2], q_[3], t_, true); }
    }
}

__device__ __forceinline__ void attn_item(const unsigned char* __restrict__ Q8, const bf16* __restrict__ WUKT, const unsigned char* __restrict__ Cb, const unsigned char* __restrict__ CT8b, unsigned char* __restrict__ MIXp, const bf16* __restrict__ WUVT, int tok0, int pos0, int n, LAS char* lds, const int tid_in) {
    int tid = tid_in; asm volatile("" : "+v"(tid));
    const int wid = tid >> 6, lane = tid & 63, r32 = lane & 31, hi = lane >> 5;
    LAS char* V_lds = lds; LAS char* K_lds = lds + 2 * SHM_V;
    LAS float* wsl = (LAS float*)(lds + 2 * SHM_V + 2 * SHM_K) + wid * 64; LAS float* li_l = wsl; LAS float* al_l = wsl + 32;
    const LAS u32x4* mwl = (const LAS u32x4*)(lds + SHM_ATTN) + tid;
    float m_reg = -1e30f, l_reg = 0; f32x16 o[4] = {}; v8i qr8[2];
    const int ql_ = r32 >> 3, hd = r32 & 7;
    const int NT = n >> 6, NTP = (NT + 1) & ~1;
#define TILE_K0(j) (((j) < NT) ? (NT - 1 - (j)) * KVBLK : 0)
    const int vtw = (tid >> 2) * VT_PITCH + (tid & 3) * 16;
    const int kgo = (tid >> 3) * 128 + (tid & 7) * 16, kwo = (tid >> 3) * 128 + (((tid & 7) ^ ((tid >> 4) & 7)) << 4);
    struct { u32x4 k8, vt; } sr_[2];
#define SLOAD(i, k0) do { sr_[i].k8 = *(const u32x4*)(Cb + (size_t)(k0) * 128 + kgo); sr_[i].vt = *(const u32x4*)(CT8b + (size_t)((k0) >> 6) * 8192 + tid * 16); } while (0)
    constexpr int SE = 0, SO = 1;
    SLOAD(SE, TILE_K0(0)); SLOAD(SO, TILE_K0(1));
    qlat_stage(Q8, WUKT, tok0, lds, tid);
    __syncthreads();
    { const LAS char* Qw = lds + ((4 * wid + ql_) * 8 + hd) * 128 + hi * 32;
#pragma unroll
      for (int sx = 0; sx < 2; ++sx) { const v4i lo = *(const LAS v4i*)(Qw + 64 * sx), hi_ = *(const LAS v4i*)(Qw + 64 * sx + 16); qr8[sx] = __builtin_shufflevector(lo, hi_, 0, 1, 2, 3, 4, 5, 6, 7); } }
    const float qposf = (float)(pos0 + 4 * wid + ql_);
    bf16x8 ef; { u32x4 w = {0u, 0u, 0u, 0u}; w.x = ((ql_ == 2 * hi) ? 0x3F80u : 0u) | ((ql_ == 2 * hi + 1) ? 0x3F800000u : 0u); w.y = (hi == 0) ? ((unsigned)(137 - hd) << 7) : 0u; ef = *reinterpret_cast<bf16x8*>(&w); }
#define MASKW(s_) 0
#define MKAX(j, ax0, ax1) do { const unsigned klw0 = (hi == 0) ? (__float_as_uint((float)r32) >> 16) : 0u, klw1 = (hi == 0) ? (__float_as_uint((float)(32 + r32)) >> 16) : 0u;   \
        u32x4 w0_ = {NEG2, klw0, 0u, 0u}, w1_ = {NEG2, klw1, 0u, 0u}; if ((j) < NT) { const u32x4 Wv_ = *mwl; const int sh_ = 2 * (NT - 1 - (j)); \
            const unsigned v0_ = (unsigned)((((unsigned long long)Wv_.y << 32) | Wv_.x) >> sh_), v1_ = (unsigned)((((unsigned long long)Wv_.w << 32) | Wv_.z) >> sh_); \
            const unsigned mA_ = (v0_ & 1u) | ((v1_ & 1u) << 16), mB_ = ((v0_ >> 1) & 1u) | ((v1_ & 2u) << 15); \
            w0_.x = NEG2 & ~(mA_ * 0xffffu); w1_.x = NEG2 & ~(mB_ * 0xffffu); } \
        ax0 = *reinterpret_cast<bf16x8*>(&w0_); ax1 = *reinterpret_cast<bf16x8*>(&w1_); } while (0)
#define TILE_B0(j) ({ int r__ = r32; asm volatile("" : "+v"(r__)); const float sl__ = __uint_as_float((unsigned)(126 - (r__ & 7)) << 23) * LOG2E; \
        sl__ * ((float)TILE_K0(j) - (float)(pos0 + 4 * wid + (r__ >> 3))); })
    const LAS char* vb0 = V_lds + r32 * VT_PITCH + 32 * hi;
    constexpr int VSL = 128 * VT_PITCH, KSL = 64 * 128;
#define SWRITE(slot, i) do { *(LAS u32x4*)(V_lds + (slot) * VSL + vtw) = sr_[i].vt; *(LAS u32x4*)(K_lds + (slot) * KSL + kwo) = sr_[i].k8; } while (0)
#define SWAIT() asm volatile("s_waitcnt vmcnt(2)" ::: "memory")
#define RESC(a) do { if (__any((a) < 1.f)) { MFMA_DRAIN(); if (hi == 0) al_l[r32] = (a); asm volatile("s_waitcnt lgkmcnt(0)" ::: "memory"); \
    _Pragma("unroll") for (int d = 0; d < 4; ++d) _Pragma("unroll") for (int r = 0; r < 16; ++r) o[d][r] *= al_l[crow(r, hi)]; } } while (0)
    f32x16 pA0, pA1, pB0, pB1; float mnA, mnB, alA, alB; v8i P8; bf16x8 ax0, ax1;
    asm volatile("s_waitcnt vmcnt(0) lgkmcnt(0)" ::: "memory"); __syncthreads();
    SWRITE(0, SE); __syncthreads();
    MKAX(0, ax0, ax1); qkt(pA0, pA1, K_lds, qr8, ax0, ax1, ef, r32, hi);
    asm volatile("s_nop 15\n\ts_nop 15\n\ts_nop 15\n\ts_nop 15\n\ts_nop 15" : "+v"(pA0), "+v"(pA1));
    {
        const float base = (float)TILE_K0(0) - qposf + (float)(4 * hi), s16 = -2.0f * __uint_as_float((unsigned)(137 - hd) << 23);
#pragma unroll
        for (int r = 0; r < 16; ++r) { const float cr = (float)((r & 3) + 8 * (r >> 2));
            pA0[r] = fmaf(s16, fmaxf(base + cr, 0.f), pA0[r]); pA1[r] = fmaf(s16, fmaxf(base + cr + 32.f, 0.f), pA1[r]); }
    }
    float b0run = TILE_B0(0);
    const float b0step = __uint_as_float((unsigned)(126 - hd) << 23) * (64.0f * LOG2E);
    partialSM(pA0, pA1, b0run, m_reg, mnA, alA);
    if (2 < NTP) SLOAD(SE, TILE_K0(2));
    SWAIT(); SWRITE(1, SO); __syncthreads();
    int rp = 0, rc = 1, rn = 2;
#define RING_STEP() do { const int t__ = rp; rp = rc; rc = rn; rn = t__; } while (0)
    for (int j = 1; j + 1 < NTP; j += 2) {
        SBAR(); MKAX(j, ax0, ax1); qkt(pB0, pB1, K_lds + rc * KSL, qr8, ax0, ax1, ef, r32, hi);
        finishSM(pA0, pA1, alA, l_reg, P8); SBAR();
        SLOAD(SO, TILE_K0(j + 2)); SBAR();
        pv_d0(o, vb0 + rp * VSL, P8); PTOUCH(pB0, pB1); b0run -= b0step; partialSM(pB0, pB1, b0run, m_reg, mnB, alB);
        SWAIT(); SWRITE(rn, SE);
        RESC(alB); __syncthreads(); RING_STEP();
        SBAR(); MKAX(j + 1, ax0, ax1); qkt(pA0, pA1, K_lds + rc * KSL, qr8, ax0, ax1, ef, r32, hi);
        finishSM(pB0, pB1, alB, l_reg, P8); SBAR();
        if (j + 3 < NTP) SLOAD(SE, TILE_K0(j + 3)); SBAR();
        pv_d0(o, vb0 + rp * VSL, P8); PTOUCH(pA0, pA1); b0run -= b0step; partialSM(pA0, pA1, b0run, m_reg, mnA, alA);
        SWAIT(); SWRITE(rn, SO);
        RESC(alA); __syncthreads(); RING_STEP();
    }
    const bool lastreal = !(NT & 1);
    SBAR(); if (lastreal) { MKAX(NTP - 1, ax0, ax1); qkt(pB0, pB1, K_lds + rc * KSL, qr8, ax0, ax1, ef, r32, hi); }
    finishSM(pA0, pA1, alA, l_reg, P8); SBAR();
    pv_d0(o, vb0 + rp * VSL, P8);
    if (lastreal) {
        PTOUCH(pB0, pB1); b0run -= b0step; partialSM(pB0, pB1, b0run, m_reg, mnB, alB);
        RESC(alB);
        finishSM(pB0, pB1, alB, l_reg, P8); SBAR();
        pv_d0(o, vb0 + rc * VSL, P8);
    }
#undef RING_STEP
    MFMA_DRAIN();
    if (hi == 0) li_l[r32] = l_reg; asm volatile("s_waitcnt lgkmcnt(0)" ::: "memory");
    float rli[16];
#pragma unroll
    for (int r = 0; r < 16; ++r) rli[r] = __builtin_amdgcn_rcpf(li_l[crow(r, hi)]) * (1.0f / 16.0f);
    __syncthreads();
#pragma unroll
    for (int r = 0; r < 16; ++r) { const int orow = crow(r, hi);
        LAS bf16* zp = (LAS bf16*)lds + ((4 * wid + (orow >> 3)) * 8 + (orow & 7)) * 128 + r32;
#pragma unroll
        for (int d0 = 0; d0 < 4; ++d0) zp[d0 * 32] = (bf16)f2bf(o[d0][r] * rli[r]); }
    __syncthreads();
    {
        typedef unsigned u32x2 __attribute__((ext_vector_type(2)));
        bf16x8 bo[8];
        { const LAS char* zq = lds + ((r32 * 8 + wid) * 128 + 8 * hi) * 2;
#pragma unroll
          for (int s = 0; s < 8; ++s) bo[s] = *(const LAS bf16x8*)(zq + s * 32); }
        const bf16* wv = WUVT + (size_t)wid * 8192 + (size_t)r32 * 128 + 8 * hi;
#pragma unroll
        for (int mt = 0; mt < 2; ++mt) {
            f32x16 acc = {};
#pragma unroll
            for (int s = 0; s < 8; ++s) { const bf16x8 af = *(const bf16x8*)(wv + mt * 4096 + 16 * s); acc = __builtin_amdgcn_mfma_f32_32x32x16_bf16(af, bo[s], acc, 0, 0, 0); }
            unsigned char* op = MIXp + (size_t)(tok0 + r32) * K2 + wid * 64 + 32 * mt + 4 * hi;
#pragma unroll
            for (int r4 = 0; r4 < 4; ++r4) { float q_[4];
#pragma unroll
                for (int e = 0; e < 4; ++e) q_[e] = fminf(fmaxf(acc[4 * r4 + e] * 16.0f, -448.f), 448.f);
                const int t_ = __builtin_amdgcn_cvt_pk_fp8_f32(q_[0], q_[1], 0, false); *(unsigned*)(op + 8 * r4) = (unsigned)__builtin_amdgcn_cvt_pk_fp8_f32(q_[2], q_[3], t_, true); }
        }
    }
    __syncthreads();
#undef SLOAD
#undef SWRITE
#undef SWAIT
#undef RESC
#undef TILE_K0
#undef MASKW
#undef MKAX
#undef TILE_B0
}
}

__device__ __forceinline__ int tid_from(const int wid6) { int l; asm volatile("v_mbcnt_lo_u32_b32 %0, -1, 0\n\tv_mbcnt_hi_u32_b32 %0, -1, %0" : "=v"(l)); return wid6 | l; }
__device__ __forceinline__ void ph_attn_fast(const Args& a, LAS unsigned char* lds, const int variant, const int wid6) {
    const bf16* P1 = (const bf16*)(a.ws + WS_P1); unsigned char* MIX = a.ws + WS_MIX;
    const int G = gridDim.x;
    for (int it = blockIdx.x; it < BATCH * 64; it += G) {
        const int tid = tid_from(wid6);
        const int lane = tid & 63, wid = tid >> 6;
        const int gg = it & 255, m = it >> 8;
        const int b = (gg & 7) + 8 * (gg >> 6), jg = (gg >> 3) & 7, qb = (m & 1) ? (63 - jg - 8 * (m >> 1)) : (jg + 8 * (m >> 1));
        const int pos0 = qb * 32, tok0 = b * SEQ + pos0, n = ((pos0 >> 6) + 1) << 6;
        { unsigned w0l, w0h, w1l, w1h;
          if (variant == 2) { w0l = w0h = w1l = w1h = 0xffffffffu; }
          else if (ATT_VARIANT == 3 && variant == 3) dsa::idx_select<3>(P1, b, tok0 + 4 * wid, n, tid, (LAS char*)lds, (const float*)(a.ws + WS_ZT), w0l, w0h, w1l, w1h);
          else dsa::idx_select<0>(P1, b, tok0 + 4 * wid, n, tid, (LAS char*)lds, (const float*)(a.ws + WS_ZT), w0l, w0h, w1l, w1h);
          ((LAS dsa::u32x4*)(lds + dsa::SHM_ATTN))[tid] = (dsa::u32x4){w0l, w0h, w1l, w1h};
          asm volatile("s_waitcnt lgkmcnt(0)" ::: "memory");
          if (ATT_VARIANT && (variant == 1 || variant == 3)) { __syncthreads(); continue; } }
        dsa::attn_item(a.ws + WS_Q8, (const bf16*)(a.ws + WS_WUKT), a.ws + WS_CN + (size_t)b * SEQ * 128, a.ws + WS_CT8 + (size_t)b * (SEQ / 64) * 8192, variant ? ((a.ws + WS_END) - (size_t)tok0 * K2 + (size_t)(tok0 & 4095) * K2) : MIX, (const bf16*)(a.ws + WS_WUVT), tok0, pos0, n, (LAS char*)lds, tid);
    }
}

__device__ __forceinline__ void ph_fixup(const Args& a, int gtid, int gthreads) {
    const float* HF = (const float*)(a.ws + WS_HF); const float* HL = (const float*)(a.ws + WS_HL); const float* CONVP = (const float*)(a.ws + WS_CONVP); unsigned char* ACT = a.ws + WS_ACT;
    constexpr int CH = FF / 4;
    for (int i = gtid; i < (NTOK / 256) * 2 * CH; i += gthreads) {
        const int pm = i / (2 * CH), rem = i - pm * (2 * CH), t = rem / CH, ch = rem - t * CH;
        if ((pm & 7) == 0) continue;
        const int jc = ch * 4, j = jc >> 7, ii = jc & 127, cg_ = 256 * j + ii;
        float r[4];
        f32x4 v[2];
#pragma unroll
        for (int half = 0; half < 2; ++half) {
            const int c = cg_ + half * 128;
            const f32x4 lm2 = *(const f32x4*)(HL + (size_t)((pm - 1) * 2 + 0) * N3 + c), lm1 = *(const f32x4*)(HL + (size_t)((pm - 1) * 2 + 1) * N3 + c);
            const f32x4 f0 = *(const f32x4*)(HF + (size_t)(pm * 2 + 0) * N3 + c), f1 = *(const f32x4*)(HF + (size_t)(pm * 2 + 1) * N3 + c);
            const f32x4 w0 = *(const f32x4*)(CONVP + c), w1 = *(const f32x4*)(CONVP + N3 + c), w2 = *(const f32x4*)(CONVP + 2 * N3 + c), bb = *(const f32x4*)(CONVP + 3 * N3 + c);
            v[half] = (t == 0) ? (bb + w0 * lm2 + w1 * lm1 + w2 * f0) : (bb + w0 * lm1 + w1 * f0 + w2 * f1);
        }
#pragma unroll
        for (int e = 0; e < 4; ++e) r[e] = v[0][e] / (1.0f + exp2f(-v[0][e])) * v[1][e];
#pragma unroll
        for (int e = 0; e < 4; ++e) r[e] = fminf(fmaxf(r[e], -448.f), 448.f);
        const int t_ = __builtin_amdgcn_cvt_pk_fp8_f32(r[0], r[1], 0, false);
        *(unsigned*)(ACT + (size_t)(pm * 256 + t) * FF + jc) = (unsigned)__builtin_amdgcn_cvt_pk_fp8_f32(r[2], r[3], t_, true);
    }
}

__device__ __forceinline__ void ph_final(const Args& a, int gw, int ngw, int lane) {
    const bf16* X2 = (const bf16*)(a.ws + WS_X2); const float* ss3 = (const float*)(a.ws + WS_CTL + 256 * 1024);
    for (int m = gw; m < NTOK; m += ngw) {
        const float rinv = 1.0f / sqrtf(ss3[m] * (1.0f / DM) + EPS);
#pragma unroll
        for (int h2 = 0; h2 < 2; ++h2) {
            const int c0 = h2 * 512 + 8 * lane;
            const v4u t = *(const v4u*)(X2 + (size_t)m * DM + c0);
            const f32x4 g0 = *(const f32x4*)(a.g_final + c0), g1 = *(const f32x4*)(a.g_final + c0 + 4);
            f32x4 o0, o1;
            o0.x = bflo(t.x) * rinv * g0.x; o0.y = bfhi(t.x) * rinv * g0.y; o0.z = bflo(t.y) * rinv * g0.z; o0.w = bfhi(t.y) * rinv * g0.w;
            o1.x = bflo(t.z) * rinv * g1.x; o1.y = bfhi(t.z) * rinv * g1.y; o1.z = bflo(t.w) * rinv * g1.z; o1.w = bfhi(t.w) * rinv * g1.w;
            *(f32x4*)(a.out + (size_t)m * DM + c0) = o0; *(f32x4*)(a.out + (size_t)m * DM + c0 + 4) = o1;
        }
    }
}

#define XB_TMO      128
#define XB_XCNT(j)  (256  + 64 * (j))
#define XB_XSUB(j)  (1280 + 64 * (j))
#define XB_XGEN(j)  (2304 + 64 * (j))
#define XB_TOP      3328
#define XB_TOPGEN   3392
#define XCD_BAR_WORDS 3456
#define XB_SPIN_CAP (1u << 18)
__device__ __forceinline__ unsigned xb_ld(unsigned* p)              { return __hip_atomic_load(p, __ATOMIC_RELAXED, __HIP_MEMORY_SCOPE_AGENT); }
__device__ __forceinline__ unsigned xb_add(unsigned* p, unsigned v) { return __hip_atomic_fetch_add(p, v, __ATOMIC_RELAXED, __HIP_MEMORY_SCOPE_AGENT); }
__device__ __forceinline__ unsigned xb_xcc_id() { return (unsigned)__builtin_amdgcn_s_getreg((3 << 11) | 20) & 0xFu; }
#define XB_SPIN(cond, bar) do { unsigned _sp = 0; while (cond) { __builtin_amdgcn_s_sleep(1); \
    if ((++_sp & 255u) == 0u) { if (xb_ld(&(bar)[XB_TMO])) break; if (_sp > XB_SPIN_CAP) { atomicAdd(&(bar)[XB_TMO], 1u); break; } } } } while (0)
struct XcdBarrier { unsigned* bar; unsigned x; volatile LAS unsigned* st; };
__device__ __forceinline__ XcdBarrier xcd_barrier_post(unsigned* bar, volatile LAS unsigned* st, const int tid) {
    XcdBarrier b; b.bar = bar; b.x = xb_xcc_id(); b.st = st;
    if (tid == 0) (void)xb_add(&bar[XB_XCNT(b.x)], 1u);
    return b;
}
__device__ __forceinline__ void xcd_barrier_complete(unsigned* bar, unsigned x, unsigned& nloc, unsigned& nx) {
    const unsigned G = gridDim.x * gridDim.y * gridDim.z;
    unsigned sum, cnt, mine, sp = 0u;
    for (;;) {
        sum = 0u; cnt = 0u; mine = 0u;
#pragma unroll
        for (unsigned j = 0; j < 16; ++j) { const unsigned c = xb_ld(&bar[XB_XCNT(j)]); sum += c; cnt += (c > 0u) ? 1u : 0u; mine = (j == x) ? c : mine; }
        if (sum == G) break;
        __builtin_amdgcn_s_sleep(1);
        if ((++sp & 255u) == 0u) { if (xb_ld(&bar[XB_TMO])) break; if (sp > XB_SPIN_CAP) { atomicAdd(&bar[XB_TMO], 1u); break; } }
    }
    nloc = mine > 0u ? mine : 1u; nx = cnt > 0u ? cnt : 1u;
}
__device__ __forceinline__ void xcd_barrier(const XcdBarrier& b, const int tid) {
    asm volatile("s_waitcnt vmcnt(0)" ::: "memory");
    __syncthreads();
    if (tid == 0) {
        unsigned* bar = b.bar;
        __builtin_amdgcn_s_waitcnt(0);
        unsigned nloc = b.st[0], nx = b.st[1];
        if (nloc == 0u) { xcd_barrier_complete(bar, b.x, nloc, nx); b.st[0] = nloc; b.st[1] = nx; }
        const unsigned old = xb_add(&bar[XB_XSUB(b.x)], 1u);
        const unsigned gen = old / nloc;
        if (old + 1u == (gen + 1u) * nloc) {
            __builtin_amdgcn_fence(__ATOMIC_RELEASE, "agent");
            asm volatile("s_waitcnt vmcnt(0)" ::: "memory");
            const unsigned og = xb_add(&bar[XB_TOP], 1u);
            const unsigned tg = og / nx;
            if (og + 1u == (tg + 1u) * nx) xb_add(&bar[XB_TOPGEN], 1u);
            else XB_SPIN(xb_ld(&bar[XB_TOPGEN]) == tg, bar);
            __builtin_amdgcn_fence(__ATOMIC_ACQUIRE, "agent");
            xb_add(&bar[XB_XGEN(b.x)], 1u);
            asm volatile("s_waitcnt vmcnt(0)" ::: "memory");
        } else {
            XB_SPIN(xb_ld(&bar[XB_XGEN(b.x)]) == gen, bar);
            __builtin_amdgcn_fence(__ATOMIC_ACQUIRE, "agent");
            asm volatile("s_waitcnt vmcnt(0)" ::: "memory");
        }
    }
    __syncthreads();
}

constexpr int NPHASE = 8;
#define IDS() const int tid = TIDK, lane = tid & 63, wave = __builtin_amdgcn_readfirstlane(tid >> 6); const int G = gridDim.x; \
    const int gtid = blockIdx.x * (NWAVES * 64) + tid, gthreads = G * NWAVES * 64, gw = blockIdx.x * NWAVES + wave, ngw = G * NWAVES; (void)lane; (void)wave; (void)gtid; (void)gthreads; (void)gw; (void)ngw;
__global__ void __launch_bounds__(NWAVES * 64, 2) fwd_kernel(Args a_unused) {
    extern __shared__ __attribute__((aligned(16))) unsigned char lds_raw[];
    LAS unsigned char* lds = (LAS unsigned char*)lds_raw;
    const kargp_t kp = (kargp_t)__builtin_amdgcn_kernarg_segment_ptr();
    const int lo = karg_int<136>(kp), hi = karg_int<140>(kp);
#define LOADA() const Args a = load_args(kp)
    volatile LAS unsigned* xb_st = (volatile LAS unsigned*)(lds + XB_LDS_OFF);
    const int wid6 = __builtin_amdgcn_readfirstlane((int)threadIdx.x) & ~63;
#define TIDK tid_from(wid6)
    { const int t0 = TIDK; if (t0 < 4) xb_st[t0] = 0u;
      __syncthreads();
      (void)xcd_barrier_post((unsigned*)((unsigned char*)karg_ptr<128>(kp) + WS_CTL + XB_CTL_OFF) + karg_int<144>(kp) * XCD_BAR_WORDS, xb_st, t0); }
    if (lo < 0) cg::this_grid().sync();
#define IN(k) (lo <= (k) && (k) < hi)
#define SEAM(k) do { if (IN(k) && IN((k) + 1)) { { XcdBarrier xb_; xb_.bar = (unsigned*)((unsigned char*)karg_ptr<128>(kp) + WS_CTL + XB_CTL_OFF) + karg_int<144>(kp) * XCD_BAR_WORDS; xb_.x = xb_xcc_id(); \
        xb_.st = (volatile LAS unsigned*)(lds + XB_LDS_OFF); xcd_barrier(xb_, TIDK); } } } while (0)
    if (IN(0)) { LOADA(); IDS(); ph_prologue(a, lds, tid, gtid, gthreads, gw, ngw, lane); }
    SEAM(0);
    if (IN(1)) {
        unsigned char* ws = (unsigned char*)karg_ptr<128>(kp);
        pg8::Gemm g{(const bf16*)(ws + WS_HB), (const bf16*)(ws + WS_W1T), NTOK, N1, DM}; pg8::StaticOrder S; S.init(NTOK, N1, (int)gridDim.x, (int)blockIdx.x);
        pg8::EpiStore E{(bf16*)(ws + WS_P1), N1, nullptr, ws + WS_Q8, ws + WS_U8};
        pg8::gemm_phase<pg8::EpiStore, pg8::StaticOrder, true, true>(lds, g, S, E, TIDK);
    }
    SEAM(1);
    if (IN(2)) { LOADA(); IDS(); ph_cnorm_pool(a, gw, ngw, lane); }
    SEAM(2);
    if (IN(3)) { LOADA(); ph_attn_fast(a, lds, (ATT_VARIANT && a.li == 1) ? ATT_VARIANT : 0, wid6); }
    SEAM(3);
    if (IN(4)) {
        unsigned char* ws = (unsigned char*)karg_ptr<128>(kp);
        pg8::Gemm g{(const bf16*)(ws + WS_MIX), (const bf16*)(ws + WS_W2T), NTOK, DM, K2 / 2}; pg8::StaticOrder S; S.init(NTOK, DM, (int)gridDim.x, (int)blockIdx.x);
        pg8::EpiResid<false> E{(const void*)(ws + WS_HB), (bf16*)(ws + WS_X1B), (float*)(ws + WS_CTL), ws + WS_X1F8, 1.0f / 1024.0f, (const float*)(ws + WS_RS), (const float*)karg_ptr<8>(kp)};
        pg8::gemm_phase<pg8::EpiResid<false>, pg8::StaticOrder, true, true, true>(lds, g, S, E, TIDK);
    }
    SEAM(4);
    if (IN(5)) {
        unsigned char* ws = (unsigned char*)karg_ptr<128>(kp);
        pg8::Gemm g{(const bf16*)(ws + WS_X1F8), (const bf16*)(ws + WS_W3T), NTOK, N3, DM / 2}; pg8::StaticOrder S; S.init(NTOK, N3, (int)gridDim.x, (int)blockIdx.x);
        pg8::EpiConvGlu E{ws + WS_ACT, (const float*)(ws + WS_CTL), (const float*)(ws + WS_CONVP), (float*)(ws + WS_HF), (float*)(ws + WS_HL), (LAS float*)(lds + HALO_LDS_OFF)};
        pg8::gemm_phase<pg8::EpiConvGlu, pg8::StaticOrder, true, true, true>(lds, g, S, E, TIDK);
    }
    SEAM(5);
    if (IN(6)) { LOADA(); IDS(); ph_fixup(a, gtid, gthreads); }
    SEAM(6);
    if (IN(7)) {
        unsigned char* ws = (unsigned char*)karg_ptr<128>(kp);
        pg8::Gemm g{(const bf16*)(ws + WS_ACT), (const bf16*)(ws + WS_W4T), NTOK, DM, FF / 2}; pg8::StaticOrder S; S.init(NTOK, DM, (int)gridDim.x, (int)blockIdx.x);
        pg8::EpiFinal E{(const bf16*)(ws + WS_X1B), (float*)karg_ptr<120>(kp), (float*)(ws + WS_CTL + 256 * 1024), (unsigned*)(ws + WS_CTL + PCNT_CTL_OFF), (const float*)karg_ptr<112>(kp)};
        pg8::gemm_phase<pg8::EpiFinal, pg8::StaticOrder, true, true, true>(lds, g, S, E, TIDK);
    }
#undef IN
#undef SEAM
}

extern "C" void kernel_launch(void* const* d_in, const int* in_sizes, int n_in, void* d_out, int out_size, void* d_ws, size_t ws_size, hipStream_t stream) {
    static int grid = 0;
    if (grid == 0) {
        if (n_in != 15 || in_sizes[0] != NTOK * DM || out_size != NTOK * DM || ws_size < WS_END) { fprintf(stderr, "kernel_launch: unexpected shapes / workspace (n_in %d, ws %zu)\n", n_in, ws_size); grid = -1; return; }
        int dev = 0, cus = 0, per_cu = 0;
        hipGetDevice(&dev); hipDeviceGetAttribute(&cus, hipDeviceAttributeMultiprocessorCount, dev);
        if (hipFuncSetAttribute((const void*)fwd_kernel, hipFuncAttributeMaxDynamicSharedMemorySize, LDS_BYTES) != hipSuccess) { fprintf(stderr, "kernel_launch: hipFuncSetAttribute failed\n"); grid = -1; return; }
        if (hipOccupancyMaxActiveBlocksPerMultiprocessor(&per_cu, (const void*)fwd_kernel, NWAVES * 64, LDS_BYTES) != hipSuccess || per_cu < 1) { fprintf(stderr, "kernel_launch: occupancy query says %d\n", per_cu); per_cu = 1; }
        (void)hipGetLastError();
        grid = cus;
        if (grid != 256) fprintf(stderr, "kernel_launch: %d CUs (tuned for 256)\n", grid);
    }
    if (grid < 0) return;
    hipMemsetAsync((char*)d_ws + WS_CTL, 0, CTL_ZERO_BYTES, stream);
    Args a{};
    a.x = (const float*)d_in[0]; a.g_mix = (const float*)d_in[1]; a.w_in = (const float*)d_in[2]; a.g_kv = (const float*)d_in[3]; a.w_uk = (const float*)d_in[4]; a.w_uv = (const float*)d_in[5];
    a.w_pool = (const float*)d_in[6]; a.pool_scale = (const float*)d_in[7]; a.w_o = (const float*)d_in[8]; a.g_ffn = (const float*)d_in[9]; a.w_up = (const float*)d_in[10];
    a.conv_w = (const float*)d_in[11]; a.conv_b = (const float*)d_in[12]; a.w_down = (const float*)d_in[13]; a.g_final = (const float*)d_in[14];
    a.out = (float*)d_out; a.ws = (unsigned char*)d_ws;
#if REP_PH >= 0
    { void* args[] = {&a};
      if (REP_PH >= 100) {
        a.ph_lo = 0; a.ph_hi = NPHASE; a.li = 0; hipLaunchCooperativeKernel((const void*)fwd_kernel, dim3(grid), dim3(NWAVES * 64), args, LDS_BYTES, stream);
        a.ph_lo = 0; a.ph_hi = REP_PH - 100; a.li = 1; hipLaunchCooperativeKernel((const void*)fwd_kernel, dim3(grid), dim3(NWAVES * 64), args, LDS_BYTES, stream);
      } else if (REP_PH == 4 || REP_PH == 7) {
        a.ph_lo = 0; a.ph_hi = NPHASE; a.li = 0; hipLaunchCooperativeKernel((const void*)fwd_kernel, dim3(grid), dim3(NWAVES * 64), args, LDS_BYTES, stream);
        a.ph_lo = REP_PH; a.ph_hi = REP_PH + 1; a.li = 1; hipLaunchCooperativeKernel((const void*)fwd_kernel, dim3(grid), dim3(NWAVES * 64), args, LDS_BYTES, stream);
      } else {
      a.ph_lo = 0; a.ph_hi = REP_PH + 1; a.li = 0; hipLaunchCooperativeKernel((const void*)fwd_kernel, dim3(grid), dim3(NWAVES * 64), args, LDS_BYTES, stream);
      a.ph_lo = REP_PH; a.ph_hi = REP_PH + 1; a.li = 1; hipLaunchCooperativeKernel((const void*)fwd_kernel, dim3(grid), dim3(NWAVES * 64), args, LDS_BYTES, stream);
      if (REP_PH + 1 < NPHASE) { a.ph_lo = REP_PH + 1; a.ph_hi = NPHASE; a.li = 2; hipLaunchCooperativeKernel((const void*)fwd_kernel, dim3(grid), dim3(NWAVES * 64), args, LDS_BYTES, stream); } } }
#elif MK_ONE_LAUNCH
    a.ph_lo = 0; a.ph_hi = NPHASE;
    void* args[] = {&a};
    hipError_t e = hipLaunchCooperativeKernel((const void*)fwd_kernel, dim3(grid), dim3(NWAVES * 64), args, LDS_BYTES, stream);
    if (e != hipSuccess) fprintf(stderr, "cooperative launch failed: %s (grid %d)\n", hipGetErrorString(e), grid);
#else
    for (int ph = 0; ph < NPHASE; ++ph) {
        a.ph_lo = ph; a.ph_hi = ph + 1;
        hipLaunchKernelGGL(fwd_kernel, dim3(grid), dim3(NWAVES * 64), LDS_BYTES, stream, a);
    }
#endif
}
```
